# Optimizing an MI355X kernel written in HIP

```python
import math
import jax
import jax.numpy as jnp
from jax import lax
import numpy as np

D_MODEL = 1024
BATCH = 4
SEQ = 8192
DEPTH = 2

GRID_W = 64
CTX_LEN = 256
ROPE_BASE = 10000.0
EPS = 1e-6
N_MOD = 6
N_EVEN = (DEPTH + 1) // 2
N_ODD = DEPTH // 2
ATTN_BLK = 128
CONV_W = 4
CONV_PAD = (2, 1)

MLA_HEADS = 8
MLA_NOPE = 64
MLA_ROPE = 32
MLA_QK = MLA_NOPE + MLA_ROPE
MLA_V = 64
MLA_Q_RANK = 384
MLA_KV_RANK = 256
LRU_WIDTH = 512
LRU_BLOCKS = 8
LRU_BLOCK_DIM = LRU_WIDTH // LRU_BLOCKS
LRU_C = 8.0
AB_IN = MLA_Q_RANK + MLA_KV_RANK + MLA_ROPE + 2 * LRU_WIDTH
AB_OUT = MLA_HEADS * MLA_V + LRU_WIDTH
SWA_HEADS = 8
SWA_KV_HEADS = 2
SWA_HD = 64
WINDOW = 128
SSD_HEADS = 8
SSD_HD = 64
SSD_INNER = SSD_HEADS * SSD_HD
SSD_STATE = 128
SSD_GROUPS = 2
SSD_CHUNK = 128
SSD_CONV_DIM = SSD_INNER + 2 * SSD_GROUPS * SSD_STATE
CD_IN = SWA_HEADS * SWA_HD + 2 * SWA_KV_HEADS * SWA_HD + SSD_INNER + SSD_CONV_DIM + 2 * SSD_HEADS
CD_OUT = SWA_HEADS * SWA_HD + SSD_INNER
N_EXPERTS = 32
N_GROUPS = 4
EXPERTS_PER_GROUP = N_EXPERTS // N_GROUPS
TOP_K = 2
D_EXPERT = 512
MOE_BLK = 256

F32 = jnp.float32

kernel_name = 'hybrid_mla_rglru_swa_ssd_moe_dit'


def rmsnorm(x, g):
    xf = x.astype(F32)
    y = xf * lax.rsqrt(jnp.mean(xf * xf, axis=-1, keepdims=True) + EPS)
    return (y * g.astype(F32)).astype(x.dtype)


def modulate(x, g, shift, scale):
    return rmsnorm(x, g) * (1.0 + scale) + shift


def grid_positions(n):
    rows = n // GRID_W
    row = jnp.repeat(jnp.arange(rows, dtype=F32), GRID_W)
    col = jnp.tile(jnp.arange(GRID_W, dtype=F32), rows)
    return row, col


def rope_1d(x, pos):
    f = x.shape[-1] // 2
    inv = ROPE_BASE ** (-jnp.arange(f, dtype=F32) / f)
    ang = pos[:, None] * inv[None, :]
    cos = jnp.cos(ang)[None, :, None, :]
    sin = jnp.sin(ang)[None, :, None, :]
    x1 = x[..., :f].astype(F32)
    x2 = x[..., f:].astype(F32)
    return jnp.concatenate([x1 * cos - x2 * sin, x1 * sin + x2 * cos], axis=-1).astype(x.dtype)


def rope_2d(x, row, col):
    half = x.shape[-1] // 2
    return jnp.concatenate([rope_1d(x[..., :half], row), rope_1d(x[..., half:], col)], axis=-1)


def centred_dwconv(x, w, b):
    y = lax.conv_general_dilated(x, w[:, None, :].astype(x.dtype), window_strides=(1,), padding=[CONV_PAD], dimension_numbers=('NWC', 'WIO', 'NWC'), feature_group_count=x.shape[-1])
    return y + b.astype(x.dtype)


def full_attention(q, k, v):
    sc = jnp.einsum('bqhd,bkhd->bhqk', q, k).astype(F32) * q.shape[-1] ** -0.5
    p = jax.nn.softmax(sc, axis=-1).astype(v.dtype)
    return jnp.einsum('bhqk,bkhd->bqhd', p, v)


def dense_attention_blocks(q, k, v):
    b, s, h, dq = q.shape
    nb = s // ATTN_BLK
    qb = jnp.moveaxis(q.reshape(b, nb, ATTN_BLK, h, dq), 1, 0)
    out = lax.map(lambda qi: full_attention(qi, k, v), qb)
    return jnp.moveaxis(out, 0, 1).reshape(b, s, h * v.shape[-1])


def sink_logits(sink, hkv, grp, lead_shape):
    return jnp.broadcast_to(sink.reshape(hkv, grp)[None, :, :, None, None].astype(F32), lead_shape + (1,))


def sink_attention(q, k, v, sink):
    b, n, hq, hd = q.shape
    hkv = k.shape[2]
    grp = hq // hkv
    qg = q.reshape(b, n, hkv, grp, hd)
    sc = jnp.einsum('bqkgd,bckd->bkgqc', qg, k).astype(F32) * hd ** -0.5
    sk = sink_logits(sink, hkv, grp, sc.shape[:-1])
    p = jax.nn.softmax(jnp.concatenate([sk, sc], axis=-1), axis=-1)[..., 1:].astype(v.dtype)
    return jnp.einsum('bkgqc,bckd->bqkgd', p, v).reshape(b, n, hq * hd)


def window_attention(q, k, v, k_ctx, v_ctx, sink):
    b, s, hq, hd = q.shape
    hkv = k.shape[2]
    grp = hq // hkv
    nb = s // ATTN_BLK
    n_ctx = k_ctx.shape[1]
    scale = hd ** -0.5
    qb = jnp.moveaxis(q.reshape(b, nb, ATTN_BLK, hkv, grp, hd), 1, 0)

    def band(t):
        tb = jnp.pad(t.reshape(b, nb, ATTN_BLK, hkv, hd), ((0, 0), (1, 1), (0, 0), (0, 0), (0, 0)))
        return jnp.moveaxis(jnp.concatenate([tb[:, :-2], tb[:, 1:-1], tb[:, 2:]], axis=2), 1, 0)

    kb, vb = band(k), band(v)
    q_off = jnp.arange(ATTN_BLK)[:, None]
    k_off = jnp.arange(3 * ATTN_BLK)[None, :] - ATTN_BLK
    near = jnp.abs(k_off - q_off) <= WINDOW
    sk = sink_logits(sink, hkv, grp, (b, hkv, grp, ATTN_BLK))

    def one(args):
        blk, qi, ki, vi = args
        kpos = blk * ATTN_BLK + k_off
        valid = near & (kpos >= 0) & (kpos < s)
        s_band = jnp.where(valid, jnp.einsum('bqkgd,bskd->bkgqs', qi, ki).astype(F32) * scale, -jnp.inf)
        s_ctx = jnp.einsum('bqkgd,bckd->bkgqc', qi, k_ctx).astype(F32) * scale
        p = jax.nn.softmax(jnp.concatenate([sk, s_ctx, s_band], axis=-1), axis=-1).astype(v.dtype)
        return (jnp.einsum('bkgqc,bckd->bqkgd', p[..., 1:1 + n_ctx], v_ctx)
                + jnp.einsum('bkgqs,bskd->bqkgd', p[..., 1 + n_ctx:], vi))

    out = lax.map(one, (jnp.arange(nb), qb, kb, vb))
    return jnp.moveaxis(out, 0, 1).reshape(b, s, hq * hd)


def block_diag(x, w):
    b, n, _ = x.shape
    nblk, di, do = w.shape
    return jnp.einsum('blhi,hij->blhj', x.reshape(b, n, nblk, di), w).reshape(b, n, nblk * do)


def linear_scan(a, b, h0, reverse):
    def comb(l, r):
        return r[0] * l[0], r[0] * l[1] + r[1]
    a_cum, b_cum = lax.associative_scan(comb, (a, b), reverse=reverse, axis=1)
    return a_cum * h0[:, None, :] + b_cum


def rglru_direction(xc, w_a, b_a, w_x, b_x, lam, h0, reverse):
    r = jax.nn.sigmoid(block_diag(xc, w_a) + b_a)
    i = jax.nn.sigmoid(block_diag(xc, w_x) + b_x)
    log_a = -LRU_C * r * jax.nn.softplus(-lam.astype(F32))
    bterm = jnp.sqrt(-jnp.expm1(2.0 * log_a)) * (i * xc)
    return linear_scan(jnp.exp(log_a), bterm, h0, reverse)


def segsum(a):
    t = a.shape[-1]
    ar = jnp.broadcast_to(a[..., :, None], a.shape + (t,))
    ar = jnp.where(jnp.tril(jnp.ones((t, t), bool), -1), ar, 0.0)
    cs = jnp.cumsum(ar, axis=-2)
    return jnp.where(jnp.tril(jnp.ones((t, t), bool)), cs, -jnp.inf)


def ssd_chunked(x, dt, A, bm, cm, h0, want_y):
    b, n, h, p = x.shape
    nc = n // SSD_CHUNK
    rep = h // bm.shape[2]
    bh = jnp.repeat(bm, rep, axis=2).reshape(b, nc, SSD_CHUNK, h, -1)
    ch = jnp.repeat(cm, rep, axis=2).reshape(b, nc, SSD_CHUNK, h, -1)
    xdt = (x * dt[..., None]).reshape(b, nc, SSD_CHUNK, h, p)
    a = jnp.moveaxis((dt * A).reshape(b, nc, SSD_CHUNK, h), -1, 1)
    a_cum = jnp.cumsum(a, axis=-1)
    decay_to_end = jnp.exp(a_cum[..., -1:] - a_cum)
    states = jnp.einsum('bclhn,bhcl,bclhp->bchpn', bh, decay_to_end, xdt)
    states = jnp.concatenate([h0[:, None], states], axis=1)
    chunk_decay = jnp.exp(segsum(jnp.pad(a_cum[..., -1], ((0, 0), (0, 0), (1, 0)))))
    states = jnp.einsum('bhzc,bchpn->bzhpn', chunk_decay, states)
    final = states[:, -1]
    if not want_y:
        return None, final
    scores = jnp.einsum('bclhn,bcshn->bhcls', ch, bh) * jnp.exp(segsum(a))
    y_diag = jnp.einsum('bhcls,bcshp->bclhp', scores, xdt)
    y_off = jnp.einsum('bclhn,bchpn,bhcl->bclhp', ch, states[:, :-1], jnp.exp(a_cum))
    return (y_diag + y_off).reshape(b, n, h, p), final


def ssd_direction(xs, dt_raw, bm, cm, a_log, dt_bias, d_skip, h0, reverse, want_y):
    A = -jnp.exp(a_log.astype(F32))
    dt = jax.nn.softplus(dt_raw + dt_bias.astype(F32))
    flip = (lambda t: jnp.flip(t, axis=1)) if reverse else (lambda t: t)
    y, h_fin = ssd_chunked(flip(xs), flip(dt), A, flip(bm), flip(cm), h0, want_y)
    if want_y:
        y = flip(y) + d_skip.astype(F32)[:, None] * xs
    return y, h_fin


def mixer_ab(h_lat, h_ctx, row, col, need_ctx, w_in, w_out, q_norm_g, w_q_up, kv_norm_g, w_kv_up,
             q_head_g, k_head_g, conv_w, conv_b, w_a, b_a, w_x, b_x, lam):
    cuts = np.cumsum([MLA_Q_RANK, MLA_KV_RANK, MLA_ROPE, LRU_WIDTH]).tolist()
    cq_l, ckv_l, kr_l, xr_l, gr_l = jnp.split(h_lat @ w_in, cuts, axis=-1)
    cq_c, ckv_c, kr_c, xr_c, gr_c = jnp.split(h_ctx @ w_in, cuts, axis=-1)
    bsz, n_ctx = h_ctx.shape[:2]

    def heads_q(cq):
        b, n = cq.shape[:2]
        q = (rmsnorm(cq, q_norm_g) @ w_q_up).reshape(b, n, MLA_HEADS, MLA_QK)
        return rmsnorm(q, q_head_g)

    def heads_kv(ckv, kr):
        b, n = ckv.shape[:2]
        kv = (rmsnorm(ckv, kv_norm_g) @ w_kv_up).reshape(b, n, MLA_HEADS, MLA_NOPE + MLA_V)
        k_rope = jnp.broadcast_to(kr[:, :, None, :], (b, n, MLA_HEADS, MLA_ROPE))
        k = rmsnorm(jnp.concatenate([kv[..., :MLA_NOPE], k_rope], axis=-1), k_head_g)
        return k, kv[..., MLA_NOPE:]

    def rope_tail(t):
        return jnp.concatenate([t[..., :MLA_NOPE], rope_2d(t[..., MLA_NOPE:], row, col)], axis=-1)

    k_c, v_c = heads_kv(ckv_c, kr_c)
    k_l, v_l = heads_kv(ckv_l, kr_l)
    q_l = rope_tail(heads_q(cq_l))
    k_l = rope_tail(k_l)
    attn_l = dense_attention_blocks(q_l, jnp.concatenate([k_c, k_l], axis=1), jnp.concatenate([v_c, v_l], axis=1))

    xc_l = centred_dwconv(xr_l, conv_w, conv_b).astype(F32)
    xc_c = centred_dwconv(xr_c, conv_w, conv_b).astype(F32)
    zero = jnp.zeros((bsz, LRU_WIDTH), F32)
    hs_l, hs_c = [], []
    for d, rev in enumerate((False, True)):
        prm = (w_a[d], b_a[d], w_x[d], b_x[d], lam[d])
        h_c = rglru_direction(xc_c, *prm, zero, rev)
        h_end = h_c[:, 0] if rev else h_c[:, -1]
        hs_l.append(rglru_direction(xc_l, *prm, h_end, rev))
        hs_c.append(h_c)
    lru_l = (hs_l[0] + hs_l[1]).astype(h_lat.dtype) * jax.nn.gelu(gr_l)
    y_l = jnp.concatenate([attn_l, lru_l], axis=-1) @ w_out
    if not need_ctx:
        return y_l, None
    attn_c = full_attention(heads_q(cq_c), k_c, v_c).reshape(bsz, n_ctx, -1)
    lru_c = (hs_c[0] + hs_c[1]).astype(h_ctx.dtype) * jax.nn.gelu(gr_c)
    y_c = jnp.concatenate([attn_c, lru_c], axis=-1) @ w_out
    return y_l, y_c


def mixer_cd(h_lat, h_ctx, row, col, need_ctx, w_in, w_out, q_head_g, k_head_g, sink,
             conv_w, conv_b, a_log, dt_bias, d_skip, norm_g):
    q_w = SWA_HEADS * SWA_HD
    kv_w = SWA_KV_HEADS * SWA_HD
    cuts = np.cumsum([q_w, kv_w, kv_w, SSD_INNER, SSD_CONV_DIM]).tolist()
    q_l, k_l, v_l, z_l, xbc_l, dt_l = jnp.split(h_lat @ w_in, cuts, axis=-1)
    q_c, k_c, v_c, z_c, xbc_c, dt_c = jnp.split(h_ctx @ w_in, cuts, axis=-1)
    bsz, n_lat = h_lat.shape[:2]
    n_ctx = h_ctx.shape[1]

    def heads(t, nh):
        return t.reshape(t.shape[0], t.shape[1], nh, SWA_HD)

    k_c = rmsnorm(heads(k_c, SWA_KV_HEADS), k_head_g)
    v_c = heads(v_c, SWA_KV_HEADS)
    q_lh = rope_2d(rmsnorm(heads(q_l, SWA_HEADS), q_head_g), row, col)
    k_lh = rope_2d(rmsnorm(heads(k_l, SWA_KV_HEADS), k_head_g), row, col)
    attn_l = window_attention(q_lh, k_lh, heads(v_l, SWA_KV_HEADS), k_c, v_c, sink)

    def ssd_prep(xbc, dtr):
        b, n = xbc.shape[:2]
        u = jax.nn.silu(centred_dwconv(xbc, conv_w, conv_b)).astype(F32)
        xs = u[..., :SSD_INNER].reshape(b, n, SSD_HEADS, SSD_HD)
        bm = u[..., SSD_INNER:SSD_INNER + SSD_GROUPS * SSD_STATE].reshape(b, n, SSD_GROUPS, SSD_STATE)
        cm = u[..., SSD_INNER + SSD_GROUPS * SSD_STATE:].reshape(b, n, SSD_GROUPS, SSD_STATE)
        return xs, bm, cm, dtr.astype(F32).reshape(b, n, 2, SSD_HEADS)

    xs_l, bm_l, cm_l, dtr_l = ssd_prep(xbc_l, dt_l)
    xs_c, bm_c, cm_c, dtr_c = ssd_prep(xbc_c, dt_c)
    h0 = jnp.zeros((bsz, SSD_HEADS, SSD_HD, SSD_STATE), F32)
    ys_l, ys_c = [], []
    for d in range(2):
        y_c, h_c = ssd_direction(xs_c, dtr_c[:, :, d], bm_c, cm_c, a_log[d], dt_bias[d], d_skip[d], h0, d == 1, need_ctx)
        y_l, _ = ssd_direction(xs_l, dtr_l[:, :, d], bm_l, cm_l, a_log[d], dt_bias[d], d_skip[d], h_c, d == 1, True)
        ys_l.append(y_l)
        ys_c.append(y_c)

    def gated_out(ys, z, n):
        y = (ys[0] + ys[1]).reshape(bsz, n, SSD_INNER).astype(z.dtype)
        return rmsnorm(y * jax.nn.silu(z), norm_g)

    y_lat = jnp.concatenate([attn_l, gated_out(ys_l, z_l, n_lat)], axis=-1) @ w_out
    if not need_ctx:
        return y_lat, None
    q_ch = rmsnorm(heads(q_c, SWA_HEADS), q_head_g)
    attn_c = sink_attention(q_ch, k_c, v_c, sink)
    y_ctx = jnp.concatenate([attn_c, gated_out(ys_c, z_c, n_ctx)], axis=-1) @ w_out
    return y_lat, y_ctx


def moe_ffn(h, router_w, router_b, w_gate, w_up, w_down):
    n, d = h.shape
    scores = jax.nn.sigmoid((h @ router_w).astype(F32))
    biased = (scores + router_b.astype(F32)).reshape(n, N_GROUPS, EXPERTS_PER_GROUP)
    group_score = lax.top_k(biased, TOP_K)[0].sum(-1)
    g_sel = jnp.argmax(group_score, axis=-1)
    in_group = jnp.take_along_axis(biased, g_sel[:, None, None], axis=1)[:, 0]
    _, local = lax.top_k(in_group, TOP_K)
    e_sel = g_sel[:, None] * EXPERTS_PER_GROUP + local
    s_sel = jnp.take_along_axis(scores, e_sel, axis=1)
    w_sel = s_sel / jnp.sum(s_sel, axis=-1, keepdims=True)

    m = n * TOP_K
    n_blocks = -(-m // MOE_BLK) + N_EXPERTS
    e_flat = e_sel.reshape(m)
    tok_flat = jnp.repeat(jnp.arange(n, dtype=jnp.int32), TOP_K)
    w_flat = w_sel.reshape(m)
    counts = jnp.bincount(e_flat, length=N_EXPERTS)
    padded = (counts + MOE_BLK - 1) // MOE_BLK * MOE_BLK
    pad_end = jnp.cumsum(padded)
    pad_start = pad_end - padded
    start = jnp.cumsum(counts) - counts
    order = jnp.argsort(e_flat)
    e_sorted = e_flat[order]
    dest = pad_start[e_sorted] + jnp.arange(m, dtype=jnp.int32) - start[e_sorted]
    slot_tok = jnp.full((n_blocks * MOE_BLK,), n, jnp.int32).at[dest].set(tok_flat[order])
    slot_w = jnp.zeros((n_blocks * MOE_BLK,), h.dtype).at[dest].set(w_flat[order].astype(h.dtype))
    block_expert = jnp.minimum(jnp.searchsorted(pad_end, jnp.arange(n_blocks) * MOE_BLK, side='right'), N_EXPERTS - 1)
    h_pad = jnp.concatenate([h, jnp.zeros((1, d), h.dtype)], axis=0)
    xb = h_pad[slot_tok].reshape(n_blocks, MOE_BLK, d)

    def expert_block(args):
        xi, e = args
        return (jax.nn.silu(xi @ w_gate[e]) * (xi @ w_up[e])) @ w_down[e]

    yb = lax.map(expert_block, (xb, block_expert)).reshape(n_blocks * MOE_BLK, d)
    return jax.ops.segment_sum(yb * slot_w[:, None], slot_tok, num_segments=n + 1)[:n]


def setup_inputs(seed: int = 0) -> dict:
    key = jax.random.key(seed)
    keys = iter(jax.random.split(key, 64))

    def normal(shape, scale):
        return jax.random.normal(next(keys), shape, F32) * scale

    def gain(shape):
        return 1.0 + normal(shape, 0.02)

    def uniform(shape, lo, hi):
        return jax.random.uniform(next(keys), shape, F32, lo, hi)

    lru_a = uniform((N_EVEN, 2, LRU_WIDTH), 0.9, 0.999) ** (1.0 / LRU_C)
    ssd_dt = jnp.exp(uniform((N_ODD, 2, SSD_HEADS), math.log(1e-3), math.log(1e-1)))
    return {
        'x': normal((BATCH, SEQ, D_MODEL), 1.0),
        'c': normal((BATCH, D_MODEL), 1.0),
        'ctx': normal((BATCH, CTX_LEN, D_MODEL), 1.0),
        'c_ctx': normal((D_MODEL,), 1.0),
        'ada_w': normal((DEPTH, D_MODEL, N_MOD * D_MODEL), D_MODEL ** -0.5),
        'ada_b': normal((DEPTH, N_MOD * D_MODEL), 0.02),
        'norm1_g': gain((DEPTH, D_MODEL)),
        'norm2_g': gain((DEPTH, D_MODEL)),
        'ab_w_in': normal((N_EVEN, D_MODEL, AB_IN), D_MODEL ** -0.5),
        'ab_w_out': normal((N_EVEN, AB_OUT, D_MODEL), AB_OUT ** -0.5),
        'mla_q_norm_g': gain((N_EVEN, MLA_Q_RANK)),
        'mla_w_q_up': normal((N_EVEN, MLA_Q_RANK, MLA_HEADS * MLA_QK), MLA_Q_RANK ** -0.5),
        'mla_kv_norm_g': gain((N_EVEN, MLA_KV_RANK)),
        'mla_w_kv_up': normal((N_EVEN, MLA_KV_RANK, MLA_HEADS * (MLA_NOPE + MLA_V)), MLA_KV_RANK ** -0.5),
        'mla_q_head_g': gain((N_EVEN, MLA_QK)),
        'mla_k_head_g': gain((N_EVEN, MLA_QK)),
        'lru_conv_w': normal((N_EVEN, CONV_W, LRU_WIDTH), CONV_W ** -0.5),
        'lru_conv_b': normal((N_EVEN, LRU_WIDTH), 0.02),
        'lru_w_a': normal((N_EVEN, 2, LRU_BLOCKS, LRU_BLOCK_DIM, LRU_BLOCK_DIM), LRU_BLOCK_DIM ** -0.5),
        'lru_b_a': normal((N_EVEN, 2, LRU_WIDTH), 0.02),
        'lru_w_x': normal((N_EVEN, 2, LRU_BLOCKS, LRU_BLOCK_DIM, LRU_BLOCK_DIM), LRU_BLOCK_DIM ** -0.5),
        'lru_b_x': normal((N_EVEN, 2, LRU_WIDTH), 0.02),
        'lru_lambda': jnp.log(lru_a) - jnp.log1p(-lru_a),
        'cd_w_in': normal((N_ODD, D_MODEL, CD_IN), D_MODEL ** -0.5),
        'cd_w_out': normal((N_ODD, CD_OUT, D_MODEL), CD_OUT ** -0.5),
        'swa_q_head_g': gain((N_ODD, SWA_HD)),
        'swa_k_head_g': gain((N_ODD, SWA_HD)),
        'swa_sink': normal((N_ODD, SWA_HEADS), 0.5),
        'ssd_conv_w': normal((N_ODD, CONV_W, SSD_CONV_DIM), CONV_W ** -0.5),
        'ssd_conv_b': normal((N_ODD, SSD_CONV_DIM), 0.02),
        'ssd_a_log': jnp.log(uniform((N_ODD, 2, SSD_HEADS), 1.0, 16.0)),
        'ssd_dt_bias': ssd_dt + jnp.log(-jnp.expm1(-ssd_dt)),
        'ssd_d': gain((N_ODD, 2, SSD_HEADS)),
        'ssd_norm_g': gain((N_ODD, SSD_INNER)),
        'router_w': normal((D_MODEL, N_EXPERTS), D_MODEL ** -0.5),
        'router_b': normal((N_EXPERTS,), 0.01),
        'moe_w_gate': normal((DEPTH, N_EXPERTS, D_MODEL, D_EXPERT), D_MODEL ** -0.5),
        'moe_w_up': normal((DEPTH, N_EXPERTS, D_MODEL, D_EXPERT), D_MODEL ** -0.5),
        'moe_w_down': normal((DEPTH, N_EXPERTS, D_EXPERT, D_MODEL), D_EXPERT ** -0.5),
    }


def reference(x, c, ctx, c_ctx, ada_w, ada_b, norm1_g, norm2_g,
              ab_w_in, ab_w_out, mla_q_norm_g, mla_w_q_up, mla_kv_norm_g, mla_w_kv_up, mla_q_head_g, mla_k_head_g,
              lru_conv_w, lru_conv_b, lru_w_a, lru_b_a, lru_w_x, lru_b_x, lru_lambda,
              cd_w_in, cd_w_out, swa_q_head_g, swa_k_head_g, swa_sink,
              ssd_conv_w, ssd_conv_b, ssd_a_log, ssd_dt_bias, ssd_d, ssd_norm_g,
              router_w, router_b, moe_w_gate, moe_w_up, moe_w_down):
    bsz, n_lat, d = x.shape
    n_ctx = ctx.shape[1]
    row, col = grid_positions(n_lat)
    x_lat, x_ctx = x, ctx
    for layer in range(DEPTH):
        need_ctx = layer < DEPTH - 1
        mod_l = (jax.nn.silu(c) @ ada_w[layer] + ada_b[layer]).reshape(bsz, N_MOD, 1, d)
        mod_c = (jax.nn.silu(c_ctx) @ ada_w[layer] + ada_b[layer]).reshape(N_MOD, d)
        h_lat = modulate(x_lat, norm1_g[layer], mod_l[:, 0], mod_l[:, 1])
        h_ctx = modulate(x_ctx, norm1_g[layer], mod_c[0], mod_c[1])
        i = layer // 2
        if layer % 2 == 0:
            y_lat, y_ctx = mixer_ab(h_lat, h_ctx, row, col, need_ctx, ab_w_in[i], ab_w_out[i],
                                    mla_q_norm_g[i], mla_w_q_up[i], mla_kv_norm_g[i], mla_w_kv_up[i],
                                    mla_q_head_g[i], mla_k_head_g[i], lru_conv_w[i], lru_conv_b[i],
                                    lru_w_a[i], lru_b_a[i], lru_w_x[i], lru_b_x[i], lru_lambda[i])
        else:
            y_lat, y_ctx = mixer_cd(h_lat, h_ctx, row, col, need_ctx, cd_w_in[i], cd_w_out[i],
                                    swa_q_head_g[i], swa_k_head_g[i], swa_sink[i], ssd_conv_w[i], ssd_conv_b[i],
                                    ssd_a_log[i], ssd_dt_bias[i], ssd_d[i], ssd_norm_g[i])
        x_lat = x_lat + mod_l[:, 2] * y_lat
        h2_lat = modulate(x_lat, norm2_g[layer], mod_l[:, 3], mod_l[:, 4]).reshape(bsz * n_lat, d)
        if need_ctx:
            x_ctx = x_ctx + mod_c[2] * y_ctx
            h2_ctx = modulate(x_ctx, norm2_g[layer], mod_c[3], mod_c[4]).reshape(bsz * n_ctx, d)
            f = moe_ffn(jnp.concatenate([h2_lat, h2_ctx], axis=0), router_w, router_b,
                        moe_w_gate[layer], moe_w_up[layer], moe_w_down[layer])
            x_ctx = x_ctx + mod_c[5] * f[bsz * n_lat:].reshape(bsz, n_ctx, d)
            f_lat = f[:bsz * n_lat]
        else:
            f_lat = moe_ffn(h2_lat, router_w, router_b, moe_w_gate[layer], moe_w_up[layer], moe_w_down[layer])
        x_lat = x_lat + mod_l[:, 5] * f_lat.reshape(bsz, n_lat, d)
    return x_lat
```

```cpp
#include <hip/hip_runtime.h>
#include <hip/hip_cooperative_groups.h>
#include <cstdio>
#include <cstdint>
#include <cstring>
namespace cg = cooperative_groups;

#define DI __device__ __forceinline__
typedef unsigned short bf16;
typedef __attribute__((ext_vector_type(8))) short bf16x8;
typedef __attribute__((ext_vector_type(16))) float f32x16;
typedef __attribute__((ext_vector_type(8))) float f32x8;
typedef __attribute__((ext_vector_type(4))) float f32x4;
typedef __attribute__((ext_vector_type(2))) float f32x2;
typedef __attribute__((ext_vector_type(4))) unsigned u32x4;
typedef __attribute__((ext_vector_type(2))) unsigned u32x2;
typedef __attribute__((ext_vector_type(2))) __bf16 bfx2;
typedef __attribute__((ext_vector_type(8))) __bf16 bfx8;

constexpr int D = 1024, NB = 4, SEQ = 8192, LC = 256;
constexpr int NL = NB * SEQ;
constexpr int NC = NB * LC;
constexpr int NT = NL + NC;
constexpr int NPOS = SEQ + LC;
constexpr int C1LD = 1696, C2LD = 2320;
constexpr int NCH = 66;
constexpr float EPS = 1e-6f;
constexpr float LOG2E = 1.4426950408889634f;
constexpr int NSLOT = 2 * NT;

DI float bf2f(bf16 u) { return __uint_as_float(((unsigned)u) << 16); }
DI float lo16(unsigned u) { return __uint_as_float(u << 16); }
DI float hi16(unsigned u) { return __uint_as_float(u & 0xffff0000u); }
DI unsigned pack2(float a, float b) { f32x2 v = {a, b}; bfx2 r = __builtin_convertvector(v, bfx2); return __builtin_bit_cast(unsigned, r); }
DI bf16 f2bf(float x) { return (bf16)(pack2(x, 0.f) & 0xffffu); }
DI bf16x8 pack8(const float (&v)[8]) { f32x8 t; for (int i = 0; i < 8; ++i) t[i] = v[i]; bfx8 r = __builtin_convertvector(t, bfx8); return __builtin_bit_cast(bf16x8, r); }
DI u32x2 pack4(float a, float b, float c, float d) { u32x2 r; r[0] = pack2(a, b); r[1] = pack2(c, d); return r; }
DI void unpack8(u32x4 raw, float (&v)[8]) { for (int i = 0; i < 4; ++i) { v[2 * i] = lo16(raw[i]); v[2 * i + 1] = hi16(raw[i]); } }
DI int crow(int i, int h) { return (i & 3) + 8 * (i >> 2) + 4 * h; }
DI int swap23(int p) { return (p & ~12) | ((p & 4) << 1) | ((p & 8) >> 1); }
DI f32x16 mfma32(bf16x8 a, bf16x8 b, f32x16 c) { return __builtin_amdgcn_mfma_f32_32x32x16_bf16(a, b, c, 0, 0, 0); }
DI f32x4 mfma16(bf16x8 a, bf16x8 b, f32x4 c) { return __builtin_amdgcn_mfma_f32_16x16x32_bf16(a, b, c, 0, 0, 0); }
DI float sigmoidf_(float x) { return 1.f / (1.f + __expf(-x)); }
DI float siluf_(float x) { return x / (1.f + __expf(-x)); }
DI float softplusf_(float x) { return x > 20.f ? x : log1pf(__expf(x)); }
DI float geluf_(float x) { float u = 0.7978845608028654f * (x + 0.044715f * x * x * x); float t = 1.f - 2.f / (1.f + __expf(2.f * u)); return 0.5f * x * (1.f + t); }
DI float xor32(float v) { return v + __shfl_xor(v, 32); }
DI float wave_sum(float v) { for (int o = 32; o >= 1; o >>= 1) v += __shfl_xor(v, o); return v; }

DI void tok_info(int tok, int& bmod, int& b, int& pos, bool& lat) {
  if (tok < NL) { b = tok >> 13; bmod = b; pos = LC + (tok & (SEQ - 1)); lat = true; }
  else { int t = tok - NL; b = t >> 8; bmod = 4; pos = t & (LC - 1); lat = false; }
}

struct Params {
  const float *x, *c, *ctx, *c_ctx, *ada_w, *ada_b, *norm1_g, *norm2_g;
  const float *ab_w_in, *ab_w_out, *mla_q_norm_g, *mla_w_q_up, *mla_kv_norm_g, *mla_w_kv_up, *mla_q_head_g, *mla_k_head_g;
  const float *lru_conv_w, *lru_conv_b, *lru_w_a, *lru_b_a, *lru_w_x, *lru_b_x, *lru_lambda;
  const float *cd_w_in, *cd_w_out, *swa_q_head_g, *swa_k_head_g, *swa_sink;
  const float *ssd_conv_w, *ssd_conv_b, *ssd_a_log, *ssd_dt_bias, *ssd_d, *ssd_norm_g;
  const float *router_w, *router_b, *moe_w_gate, *moe_w_up, *moe_w_down;
  float* out;
  float* mods;
  float* ropeM;
  float* ropeS;
  float* msh;
  bf16 *win0t, *wqt, *wkvt, *wout0t, *win1t, *wout1t, *wlrut, *wgut, *wdt;
  float* xc;
  bf16* h;
  bf16* cbuf;
  bf16* qkv;
  bf16* ycat;
  bf16* ut;
  float *ssqc, *ssqx, *ssq2;
  float* comp;
  float *dtr, *dtv, *acs;
  int* cnt;
  int* tokinfo;
  float* tokw;
  int* list;
  unsigned* bar;
  int pad0;
  int pad1;
};
constexpr size_t QB_OFF = 0, KB_OFF = (size_t)NB * 8 * NPOS * 96, VT_OFF = 2 * KB_OFF;
constexpr size_t Q2_OFF = 0, K2_OFF = (size_t)NB * 8 * NPOS * 64, V2T_OFF = K2_OFF + (size_t)NB * 2 * NPOS * 64,
                 ST_OFF = V2T_OFF + (size_t)NB * 2 * 64 * NPOS;
constexpr size_t QKV_ELEMS = (size_t)NSLOT * 1024;
static_assert(VT_OFF + (size_t)NB * 8 * 64 * NPOS <= QKV_ELEMS, "qkv region");
static_assert(ST_OFF + (size_t)NB * 2 * 8 * NCH * 64 * 128 <= QKV_ELEMS, "qkv region L1");
template <int WM, int WN, class PRow, class QRow>
DI void gemm_core(bf16* smem, int K, int krot, PRow prow, QRow qrow, f32x16 (&acc)[WM][WN], int hook_kt, const float (&hs)[WN]) {
  constexpr int TP = 64 * WM, TQ = 128 * WN, LD = 72, NP = TP / 64, NQ = TQ / 64;
  const int tid = threadIdx.x, lane = tid & 63, wid = tid >> 6, wr = wid >> 2, wc = wid & 3, r = lane & 31, h = lane >> 5;
  const int c8 = tid & 7, rr = tid >> 3;
  bf16* sP0 = smem;
  bf16* sQ0 = smem + 2 * TP * LD;
  const bf16* pP[NP];
  const bf16* pQ[NQ];
#pragma unroll
  for (int i = 0; i < NP; ++i) pP[i] = prow(rr + 64 * i) + c8 * 8;
#pragma unroll
  for (int i = 0; i < NQ; ++i) pQ[i] = qrow(rr + 64 * i) + c8 * 8;
  u32x4 rP[NP], rQ[NQ];
  const int nkt = K >> 6;
#pragma unroll
  for (int i = 0; i < WM; ++i)
#pragma unroll
    for (int j = 0; j < WN; ++j)
#pragma unroll
      for (int e = 0; e < 16; ++e) acc[i][j][e] = 0.f;
  {
    const int ko = (krot % nkt) * 64;
#pragma unroll
    for (int i = 0; i < NP; ++i) rP[i] = *(const u32x4*)(pP[i] + ko);
#pragma unroll
    for (int i = 0; i < NQ; ++i) rQ[i] = *(const u32x4*)(pQ[i] + ko);
#pragma unroll
    for (int i = 0; i < NP; ++i) *(u32x4*)(sP0 + (rr + 64 * i) * LD + c8 * 8) = rP[i];
#pragma unroll
    for (int i = 0; i < NQ; ++i) *(u32x4*)(sQ0 + (rr + 64 * i) * LD + c8 * 8) = rQ[i];
  }
  __syncthreads();
  for (int kt = 0; kt < nkt; ++kt) {
    const int buf = kt & 1;
    if (kt + 1 < nkt) {
      const int ko = ((kt + 1 + krot) % nkt) * 64;
#pragma unroll
      for (int i = 0; i < NP; ++i) rP[i] = *(const u32x4*)(pP[i] + ko);
#pragma unroll
      for (int i = 0; i < NQ; ++i) rQ[i] = *(const u32x4*)(pQ[i] + ko);
    }
    if (kt == hook_kt) {
#pragma unroll
      for (int i = 0; i < WM; ++i)
#pragma unroll
        for (int j = 0; j < WN; ++j)
#pragma unroll
          for (int e = 0; e < 16; ++e) acc[i][j][e] *= hs[j];
    }
    const bf16* sP = sP0 + buf * TP * LD + (wr * WM * 32 + r) * LD + h * 8;
    const bf16* sQ = sQ0 + buf * TQ * LD + (wc * WN * 32 + r) * LD + h * 8;
#pragma unroll
    for (int ks = 0; ks < 4; ++ks) {
      bf16x8 a[WM], b[WN];
#pragma unroll
      for (int i = 0; i < WM; ++i) a[i] = *(const bf16x8*)(sP + i * 32 * LD + ks * 16);
#pragma unroll
      for (int j = 0; j < WN; ++j) b[j] = *(const bf16x8*)(sQ + j * 32 * LD + ks * 16);
#pragma unroll
      for (int i = 0; i < WM; ++i)
#pragma unroll
        for (int j = 0; j < WN; ++j) acc[i][j] = mfma32(a[i], b[j], acc[i][j]);
    }
    if (kt + 1 < nkt) {
      const int nb = buf ^ 1;
#pragma unroll
      for (int i = 0; i < NP; ++i) *(u32x4*)(sP0 + nb * TP * LD + (rr + 64 * i) * LD + c8 * 8) = rP[i];
#pragma unroll
      for (int i = 0; i < NQ; ++i) *(u32x4*)(sQ0 + nb * TQ * LD + (rr + 64 * i) * LD + c8 * 8) = rQ[i];
    }
    __syncthreads();
  }
}

struct WaveId { int lane, wid, wr, wc, r, h; };
DI WaveId wave_id() { WaveId w; w.lane = threadIdx.x & 63; w.wid = threadIdx.x >> 6; w.wr = w.wid >> 2; w.wc = w.wid & 3; w.r = w.lane & 31; w.h = w.lane >> 5; return w; }

DI void gemm_c1_item(const Params& P, bf16* smem, int pt, int qt) {
  f32x16 acc[2][2];
  const float hs[2] = {1.f, 1.f};
  const int p0 = pt * 128, q0 = qt * 256;
  gemm_core<2, 2>(smem, 1024, 0,
      [&](int rp) { return P.win0t + (size_t)(p0 + rp) * 1024; },
      [&](int rq) { return P.h + (size_t)(q0 + rq) * 1024; }, acc, -1, hs);
  const WaveId w = wave_id();
  const int grp = (p0 + w.wr * 64) >> 6;
#pragma unroll
  for (int j = 0; j < 2; ++j) {
    const int tok = q0 + w.wc * 64 + j * 32 + w.r;
    float ss = 0.f;
#pragma unroll
    for (int i = 0; i < 2; ++i)
#pragma unroll
      for (int g = 0; g < 4; ++g) {
        const int f0 = p0 + w.wr * 64 + i * 32 + 8 * g + 4 * w.h;
        const float a0 = acc[i][j][4 * g], a1 = acc[i][j][4 * g + 1], a2 = acc[i][j][4 * g + 2], a3 = acc[i][j][4 * g + 3];
        ss += a0 * a0 + a1 * a1 + a2 * a2 + a3 * a3;
        if (f0 < C1LD) *(u32x2*)(P.cbuf + (size_t)tok * C1LD + f0) = pack4(a0, a1, a2, a3);
      }
    ss = xor32(ss);
    if (w.h == 0 && grp < 10) P.ssqc[tok * 16 + grp] = ss;
  }
}

#define rope_pair(X1, X2, TAB) do { const float* tb_ = (TAB); const float cs_ = tb_[0], sn_ = tb_[1]; const float a_ = (X1) * cs_ - (X2) * sn_, b_ = (X1) * sn_ + (X2) * cs_; (X1) = a_; (X2) = b_; } while (0)

DI void gemm_q_item(const Params& P, bf16* smem, int pt, int qt) {
  f32x16 acc[3][1];
  const float hs[1] = {1.f};
  const int p0 = pt * 192, q0 = qt * 128;
  gemm_core<3, 1>(smem, 384, 0,
      [&](int rp) { return P.wqt + (size_t)(p0 + rp) * 384; },
      [&](int rq) { return P.cbuf + (size_t)(q0 + rq) * C1LD; }, acc, -1, hs);
  const WaveId w = wave_id();
  const int hd = pt * 2 + w.wr;
  const float qscale = 0.10206207261596575f * LOG2E;
#pragma unroll
  for (int j = 0; j < 1; ++j) {
    const int tok = q0 + w.wc * 32 + w.r;
    int bmod, b, pos; bool lat; tok_info(tok, bmod, b, pos, lat);
    float s6 = 0.f;
    for (int g = 0; g < 6; ++g) s6 += P.ssqc[tok * 16 + g];
    const float rstd = rsqrtf(s6 * (1.f / 384.f) + EPS);
    float ss = 0.f;
#pragma unroll
    for (int i = 0; i < 3; ++i)
#pragma unroll
      for (int e = 0; e < 16; ++e) { acc[i][j][e] *= rstd; ss += acc[i][j][e] * acc[i][j][e]; }
    ss = xor32(ss);
    const float r2 = rsqrtf(ss * (1.f / 96.f) + EPS);
#pragma unroll
    for (int i = 0; i < 3; ++i)
#pragma unroll
      for (int g = 0; g < 4; ++g) {
        const f32x4 gg = *(const f32x4*)(P.mla_q_head_g + i * 32 + 8 * g + 4 * w.h);
#pragma unroll
        for (int e = 0; e < 4; ++e) acc[i][j][4 * g + e] *= r2 * gg[e];
      }
    if (lat) {
      const int sq = tok & (SEQ - 1), rowp = sq >> 6, colp = sq & 63;
#pragma unroll
      for (int e = 0; e < 4; ++e) {
        rope_pair(acc[2][j][e], acc[2][j][4 + e], P.ropeM + (rowp * 8 + 4 * w.h + e) * 2);
        rope_pair(acc[2][j][8 + e], acc[2][j][12 + e], P.ropeM + (colp * 8 + 4 * w.h + e) * 2);
      }
    }
    bf16* dst = P.qkv + QB_OFF + ((size_t)(b * 8 + hd) * NPOS + pos) * 96;
#pragma unroll
    for (int i = 0; i < 3; ++i)
#pragma unroll
      for (int g = 0; g < 4; ++g)
        *(u32x2*)(dst + i * 32 + 8 * g + 4 * w.h) = pack4(acc[i][j][4 * g] * qscale, acc[i][j][4 * g + 1] * qscale, acc[i][j][4 * g + 2] * qscale, acc[i][j][4 * g + 3] * qscale);
  }
}

DI void gemm_kv_item(const Params& P, bf16* smem, int pt, int qt) {
  f32x16 acc[4][1];
  const float hs[1] = {1.f};
  const int p0 = pt * 256, q0 = qt * 128;
  gemm_core<4, 1>(smem, 256, 0,
      [&](int rp) { return P.wkvt + (size_t)(p0 + rp) * 256; },
      [&](int rq) { return P.cbuf + (size_t)(q0 + rq) * C1LD + 384; }, acc, -1, hs);
  const WaveId w = wave_id();
  const int hd = pt * 2 + w.wr;
#pragma unroll
  for (int j = 0; j < 1; ++j) {
    const int tok = q0 + w.wc * 32 + w.r;
    int bmod, b, pos; bool lat; tok_info(tok, bmod, b, pos, lat);
    float s4 = 0.f;
    for (int g = 6; g < 10; ++g) s4 += P.ssqc[tok * 16 + g];
    const float rstd = rsqrtf(s4 * (1.f / 256.f) + EPS);
    float kr[16];
    {
      const bf16* src = P.cbuf + (size_t)tok * C1LD + 640 + 16 * w.h;
      float t8[8];
      unpack8(*(const u32x4*)src, t8);
      for (int i = 0; i < 8; ++i) kr[i] = t8[i];
      unpack8(*(const u32x4*)(src + 8), t8);
      for (int i = 0; i < 8; ++i) kr[8 + i] = t8[i];
    }
    float ss = 0.f;
#pragma unroll
    for (int i = 0; i < 2; ++i)
#pragma unroll
      for (int e = 0; e < 16; ++e) { acc[i][j][e] *= rstd; ss += acc[i][j][e] * acc[i][j][e]; }
#pragma unroll
    for (int i = 0; i < 16; ++i) ss += kr[i] * kr[i];
    ss = xor32(ss);
    const float r2 = rsqrtf(ss * (1.f / 96.f) + EPS);
    bf16* dst = P.qkv + KB_OFF + ((size_t)(b * 8 + hd) * NPOS + pos) * 96;
#pragma unroll
    for (int i = 0; i < 2; ++i)
#pragma unroll
      for (int g = 0; g < 4; ++g) {
        const f32x4 gg = *(const f32x4*)(P.mla_k_head_g + i * 32 + 8 * g + 4 * w.h);
        *(u32x2*)(dst + i * 32 + 8 * g + 4 * w.h) = pack4(acc[i][j][4 * g] * r2 * gg[0], acc[i][j][4 * g + 1] * r2 * gg[1], acc[i][j][4 * g + 2] * r2 * gg[2], acc[i][j][4 * g + 3] * r2 * gg[3]);
      }
#pragma unroll
    for (int i = 0; i < 16; ++i) kr[i] *= r2 * P.mla_k_head_g[64 + 16 * w.h + i];
    if (lat) {
      const int sq = tok & (SEQ - 1);
      const int pp = w.h ? (sq & 63) : (sq >> 6);
#pragma unroll
      for (int i = 0; i < 8; ++i) rope_pair(kr[i], kr[8 + i], P.ropeM + (pp * 8 + i) * 2);
    }
    {
      u32x4 o0, o1;
      for (int i = 0; i < 4; ++i) { o0[i] = pack2(kr[2 * i], kr[2 * i + 1]); o1[i] = pack2(kr[8 + 2 * i], kr[8 + 2 * i + 1]); }
      *(u32x4*)(dst + 64 + 16 * w.h) = o0;
      *(u32x4*)(dst + 64 + 16 * w.h + 8) = o1;
    }
    const int posp = (pos & ~15) | swap23(pos & 15);
    bf16* vdst = P.qkv + VT_OFF + (size_t)(b * 8 + hd) * 64 * NPOS + posp;
#pragma unroll
    for (int i = 0; i < 2; ++i)
#pragma unroll
      for (int e = 0; e < 16; ++e) vdst[(size_t)(i * 32 + crow(e, w.h)) * NPOS] = f2bf(acc[2 + i][j][e] * rstd);
  }
}

DI void gemm_out_item(const Params& P, bf16* smem, int layer, int pt, int qt) {
  f32x16 acc[2][2];
  const int p0 = pt * 128, q0 = qt * 256;
  const WaveId w = wave_id();
  float hs[2] = {1.f, 1.f};
  if (layer == 1) {
#pragma unroll
    for (int j = 0; j < 2; ++j) {
      const int tok = q0 + w.wc * 64 + j * 32 + w.r;
      float s = 0.f;
      for (int g = 0; g < 8; ++g) s += P.ssq2[tok * 8 + g];
      hs[j] = rsqrtf(s * (1.f / 512.f) + EPS);
    }
  }
  const bf16* wt = layer ? P.wout1t : P.wout0t;
  gemm_core<2, 2>(smem, 1024, layer ? 8 : 0,
      [&](int rp) { return wt + (size_t)(p0 + rp) * 1024; },
      [&](int rq) { return P.ycat + (size_t)(q0 + rq) * 1024; }, acc, layer ? 8 : -1, hs);
  const int grp = (p0 + w.wr * 64) >> 6;
#pragma unroll
  for (int j = 0; j < 2; ++j) {
    const int tok = q0 + w.wc * 64 + j * 32 + w.r;
    int bmod, b, pos; bool lat; tok_info(tok, bmod, b, pos, lat);
    const float* src = layer ? (P.out + (size_t)tok * 1024) : (lat ? P.x + (size_t)tok * 1024 : P.ctx + (size_t)(tok - NL) * 1024);
    float* dst = lat ? P.out + (size_t)tok * 1024 : P.xc + (size_t)(tok - NL) * 1024;
    const float* m2 = P.mods + ((size_t)(layer * 5 + bmod) * 6 + 2) * 1024;
    float ss = 0.f;
#pragma unroll
    for (int i = 0; i < 2; ++i)
#pragma unroll
      for (int g = 0; g < 4; ++g) {
        const int f0 = p0 + w.wr * 64 + i * 32 + 8 * g + 4 * w.h;
        const f32x4 xv = *(const f32x4*)(src + f0);
        const f32x4 mv = *(const f32x4*)(m2 + f0);
        f32x4 o;
#pragma unroll
        for (int e = 0; e < 4; ++e) { o[e] = xv[e] + mv[e] * acc[i][j][4 * g + e]; ss += o[e] * o[e]; }
        *(f32x4*)(dst + f0) = o;
      }
    ss = xor32(ss);
    if (w.h == 0) P.ssqx[tok * 16 + grp] = ss;
  }
}

DI void moe1_item(const Params& P, bf16* smem, int layer, int e, int m0, int pt, int cnt_e, int off_e) {
  f32x16 acc[2][2];
  const float hs[2] = {1.f, 1.f};
  const int* lst = P.list + (size_t)e * NT;
  gemm_core<2, 2>(smem, 1024, 0,
      [&](int rp) { return P.wgut + ((size_t)e * 1024 + pt * 128 + rp) * 1024; },
      [&](int rq) { int m = m0 + rq; if (m > cnt_e - 1) m = cnt_e - 1; return P.h + (size_t)lst[m] * 1024; }, acc, -1, hs);
  const WaveId w = wave_id();
#pragma unroll
  for (int j = 0; j < 2; ++j) {
    const int m = m0 + w.wc * 64 + j * 32 + w.r;
    if (m < cnt_e) {
      bf16* dst = P.cbuf + (size_t)(off_e + m) * 512 + pt * 64 + w.wr * 32;
#pragma unroll
      for (int g = 0; g < 4; ++g) {
        float o[4];
#pragma unroll
        for (int k = 0; k < 4; ++k) o[k] = siluf_(acc[0][j][4 * g + k]) * acc[1][j][4 * g + k];
        *(u32x2*)(dst + 8 * g + 4 * w.h) = pack4(o[0], o[1], o[2], o[3]);
      }
    }
  }
}
DI void moe2_item(const Params& P, bf16* smem, int e, int m0, int pt, int cnt_e, int off_e, int total) {
  f32x16 acc[2][2];
  const float hs[2] = {1.f, 1.f};
  gemm_core<2, 2>(smem, 512, 0,
      [&](int rp) { return P.wdt + ((size_t)e * 1024 + pt * 128 + rp) * 512; },
      [&](int rq) { int s = off_e + m0 + rq; if (s > total - 1) s = total - 1; return P.cbuf + (size_t)s * 512; }, acc, -1, hs);
  const WaveId w = wave_id();
#pragma unroll
  for (int j = 0; j < 2; ++j) {
    const int m = m0 + w.wc * 64 + j * 32 + w.r;
    if (m < cnt_e) {
      bf16* dst = P.qkv + (size_t)(off_e + m) * 1024 + pt * 128 + w.wr * 64;
#pragma unroll
      for (int i = 0; i < 2; ++i)
#pragma unroll
        for (int g = 0; g < 4; ++g)
          *(u32x2*)(dst + i * 32 + 8 * g + 4 * w.h) = pack4(acc[i][j][4 * g], acc[i][j][4 * g + 1], acc[i][j][4 * g + 2], acc[i][j][4 * g + 3]);
    }
  }
}

DI void gemm_c2_item(const Params& P, bf16* smem, int pt, int qt) {
  f32x16 acc[2][2];
  const float hs[2] = {1.f, 1.f};
  const int p0 = pt * 128, q0 = qt * 256;
  gemm_core<2, 2>(smem, 1024, 0,
      [&](int rp) { return P.win1t + (size_t)(p0 + rp) * 1024; },
      [&](int rq) { return P.h + (size_t)(q0 + rq) * 1024; }, acc, -1, hs);
  const WaveId w = wave_id();
  const int fb = (p0 + w.wr * 64) >> 6;
  const float qscale = 0.125f * LOG2E;
#pragma unroll
  for (int j = 0; j < 2; ++j) {
    const int tok = q0 + w.wc * 64 + j * 32 + w.r;
    int bmod, b, pos; bool lat; tok_info(tok, bmod, b, pos, lat);
    if (fb < 10) {
      const bool isq = fb < 8;
      const float* gain = isq ? P.swa_q_head_g : P.swa_k_head_g;
      float ss = 0.f;
#pragma unroll
      for (int i = 0; i < 2; ++i)
#pragma unroll
        for (int e = 0; e < 16; ++e) ss += acc[i][j][e] * acc[i][j][e];
      ss = xor32(ss);
      const float r2 = rsqrtf(ss * (1.f / 64.f) + EPS);
#pragma unroll
      for (int i = 0; i < 2; ++i)
#pragma unroll
        for (int g = 0; g < 4; ++g) {
          const f32x4 gg = *(const f32x4*)(gain + i * 32 + 8 * g + 4 * w.h);
#pragma unroll
          for (int e = 0; e < 4; ++e) acc[i][j][4 * g + e] *= r2 * gg[e];
        }
      if (lat) {
        const int sq = tok & (SEQ - 1), rowp = sq >> 6, colp = sq & 63;
#pragma unroll
        for (int e = 0; e < 4; ++e) {
          rope_pair(acc[0][j][e], acc[0][j][8 + e], P.ropeS + (rowp * 16 + 4 * w.h + e) * 2);
          rope_pair(acc[0][j][4 + e], acc[0][j][12 + e], P.ropeS + (rowp * 16 + 8 + 4 * w.h + e) * 2);
          rope_pair(acc[1][j][e], acc[1][j][8 + e], P.ropeS + (colp * 16 + 4 * w.h + e) * 2);
          rope_pair(acc[1][j][4 + e], acc[1][j][12 + e], P.ropeS + (colp * 16 + 8 + 4 * w.h + e) * 2);
        }
      }
      if (isq && !lat) continue;
      const float sc = isq ? qscale : 1.f;
      bf16* dst = isq ? P.qkv + Q2_OFF + ((size_t)(b * 8 + fb) * NPOS + pos) * 64
                      : P.qkv + K2_OFF + ((size_t)(b * 2 + (fb - 8)) * NPOS + pos) * 64;
#pragma unroll
      for (int i = 0; i < 2; ++i)
#pragma unroll
        for (int g = 0; g < 4; ++g)
          *(u32x2*)(dst + i * 32 + 8 * g + 4 * w.h) = pack4(acc[i][j][4 * g] * sc, acc[i][j][4 * g + 1] * sc, acc[i][j][4 * g + 2] * sc, acc[i][j][4 * g + 3] * sc);
    } else if (fb < 12) {
      const int posp = (pos & ~15) | swap23(pos & 15);
      bf16* vdst = P.qkv + V2T_OFF + (size_t)(b * 2 + (fb - 10)) * 64 * NPOS + posp;
#pragma unroll
      for (int i = 0; i < 2; ++i)
#pragma unroll
        for (int e = 0; e < 16; ++e) vdst[(size_t)(i * 32 + crow(e, w.h)) * NPOS] = f2bf(acc[i][j][e]);
    } else if (fb < 36) {
      bf16* dst = P.cbuf + (size_t)tok * C2LD + fb * 64;
#pragma unroll
      for (int i = 0; i < 2; ++i)
#pragma unroll
        for (int g = 0; g < 4; ++g)
          *(u32x2*)(dst + i * 32 + 8 * g + 4 * w.h) = pack4(acc[i][j][4 * g], acc[i][j][4 * g + 1], acc[i][j][4 * g + 2], acc[i][j][4 * g + 3]);
    } else if (fb == 36) {
#pragma unroll
      for (int g = 0; g < 2; ++g) {
        f32x4 o = {acc[0][j][4 * g], acc[0][j][4 * g + 1], acc[0][j][4 * g + 2], acc[0][j][4 * g + 3]};
        *(f32x4*)(P.dtr + (size_t)tok * 16 + 8 * g + 4 * w.h) = o;
      }
    }
  }
}
template <int DQK, bool WIN>
DI void attn_item(bf16* smem, const bf16* Qp, const bf16* Kp, const bf16* Vtp, int qrow0, int nq, int ntiles, int nctx, int band_k0, int q_lat0,
                  float negM, float sinkterm, bf16* outp) {
  constexpr int KS = DQK / 16, LDK = DQK + 8, LDV = 72, CPR = DQK / 8, NCK = 64 * CPR;
  const int tid = threadIdx.x, lane = tid & 63, w = tid >> 6, r = lane & 31, h = lane >> 5;
  bf16* sK = smem;
  bf16* sV = smem + 2 * 64 * LDK;
  bf16x8 qf[2][KS];
#pragma unroll
  for (int qt = 0; qt < 2; ++qt) {
    int qi = w * 64 + qt * 32 + r;
    if (qi > nq - 1) qi = nq - 1;
#pragma unroll
    for (int s = 0; s < KS; ++s) qf[qt][s] = *(const bf16x8*)(Qp + (size_t)(qrow0 + qi) * DQK + s * 16 + h * 8);
  }
  f32x16 O[2][2];
#pragma unroll
  for (int a = 0; a < 2; ++a)
#pragma unroll
    for (int b = 0; b < 2; ++b)
#pragma unroll
      for (int e = 0; e < 16; ++e) O[a][b][e] = 0.f;
  float lsum[2] = {0.f, 0.f};
  const int kr0 = tid / CPR, kc0 = tid % CPR;
  const int id1 = tid + 512;
  const bool has1 = id1 < NCK;
  const int kr1 = has1 ? id1 / CPR : 0, kc1 = has1 ? id1 % CPR : 0;
  const int vr = tid >> 3, vc = tid & 7;
  u32x4 rK0, rK1, rV;
  rK1 = rK0 = rV = u32x4{0, 0, 0, 0};
  auto tilepos = [&](int t) { return t < nctx ? t * 64 : LC + band_k0 + (t - nctx) * 64; };
  auto gload = [&](int t) {
    const int pos = tilepos(t);
    rK0 = *(const u32x4*)(Kp + (size_t)(pos + kr0) * DQK + kc0 * 8);
    if (has1) rK1 = *(const u32x4*)(Kp + (size_t)(pos + kr1) * DQK + kc1 * 8);
    rV = *(const u32x4*)(Vtp + (size_t)vr * NPOS + pos + vc * 8);
  };
  auto swrite = [&](int buf) {
    *(u32x4*)(sK + buf * 64 * LDK + kr0 * LDK + kc0 * 8) = rK0;
    if (has1) *(u32x4*)(sK + buf * 64 * LDK + kr1 * LDK + kc1 * 8) = rK1;
    *(u32x4*)(sV + buf * 64 * LDV + vr * LDV + vc * 8) = rV;
  };
  gload(0); swrite(0);
  __syncthreads();
  const int qw = q_lat0 + w * 64;
  for (int t = 0; t < ntiles; ++t) {
    const int buf = t & 1;
    if (t + 1 < ntiles) gload(t + 1);
    bool act = (w * 64 < nq);
    int kk0 = 0;
    const bool band = WIN && t >= nctx;
    if (band) { kk0 = band_k0 + (t - nctx) * 64; act = act && (kk0 + 63 >= qw - 128) && (kk0 <= qw + 191); }
    if (act) {
      const bf16* sKb = sK + buf * 64 * LDK;
      const bf16* sVb = sV + buf * 64 * LDV;
#pragma unroll 1
      for (int ksub = 0; ksub < 2; ++ksub) {
        bf16x8 pb[2][2];
        {
          bf16x8 kf[KS];
#pragma unroll
          for (int s = 0; s < KS; ++s) kf[s] = *(const bf16x8*)(sKb + (ksub * 32 + r) * LDK + s * 16 + h * 8);
#pragma unroll
          for (int qt = 0; qt < 2; ++qt) {
            f32x16 sc;
#pragma unroll
            for (int e = 0; e < 16; ++e) sc[e] = negM;
#pragma unroll
            for (int s = 0; s < KS; ++s) sc = mfma32(kf[s], qf[qt][s], sc);
            float p[16];
#pragma unroll
            for (int e = 0; e < 16; ++e) p[e] = __builtin_amdgcn_exp2f(sc[e]);
            if (band) {
              const int qi = qw + qt * 32 + r;
#pragma unroll
              for (int e = 0; e < 16; ++e) {
                const int dd = qi - (kk0 + ksub * 32 + crow(e, h));
                if (dd > 128 || dd < -128) p[e] = 0.f;
              }
            }
            float ps = 0.f;
#pragma unroll
            for (int e = 0; e < 16; ++e) ps += p[e];
            lsum[qt] += ps;
            float p0[8], p1[8];
#pragma unroll
            for (int e = 0; e < 8; ++e) { p0[e] = p[e]; p1[e] = p[8 + e]; }
            pb[qt][0] = pack8(p0); pb[qt][1] = pack8(p1);
          }
        }
#pragma unroll
        for (int dt = 0; dt < 2; ++dt)
#pragma unroll
          for (int st = 0; st < 2; ++st) {
            const bf16x8 vf = *(const bf16x8*)(sVb + (dt * 32 + r) * LDV + ksub * 32 + st * 16 + h * 8);
            O[0][dt] = mfma32(vf, pb[0][st], O[0][dt]);
            O[1][dt] = mfma32(vf, pb[1][st], O[1][dt]);
          }
      }
    }
    if (t + 1 < ntiles) swrite(buf ^ 1);
    __syncthreads();
  }
#pragma unroll
  for (int qt = 0; qt < 2; ++qt) {
    const float l = xor32(lsum[qt]) + sinkterm;
    const float inv = 1.f / l;
    const int qi = w * 64 + qt * 32 + r;
    if (qi < nq) {
      bf16* dst = outp + (size_t)qi * 1024;
#pragma unroll
      for (int dt = 0; dt < 2; ++dt)
#pragma unroll
        for (int g = 0; g < 4; ++g)
          *(u32x2*)(dst + dt * 32 + 8 * g + 4 * h) = pack4(O[qt][dt][4 * g] * inv, O[qt][dt][4 * g + 1] * inv, O[qt][dt][4 * g + 2] * inv, O[qt][dt][4 * g + 3] * inv);
    }
  }
}

DI void lru_item(const Params& P, const float* sTaps, int bi, int j, int ck, int pass) {
  const int lane = threadIdx.x & 63, col = lane & 15, g = lane >> 4;
  const bool isctx = ck < 2;
  const int L = isctx ? LC : SEQ;
  const int sp0 = isctx ? ck * 128 : (ck - 2) * 128;
  const int tokbase = isctx ? (NL + bi * LC + sp0) : (bi * SEQ + sp0);
  const bf16* C1 = P.cbuf;
  for (int dir = 0; dir < 2; ++dir) {
    bf16x8 wb[8][2];
#pragma unroll
    for (int n = 0; n < 8; ++n)
#pragma unroll
      for (int s = 0; s < 2; ++s)
        wb[n][s] = *(const bf16x8*)(P.wlrut + ((size_t)(((dir * 2 + (n >> 2)) * 8 + j) * 64 + 16 * (n & 3) + col)) * 64 + 32 * s + 8 * g);
    bf16x8 idf[4];
#pragma unroll
    for (int n = 0; n < 4; ++n)
#pragma unroll
      for (int jj = 0; jj < 8; ++jj) idf[n][jj] = ((8 * g + jj) == 16 * (n & 1) + col) ? (short)0x3F80 : (short)0;
    float ba[4], bx[4], sp[4], hst[4], arun[4];
#pragma unroll
    for (int n = 0; n < 4; ++n) {
      const int c = 64 * j + 16 * n + col;
      ba[n] = P.lru_b_a[dir * 512 + c];
      bx[n] = P.lru_b_x[dir * 512 + c];
      sp[n] = 8.f * softplusf_(-P.lru_lambda[dir * 512 + c]);
      hst[n] = 0.f; arun[n] = 1.f;
    }
    if (pass == 1) {
      const int npre = dir == 0 ? ck : (ck == 1 ? 0 : (ck == 0 ? 1 : 67 - ck));
      for (int i = 0; i < npre; ++i) {
        const int c = dir == 0 ? i : (i == 0 ? 1 : (i == 1 ? 0 : 67 - i));
#pragma unroll
        for (int n = 0; n < 4; ++n) {
          const f32x2 cm = *(const f32x2*)(P.comp + ((size_t)((bi * 2 + dir) * NCH + c) * 512 + 64 * j + 16 * n + col) * 2);
          hst[n] = cm[0] * hst[n] + cm[1];
        }
      }
    }
    for (int step = 0; step < 8; ++step) {
      const int st = dir ? 7 - step : step;
      const int t0 = st * 16;
      bf16x8 af[2];
      {
        const int t = t0 + col;
#pragma unroll
        for (int s = 0; s < 2; ++s) {
          const int c0 = 64 * j + 32 * s + 8 * g;
          float a8[8];
          {
            const f32x4 b0 = *(const f32x4*)(sTaps + 2048 + c0), b1 = *(const f32x4*)(sTaps + 2048 + c0 + 4);
            for (int i = 0; i < 4; ++i) { a8[i] = b0[i]; a8[4 + i] = b1[i]; }
          }
#pragma unroll
          for (int k = 0; k < 4; ++k) {
            const int tt = sp0 + t + k - 2;
            if (tt >= 0 && tt < L) {
              float x8[8];
              unpack8(*(const u32x4*)(C1 + (size_t)(tokbase + t + k - 2) * C1LD + 672 + c0), x8);
              const f32x4 w0 = *(const f32x4*)(sTaps + k * 512 + c0), w1 = *(const f32x4*)(sTaps + k * 512 + c0 + 4);
              for (int i = 0; i < 4; ++i) { a8[i] += w0[i] * x8[i]; a8[4 + i] += w1[i] * x8[4 + i]; }
            }
          }
          af[s] = pack8(a8);
        }
      }
      f32x4 ag[8], xcC[4];
      const f32x4 z4 = {0.f, 0.f, 0.f, 0.f};
#pragma unroll
      for (int n = 0; n < 8; ++n) { ag[n] = mfma16(af[0], wb[n][0], z4); ag[n] = mfma16(af[1], wb[n][1], ag[n]); }
#pragma unroll
      for (int n = 0; n < 4; ++n) xcC[n] = mfma16(af[n >> 1], idf[n], z4);
#pragma unroll
      for (int n = 0; n < 4; ++n) {
        float av[4], bv[4];
#pragma unroll
        for (int e = 0; e < 4; ++e) {
          const float rg = sigmoidf_(ag[n][e] + ba[n]);
          const float ig = sigmoidf_(ag[4 + n][e] + bx[n]);
          const float la = -sp[n] * rg;
          av[e] = __expf(la);
          bv[e] = sqrtf(fmaxf(-expm1f(2.f * la), 0.f)) * ig * xcC[n][e];
        }
        float A = 1.f, H = 0.f;
        if (dir == 0) { for (int e = 0; e < 4; ++e) { H = av[e] * H + bv[e]; A *= av[e]; } }
        else { for (int e = 3; e >= 0; --e) { H = av[e] * H + bv[e]; A *= av[e]; } }
        float A1, H1, Aex, Hex, At, Ht;
        if (dir == 0) {
          A1 = __shfl_up(A, 16); H1 = __shfl_up(H, 16);
          if (g >= 1) { H = A * H1 + H; A = A * A1; }
          A1 = __shfl_up(A, 32); H1 = __shfl_up(H, 32);
          if (g >= 2) { H = A * H1 + H; A = A * A1; }
          Aex = __shfl_up(A, 16); Hex = __shfl_up(H, 16);
          if (g == 0) { Aex = 1.f; Hex = 0.f; }
          At = __shfl(A, col + 48); Ht = __shfl(H, col + 48);
        } else {
          A1 = __shfl_down(A, 16); H1 = __shfl_down(H, 16);
          if (g <= 2) { H = A * H1 + H; A = A * A1; }
          A1 = __shfl_down(A, 32); H1 = __shfl_down(H, 32);
          if (g <= 1) { H = A * H1 + H; A = A * A1; }
          Aex = __shfl_down(A, 16); Hex = __shfl_down(H, 16);
          if (g == 3) { Aex = 1.f; Hex = 0.f; }
          At = __shfl(A, col); Ht = __shfl(H, col);
        }
        if (pass == 0) {
          hst[n] = At * hst[n] + Ht; arun[n] = At * arun[n];
        } else {
          float hc = Aex * hst[n] + Hex;
          hst[n] = At * hst[n] + Ht;
          float o[4];
          if (dir == 0) { for (int e = 0; e < 4; ++e) { hc = av[e] * hc + bv[e]; o[e] = hc; } }
          else { for (int e = 3; e >= 0; --e) { hc = av[e] * hc + bv[e]; o[e] = hc; } }
          const int c = 64 * j + 16 * n + col;
#pragma unroll
          for (int e = 0; e < 4; ++e) {
            const size_t tok = tokbase + t0 + 4 * g + e;
            bf16* yp = P.ycat + tok * 1024 + 512 + c;
            if (dir == 0) *yp = f2bf(o[e]);
            else {
              const float hf = bf2f(*yp);
              const float gr = bf2f(C1[tok * C1LD + 1184 + c]);
              *yp = f2bf((hf + o[e]) * geluf_(gr));
            }
          }
        }
      }
    }
    if (pass == 0 && g == 0) {
#pragma unroll
      for (int n = 0; n < 4; ++n) {
        f32x2 cm = {arun[n], hst[n]};
        *(f32x2*)(P.comp + ((size_t)((bi * 2 + dir) * NCH + ck) * 512 + 64 * j + 16 * n + col) * 2) = cm;
      }
    }
  }
}
DI void chunk_geom(int bi, int ck, int& L, int& sp0, int& tokbase, int& pos0) {
  const bool isctx = ck < 2;
  L = isctx ? LC : SEQ;
  sp0 = isctx ? ck * 128 : (ck - 2) * 128;
  tokbase = isctx ? (NL + bi * LC + sp0) : (bi * SEQ + sp0);
  pos0 = isctx ? sp0 : LC + sp0;
}

DI void ssd_conv_item(const Params& P, int gc, int cr) {
  const int bi = gc / NCH, ck = gc % NCH;
  int L, sp0, tokbase, pos0; chunk_geom(bi, ck, L, sp0, tokbase, pos0);
  const int tid = threadIdx.x, t = tid & 127, cg = tid >> 7;
  const int tok = tokbase + t, pos = pos0 + t, posp = (pos & ~15) | swap23(pos & 15);
  for (int i = 0; i < 8; ++i) {
    const int c0 = cr * 256 + cg * 64 + i * 8;
    float a8[8];
    {
      const f32x4 b0 = *(const f32x4*)(P.ssd_conv_b + c0), b1 = *(const f32x4*)(P.ssd_conv_b + c0 + 4);
      for (int e = 0; e < 4; ++e) { a8[e] = b0[e]; a8[4 + e] = b1[e]; }
    }
#pragma unroll
    for (int k = 0; k < 4; ++k) {
      const int tt = sp0 + t + k - 2;
      if (tt >= 0 && tt < L) {
        float x8[8];
        unpack8(*(const u32x4*)(P.cbuf + (size_t)(tok + k - 2) * C2LD + 1280 + c0), x8);
        const f32x4 w0 = *(const f32x4*)(P.ssd_conv_w + k * 1024 + c0), w1 = *(const f32x4*)(P.ssd_conv_w + k * 1024 + c0 + 4);
        for (int e = 0; e < 4; ++e) { a8[e] += w0[e] * x8[e]; a8[4 + e] += w1[e] * x8[4 + e]; }
      }
    }
#pragma unroll
    for (int e = 0; e < 8; ++e) a8[e] = siluf_(a8[e]);
    const bf16x8 o = pack8(a8);
    *(bf16x8*)(P.h + (size_t)tok * 1024 + c0) = o;
#pragma unroll
    for (int e = 0; e < 8; ++e) P.ut[((size_t)(bi * 1024 + c0 + e)) * NPOS + posp] = (bf16)o[e];
  }
}

DI void ssd_cumsum_item(const Params& P, int gc) {
  const int bi = gc / NCH, ck = gc % NCH;
  int L, sp0, tokbase, pos0; chunk_geom(bi, ck, L, sp0, tokbase, pos0);
  const int lane = threadIdx.x & 63;
  if (lane < 16) {
    const float A = -__expf(P.ssd_a_log[lane]);
    const float bias = P.ssd_dt_bias[lane];
    float cs = 0.f;
    for (int t = 0; t < 128; ++t) {
      const size_t o = (size_t)(tokbase + t) * 16 + lane;
      const float dt = softplusf_(P.dtr[o] + bias);
      cs += dt * A;
      P.dtv[o] = dt;
      P.acs[o] = cs;
    }
  }
}

DI void ssd_passA_item(const Params& P, int gc, int hd, int dir, int pt, int nt) {
  const int bi = gc / NCH, ck = gc % NCH;
  int L, sp0, tokbase, pos0; chunk_geom(bi, ck, L, sp0, tokbase, pos0);
  const int lane = threadIdx.x & 63, r = lane & 31, h = lane >> 5;
  const int idx = dir * 8 + hd, grp = hd >> 2;
  const float total = P.acs[(size_t)(tokbase + 127) * 16 + idx];
  const float Ah = -__expf(P.ssd_a_log[idx]);
  const bf16* xrow = P.ut + ((size_t)(bi * 1024 + hd * 64 + 32 * pt + r)) * NPOS + pos0;
  const bf16* brow = P.ut + ((size_t)(bi * 1024 + 512 + grp * 128 + 32 * nt + r)) * NPOS + pos0;
  f32x16 acc;
#pragma unroll
  for (int e = 0; e < 16; ++e) acc[e] = 0.f;
#pragma unroll
  for (int ks = 0; ks < 8; ++ks) {
    const bf16x8 af = *(const bf16x8*)(xrow + 16 * ks + 8 * h);
    float b8[8];
    unpack8(*(const u32x4*)(brow + 16 * ks + 8 * h), b8);
#pragma unroll
    for (int jj = 0; jj < 8; ++jj) {
      const int l = 16 * ks + 8 * (jj >> 2) + 4 * h + (jj & 3);
      const size_t o = (size_t)(tokbase + l) * 16 + idx;
      const float dt = P.dtv[o], cs = P.acs[o];
      const float wgt = dir == 0 ? dt * __expf(total - cs) : dt * __expf(cs - dt * Ah);
      b8[jj] *= wgt;
    }
    acc = mfma32(af, pack8(b8), acc);
  }
  bf16* dst = P.qkv + ST_OFF + ((size_t)(((bi * 2 + dir) * 8 + hd) * NCH + ck)) * 8192 + 32 * nt + r;
#pragma unroll
  for (int e = 0; e < 16; ++e) dst[(32 * pt + crow(e, h)) * 128] = f2bf(acc[e]);
}

DI void ssd_passB(const Params& P, int bid, int nblk) {
  const int nthr = nblk * 512;
  for (int id = bid * 512 + threadIdx.x; id < NB * 2 * 8 * 2048; id += nthr) {
    const int e4 = id & 2047, hd = (id >> 11) & 7, dir = (id >> 14) & 1, bi = id >> 15;
    bf16* base = P.qkv + ST_OFF + ((size_t)((bi * 2 + dir) * 8 + hd)) * NCH * 8192 + e4 * 4;
    const int idx = dir * 8 + hd;
    float S0 = 0.f, S1 = 0.f, S2 = 0.f, S3 = 0.f;
    for (int i0 = 0; i0 < NCH; i0 += 6) {
      u32x2 raw[6]; float dec[6]; int cks[6];
#pragma unroll
      for (int u = 0; u < 6; ++u) {
        const int i = i0 + u;
        const int ck = dir == 0 ? i : (i == 0 ? 1 : (i == 1 ? 0 : 67 - i));
        cks[u] = ck;
        int L, sp0, tokbase, pos0; chunk_geom(bi, ck, L, sp0, tokbase, pos0);
        raw[u] = *(const u32x2*)(base + (size_t)ck * 8192);
        dec[u] = __expf(P.acs[(size_t)(tokbase + 127) * 16 + idx]);
      }
#pragma unroll
      for (int u = 0; u < 6; ++u) {
        *(u32x2*)(base + (size_t)cks[u] * 8192) = pack4(S0, S1, S2, S3);
        S0 = dec[u] * S0 + lo16(raw[u][0]); S1 = dec[u] * S1 + hi16(raw[u][0]);
        S2 = dec[u] * S2 + lo16(raw[u][1]); S3 = dec[u] * S3 + hi16(raw[u][1]);
      }
    }
  }
}

DI void ssd_passC_item(const Params& P, int bi, int ck, int hd, int lt) {
  int L, sp0, tokbase, pos0; chunk_geom(bi, ck, L, sp0, tokbase, pos0);
  const int lane = threadIdx.x & 63, r = lane & 31, h = lane >> 5;
  const int grp = hd >> 2;
  const int l = lt * 32 + r;
  const size_t tok = tokbase + l;
  const bf16* U = P.h;
  bf16x8 cfr[8];
#pragma unroll
  for (int ks = 0; ks < 8; ++ks) cfr[ks] = *(const bf16x8*)(U + tok * 1024 + 768 + grp * 128 + 16 * ks + 8 * h);
  f32x16 acc[2];
#pragma unroll
  for (int pt = 0; pt < 2; ++pt)
#pragma unroll
    for (int e = 0; e < 16; ++e) acc[pt][e] = 0.f;
  for (int dir = 0; dir < 2; ++dir) {
    const int idx = dir * 8 + hd;
    const float Ah = -__expf(P.ssd_a_log[idx]);
    const float csl = P.acs[tok * 16 + idx], dtl = P.dtv[tok * 16 + idx];
    const float exl = csl - dtl * Ah;
    const float total = P.acs[(size_t)(tokbase + 127) * 16 + idx];
    const float fac = dir == 0 ? __expf(csl) : __expf(total - exl);
#pragma unroll
    for (int pt = 0; pt < 2; ++pt) {
      f32x16 yo;
#pragma unroll
      for (int e = 0; e < 16; ++e) yo[e] = 0.f;
      const bf16* srow = P.qkv + ST_OFF + ((size_t)(((bi * 2 + dir) * 8 + hd) * NCH + ck)) * 8192 + (32 * pt + r) * 128;
#pragma unroll
      for (int ks = 0; ks < 8; ++ks) yo = mfma32(*(const bf16x8*)(srow + 16 * ks + 8 * h), cfr[ks], yo);
#pragma unroll
      for (int e = 0; e < 16; ++e) acc[pt][e] += fac * yo[e];
    }
    const int st_lo = dir == 0 ? 0 : lt, st_hi = dir == 0 ? lt : 3;
    for (int st = st_lo; st <= st_hi; ++st) {
      f32x16 G;
#pragma unroll
      for (int e = 0; e < 16; ++e) G[e] = 0.f;
      const bf16* brow = U + (size_t)(tokbase + st * 32 + r) * 1024 + 512 + grp * 128;
#pragma unroll
      for (int ks = 0; ks < 8; ++ks) G = mfma32(*(const bf16x8*)(brow + 16 * ks + 8 * h), cfr[ks], G);
      float m[16];
#pragma unroll
      for (int e = 0; e < 16; ++e) {
        const int s = st * 32 + crow(e, h);
        const size_t o = (size_t)(tokbase + s) * 16 + idx;
        const float cs_s = P.acs[o], dt_s = P.dtv[o];
        float v;
        if (dir == 0) v = (s <= l) ? G[e] * __expf(csl - cs_s) * dt_s : 0.f;
        else v = (s >= l) ? G[e] * __expf((cs_s - dt_s * Ah) - exl) * dt_s : 0.f;
        m[e] = v;
      }
      float m0[8], m1[8];
#pragma unroll
      for (int e = 0; e < 8; ++e) { m0[e] = m[e]; m1[e] = m[8 + e]; }
      const bf16x8 pb0 = pack8(m0), pb1 = pack8(m1);
#pragma unroll
      for (int pt = 0; pt < 2; ++pt) {
        const bf16* xrow = P.ut + ((size_t)(bi * 1024 + hd * 64 + 32 * pt + r)) * NPOS + pos0 + st * 32;
        acc[pt] = mfma32(*(const bf16x8*)(xrow + 8 * h), pb0, acc[pt]);
        acc[pt] = mfma32(*(const bf16x8*)(xrow + 16 + 8 * h), pb1, acc[pt]);
      }
    }
  }
  const float dsk = P.ssd_d[hd] + P.ssd_d[8 + hd];
  float ss = 0.f;
#pragma unroll
  for (int pt = 0; pt < 2; ++pt)
#pragma unroll
    for (int g = 0; g < 4; ++g) {
      const int p0 = 32 * pt + 8 * g + 4 * h;
      const u32x2 xr = *(const u32x2*)(U + tok * 1024 + hd * 64 + p0);
      const u32x2 zr = *(const u32x2*)(P.cbuf + tok * C2LD + 768 + hd * 64 + p0);
      const float xs[4] = {lo16(xr[0]), hi16(xr[0]), lo16(xr[1]), hi16(xr[1])};
      const float zz[4] = {lo16(zr[0]), hi16(zr[0]), lo16(zr[1]), hi16(zr[1])};
      float o[4];
#pragma unroll
      for (int e = 0; e < 4; ++e) { o[e] = (acc[pt][4 * g + e] + dsk * xs[e]) * siluf_(zz[e]); ss += o[e] * o[e]; }
      *(u32x2*)(P.ycat + tok * 1024 + 512 + hd * 64 + p0) = pack4(o[0], o[1], o[2], o[3]);
    }
  ss = xor32(ss);
  if (h == 0) P.ssq2[tok * 8 + hd] = ss;
}

DI void row_pass(const Params& P, int mode, int tok, const int* sOff) {
  const int lane = threadIdx.x & 63;
  int bmod, b, pos; bool lat; tok_info(tok, bmod, b, pos, lat);
  const float* src = mode == 0 ? (lat ? P.x + (size_t)tok * 1024 : P.ctx + (size_t)(tok - NL) * 1024)
                               : (lat ? P.out + (size_t)tok * 1024 : P.xc + (size_t)(tok - NL) * 1024);
  f32x4 v[4];
#pragma unroll
  for (int i = 0; i < 4; ++i) v[i] = *(const f32x4*)(src + 4 * lane + 256 * i);
  if (mode >= 1) {
    const int layer = mode - 1;
    const int* ti = P.tokinfo + (size_t)tok * 4;
    const int s0 = sOff[ti[0]] + ti[1], s1 = sOff[ti[2]] + ti[3];
    const float w0 = P.tokw[tok * 2], w1 = P.tokw[tok * 2 + 1];
    const float* m5 = P.mods + ((size_t)(layer * 5 + bmod) * 6 + 5) * 1024;
    float* dst = lat ? P.out + (size_t)tok * 1024 : P.xc + (size_t)(tok - NL) * 1024;
#pragma unroll
    for (int i = 0; i < 4; ++i) {
      const int k = 4 * lane + 256 * i;
      const u32x2 y0 = *(const u32x2*)(P.qkv + (size_t)s0 * 1024 + k), y1 = *(const u32x2*)(P.qkv + (size_t)s1 * 1024 + k);
      const f32x4 mv = *(const f32x4*)(m5 + k);
      v[i][0] += mv[0] * (w0 * lo16(y0[0]) + w1 * lo16(y1[0]));
      v[i][1] += mv[1] * (w0 * hi16(y0[0]) + w1 * hi16(y1[0]));
      v[i][2] += mv[2] * (w0 * lo16(y0[1]) + w1 * lo16(y1[1]));
      v[i][3] += mv[3] * (w0 * hi16(y0[1]) + w1 * hi16(y1[1]));
      *(f32x4*)(dst + k) = v[i];
    }
    if (mode == 2) return;
  }
  const int layer = mode;
  float ss = 0.f;
#pragma unroll
  for (int i = 0; i < 4; ++i) ss += v[i][0] * v[i][0] + v[i][1] * v[i][1] + v[i][2] * v[i][2] + v[i][3] * v[i][3];
  ss = wave_sum(ss);
  const float rstd = rsqrtf(ss * (1.f / 1024.f) + EPS);
  const float* g1 = P.norm1_g + layer * 1024;
  const float* sh = P.mods + ((size_t)(layer * 5 + bmod) * 6 + 0) * 1024;
  const float* sc = P.mods + ((size_t)(layer * 5 + bmod) * 6 + 1) * 1024;
#pragma unroll
  for (int i = 0; i < 4; ++i) {
    const int k = 4 * lane + 256 * i;
    const f32x4 gv = *(const f32x4*)(g1 + k), sv = *(const f32x4*)(sc + k), hv = *(const f32x4*)(sh + k);
    float o[4];
#pragma unroll
    for (int e = 0; e < 4; ++e) o[e] = v[i][e] * rstd * gv[e] * (1.f + sv[e]) + hv[e];
    *(u32x2*)(P.h + (size_t)tok * 1024 + k) = pack4(o[0], o[1], o[2], o[3]);
  }
}

DI void router_item(const Params& P, int layer, const float* sW, int wi) {
  const int lane = threadIdx.x & 63, r = lane & 31, kk = lane >> 5;
  const int tok = wi * 32 + r;
  int bmod, b, pos; bool lat; tok_info(tok, bmod, b, pos, lat);
  float s16 = 0.f;
#pragma unroll
  for (int i = 0; i < 4; ++i) { const f32x4 t = *(const f32x4*)(P.ssqx + (size_t)tok * 16 + 4 * i); s16 += t[0] + t[1] + t[2] + t[3]; }
  const float rstd = rsqrtf(s16 * (1.f / 1024.f) + EPS);
  const float* xrow = (lat ? P.out + (size_t)tok * 1024 : P.xc + (size_t)(tok - NL) * 1024) + 512 * kk;
  const float* g2 = P.norm2_g + layer * 1024 + 512 * kk;
  const float* sh = P.mods + ((size_t)(layer * 5 + bmod) * 6 + 3) * 1024 + 512 * kk;
  const float* sc = P.mods + ((size_t)(layer * 5 + bmod) * 6 + 4) * 1024 + 512 * kk;
  bf16* hrow = P.h + (size_t)tok * 1024 + 512 * kk;
  const float* wcol = sW + (512 * kk) * 32 + r;
  f32x16 acc;
#pragma unroll
  for (int e = 0; e < 16; ++e) acc[e] = 0.f;
  for (int s4 = 0; s4 < 128; ++s4) {
    const f32x4 xv = *(const f32x4*)(xrow + 4 * s4), gv = *(const f32x4*)(g2 + 4 * s4), sv = *(const f32x4*)(sc + 4 * s4), hv = *(const f32x4*)(sh + 4 * s4);
    float o[4];
#pragma unroll
    for (int e = 0; e < 4; ++e) o[e] = xv[e] * rstd * gv[e] * (1.f + sv[e]) + hv[e];
    *(u32x2*)(hrow + 4 * s4) = pack4(o[0], o[1], o[2], o[3]);
#pragma unroll
    for (int e = 0; e < 4; ++e) acc = __builtin_amdgcn_mfma_f32_32x32x2f32(wcol[(4 * s4 + e) * 32], o[e], acc, 0, 0, 0);
  }
  float lo[16], hi[16];
#pragma unroll
  for (int i = 0; i < 16; ++i) { const float oth = __shfl_xor(acc[i], 32); lo[i] = kk == 0 ? acc[i] : oth; hi[i] = kk == 0 ? oth : acc[i]; }
  float bestg = -3.0e38f, bu0 = 0.f, bu1 = 0.f;
  int be0 = 0, be1 = 0;
#pragma unroll
  for (int q = 0; q < 4; ++q) {
    float v1 = -3.0e38f, v2 = -3.0e38f, u1 = 0.f, u2 = 0.f;
    int i1 = 0, i2 = 0;
#pragma unroll
    for (int m = 0; m < 8; ++m) {
      const float lg = m < 4 ? lo[4 * q + (m & 3)] : hi[4 * q + (m & 3)];
      const float u = 1.f / (1.f + expf(-lg));
      const float xb = u + P.router_b[8 * q + m];
      if (xb > v1) { v2 = v1; i2 = i1; u2 = u1; v1 = xb; i1 = m; u1 = u; }
      else if (xb > v2) { v2 = xb; i2 = m; u2 = u; }
    }
    const float gs = v1 + v2;
    if (gs > bestg) { bestg = gs; be0 = 8 * q + i1; be1 = 8 * q + i2; bu0 = u1; bu1 = u2; }
  }
  if (kk == 0) {
    const float inv = 1.f / (bu0 + bu1);
    const int p0 = atomicAdd(P.cnt + layer * 32 + be0, 1);
    const int p1 = atomicAdd(P.cnt + layer * 32 + be1, 1);
    int* ti = P.tokinfo + (size_t)tok * 4;
    ti[0] = be0; ti[1] = p0; ti[2] = be1; ti[3] = p1;
    P.tokw[tok * 2] = bu0 * inv; P.tokw[tok * 2 + 1] = bu1 * inv;
    P.list[(size_t)be0 * NT + p0] = tok;
    P.list[(size_t)be1 * NT + p1] = tok;
  }
}
DI void conv_tile(float* sT, const float* src, int K, int N, bf16* dst, int dld, int rmode, const float* scale, int koff, int tk, int tn) {
  const int tid = threadIdx.x;
  const int k0 = tk * 64, n0 = tn * 64;
  {
    const int kk = tid >> 4, n4 = (tid & 15) * 4;
#pragma unroll
    for (int p = 0; p < 2; ++p) {
      const int k = k0 + kk + 32 * p;
      f32x4 v = {0.f, 0.f, 0.f, 0.f};
      if (n0 + n4 < N) v = *(const f32x4*)(src + (size_t)k * N + n0 + n4);
      float s = 1.f;
      if (scale != nullptr && k >= koff) s = scale[k - koff];
#pragma unroll
      for (int e = 0; e < 4; ++e) sT[(kk + 32 * p) * 65 + n4 + e] = v[e] * s;
    }
  }
  __syncthreads();
  {
    const int n = tid >> 3, kc = (tid & 7) * 8;
    if (n0 + n < N) {
      float v8[8];
#pragma unroll
      for (int e = 0; e < 8; ++e) v8[e] = sT[(kc + e) * 65 + n];
      const int nn = n0 + n;
      const int row = rmode == 0 ? nn : (64 * (nn >> 5) + (nn & 31) + (rmode == 2 ? 32 : 0));
      *(bf16x8*)(dst + (size_t)row * dld + k0 + kc) = pack8(v8);
    }
  }
  __syncthreads();
}

DI void conv_moe_tile(const Params& P, float* sT, int layer, int t) {
  const int e = t / 384, u = t % 384;
  if (u < 128) conv_tile(sT, P.moe_w_gate + ((size_t)(layer * 32 + e)) * 1024 * 512, 1024, 512, P.wgut + (size_t)e * 1024 * 1024, 1024, 1, nullptr, 0, u >> 3, u & 7);
  else if (u < 256) conv_tile(sT, P.moe_w_up + ((size_t)(layer * 32 + e)) * 1024 * 512, 1024, 512, P.wgut + (size_t)e * 1024 * 1024, 1024, 2, nullptr, 0, (u - 128) >> 3, (u - 128) & 7);
  else conv_tile(sT, P.moe_w_down + ((size_t)(layer * 32 + e)) * 512 * 1024, 512, 1024, P.wdt + (size_t)e * 1024 * 512, 512, 0, nullptr, 0, (u - 256) >> 4, (u - 256) & 15);
}

constexpr int NCONV_DENSE = 432 + 72 + 64 + 256 + 592 + 256 + 32;
DI void conv_dense_tile(const Params& P, float* sT, int t) {
  if (t < 432) { conv_tile(sT, P.ab_w_in, 1024, 1696, P.win0t, 1024, 0, nullptr, 0, t / 27, t % 27); return; }
  t -= 432;
  if (t < 72) { conv_tile(sT, P.mla_w_q_up, 384, 768, P.wqt, 384, 0, P.mla_q_norm_g, 0, t / 12, t % 12); return; }
  t -= 72;
  if (t < 64) { conv_tile(sT, P.mla_w_kv_up, 256, 1024, P.wkvt, 256, 0, P.mla_kv_norm_g, 0, t / 16, t % 16); return; }
  t -= 64;
  if (t < 256) { conv_tile(sT, P.ab_w_out, 1024, 1024, P.wout0t, 1024, 0, nullptr, 0, t / 16, t % 16); return; }
  t -= 256;
  if (t < 592) { conv_tile(sT, P.cd_w_in, 1024, 2320, P.win1t, 1024, 0, nullptr, 0, t / 37, t % 37); return; }
  t -= 592;
  if (t < 256) { conv_tile(sT, P.cd_w_out, 1024, 1024, P.wout1t, 1024, 0, P.ssd_norm_g, 512, t / 16, t % 16); return; }
  t -= 256;
  {
    const int blk = t & 7, gate = (t >> 3) & 1, dir = t >> 4;
    const float* src = (gate ? P.lru_w_x : P.lru_w_a) + ((size_t)(dir * 8 + blk)) * 4096;
    conv_tile(sT, src, 64, 64, P.wlrut + ((size_t)((dir * 2 + gate) * 8 + blk)) * 4096, 64, 0, nullptr, 0, 0, 0);
  }
}

DI void mods_item(const Params& P, float* sS, float* sR, int layer, int cb) {
  const int tid = threadIdx.x, col = tid & 63, kq = tid >> 6;
  float a[5] = {0.f, 0.f, 0.f, 0.f, 0.f};
  const float* wp = P.ada_w + (size_t)layer * 1024 * 6144 + cb * 64 + col;
  for (int k = kq * 128; k < kq * 128 + 128; ++k) {
    const float wv = wp[(size_t)k * 6144];
#pragma unroll
    for (int v = 0; v < 5; ++v) a[v] += sS[v * 1024 + k] * wv;
  }
#pragma unroll
  for (int v = 0; v < 5; ++v) sR[(kq * 5 + v) * 64 + col] = a[v];
  __syncthreads();
  if (tid < 320) {
    const int v = tid >> 6;
    float s = P.ada_b[layer * 6144 + cb * 64 + col];
    for (int q = 0; q < 8; ++q) s += sR[(q * 5 + v) * 64 + col];
    P.mods[((size_t)(layer * 5 + v)) * 6144 + cb * 64 + col] = s;
  }
  __syncthreads();
}

constexpr int NPHASE = 20;
constexpr int GEMM_LDS = (256 + 256) * 2 * 72 * 2;

DI void run_phase(const Params& P, int ph, unsigned char* lds, int bid, int nblk) {
  bf16* smem = (bf16*)lds;
  float* fsm = (float*)lds;
  int* ism = (int*)lds;
  const int tid = threadIdx.x, wid = tid >> 6;
  const int gw = bid * 8 + wid, ngw = nblk * 8;
  switch (ph) {
    case 0: {
      if (bid == 0) {
        if (tid < 64) P.cnt[tid] = 0;
        for (int i = tid; i < 128 * 8; i += 512) {
          const int p = i >> 3, f = i & 7;
          float rev = (float)p * __builtin_amdgcn_exp2f(-(float)f * (13.287712379549449f / 8.f)) * 0.15915494309189535f;
          rev -= floorf(rev);
          P.ropeM[i * 2] = __builtin_amdgcn_cosf(rev); P.ropeM[i * 2 + 1] = __builtin_amdgcn_sinf(rev);
        }
        for (int i = tid; i < 128 * 16; i += 512) {
          const int p = i >> 4, f = i & 15;
          float rev = (float)p * __builtin_amdgcn_exp2f(-(float)f * (13.287712379549449f / 16.f)) * 0.15915494309189535f;
          rev -= floorf(rev);
          P.ropeS[i * 2] = __builtin_amdgcn_cosf(rev); P.ropeS[i * 2 + 1] = __builtin_amdgcn_sinf(rev);
        }
        if (tid == 0) {
          float gq = 0.f, gk = 0.f, sq = 0.f, sk = 0.f, sm = 0.f;
          for (int i = 0; i < 96; ++i) { gq = fmaxf(gq, fabsf(P.mla_q_head_g[i])); gk = fmaxf(gk, fabsf(P.mla_k_head_g[i])); }
          for (int i = 0; i < 64; ++i) { sq = fmaxf(sq, fabsf(P.swa_q_head_g[i])); sk = fmaxf(sk, fabsf(P.swa_k_head_g[i])); }
          for (int i = 0; i < 8; ++i) sm = fmaxf(sm, P.swa_sink[i]);
          P.msh[0] = 9.797958971132712f * gq * gk * LOG2E;
          P.msh[1] = fmaxf(8.f * sq * sk, sm) * LOG2E;
        }
      }
      for (int i = tid; i < 5 * 1024; i += 512) {
        const float v = i < 4096 ? P.c[i] : P.c_ctx[i - 4096];
        fsm[i] = siluf_(v);
      }
      __syncthreads();
      for (int it = bid; it < 2 * 96; it += nblk) mods_item(P, fsm, fsm + 5120, it / 96, it % 96);
      __syncthreads();
      for (int it = bid; it < NCONV_DENSE + 32 * 384; it += nblk) {
        if (it < NCONV_DENSE) conv_dense_tile(P, fsm, it); else conv_moe_tile(P, fsm, 0, it - NCONV_DENSE);
      }
    } break;
    case 1: {
      for (int tok = gw; tok < NT; tok += ngw) row_pass(P, 0, tok, nullptr);
    } break;
    case 2: {
      for (int it = bid; it < 14 * 132; it += nblk) gemm_c1_item(P, smem, it % 14, it / 14);
    } break;
    case 3: {
      for (int it = bid; it < 264 * 8; it += nblk) {
        const int qt = it >> 3, u = it & 7;
        if (u < 4) gemm_q_item(P, smem, u, qt); else gemm_kv_item(P, smem, u - 4, qt);
      }
      __syncthreads();
      for (int i = tid; i < 2560; i += 512) fsm[i] = i < 2048 ? P.lru_conv_w[i] : P.lru_conv_b[i - 2048];
      __syncthreads();
      for (int it = gw; it < NB * 8 * NCH; it += ngw) lru_item(P, fsm, it / (8 * NCH), (it / NCH) & 7, it % NCH, 0);
    } break;
    case 4: {
      for (int i = tid; i < 2560; i += 512) fsm[i] = i < 2048 ? P.lru_conv_w[i] : P.lru_conv_b[i - 2048];
      __syncthreads();
      for (int it = gw; it < NB * 8 * NCH; it += ngw) lru_item(P, fsm, it / (8 * NCH), (it / NCH) & 7, it % NCH, 1);
      __syncthreads();
      const float negM = -P.msh[0];
      for (int it = bid; it < 32 + 512; it += nblk) {
        if (it < 32) {
          const int b = it >> 3, hd = it & 7;
          const size_t hb = (size_t)(b * 8 + hd) * NPOS;
          attn_item<96, false>(smem, P.qkv + QB_OFF + hb * 96, P.qkv + KB_OFF + hb * 96, P.qkv + VT_OFF + hb * 64, 0, 256, 4, 4, 0, 0, negM, 0.f,
                               P.ycat + (size_t)(NL + b * LC) * 1024 + hd * 64);
        } else {
          const int u = it - 32, qb = u & 15, hd = (u >> 4) & 7, b = u >> 7;
          const size_t hb = (size_t)(b * 8 + hd) * NPOS;
          attn_item<96, false>(smem, P.qkv + QB_OFF + hb * 96, P.qkv + KB_OFF + hb * 96, P.qkv + VT_OFF + hb * 64, LC + qb * 512, 512, 132, 132, 0, 0, negM, 0.f,
                               P.ycat + (size_t)(b * SEQ + qb * 512) * 1024 + hd * 64);
        }
      }
    } break;
    case 5: {
      for (int it = bid; it < 8 * 132; it += nblk) gemm_out_item(P, smem, 0, it & 7, it >> 3);
    } break;
    case 6: case 16: {
      const int layer = ph == 6 ? 0 : 1;
      for (int i = tid; i < 8192; i += 512) ((f32x4*)fsm)[i] = ((const f32x4*)P.router_w)[i];
      __syncthreads();
      const int nit = (layer == 0 ? NT : NL) / 32;
      for (int it = gw; it < nit; it += ngw) router_item(P, layer, fsm, it);
      if (layer == 1) {
        __syncthreads();
        for (int it = bid; it < 32 * 384; it += nblk) conv_moe_tile(P, fsm, 1, it);
      }
    } break;
    case 7: case 8: case 17: case 18: {
      const int layer = ph >= 17 ? 1 : 0;
      const bool second = (ph == 8 || ph == 18);
      __syncthreads();
      if (tid == 0) {
        int off = 0, toff = 0;
        for (int e = 0; e < 32; ++e) { const int c = P.cnt[layer * 32 + e]; ism[e] = c; ism[32 + e] = off; ism[65 + e] = toff; off += c; toff += (c + 255) >> 8; }
        ism[64] = off; ism[97] = toff;
      }
      __syncthreads();
      const int ntile = ism[97], total = ism[64];
      for (int it = bid; it < ntile * 8; it += nblk) {
        const int mtg = it >> 3, pt = it & 7;
        int e = 0;
        while (e < 31 && ism[65 + e + 1] <= mtg) ++e;
        const int m0 = (mtg - ism[65 + e]) * 256, cnt_e = ism[e], off_e = ism[32 + e];
        bf16* gsm = smem + 256;
        if (!second) moe1_item(P, gsm, layer, e, m0, pt, cnt_e, off_e); else moe2_item(P, gsm, e, m0, pt, cnt_e, off_e, total);
      }
    } break;
    case 9: case 19: {
      const int layer = ph == 9 ? 0 : 1;
      __syncthreads();
      if (tid == 0) { int off = 0; for (int e = 0; e < 32; ++e) { ism[e] = off; off += P.cnt[layer * 32 + e]; } }
      __syncthreads();
      const int ntok = layer == 0 ? NT : NL;
      for (int tok = gw; tok < ntok; tok += ngw) row_pass(P, layer == 0 ? 1 : 2, tok, ism);
    } break;
    case 10: {
      for (int it = bid; it < 19 * 132; it += nblk) gemm_c2_item(P, smem, it % 19, it / 19);
    } break;
    case 11: {
      for (int it = gw; it < NB * NCH; it += ngw) ssd_cumsum_item(P, it);
      for (int it = bid; it < NB * NCH * 4; it += nblk) ssd_conv_item(P, it >> 2, it & 3);
      __syncthreads();
      const float negM = -P.msh[1];
      for (int it = bid; it < 512; it += nblk) {
        const int qb = it & 15, hq = (it >> 4) & 7, b = it >> 7;
        const size_t hb = (size_t)(b * 8 + hq) * NPOS, kb = (size_t)(b * 2 + (hq >> 2)) * NPOS;
        const int k0 = qb * 512 - 128 < 0 ? 0 : qb * 512 - 128;
        const int k1 = qb * 512 + 640 > SEQ ? SEQ : qb * 512 + 640;
        const float sinkterm = __builtin_amdgcn_exp2f(P.swa_sink[hq] * LOG2E + negM);
        attn_item<64, true>(smem, P.qkv + Q2_OFF + hb * 64, P.qkv + K2_OFF + kb * 64, P.qkv + V2T_OFF + kb * 64, LC + qb * 512, 512, 4 + (k1 - k0) / 64, 4, k0, qb * 512,
                            negM, sinkterm, P.ycat + (size_t)(b * SEQ + qb * 512) * 1024 + hq * 64);
      }
    } break;
    case 12: {
      for (int it = gw; it < NB * NCH * 8 * 2 * 8; it += ngw) {
        const int tile = it & 7, dir = (it >> 3) & 1, hd = (it >> 4) & 7, gc = it >> 7;
        ssd_passA_item(P, gc, hd, dir, tile >> 2, tile & 3);
      }
    } break;
    case 13: ssd_passB(P, bid, nblk); break;
    case 14: {
      for (int it = gw; it < NB * 64 * 8 * 4; it += ngw) {
        const int lt = it & 3, hd = (it >> 2) & 7, c = (it >> 5) & 63, bi = it >> 11;
        ssd_passC_item(P, bi, c + 2, hd, lt);
      }
    } break;
    case 15: {
      for (int it = bid; it < 8 * 128; it += nblk) gemm_out_item(P, smem, 1, it & 7, it >> 3);
    } break;
    default: break;
  }
}
#define XB_TMO      128
#define XB_XCNT(j)  (256  + 64 * (j))
#define XB_XSUB(j)  (1280 + 64 * (j))
#define XB_XGEN(j)  (2304 + 64 * (j))
#define XB_TOP      3328
#define XB_TOPGEN   3392
#define XCD_BAR_WORDS 3456
#define XB_SPIN_CAP (1u << 22)
#define LAS __attribute__((address_space(3)))
DI unsigned xb_ld(unsigned* p) { return __hip_atomic_load(p, __ATOMIC_RELAXED, __HIP_MEMORY_SCOPE_AGENT); }
DI unsigned xb_add(unsigned* p, unsigned v) { return __hip_atomic_fetch_add(p, v, __ATOMIC_RELAXED, __HIP_MEMORY_SCOPE_AGENT); }
DI unsigned xb_xcc_id() { return (unsigned)__builtin_amdgcn_s_getreg((3 << 11) | 20) & 0xFu; }
#define XB_SPIN(cond, bar) do { unsigned _sp = 0; while (cond) { __builtin_amdgcn_s_sleep(1); \
    if ((++_sp & 255u) == 0u) { if (xb_ld(&(bar)[XB_TMO])) break; if (_sp > XB_SPIN_CAP) { atomicAdd(&(bar)[XB_TMO], 1u); break; } } } } while (0)
struct XcdBarrier { unsigned* bar; unsigned x; volatile LAS unsigned* st; };
DI XcdBarrier xcd_barrier_post(unsigned* bar, volatile LAS unsigned* st) {
  XcdBarrier b; b.bar = bar; b.x = xb_xcc_id(); b.st = st;
  if (threadIdx.x == 0) (void)xb_add(&bar[XB_XCNT(b.x)], 1u);
  return b;
}
DI void xcd_barrier_complete(unsigned* bar, unsigned x, unsigned& nloc, unsigned& nx) {
  const unsigned G = gridDim.x * gridDim.y * gridDim.z;
  unsigned sum, cnt, mine, sp = 0u;
  for (;;) {
    sum = 0u; cnt = 0u; mine = 0u;
#pragma unroll
    for (unsigned j = 0; j < 16; ++j) { const unsigned c = xb_ld(&bar[XB_XCNT(j)]); sum += c; cnt += (c > 0u) ? 1u : 0u; mine = (j == x) ? c : mine; }
    if (sum == G) break;
    __builtin_amdgcn_s_sleep(1);
    if ((++sp & 255u) == 0u) { if (xb_ld(&bar[XB_TMO])) break; if (sp > XB_SPIN_CAP) { atomicAdd(&bar[XB_TMO], 1u); break; } }
  }
  nloc = mine > 0u ? mine : 1u; nx = cnt > 0u ? cnt : 1u;
}
DI void xcd_barrier(const XcdBarrier& b) {
  asm volatile("s_waitcnt vmcnt(0)" ::: "memory");
  __syncthreads();
  if (threadIdx.x == 0) {
    unsigned* bar = b.bar;
    __builtin_amdgcn_s_waitcnt(0);
    unsigned nloc = b.st[0], nx = b.st[1];
    if (nloc == 0u) { xcd_barrier_complete(bar, b.x, nloc, nx); b.st[0] = nloc; b.st[1] = nx; }
    const unsigned old = xb_add(&bar[XB_XSUB(b.x)], 1u);
    const unsigned gen = old / nloc;
    if (old + 1u == (gen + 1u) * nloc) {
      __builtin_amdgcn_fence(__ATOMIC_RELEASE, "agent");
      asm volatile("s_waitcnt vmcnt(0)" ::: "memory");
      const unsigned og = xb_add(&bar[XB_TOP], 1u);
      const unsigned tg = og / nx;
      if (og + 1u == (tg + 1u) * nx) xb_add(&bar[XB_TOPGEN], 1u);
      else XB_SPIN(xb_ld(&bar[XB_TOPGEN]) == tg, bar);
      __builtin_amdgcn_fence(__ATOMIC_ACQUIRE, "agent");
      xb_add(&bar[XB_XGEN(b.x)], 1u);
      asm volatile("s_waitcnt vmcnt(0)" ::: "memory");
    } else {
      XB_SPIN(xb_ld(&bar[XB_XGEN(b.x)]) == gen, bar);
      __builtin_amdgcn_fence(__ATOMIC_ACQUIRE, "agent");
      asm volatile("s_waitcnt vmcnt(0)" ::: "memory");
    }
  }
  __syncthreads();
}

#ifndef ONE_LAUNCH
#define ONE_LAUNCH 1
#endif
constexpr int LDS_BYTES = GEMM_LDS + 1024;

#if ONE_LAUNCH
#define BAR_ARG , const XcdBarrier& xb
#define BAR_PASS , xb
#else
#define BAR_ARG
#define BAR_PASS
#endif
template <int PH>
DI void phase_step(unsigned char* lds, int ph_lo, int ph_hi BAR_ARG) {
  if (PH >= ph_lo && PH < ph_hi) {
    const __attribute__((address_space(4))) Params* kp = (const __attribute__((address_space(4))) Params*)__builtin_amdgcn_kernarg_segment_ptr();
    asm volatile("" : "+s"(kp));
    run_phase(*(const Params*)kp, PH, lds, blockIdx.x, gridDim.x);
#if ONE_LAUNCH
    if (PH + 1 < ph_hi) {
      if (PH == 0) cg::this_grid().sync(); else xcd_barrier(xb);
    }
#endif
  }
}

__global__ void __launch_bounds__(512, 2) mega(Params P, int ph_lo, int ph_hi) {
  extern __shared__ __attribute__((aligned(16))) unsigned char lds[];
#if ONE_LAUNCH
  volatile LAS unsigned* st = (volatile LAS unsigned*)(lds + GEMM_LDS + 512);
  if (threadIdx.x < 2) st[threadIdx.x] = 0u;
  __syncthreads();
  XcdBarrier xb = xcd_barrier_post(P.bar, st);
#endif
#define STEP(N) phase_step<N>(lds, ph_lo, ph_hi BAR_PASS);
  STEP(0) STEP(1) STEP(2) STEP(3) STEP(4) STEP(5) STEP(6) STEP(7) STEP(8) STEP(9)
  STEP(10) STEP(11) STEP(12) STEP(13) STEP(14) STEP(15) STEP(16) STEP(17) STEP(18) STEP(19)
#undef STEP
}

static size_t carve(size_t& off, size_t bytes) { size_t o = off; off = (off + bytes + 255) & ~(size_t)255; return o; }

extern "C" void kernel_launch(void* const* d_in, const int* in_sizes, int n_in, void* d_out, int out_size, void* d_ws, size_t ws_size, hipStream_t stream) {
  static int grid = 0;
  if (grid == 0) {
    int dev = 0, cus = 0, per_cu = 0;
    hipGetDevice(&dev);
    hipDeviceGetAttribute(&cus, hipDeviceAttributeMultiprocessorCount, dev);
    if (hipFuncSetAttribute((const void*)mega, hipFuncAttributeMaxDynamicSharedMemorySize, LDS_BYTES) != hipSuccess) { fprintf(stderr, "kernel_launch: hipFuncSetAttribute failed\n"); }
    hipOccupancyMaxActiveBlocksPerMultiprocessor(&per_cu, (const void*)mega, 512, LDS_BYTES);
    if (per_cu < 1) { fprintf(stderr, "kernel_launch: occupancy query says %d blocks per CU\n", per_cu); per_cu = 1; }
    (void)hipGetLastError();
    grid = cus;
  }
  Params P;
  memset(&P, 0, sizeof(P));
  const float** in = (const float**)&P;
  for (int i = 0; i < 39 && i < n_in; ++i) in[i] = (const float*)d_in[i];
  P.out = (float*)d_out;
  char* ws = (char*)d_ws;
  size_t off = 0;
  P.bar = (unsigned*)(ws + carve(off, XCD_BAR_WORDS * 4));
  P.mods = (float*)(ws + carve(off, 2 * 5 * 6144 * 4));
  P.ropeM = (float*)(ws + carve(off, 128 * 8 * 2 * 4));
  P.ropeS = (float*)(ws + carve(off, 128 * 16 * 2 * 4));
  P.msh = (float*)(ws + carve(off, 64));
  P.win0t = (bf16*)(ws + carve(off, (size_t)1792 * 1024 * 2));
  P.wqt = (bf16*)(ws + carve(off, (size_t)768 * 384 * 2));
  P.wkvt = (bf16*)(ws + carve(off, (size_t)1024 * 256 * 2));
  P.wout0t = (bf16*)(ws + carve(off, (size_t)1024 * 1024 * 2));
  P.win1t = (bf16*)(ws + carve(off, (size_t)2432 * 1024 * 2));
  P.wout1t = (bf16*)(ws + carve(off, (size_t)1024 * 1024 * 2));
  P.wlrut = (bf16*)(ws + carve(off, (size_t)32 * 4096 * 2));
  P.wgut = (bf16*)(ws + carve(off, (size_t)32 * 1024 * 1024 * 2));
  P.wdt = (bf16*)(ws + carve(off, (size_t)32 * 1024 * 512 * 2));
  P.ut = P.wgut;
  P.xc = (float*)(ws + carve(off, (size_t)NC * 1024 * 4));
  P.h = (bf16*)(ws + carve(off, (size_t)NT * 1024 * 2));
  P.cbuf = (bf16*)(ws + carve(off, (size_t)NT * C2LD * 2));
  P.qkv = (bf16*)(ws + carve(off, QKV_ELEMS * 2));
  P.ycat = (bf16*)(ws + carve(off, (size_t)NT * 1024 * 2));
  P.ssqc = (float*)(ws + carve(off, (size_t)NT * 16 * 4));
  P.ssqx = (float*)(ws + carve(off, (size_t)NT * 16 * 4));
  P.ssq2 = (float*)(ws + carve(off, (size_t)NT * 8 * 4));
  P.comp = (float*)(ws + carve(off, (size_t)NB * 2 * NCH * 512 * 2 * 4));
  P.dtr = (float*)(ws + carve(off, (size_t)NT * 16 * 4));
  P.dtv = (float*)(ws + carve(off, (size_t)NT * 16 * 4));
  P.acs = (float*)(ws + carve(off, (size_t)NT * 16 * 4));
  P.cnt = (int*)(ws + carve(off, 64 * 4));
  P.tokinfo = (int*)(ws + carve(off, (size_t)NT * 4 * 4));
  P.tokw = (float*)(ws + carve(off, (size_t)NT * 2 * 4));
  P.list = (int*)(ws + carve(off, (size_t)32 * NT * 4));
  if (off > ws_size || n_in != 39 || out_size != NL * 1024) {
    fprintf(stderr, "kernel_launch: needs %zu bytes of workspace (got %zu), 39 inputs (got %d), out %d (got %d); nothing launched\n", off, ws_size, n_in, NL * 1024, out_size);
    return;
  }
#if ONE_LAUNCH
  hipMemsetAsync(P.bar, 0, XCD_BAR_WORDS * 4, stream);
  int lo = 0, hi = NPHASE;
  void* args[] = {&P, &lo, &hi};
  hipError_t e = hipLaunchCooperativeKernel((const void*)mega, dim3(grid), dim3(512), args, LDS_BYTES, stream);
  if (e != hipSuccess) fprintf(stderr, "kernel_launch: cooperative launch failed: %s (grid %d)\n", hipGetErrorString(e), grid);
#else
  for (int ph = 0; ph < NPHASE; ++ph) hipLaunchKernelGGL(mega, dim3(grid), dim3(512), LDS_BYTES, stream, P, ph, ph + 1);
#endif
}
```

```cpp
#include <hip/hip_runtime.h>
#include <hip/hip_cooperative_groups.h>
#include <cstdio>
#include <cstdint>
#include <cstring>
namespace cg = cooperative_groups;

#define DI __device__ __forceinline__
typedef unsigned short bf16;
typedef __attribute__((ext_vector_type(8))) short bf16x8;
typedef __attribute__((ext_vector_type(16))) float f32x16;
typedef __attribute__((ext_vector_type(8))) float f32x8;
typedef __attribute__((ext_vector_type(4))) float f32x4;
typedef __attribute__((ext_vector_type(2))) float f32x2;
typedef __attribute__((ext_vector_type(4))) unsigned u32x4;
typedef __attribute__((ext_vector_type(2))) unsigned u32x2;
typedef __attribute__((ext_vector_type(2))) __bf16 bfx2;
typedef __attribute__((ext_vector_type(8))) __bf16 bfx8;

constexpr int D = 1024, NB = 4, SEQ = 8192, LC = 256;
constexpr int NL = NB * SEQ;
constexpr int NC = NB * LC;
constexpr int NT = NL + NC;
constexpr int NPOS = SEQ + LC;
constexpr int C1LD = 1696, C2LD = 2320;
constexpr int NCH = 66;
constexpr float EPS = 1e-6f;
constexpr float LOG2E = 1.4426950408889634f;
constexpr int NSLOT = 2 * NT;

DI float bf2f(bf16 u) { return __uint_as_float(((unsigned)u) << 16); }
DI float lo16(unsigned u) { return __uint_as_float(u << 16); }
DI float hi16(unsigned u) { return __uint_as_float(u & 0xffff0000u); }
DI unsigned pack2(float a, float b) { f32x2 v = {a, b}; bfx2 r = __builtin_convertvector(v, bfx2); return __builtin_bit_cast(unsigned, r); }
DI bf16 f2bf(float x) { return (bf16)(pack2(x, 0.f) & 0xffffu); }
DI bf16x8 pack8(const float (&v)[8]) { f32x8 t; for (int i = 0; i < 8; ++i) t[i] = v[i]; bfx8 r = __builtin_convertvector(t, bfx8); return __builtin_bit_cast(bf16x8, r); }
DI u32x2 pack4(float a, float b, float c, float d) { u32x2 r; r[0] = pack2(a, b); r[1] = pack2(c, d); return r; }
DI void unpack8(u32x4 raw, float (&v)[8]) { for (int i = 0; i < 4; ++i) { v[2 * i] = lo16(raw[i]); v[2 * i + 1] = hi16(raw[i]); } }
DI int crow(int i, int h) { return (i & 3) + 8 * (i >> 2) + 4 * h; }
DI int swap23(int p) { return (p & ~12) | ((p & 4) << 1) | ((p & 8) >> 1); }
DI f32x16 mfma32(bf16x8 a, bf16x8 b, f32x16 c) { return __builtin_amdgcn_mfma_f32_32x32x16_bf16(a, b, c, 0, 0, 0); }
DI f32x4 mfma16(bf16x8 a, bf16x8 b, f32x4 c) { return __builtin_amdgcn_mfma_f32_16x16x32_bf16(a, b, c, 0, 0, 0); }
DI float sigmoidf_(float x) { return 1.f / (1.f + __expf(-x)); }
DI float siluf_(float x) { return x / (1.f + __expf(-x)); }
DI float softplusf_(float x) { return x > 20.f ? x : log1pf(__expf(x)); }
DI float geluf_(float x) { float u = 0.7978845608028654f * (x + 0.044715f * x * x * x); float t = 1.f - 2.f / (1.f + __expf(2.f * u)); return 0.5f * x * (1.f + t); }
DI float xor32(float v) { return v + __shfl_xor(v, 32); }
DI float wave_sum(float v) { for (int o = 32; o >= 1; o >>= 1) v += __shfl_xor(v, o); return v; }

DI void tok_info(int tok, int& bmod, int& b, int& pos, bool& lat) {
  if (tok < NL) { b = tok >> 13; bmod = b; pos = LC + (tok & (SEQ - 1)); lat = true; }
  else { int t = tok - NL; b = t >> 8; bmod = 4; pos = t & (LC - 1); lat = false; }
}

struct Params {
  const float *x, *c, *ctx, *c_ctx, *ada_w, *ada_b, *norm1_g, *norm2_g;
  const float *ab_w_in, *ab_w_out, *mla_q_norm_g, *mla_w_q_up, *mla_kv_norm_g, *mla_w_kv_up, *mla_q_head_g, *mla_k_head_g;
  const float *lru_conv_w, *lru_conv_b, *lru_w_a, *lru_b_a, *lru_w_x, *lru_b_x, *lru_lambda;
  const float *cd_w_in, *cd_w_out, *swa_q_head_g, *swa_k_head_g, *swa_sink;
  const float *ssd_conv_w, *ssd_conv_b, *ssd_a_log, *ssd_dt_bias, *ssd_d, *ssd_norm_g;
  const float *router_w, *router_b, *moe_w_gate, *moe_w_up, *moe_w_down;
  float* out;
  float* mods;
  float* ropeM;
  float* ropeS;
  float* msh;
  bf16 *win0t, *wqt, *wkvt, *wout0t, *win1t, *wout1t, *wlrut, *wgut, *wdt, *wrt;
  float* xc;
  bf16* h;
  bf16* cbuf;
  bf16* qkv;
  bf16* ycat;
  bf16* ut;
  float *ssqc, *ssqx, *ssq2;
  float* comp;
  float *dtr, *dtv, *acs;
  int* cnt;
  int* tokinfo;
  float* tokw;
  int* list;
  unsigned* bar;
  int pad0;
  int pad1;
};
constexpr size_t QB_OFF = 0, KB_OFF = (size_t)NB * 8 * NPOS * 96, VT_OFF = 2 * KB_OFF;
constexpr size_t Q2_OFF = 0, K2_OFF = (size_t)NB * 8 * NPOS * 64, V2T_OFF = K2_OFF + (size_t)NB * 2 * NPOS * 64,
                 ST_OFF = V2T_OFF + (size_t)NB * 2 * 64 * NPOS;
constexpr size_t QKV_ELEMS = (size_t)NSLOT * 1024;
static_assert(VT_OFF + (size_t)NB * 8 * 64 * NPOS <= QKV_ELEMS, "qkv region");
static_assert(ST_OFF + (size_t)NB * 2 * 8 * NCH * 64 * 128 <= QKV_ELEMS, "qkv region L1");
#define REPMASK 0
#define PROBE_PH (-1)
template <int WM, int WN, bool ZERO = true, class PRow, class QRow>
DI void gemm_core(bf16* smem, int K, int krot, PRow prow, QRow qrow, f32x16 (&acc)[WM][WN], int hook_kt, const float (&hs)[WN]) {
  constexpr int TP = 64 * WM, TQ = 128 * WN, LD = 72, NP = TP / 64, NQ = TQ / 64;
  const int tid = threadIdx.x, lane = tid & 63, wid = tid >> 6, wr = wid >> 2, wc = wid & 3, r = lane & 31, h = lane >> 5;
  const int c8 = tid & 7, rr = tid >> 3;
  bf16* sP0 = smem;
  bf16* sQ0 = smem + 2 * TP * LD;
  const bf16* pP[NP];
  const bf16* pQ[NQ];
#pragma unroll
  for (int i = 0; i < NP; ++i) pP[i] = prow(rr + 64 * i) + c8 * 8;
#pragma unroll
  for (int i = 0; i < NQ; ++i) pQ[i] = qrow(rr + 64 * i) + c8 * 8;
  u32x4 rP[NP], rQ[NQ];
  const int nkt = K >> 6;
  if (ZERO) {
#pragma unroll
    for (int i = 0; i < WM; ++i)
#pragma unroll
      for (int j = 0; j < WN; ++j)
#pragma unroll
        for (int e = 0; e < 16; ++e) acc[i][j][e] = 0.f;
  }
  {
    const int ko = (krot % nkt) * 64;
#pragma unroll
    for (int i = 0; i < NP; ++i) rP[i] = *(const u32x4*)(pP[i] + ko);
#pragma unroll
    for (int i = 0; i < NQ; ++i) rQ[i] = *(const u32x4*)(pQ[i] + ko);
#pragma unroll
    for (int i = 0; i < NP; ++i) *(u32x4*)(sP0 + (rr + 64 * i) * LD + c8 * 8) = rP[i];
#pragma unroll
    for (int i = 0; i < NQ; ++i) *(u32x4*)(sQ0 + (rr + 64 * i) * LD + c8 * 8) = rQ[i];
  }
  __syncthreads();
  for (int kt = 0; kt < nkt; ++kt) {
    const int buf = kt & 1;
    if (kt + 1 < nkt) {
      const int ko = ((kt + 1 + krot) % nkt) * 64;
#pragma unroll
      for (int i = 0; i < NP; ++i) rP[i] = *(const u32x4*)(pP[i] + ko);
#pragma unroll
      for (int i = 0; i < NQ; ++i) rQ[i] = *(const u32x4*)(pQ[i] + ko);
    }
    if (kt == hook_kt) {
#pragma unroll
      for (int i = 0; i < WM; ++i)
#pragma unroll
        for (int j = 0; j < WN; ++j)
#pragma unroll
          for (int e = 0; e < 16; ++e) acc[i][j][e] *= hs[j];
    }
    const bf16* sP = sP0 + buf * TP * LD + (wr * WM * 32 + r) * LD + h * 8;
    const bf16* sQ = sQ0 + buf * TQ * LD + (wc * WN * 32 + r) * LD + h * 8;
#pragma unroll
    for (int ks = 0; ks < 4; ++ks) {
      bf16x8 a[WM], b[WN];
#pragma unroll
      for (int i = 0; i < WM; ++i) a[i] = *(const bf16x8*)(sP + i * 32 * LD + ks * 16);
#pragma unroll
      for (int j = 0; j < WN; ++j) b[j] = *(const bf16x8*)(sQ + j * 32 * LD + ks * 16);
#pragma unroll
      for (int i = 0; i < WM; ++i)
#pragma unroll
        for (int j = 0; j < WN; ++j) acc[i][j] = mfma32(a[i], b[j], acc[i][j]);
    }
    if (kt + 1 < nkt) {
      const int nb = buf ^ 1;
#pragma unroll
      for (int i = 0; i < NP; ++i) *(u32x4*)(sP0 + nb * TP * LD + (rr + 64 * i) * LD + c8 * 8) = rP[i];
#pragma unroll
      for (int i = 0; i < NQ; ++i) *(u32x4*)(sQ0 + nb * TQ * LD + (rr + 64 * i) * LD + c8 * 8) = rQ[i];
    }
    __syncthreads();
  }
}

struct WaveId { int lane, wid, wr, wc, r, h; };
DI WaveId wave_id() { WaveId w; w.lane = threadIdx.x & 63; w.wid = threadIdx.x >> 6; w.wr = w.wid >> 2; w.wc = w.wid & 3; w.r = w.lane & 31; w.h = w.lane >> 5; return w; }

DI void gemm_c1_item(const Params& P, bf16* smem, int pt, int qt) {
  f32x16 acc[2][2];
  const float hs[2] = {1.f, 1.f};
  const int p0 = pt * 128, q0 = qt * 256;
  gemm_core<2, 2>(smem, 1024, 0,
      [&](int rp) { return P.win0t + (size_t)(p0 + rp) * 1024; },
      [&](int rq) { return P.h + (size_t)(q0 + rq) * 1024; }, acc, -1, hs);
  const WaveId w = wave_id();
  const int grp = (p0 + w.wr * 64) >> 6;
#pragma unroll
  for (int j = 0; j < 2; ++j) {
    const int tok = q0 + w.wc * 64 + j * 32 + w.r;
    float ss = 0.f;
#pragma unroll
    for (int i = 0; i < 2; ++i)
#pragma unroll
      for (int g = 0; g < 4; ++g) {
        const int f0 = p0 + w.wr * 64 + i * 32 + 8 * g + 4 * w.h;
        const float a0 = acc[i][j][4 * g], a1 = acc[i][j][4 * g + 1], a2 = acc[i][j][4 * g + 2], a3 = acc[i][j][4 * g + 3];
        ss += a0 * a0 + a1 * a1 + a2 * a2 + a3 * a3;
        if (f0 < C1LD) *(u32x2*)(P.cbuf + (size_t)tok * C1LD + f0) = pack4(a0, a1, a2, a3);
      }
    ss = xor32(ss);
    if (w.h == 0 && grp < 10) P.ssqc[tok * 16 + grp] = ss;
  }
}

#define rope_pair(X1, X2, TAB) do { const float* tb_ = (TAB); const float cs_ = tb_[0], sn_ = tb_[1]; const float a_ = (X1) * cs_ - (X2) * sn_, b_ = (X1) * sn_ + (X2) * cs_; (X1) = a_; (X2) = b_; } while (0)

DI void gemm_q_item(const Params& P, bf16* smem, int pt, int qt) {
  f32x16 acc[3][1];
  const float hs[1] = {1.f};
  const int p0 = pt * 192, q0 = qt * 128;
  gemm_core<3, 1>(smem, 384, 0,
      [&](int rp) { return P.wqt + (size_t)(p0 + rp) * 384; },
      [&](int rq) { return P.cbuf + (size_t)(q0 + rq) * C1LD; }, acc, -1, hs);
  const WaveId w = wave_id();
  const int hd = pt * 2 + w.wr;
  const float qscale = 0.10206207261596575f * LOG2E;
#pragma unroll
  for (int j = 0; j < 1; ++j) {
    const int tok = q0 + w.wc * 32 + w.r;
    int bmod, b, pos; bool lat; tok_info(tok, bmod, b, pos, lat);
    float s6 = 0.f;
    for (int g = 0; g < 6; ++g) s6 += P.ssqc[tok * 16 + g];
    const float rstd = rsqrtf(s6 * (1.f / 384.f) + EPS);
    float ss = 0.f;
#pragma unroll
    for (int i = 0; i < 3; ++i)
#pragma unroll
      for (int e = 0; e < 16; ++e) { acc[i][j][e] *= rstd; ss += acc[i][j][e] * acc[i][j][e]; }
    ss = xor32(ss);
    const float r2 = rsqrtf(ss * (1.f / 96.f) + EPS);
#pragma unroll
    for (int i = 0; i < 3; ++i)
#pragma unroll
      for (int g = 0; g < 4; ++g) {
        const f32x4 gg = *(const f32x4*)(P.mla_q_head_g + i * 32 + 8 * g + 4 * w.h);
#pragma unroll
        for (int e = 0; e < 4; ++e) acc[i][j][4 * g + e] *= r2 * gg[e];
      }
    if (lat) {
      const int sq = tok & (SEQ - 1), rowp = sq >> 6, colp = sq & 63;
#pragma unroll
      for (int e = 0; e < 4; ++e) {
        rope_pair(acc[2][j][e], acc[2][j][4 + e], P.ropeM + (rowp * 8 + 4 * w.h + e) * 2);
        rope_pair(acc[2][j][8 + e], acc[2][j][12 + e], P.ropeM + (colp * 8 + 4 * w.h + e) * 2);
      }
    }
    bf16* dst = P.qkv + QB_OFF + ((size_t)(b * 8 + hd) * NPOS + pos) * 96;
#pragma unroll
    for (int i = 0; i < 3; ++i)
#pragma unroll
      for (int g = 0; g < 4; ++g)
        *(u32x2*)(dst + i * 32 + 8 * g + 4 * w.h) = pack4(acc[i][j][4 * g] * qscale, acc[i][j][4 * g + 1] * qscale, acc[i][j][4 * g + 2] * qscale, acc[i][j][4 * g + 3] * qscale);
  }
}

DI void gemm_kv_item(const Params& P, bf16* smem, int pt, int qt) {
  f32x16 acc[4][1];
  const float hs[1] = {1.f};
  const int p0 = pt * 256, q0 = qt * 128;
  gemm_core<4, 1>(smem, 256, 0,
      [&](int rp) { return P.wkvt + (size_t)(p0 + rp) * 256; },
      [&](int rq) { return P.cbuf + (size_t)(q0 + rq) * C1LD + 384; }, acc, -1, hs);
  const WaveId w = wave_id();
  const int hd = pt * 2 + w.wr;
#pragma unroll
  for (int j = 0; j < 1; ++j) {
    const int tok = q0 + w.wc * 32 + w.r;
    int bmod, b, pos; bool lat; tok_info(tok, bmod, b, pos, lat);
    float s4 = 0.f;
    for (int g = 6; g < 10; ++g) s4 += P.ssqc[tok * 16 + g];
    const float rstd = rsqrtf(s4 * (1.f / 256.f) + EPS);
    float kr[16];
    {
      const bf16* src = P.cbuf + (size_t)tok * C1LD + 640 + 16 * w.h;
      float t8[8];
      unpack8(*(const u32x4*)src, t8);
      for (int i = 0; i < 8; ++i) kr[i] = t8[i];
      unpack8(*(const u32x4*)(src + 8), t8);
      for (int i = 0; i < 8; ++i) kr[8 + i] = t8[i];
    }
    float ss = 0.f;
#pragma unroll
    for (int i = 0; i < 2; ++i)
#pragma unroll
      for (int e = 0; e < 16; ++e) { acc[i][j][e] *= rstd; ss += acc[i][j][e] * acc[i][j][e]; }
#pragma unroll
    for (int i = 0; i < 16; ++i) ss += kr[i] * kr[i];
    ss = xor32(ss);
    const float r2 = rsqrtf(ss * (1.f / 96.f) + EPS);
    bf16* dst = P.qkv + KB_OFF + ((size_t)(b * 8 + hd) * NPOS + pos) * 96;
#pragma unroll
    for (int i = 0; i < 2; ++i)
#pragma unroll
      for (int g = 0; g < 4; ++g) {
        const f32x4 gg = *(const f32x4*)(P.mla_k_head_g + i * 32 + 8 * g + 4 * w.h);
        *(u32x2*)(dst + i * 32 + 8 * g + 4 * w.h) = pack4(acc[i][j][4 * g] * r2 * gg[0], acc[i][j][4 * g + 1] * r2 * gg[1], acc[i][j][4 * g + 2] * r2 * gg[2], acc[i][j][4 * g + 3] * r2 * gg[3]);
      }
#pragma unroll
    for (int i = 0; i < 16; ++i) kr[i] *= r2 * P.mla_k_head_g[64 + 16 * w.h + i];
    if (lat) {
      const int sq = tok & (SEQ - 1);
      const int pp = w.h ? (sq & 63) : (sq >> 6);
#pragma unroll
      for (int i = 0; i < 8; ++i) rope_pair(kr[i], kr[8 + i], P.ropeM + (pp * 8 + i) * 2);
    }
    {
      u32x4 o0, o1;
      for (int i = 0; i < 4; ++i) { o0[i] = pack2(kr[2 * i], kr[2 * i + 1]); o1[i] = pack2(kr[8 + 2 * i], kr[8 + 2 * i + 1]); }
      *(u32x4*)(dst + 64 + 16 * w.h) = o0;
      *(u32x4*)(dst + 64 + 16 * w.h + 8) = o1;
    }
    const int posp = (pos & ~15) | swap23(pos & 15);
    bf16* vdst = P.qkv + VT_OFF + (size_t)(b * 8 + hd) * 64 * NPOS + posp;
#pragma unroll
    for (int i = 0; i < 2; ++i)
#pragma unroll
      for (int e = 0; e < 16; ++e) vdst[(size_t)(i * 32 + crow(e, w.h)) * NPOS] = f2bf(acc[2 + i][j][e] * rstd);
  }
}

DI void gemm_out_item(const Params& P, bf16* smem, int layer, int pt, int qt) {
  f32x16 acc[2][2];
  const int p0 = pt * 128, q0 = qt * 256;
  const WaveId w = wave_id();
  float hs[2] = {1.f, 1.f};
  if (layer == 1) {
#pragma unroll
    for (int j = 0; j < 2; ++j) {
      const int tok = q0 + w.wc * 64 + j * 32 + w.r;
      float s = 0.f;
      for (int g = 0; g < 8; ++g) s += P.ssq2[tok * 8 + g];
      hs[j] = rsqrtf(s * (1.f / 512.f) + EPS);
    }
  }
  const bf16* wt = layer ? P.wout1t : P.wout0t;
  gemm_core<2, 2>(smem, 1024, layer ? 8 : 0,
      [&](int rp) { return wt + (size_t)(p0 + rp) * 1024; },
      [&](int rq) { return P.ycat + (size_t)(q0 + rq) * 1024; }, acc, layer ? 8 : -1, hs);
  const int grp = (p0 + w.wr * 64) >> 6;
#pragma unroll
  for (int j = 0; j < 2; ++j) {
    const int tok = q0 + w.wc * 64 + j * 32 + w.r;
    int bmod, b, pos; bool lat; tok_info(tok, bmod, b, pos, lat);
    const float* src = layer ? (P.out + (size_t)tok * 1024) : (lat ? P.x + (size_t)tok * 1024 : P.ctx + (size_t)(tok - NL) * 1024);
    float* dst = lat ? P.out + (size_t)tok * 1024 : P.xc + (size_t)(tok - NL) * 1024;
    const float* m2 = P.mods + ((size_t)(layer * 5 + bmod) * 6 + 2) * 1024;
    float ss = 0.f;
#pragma unroll
    for (int i = 0; i < 2; ++i)
#pragma unroll
      for (int g = 0; g < 4; ++g) {
        const int f0 = p0 + w.wr * 64 + i * 32 + 8 * g + 4 * w.h;
        const f32x4 xv = *(const f32x4*)(src + f0);
        const f32x4 mv = *(const f32x4*)(m2 + f0);
        f32x4 o;
#pragma unroll
        for (int e = 0; e < 4; ++e) o[e] = xv[e] + mv[e] * acc[i][j][4 * g + e];
        *(f32x4*)(dst + f0) = o;
      }
  }
}

DI void moe1_item(const Params& P, bf16* smem, int layer, int e, int m0, int pt, int cnt_e, int off_e) {
  f32x16 acc[2][2];
  const float hs[2] = {1.f, 1.f};
  const int* lst = P.list + (size_t)e * NT;
  gemm_core<2, 2>(smem, 1024, 0,
      [&](int rp) { return P.wgut + ((size_t)e * 1024 + pt * 128 + rp) * 1024; },
      [&](int rq) { int m = m0 + rq; if (m > cnt_e - 1) m = cnt_e - 1; return P.h + (size_t)lst[m] * 1024; }, acc, -1, hs);
  const WaveId w = wave_id();
#pragma unroll
  for (int j = 0; j < 2; ++j) {
    const int m = m0 + w.wc * 64 + j * 32 + w.r;
    if (m < cnt_e) {
      bf16* dst = P.cbuf + (size_t)(off_e + m) * 512 + pt * 64 + w.wr * 32;
#pragma unroll
      for (int g = 0; g < 4; ++g) {
        float o[4];
#pragma unroll
        for (int k = 0; k < 4; ++k) o[k] = siluf_(acc[0][j][4 * g + k]) * acc[1][j][4 * g + k];
        *(u32x2*)(dst + 8 * g + 4 * w.h) = pack4(o[0], o[1], o[2], o[3]);
      }
    }
  }
}
DI void moe2_item(const Params& P, bf16* smem, int e, int m0, int pt, int cnt_e, int off_e, int total) {
  f32x16 acc[2][2];
  const float hs[2] = {1.f, 1.f};
  gemm_core<2, 2>(smem, 512, 0,
      [&](int rp) { return P.wdt + ((size_t)e * 1024 + pt * 128 + rp) * 512; },
      [&](int rq) { int s = off_e + m0 + rq; if (s > total - 1) s = total - 1; return P.cbuf + (size_t)s * 512; }, acc, -1, hs);
  const WaveId w = wave_id();
#pragma unroll
  for (int j = 0; j < 2; ++j) {
    const int m = m0 + w.wc * 64 + j * 32 + w.r;
    if (m < cnt_e) {
      bf16* dst = P.qkv + (size_t)(off_e + m) * 1024 + pt * 128 + w.wr * 64;
#pragma unroll
      for (int i = 0; i < 2; ++i)
#pragma unroll
        for (int g = 0; g < 4; ++g)
          *(u32x2*)(dst + i * 32 + 8 * g + 4 * w.h) = pack4(acc[i][j][4 * g], acc[i][j][4 * g + 1], acc[i][j][4 * g + 2], acc[i][j][4 * g + 3]);
    }
  }
}

DI void gemm_c2_item(const Params& P, bf16* smem, int pt, int qt) {
  f32x16 acc[2][2];
  const float hs[2] = {1.f, 1.f};
  const int p0 = pt * 128, q0 = qt * 256;
  gemm_core<2, 2>(smem, 1024, 0,
      [&](int rp) { return P.win1t + (size_t)(p0 + rp) * 1024; },
      [&](int rq) { return P.h + (size_t)(q0 + rq) * 1024; }, acc, -1, hs);
  const WaveId w = wave_id();
  const int fb = (p0 + w.wr * 64) >> 6;
  const float qscale = 0.125f * LOG2E;
#pragma unroll
  for (int j = 0; j < 2; ++j) {
    const int tok = q0 + w.wc * 64 + j * 32 + w.r;
    int bmod, b, pos; bool lat; tok_info(tok, bmod, b, pos, lat);
    if (fb < 10) {
      const bool isq = fb < 8;
      const float* gain = isq ? P.swa_q_head_g : P.swa_k_head_g;
      float ss = 0.f;
#pragma unroll
      for (int i = 0; i < 2; ++i)
#pragma unroll
        for (int e = 0; e < 16; ++e) ss += acc[i][j][e] * acc[i][j][e];
      ss = xor32(ss);
      const float r2 = rsqrtf(ss * (1.f / 64.f) + EPS);
#pragma unroll
      for (int i = 0; i < 2; ++i)
#pragma unroll
        for (int g = 0; g < 4; ++g) {
          const f32x4 gg = *(const f32x4*)(gain + i * 32 + 8 * g + 4 * w.h);
#pragma unroll
          for (int e = 0; e < 4; ++e) acc[i][j][4 * g + e] *= r2 * gg[e];
        }
      if (lat) {
        const int sq = tok & (SEQ - 1), rowp = sq >> 6, colp = sq & 63;
#pragma unroll
        for (int e = 0; e < 4; ++e) {
          rope_pair(acc[0][j][e], acc[0][j][8 + e], P.ropeS + (rowp * 16 + 4 * w.h + e) * 2);
          rope_pair(acc[0][j][4 + e], acc[0][j][12 + e], P.ropeS + (rowp * 16 + 8 + 4 * w.h + e) * 2);
          rope_pair(acc[1][j][e], acc[1][j][8 + e], P.ropeS + (colp * 16 + 4 * w.h + e) * 2);
          rope_pair(acc[1][j][4 + e], acc[1][j][12 + e], P.ropeS + (colp * 16 + 8 + 4 * w.h + e) * 2);
        }
      }
      if (isq && !lat) continue;
      const float sc = isq ? qscale : 1.f;
      bf16* dst = isq ? P.qkv + Q2_OFF + ((size_t)(b * 8 + fb) * NPOS + pos) * 64
                      : P.qkv + K2_OFF + ((size_t)(b * 2 + (fb - 8)) * NPOS + pos) * 64;
#pragma unroll
      for (int i = 0; i < 2; ++i)
#pragma unroll
        for (int g = 0; g < 4; ++g)
          *(u32x2*)(dst + i * 32 + 8 * g + 4 * w.h) = pack4(acc[i][j][4 * g] * sc, acc[i][j][4 * g + 1] * sc, acc[i][j][4 * g + 2] * sc, acc[i][j][4 * g + 3] * sc);
    } else if (fb < 12) {
      const int posp = (pos & ~15) | swap23(pos & 15);
      bf16* vdst = P.qkv + V2T_OFF + (size_t)(b * 2 + (fb - 10)) * 64 * NPOS + posp;
#pragma unroll
      for (int i = 0; i < 2; ++i)
#pragma unroll
        for (int e = 0; e < 16; ++e) vdst[(size_t)(i * 32 + crow(e, w.h)) * NPOS] = f2bf(acc[i][j][e]);
    } else if (fb < 36) {
      bf16* dst = P.cbuf + (size_t)tok * C2LD + fb * 64;
#pragma unroll
      for (int i = 0; i < 2; ++i)
#pragma unroll
        for (int g = 0; g < 4; ++g)
          *(u32x2*)(dst + i * 32 + 8 * g + 4 * w.h) = pack4(acc[i][j][4 * g], acc[i][j][4 * g + 1], acc[i][j][4 * g + 2], acc[i][j][4 * g + 3]);
    } else if (fb == 36) {
#pragma unroll
      for (int g = 0; g < 2; ++g) {
        f32x4 o = {acc[0][j][4 * g], acc[0][j][4 * g + 1], acc[0][j][4 * g + 2], acc[0][j][4 * g + 3]};
        *(f32x4*)(P.dtr + (size_t)tok * 16 + 8 * g + 4 * w.h) = o;
      }
    }
  }
}
template <int DQK, bool WIN>
DI void attn_item(bf16* smem, const bf16* Qp, const bf16* Kp, const bf16* Vtp, int qrow0, int nq, int ntiles, int nctx, int band_k0, int q_lat0,
                  float negM, float sinkterm, bf16* outp) {
  constexpr int KS = DQK / 16, LDK = DQK + 8, LDV = 72, CPR = DQK / 8, NCK = 64 * CPR;
  const int tid = threadIdx.x, lane = tid & 63, w = tid >> 6, r = lane & 31, h = lane >> 5;
  bf16* sK = smem;
  bf16* sV = smem + 2 * 64 * LDK;
  bf16x8 qf[2][KS];
#pragma unroll
  for (int qt = 0; qt < 2; ++qt) {
    int qi = w * 64 + qt * 32 + r;
    if (qi > nq - 1) qi = nq - 1;
#pragma unroll
    for (int s = 0; s < KS; ++s) qf[qt][s] = *(const bf16x8*)(Qp + (size_t)(qrow0 + qi) * DQK + s * 16 + h * 8);
  }
  f32x16 O[2][2];
#pragma unroll
  for (int a = 0; a < 2; ++a)
#pragma unroll
    for (int b = 0; b < 2; ++b)
#pragma unroll
      for (int e = 0; e < 16; ++e) O[a][b][e] = 0.f;
  float lsum[2] = {0.f, 0.f};
  const int kr0 = tid / CPR, kc0 = tid % CPR;
  const int id1 = tid + 512;
  const bool has1 = id1 < NCK;
  const int kr1 = has1 ? id1 / CPR : 0, kc1 = has1 ? id1 % CPR : 0;
  const int vr = tid >> 3, vc = tid & 7;
  u32x4 rK0, rK1, rV;
  rK1 = rK0 = rV = u32x4{0, 0, 0, 0};
  auto tilepos = [&](int t) { return t < nctx ? t * 64 : LC + band_k0 + (t - nctx) * 64; };
  auto gload = [&](int t) {
    const int pos = tilepos(t);
    rK0 = *(const u32x4*)(Kp + (size_t)(pos + kr0) * DQK + kc0 * 8);
    if (has1) rK1 = *(const u32x4*)(Kp + (size_t)(pos + kr1) * DQK + kc1 * 8);
    rV = *(const u32x4*)(Vtp + (size_t)vr * NPOS + pos + vc * 8);
  };
  auto swrite = [&](int buf) {
    *(u32x4*)(sK + buf * 64 * LDK + kr0 * LDK + kc0 * 8) = rK0;
    if (has1) *(u32x4*)(sK + buf * 64 * LDK + kr1 * LDK + kc1 * 8) = rK1;
    *(u32x4*)(sV + buf * 64 * LDV + vr * LDV + vc * 8) = rV;
  };
  gload(0); swrite(0);
  __syncthreads();
  const int qw = q_lat0 + w * 64;
  for (int t = 0; t < ntiles; ++t) {
    const int buf = t & 1;
    if (t + 1 < ntiles) gload(t + 1);
    bool act = (w * 64 < nq);
    int kk0 = 0;
    const bool band = WIN && t >= nctx;
    if (band) { kk0 = band_k0 + (t - nctx) * 64; act = act && (kk0 + 63 >= qw - 128) && (kk0 <= qw + 191); }
    if (act) {
      const bf16* sKb = sK + buf * 64 * LDK;
      const bf16* sVb = sV + buf * 64 * LDV;
#pragma unroll 1
      for (int ksub = 0; ksub < 2; ++ksub) {
        bf16x8 pb[2][2];
        {
          bf16x8 kf[KS];
#pragma unroll
          for (int s = 0; s < KS; ++s) kf[s] = *(const bf16x8*)(sKb + (ksub * 32 + r) * LDK + s * 16 + h * 8);
#pragma unroll
          for (int qt = 0; qt < 2; ++qt) {
            f32x16 sc;
#pragma unroll
            for (int e = 0; e < 16; ++e) sc[e] = negM;
#pragma unroll
            for (int s = 0; s < KS; ++s) sc = mfma32(kf[s], qf[qt][s], sc);
            float p[16];
#pragma unroll
            for (int e = 0; e < 16; ++e) p[e] = __builtin_amdgcn_exp2f(sc[e]);
            if (band) {
              const int qi = qw + qt * 32 + r;
#pragma unroll
              for (int e = 0; e < 16; ++e) {
                const int dd = qi - (kk0 + ksub * 32 + crow(e, h));
                if (dd > 128 || dd < -128) p[e] = 0.f;
              }
            }
            float ps = 0.f;
#pragma unroll
            for (int e = 0; e < 16; ++e) ps += p[e];
            lsum[qt] += ps;
            float p0[8], p1[8];
#pragma unroll
            for (int e = 0; e < 8; ++e) { p0[e] = p[e]; p1[e] = p[8 + e]; }
            pb[qt][0] = pack8(p0); pb[qt][1] = pack8(p1);
          }
        }
#pragma unroll
        for (int dt = 0; dt < 2; ++dt)
#pragma unroll
          for (int st = 0; st < 2; ++st) {
            const bf16x8 vf = *(const bf16x8*)(sVb + (dt * 32 + r) * LDV + ksub * 32 + st * 16 + h * 8);
            O[0][dt] = mfma32(vf, pb[0][st], O[0][dt]);
            O[1][dt] = mfma32(vf, pb[1][st], O[1][dt]);
          }
      }
    }
    if (t + 1 < ntiles) swrite(buf ^ 1);
    __syncthreads();
  }
#pragma unroll
  for (int qt = 0; qt < 2; ++qt) {
    const float l = xor32(lsum[qt]) + sinkterm;
    const float inv = 1.f / l;
    const int qi = w * 64 + qt * 32 + r;
    if (qi < nq) {
      bf16* dst = outp + (size_t)qi * 1024;
#pragma unroll
      for (int dt = 0; dt < 2; ++dt)
#pragma unroll
        for (int g = 0; g < 4; ++g)
          *(u32x2*)(dst + dt * 32 + 8 * g + 4 * h) = pack4(O[qt][dt][4 * g] * inv, O[qt][dt][4 * g + 1] * inv, O[qt][dt][4 * g + 2] * inv, O[qt][dt][4 * g + 3] * inv);
    }
  }
}

DI void lru_item(const Params& P, const float* sTaps, int bi, int j, int ck, int pass) {
  const int lane = threadIdx.x & 63, col = lane & 15, g = lane >> 4;
  const bool isctx = ck < 2;
  const int L = isctx ? LC : SEQ;
  const int sp0 = isctx ? ck * 128 : (ck - 2) * 128;
  const int tokbase = isctx ? (NL + bi * LC + sp0) : (bi * SEQ + sp0);
  const bf16* C1 = P.cbuf;
  for (int dir = 0; dir < 2; ++dir) {
    bf16x8 wb[8][2];
#pragma unroll
    for (int n = 0; n < 8; ++n)
#pragma unroll
      for (int s = 0; s < 2; ++s)
        wb[n][s] = *(const bf16x8*)(P.wlrut + ((size_t)(((dir * 2 + (n >> 2)) * 8 + j) * 64 + 16 * (n & 3) + col)) * 64 + 32 * s + 8 * g);
    bf16x8 idf[4];
#pragma unroll
    for (int n = 0; n < 4; ++n)
#pragma unroll
      for (int jj = 0; jj < 8; ++jj) idf[n][jj] = ((8 * g + jj) == 16 * (n & 1) + col) ? (short)0x3F80 : (short)0;
    float ba[4], bx[4], sp[4], hst[4], arun[4];
#pragma unroll
    for (int n = 0; n < 4; ++n) {
      const int c = 64 * j + 16 * n + col;
      ba[n] = P.lru_b_a[dir * 512 + c];
      bx[n] = P.lru_b_x[dir * 512 + c];
      sp[n] = 8.f * softplusf_(-P.lru_lambda[dir * 512 + c]);
      hst[n] = 0.f; arun[n] = 1.f;
    }
    if (pass == 1) {
      const int npre = dir == 0 ? ck : (ck == 1 ? 0 : (ck == 0 ? 1 : 67 - ck));
      for (int i = 0; i < npre; ++i) {
        const int c = dir == 0 ? i : (i == 0 ? 1 : (i == 1 ? 0 : 67 - i));
#pragma unroll
        for (int n = 0; n < 4; ++n) {
          const f32x2 cm = *(const f32x2*)(P.comp + ((size_t)((bi * 2 + dir) * NCH + c) * 512 + 64 * j + 16 * n + col) * 2);
          hst[n] = cm[0] * hst[n] + cm[1];
        }
      }
    }
    for (int step = 0; step < 8; ++step) {
      const int st = dir ? 7 - step : step;
      const int t0 = st * 16;
      bf16x8 af[2];
      {
        const int t = t0 + col;
#pragma unroll
        for (int s = 0; s < 2; ++s) {
          const int c0 = 64 * j + 32 * s + 8 * g;
          float a8[8];
          {
            const f32x4 b0 = *(const f32x4*)(sTaps + 2048 + c0), b1 = *(const f32x4*)(sTaps + 2048 + c0 + 4);
            for (int i = 0; i < 4; ++i) { a8[i] = b0[i]; a8[4 + i] = b1[i]; }
          }
#pragma unroll
          for (int k = 0; k < 4; ++k) {
            const int tt = sp0 + t + k - 2;
            if (tt >= 0 && tt < L) {
              float x8[8];
              unpack8(*(const u32x4*)(C1 + (size_t)(tokbase + t + k - 2) * C1LD + 672 + c0), x8);
              const f32x4 w0 = *(const f32x4*)(sTaps + k * 512 + c0), w1 = *(const f32x4*)(sTaps + k * 512 + c0 + 4);
              for (int i = 0; i < 4; ++i) { a8[i] += w0[i] * x8[i]; a8[4 + i] += w1[i] * x8[4 + i]; }
            }
          }
          af[s] = pack8(a8);
        }
      }
      f32x4 ag[8], xcC[4];
      const f32x4 z4 = {0.f, 0.f, 0.f, 0.f};
#pragma unroll
      for (int n = 0; n < 8; ++n) { ag[n] = mfma16(af[0], wb[n][0], z4); ag[n] = mfma16(af[1], wb[n][1], ag[n]); }
#pragma unroll
      for (int n = 0; n < 4; ++n) xcC[n] = mfma16(af[n >> 1], idf[n], z4);
#pragma unroll
      for (int n = 0; n < 4; ++n) {
        float av[4], bv[4];
#pragma unroll
        for (int e = 0; e < 4; ++e) {
          const float rg = sigmoidf_(ag[n][e] + ba[n]);
          const float ig = sigmoidf_(ag[4 + n][e] + bx[n]);
          const float la = -sp[n] * rg;
          av[e] = __expf(la);
          bv[e] = sqrtf(fmaxf(-expm1f(2.f * la), 0.f)) * ig * xcC[n][e];
        }
        float A = 1.f, H = 0.f;
        if (dir == 0) { for (int e = 0; e < 4; ++e) { H = av[e] * H + bv[e]; A *= av[e]; } }
        else { for (int e = 3; e >= 0; --e) { H = av[e] * H + bv[e]; A *= av[e]; } }
        float A1, H1, Aex, Hex, At, Ht;
        if (dir == 0) {
          A1 = __shfl_up(A, 16); H1 = __shfl_up(H, 16);
          if (g >= 1) { H = A * H1 + H; A = A * A1; }
          A1 = __shfl_up(A, 32); H1 = __shfl_up(H, 32);
          if (g >= 2) { H = A * H1 + H; A = A * A1; }
          Aex = __shfl_up(A, 16); Hex = __shfl_up(H, 16);
          if (g == 0) { Aex = 1.f; Hex = 0.f; }
          At = __shfl(A, col + 48); Ht = __shfl(H, col + 48);
        } else {
          A1 = __shfl_down(A, 16); H1 = __shfl_down(H, 16);
          if (g <= 2) { H = A * H1 + H; A = A * A1; }
          A1 = __shfl_down(A, 32); H1 = __shfl_down(H, 32);
          if (g <= 1) { H = A * H1 + H; A = A * A1; }
          Aex = __shfl_down(A, 16); Hex = __shfl_down(H, 16);
          if (g == 3) { Aex = 1.f; Hex = 0.f; }
          At = __shfl(A, col); Ht = __shfl(H, col);
        }
        if (pass == 0) {
          hst[n] = At * hst[n] + Ht; arun[n] = At * arun[n];
        } else {
          float hc = Aex * hst[n] + Hex;
          hst[n] = At * hst[n] + Ht;
          float o[4];
          if (dir == 0) { for (int e = 0; e < 4; ++e) { hc = av[e] * hc + bv[e]; o[e] = hc; } }
          else { for (int e = 3; e >= 0; --e) { hc = av[e] * hc + bv[e]; o[e] = hc; } }
          const int c = 64 * j + 16 * n + col;
#pragma unroll
          for (int e = 0; e < 4; ++e) {
            const size_t tok = tokbase + t0 + 4 * g + e;
            bf16* yp = P.ycat + tok * 1024 + 512 + c;
            if (dir == 0) *yp = f2bf(o[e]);
            else {
              const float hf = bf2f(*yp);
              const float gr = bf2f(C1[tok * C1LD + 1184 + c]);
              *yp = f2bf((hf + o[e]) * geluf_(gr));
            }
          }
        }
      }
    }
    if (pass == 0 && g == 0) {
#pragma unroll
      for (int n = 0; n < 4; ++n) {
        f32x2 cm = {arun[n], hst[n]};
        *(f32x2*)(P.comp + ((size_t)((bi * 2 + dir) * NCH + ck) * 512 + 64 * j + 16 * n + col) * 2) = cm;
      }
    }
  }
}
DI void chunk_geom(int bi, int ck, int& L, int& sp0, int& tokbase, int& pos0) {
  const bool isctx = ck < 2;
  L = isctx ? LC : SEQ;
  sp0 = isctx ? ck * 128 : (ck - 2) * 128;
  tokbase = isctx ? (NL + bi * LC + sp0) : (bi * SEQ + sp0);
  pos0 = isctx ? sp0 : LC + sp0;
}

DI void ssd_conv_item(const Params& P, int gc, int cr) {
  const int bi = gc / NCH, ck = gc % NCH;
  int L, sp0, tokbase, pos0; chunk_geom(bi, ck, L, sp0, tokbase, pos0);
  const int tid = threadIdx.x, t = tid & 127, cg = tid >> 7;
  const int tok = tokbase + t, pos = pos0 + t, posp = (pos & ~15) | swap23(pos & 15);
  for (int i = 0; i < 8; ++i) {
    const int c0 = cr * 256 + cg * 64 + i * 8;
    float a8[8];
    {
      const f32x4 b0 = *(const f32x4*)(P.ssd_conv_b + c0), b1 = *(const f32x4*)(P.ssd_conv_b + c0 + 4);
      for (int e = 0; e < 4; ++e) { a8[e] = b0[e]; a8[4 + e] = b1[e]; }
    }
#pragma unroll
    for (int k = 0; k < 4; ++k) {
      const int tt = sp0 + t + k - 2;
      if (tt >= 0 && tt < L) {
        float x8[8];
        unpack8(*(const u32x4*)(P.cbuf + (size_t)(tok + k - 2) * C2LD + 1280 + c0), x8);
        const f32x4 w0 = *(const f32x4*)(P.ssd_conv_w + k * 1024 + c0), w1 = *(const f32x4*)(P.ssd_conv_w + k * 1024 + c0 + 4);
        for (int e = 0; e < 4; ++e) { a8[e] += w0[e] * x8[e]; a8[4 + e] += w1[e] * x8[4 + e]; }
      }
    }
#pragma unroll
    for (int e = 0; e < 8; ++e) a8[e] = siluf_(a8[e]);
    const bf16x8 o = pack8(a8);
    *(bf16x8*)(P.h + (size_t)tok * 1024 + c0) = o;
#pragma unroll
    for (int e = 0; e < 8; ++e) P.ut[((size_t)(bi * 1024 + c0 + e)) * NPOS + posp] = (bf16)o[e];
  }
}

DI void ssd_cumsum_item(const Params& P, int gc) {
  const int bi = gc / NCH, ck = gc % NCH;
  int L, sp0, tokbase, pos0; chunk_geom(bi, ck, L, sp0, tokbase, pos0);
  const int lane = threadIdx.x & 63;
  if (lane < 16) {
    const float A = -__expf(P.ssd_a_log[lane]);
    const float bias = P.ssd_dt_bias[lane];
    float cs = 0.f;
    for (int t = 0; t < 128; ++t) {
      const size_t o = (size_t)(tokbase + t) * 16 + lane;
      const float dt = softplusf_(P.dtr[o] + bias);
      cs += dt * A;
      P.dtv[o] = dt;
      P.acs[o] = cs;
    }
  }
}

DI void ssd_passA_item(const Params& P, int gc, int hd, int dir, int pt, int nt) {
  const int bi = gc / NCH, ck = gc % NCH;
  int L, sp0, tokbase, pos0; chunk_geom(bi, ck, L, sp0, tokbase, pos0);
  const int lane = threadIdx.x & 63, r = lane & 31, h = lane >> 5;
  const int idx = dir * 8 + hd, grp = hd >> 2;
  const float total = P.acs[(size_t)(tokbase + 127) * 16 + idx];
  const float Ah = -__expf(P.ssd_a_log[idx]);
  const bf16* xrow = P.ut + ((size_t)(bi * 1024 + hd * 64 + 32 * pt + r)) * NPOS + pos0;
  const bf16* brow = P.ut + ((size_t)(bi * 1024 + 512 + grp * 128 + 32 * nt + r)) * NPOS + pos0;
  f32x16 acc;
#pragma unroll
  for (int e = 0; e < 16; ++e) acc[e] = 0.f;
#pragma unroll
  for (int ks = 0; ks < 8; ++ks) {
    const bf16x8 af = *(const bf16x8*)(xrow + 16 * ks + 8 * h);
    float b8[8];
    unpack8(*(const u32x4*)(brow + 16 * ks + 8 * h), b8);
#pragma unroll
    for (int jj = 0; jj < 8; ++jj) {
      const int l = 16 * ks + 8 * (jj >> 2) + 4 * h + (jj & 3);
      const size_t o = (size_t)(tokbase + l) * 16 + idx;
      const float dt = P.dtv[o], cs = P.acs[o];
      const float wgt = dir == 0 ? dt * __expf(total - cs) : dt * __expf(cs - dt * Ah);
      b8[jj] *= wgt;
    }
    acc = mfma32(af, pack8(b8), acc);
  }
  bf16* dst = P.qkv + ST_OFF + ((size_t)(((bi * 2 + dir) * 8 + hd) * NCH + ck)) * 8192 + 32 * nt + r;
#pragma unroll
  for (int e = 0; e < 16; ++e) dst[(32 * pt + crow(e, h)) * 128] = f2bf(acc[e]);
}

DI void ssd_passB(const Params& P, int bid, int nblk) {
  const int nthr = nblk * 512;
  for (int id = bid * 512 + threadIdx.x; id < NB * 2 * 8 * 2048; id += nthr) {
    const int e4 = id & 2047, hd = (id >> 11) & 7, dir = (id >> 14) & 1, bi = id >> 15;
    bf16* base = P.qkv + ST_OFF + ((size_t)((bi * 2 + dir) * 8 + hd)) * NCH * 8192 + e4 * 4;
    const int idx = dir * 8 + hd;
    float S0 = 0.f, S1 = 0.f, S2 = 0.f, S3 = 0.f;
    for (int i0 = 0; i0 < NCH; i0 += 6) {
      u32x2 raw[6]; float dec[6]; int cks[6];
#pragma unroll
      for (int u = 0; u < 6; ++u) {
        const int i = i0 + u;
        const int ck = dir == 0 ? i : (i == 0 ? 1 : (i == 1 ? 0 : 67 - i));
        cks[u] = ck;
        int L, sp0, tokbase, pos0; chunk_geom(bi, ck, L, sp0, tokbase, pos0);
        raw[u] = *(const u32x2*)(base + (size_t)ck * 8192);
        dec[u] = __expf(P.acs[(size_t)(tokbase + 127) * 16 + idx]);
      }
#pragma unroll
      for (int u = 0; u < 6; ++u) {
        *(u32x2*)(base + (size_t)cks[u] * 8192) = pack4(S0, S1, S2, S3);
        S0 = dec[u] * S0 + lo16(raw[u][0]); S1 = dec[u] * S1 + hi16(raw[u][0]);
        S2 = dec[u] * S2 + lo16(raw[u][1]); S3 = dec[u] * S3 + hi16(raw[u][1]);
      }
    }
  }
}

DI void ssd_passC_item(const Params& P, int bi, int ck, int hd, int lt) {
  int L, sp0, tokbase, pos0; chunk_geom(bi, ck, L, sp0, tokbase, pos0);
  const int lane = threadIdx.x & 63, r = lane & 31, h = lane >> 5;
  const int grp = hd >> 2;
  const int l = lt * 32 + r;
  const size_t tok = tokbase + l;
  const bf16* U = P.h;
  bf16x8 cfr[8];
#pragma unroll
  for (int ks = 0; ks < 8; ++ks) cfr[ks] = *(const bf16x8*)(U + tok * 1024 + 768 + grp * 128 + 16 * ks + 8 * h);
  f32x16 acc[2];
#pragma unroll
  for (int pt = 0; pt < 2; ++pt)
#pragma unroll
    for (int e = 0; e < 16; ++e) acc[pt][e] = 0.f;
  for (int dir = 0; dir < 2; ++dir) {
    const int idx = dir * 8 + hd;
    const float Ah = -__expf(P.ssd_a_log[idx]);
    const float csl = P.acs[tok * 16 + idx], dtl = P.dtv[tok * 16 + idx];
    const float exl = csl - dtl * Ah;
    const float total = P.acs[(size_t)(tokbase + 127) * 16 + idx];
    const float fac = dir == 0 ? __expf(csl) : __expf(total - exl);
#pragma unroll
    for (int pt = 0; pt < 2; ++pt) {
      f32x16 yo;
#pragma unroll
      for (int e = 0; e < 16; ++e) yo[e] = 0.f;
      const bf16* srow = P.qkv + ST_OFF + ((size_t)(((bi * 2 + dir) * 8 + hd) * NCH + ck)) * 8192 + (32 * pt + r) * 128;
#pragma unroll
      for (int ks = 0; ks < 8; ++ks) yo = mfma32(*(const bf16x8*)(srow + 16 * ks + 8 * h), cfr[ks], yo);
#pragma unroll
      for (int e = 0; e < 16; ++e) acc[pt][e] += fac * yo[e];
    }
    const int st_lo = dir == 0 ? 0 : lt, st_hi = dir == 0 ? lt : 3;
    for (int st = st_lo; st <= st_hi; ++st) {
      f32x16 G;
#pragma unroll
      for (int e = 0; e < 16; ++e) G[e] = 0.f;
      const bf16* brow = U + (size_t)(tokbase + st * 32 + r) * 1024 + 512 + grp * 128;
#pragma unroll
      for (int ks = 0; ks < 8; ++ks) G = mfma32(*(const bf16x8*)(brow + 16 * ks + 8 * h), cfr[ks], G);
      float m[16];
#pragma unroll
      for (int e = 0; e < 16; ++e) {
        const int s = st * 32 + crow(e, h);
        const size_t o = (size_t)(tokbase + s) * 16 + idx;
        const float cs_s = P.acs[o], dt_s = P.dtv[o];
        float v;
        if (dir == 0) v = (s <= l) ? G[e] * __expf(csl - cs_s) * dt_s : 0.f;
        else v = (s >= l) ? G[e] * __expf((cs_s - dt_s * Ah) - exl) * dt_s : 0.f;
        m[e] = v;
      }
      float m0[8], m1[8];
#pragma unroll
      for (int e = 0; e < 8; ++e) { m0[e] = m[e]; m1[e] = m[8 + e]; }
      const bf16x8 pb0 = pack8(m0), pb1 = pack8(m1);
#pragma unroll
      for (int pt = 0; pt < 2; ++pt) {
        const bf16* xrow = P.ut + ((size_t)(bi * 1024 + hd * 64 + 32 * pt + r)) * NPOS + pos0 + st * 32;
        acc[pt] = mfma32(*(const bf16x8*)(xrow + 8 * h), pb0, acc[pt]);
        acc[pt] = mfma32(*(const bf16x8*)(xrow + 16 + 8 * h), pb1, acc[pt]);
      }
    }
  }
  const float dsk = P.ssd_d[hd] + P.ssd_d[8 + hd];
  float ss = 0.f;
#pragma unroll
  for (int pt = 0; pt < 2; ++pt)
#pragma unroll
    for (int g = 0; g < 4; ++g) {
      const int p0 = 32 * pt + 8 * g + 4 * h;
      const u32x2 xr = *(const u32x2*)(U + tok * 1024 + hd * 64 + p0);
      const u32x2 zr = *(const u32x2*)(P.cbuf + tok * C2LD + 768 + hd * 64 + p0);
      const float xs[4] = {lo16(xr[0]), hi16(xr[0]), lo16(xr[1]), hi16(xr[1])};
      const float zz[4] = {lo16(zr[0]), hi16(zr[0]), lo16(zr[1]), hi16(zr[1])};
      float o[4];
#pragma unroll
      for (int e = 0; e < 4; ++e) { o[e] = (acc[pt][4 * g + e] + dsk * xs[e]) * siluf_(zz[e]); ss += o[e] * o[e]; }
      *(u32x2*)(P.ycat + tok * 1024 + 512 + hd * 64 + p0) = pack4(o[0], o[1], o[2], o[3]);
    }
  ss = xor32(ss);
  if (h == 0) P.ssq2[tok * 8 + hd] = ss;
}

DI void row_pass(const Params& P, int mode, int layer, int tok, const int* sOff) {
  const int lane = threadIdx.x & 63;
  int bmod, b, pos; bool lat; tok_info(tok, bmod, b, pos, lat);
  const float* src = mode == 0 ? (lat ? P.x + (size_t)tok * 1024 : P.ctx + (size_t)(tok - NL) * 1024)
                               : (lat ? P.out + (size_t)tok * 1024 : P.xc + (size_t)(tok - NL) * 1024);
  f32x4 v[4];
#pragma unroll
  for (int i = 0; i < 4; ++i) v[i] = *(const f32x4*)(src + 4 * lane + 256 * i);
  if (mode == 1 || mode == 2) {
    const int* ti = P.tokinfo + (size_t)tok * 4;
    const int s0 = sOff[ti[0]] + ti[1], s1 = sOff[ti[2]] + ti[3];
    const float w0 = P.tokw[tok * 2], w1 = P.tokw[tok * 2 + 1];
    const float* m5 = P.mods + ((size_t)((mode - 1) * 5 + bmod) * 6 + 5) * 1024;
    float* dst = lat ? P.out + (size_t)tok * 1024 : P.xc + (size_t)(tok - NL) * 1024;
#pragma unroll
    for (int i = 0; i < 4; ++i) {
      const int k = 4 * lane + 256 * i;
      const u32x2 y0 = *(const u32x2*)(P.qkv + (size_t)s0 * 1024 + k), y1 = *(const u32x2*)(P.qkv + (size_t)s1 * 1024 + k);
      const f32x4 mv = *(const f32x4*)(m5 + k);
      v[i][0] += mv[0] * (w0 * lo16(y0[0]) + w1 * lo16(y1[0]));
      v[i][1] += mv[1] * (w0 * hi16(y0[0]) + w1 * hi16(y1[0]));
      v[i][2] += mv[2] * (w0 * lo16(y0[1]) + w1 * lo16(y1[1]));
      v[i][3] += mv[3] * (w0 * hi16(y0[1]) + w1 * hi16(y1[1]));
      *(f32x4*)(dst + k) = v[i];
    }
    if (mode == 2) return;
  }
  float ss = 0.f;
#pragma unroll
  for (int i = 0; i < 4; ++i) ss += v[i][0] * v[i][0] + v[i][1] * v[i][1] + v[i][2] * v[i][2] + v[i][3] * v[i][3];
  ss = wave_sum(ss);
  const float rstd = rsqrtf(ss * (1.f / 1024.f) + EPS);
  const bool n2 = mode == 3;
  const float* g1 = (n2 ? P.norm2_g : P.norm1_g) + layer * 1024;
  const float* sh = P.mods + ((size_t)(layer * 5 + bmod) * 6 + (n2 ? 3 : 0)) * 1024;
  const float* sc = P.mods + ((size_t)(layer * 5 + bmod) * 6 + (n2 ? 4 : 1)) * 1024;
#pragma unroll
  for (int i = 0; i < 4; ++i) {
    const int k = 4 * lane + 256 * i;
    const f32x4 gv = *(const f32x4*)(g1 + k), sv = *(const f32x4*)(sc + k), hv = *(const f32x4*)(sh + k);
    float o[4];
#pragma unroll
    for (int e = 0; e < 4; ++e) o[e] = v[i][e] * rstd * gv[e] * (1.f + sv[e]) + hv[e];
    const u32x2 hi = pack4(o[0], o[1], o[2], o[3]);
    *(u32x2*)(P.h + (size_t)tok * 1024 + k) = hi;
    if (n2) {
      const float r0 = o[0] - lo16(hi[0]), r1 = o[1] - hi16(hi[0]), r2 = o[2] - lo16(hi[1]), r3 = o[3] - hi16(hi[1]);
      *(u32x2*)(P.ycat + (size_t)tok * 1024 + k) = pack4(r0, r1, r2, r3);
    }
  }
}

DI void router_topk(const Params& P, int layer, int tok, const f32x16& acc, int kk, bool active, int* sCnt) {
  float lo[16], hi[16];
#pragma unroll
  for (int i = 0; i < 16; ++i) { const float oth = __shfl_xor(acc[i], 32); lo[i] = kk == 0 ? acc[i] : oth; hi[i] = kk == 0 ? oth : acc[i]; }
  float bestg = -3.0e38f, bu0 = 0.f, bu1 = 0.f;
  int be0 = 0, be1 = 0;
#pragma unroll
  for (int q = 0; q < 4; ++q) {
    float v1 = -3.0e38f, v2 = -3.0e38f, u1 = 0.f, u2 = 0.f;
    int i1 = 0, i2 = 0;
#pragma unroll
    for (int m = 0; m < 8; ++m) {
      const float lg = m < 4 ? lo[4 * q + (m & 3)] : hi[4 * q + (m & 3)];
      const float u = 1.f / (1.f + expf(-lg));
      const float xb = u + P.router_b[8 * q + m];
      if (xb > v1) { v2 = v1; i2 = i1; u2 = u1; v1 = xb; i1 = m; u1 = u; }
      else if (xb > v2) { v2 = xb; i2 = m; u2 = u; }
    }
    const float gs = v1 + v2;
    if (gs > bestg) { bestg = gs; be0 = 8 * q + i1; be1 = 8 * q + i2; bu0 = u1; bu1 = u2; }
  }
  const int tid = threadIdx.x;
  if (tid < 32) sCnt[tid] = 0;
  __syncthreads();
  int r0 = 0, r1 = 0;
  if (active && kk == 0) { r0 = atomicAdd(&sCnt[be0], 1); r1 = atomicAdd(&sCnt[be1], 1); }
  __syncthreads();
  if (tid < 32) sCnt[32 + tid] = atomicAdd(P.cnt + layer * 32 + tid, sCnt[tid]);
  __syncthreads();
  if (active && kk == 0) {
    const float inv = 1.f / (bu0 + bu1);
    const int p0 = sCnt[32 + be0] + r0, p1 = sCnt[32 + be1] + r1;
    int* ti = P.tokinfo + (size_t)tok * 4;
    ti[0] = be0; ti[1] = p0; ti[2] = be1; ti[3] = p1;
    P.tokw[tok * 2] = bu0 * inv; P.tokw[tok * 2 + 1] = bu1 * inv;
    P.list[(size_t)be0 * NT + p0] = tok;
    P.list[(size_t)be1 * NT + p1] = tok;
  }
  __syncthreads();
}
DI void router_item(const Params& P, bf16* smem, int layer, int qt) {
  f32x16 acc[1][1];
  const float hs[1] = {1.f};
  const int q0 = qt * 128;
  gemm_core<1, 1, true>(smem, 1024, 0, [&](int rp) { return P.wrt + (size_t)rp * 3072; }, [&](int rq) { return P.h + (size_t)(q0 + rq) * 1024; }, acc, -1, hs);
  gemm_core<1, 1, false>(smem, 1024, 0, [&](int rp) { return P.wrt + (size_t)rp * 3072 + 1024; }, [&](int rq) { return P.h + (size_t)(q0 + rq) * 1024; }, acc, -1, hs);
  gemm_core<1, 1, false>(smem, 1024, 0, [&](int rp) { return P.wrt + (size_t)rp * 3072 + 2048; }, [&](int rq) { return P.ycat + (size_t)(q0 + rq) * 1024; }, acc, -1, hs);
  const WaveId w = wave_id();
  router_topk(P, layer, q0 + w.wc * 32 + w.r, acc[0][0], w.h, w.wr == 0, (int*)(smem + 32768));
}
DI void conv_tile(float* sT, const float* src, int K, int N, bf16* dst, int dld, int rmode, const float* scale, int koff, int tk, int tn) {
  const int tid = threadIdx.x;
  const int k0 = tk * 64, n0 = tn * 64;
  {
    const int kk = tid >> 4, n4 = (tid & 15) * 4;
#pragma unroll
    for (int p = 0; p < 2; ++p) {
      const int k = k0 + kk + 32 * p;
      f32x4 v = {0.f, 0.f, 0.f, 0.f};
      if (n0 + n4 < N) v = *(const f32x4*)(src + (size_t)k * N + n0 + n4);
      float s = 1.f;
      if (scale != nullptr && k >= koff) s = scale[k - koff];
#pragma unroll
      for (int e = 0; e < 4; ++e) sT[(kk + 32 * p) * 65 + n4 + e] = v[e] * s;
    }
  }
  __syncthreads();
  {
    const int n = tid >> 3, kc = (tid & 7) * 8;
    if (n0 + n < N) {
      float v8[8];
#pragma unroll
      for (int e = 0; e < 8; ++e) v8[e] = sT[(kc + e) * 65 + n];
      const int nn = n0 + n;
      const int row = rmode == 0 ? nn : (64 * (nn >> 5) + (nn & 31) + (rmode == 2 ? 32 : 0));
      *(bf16x8*)(dst + (size_t)row * dld + k0 + kc) = pack8(v8);
    }
  }
  __syncthreads();
}

DI void conv_moe_tile(const Params& P, float* sT, int layer, int t) {
  const int e = t / 384, u = t % 384;
  if (u < 128) conv_tile(sT, P.moe_w_gate + ((size_t)(layer * 32 + e)) * 1024 * 512, 1024, 512, P.wgut + (size_t)e * 1024 * 1024, 1024, 1, nullptr, 0, u >> 3, u & 7);
  else if (u < 256) conv_tile(sT, P.moe_w_up + ((size_t)(layer * 32 + e)) * 1024 * 512, 1024, 512, P.wgut + (size_t)e * 1024 * 1024, 1024, 2, nullptr, 0, (u - 128) >> 3, (u - 128) & 7);
  else conv_tile(sT, P.moe_w_down + ((size_t)(layer * 32 + e)) * 512 * 1024, 512, 1024, P.wdt + (size_t)e * 1024 * 512, 512, 0, nullptr, 0, (u - 256) >> 4, (u - 256) & 15);
}

constexpr int NCONV_DENSE = 432 + 72 + 64 + 256 + 592 + 256 + 32;
DI void conv_dense_tile(const Params& P, float* sT, int t) {
  if (t < 432) { conv_tile(sT, P.ab_w_in, 1024, 1696, P.win0t, 1024, 0, nullptr, 0, t / 27, t % 27); return; }
  t -= 432;
  if (t < 72) { conv_tile(sT, P.mla_w_q_up, 384, 768, P.wqt, 384, 0, P.mla_q_norm_g, 0, t / 12, t % 12); return; }
  t -= 72;
  if (t < 64) { conv_tile(sT, P.mla_w_kv_up, 256, 1024, P.wkvt, 256, 0, P.mla_kv_norm_g, 0, t / 16, t % 16); return; }
  t -= 64;
  if (t < 256) { conv_tile(sT, P.ab_w_out, 1024, 1024, P.wout0t, 1024, 0, nullptr, 0, t / 16, t % 16); return; }
  t -= 256;
  if (t < 592) { conv_tile(sT, P.cd_w_in, 1024, 2320, P.win1t, 1024, 0, nullptr, 0, t / 37, t % 37); return; }
  t -= 592;
  if (t < 256) { conv_tile(sT, P.cd_w_out, 1024, 1024, P.wout1t, 1024, 0, P.ssd_norm_g, 512, t / 16, t % 16); return; }
  t -= 256;
  {
    const int blk = t & 7, gate = (t >> 3) & 1, dir = t >> 4;
    const float* src = (gate ? P.lru_w_x : P.lru_w_a) + ((size_t)(dir * 8 + blk)) * 4096;
    conv_tile(sT, src, 64, 64, P.wlrut + ((size_t)((dir * 2 + gate) * 8 + blk)) * 4096, 64, 0, nullptr, 0, 0, 0);
  }
}

DI void mods_item(const Params& P, float* sS, float* sR, int layer, int cb) {
  const int tid = threadIdx.x, col = tid & 63, kq = tid >> 6;
  float a[5] = {0.f, 0.f, 0.f, 0.f, 0.f};
  const float* wp = P.ada_w + (size_t)layer * 1024 * 6144 + cb * 64 + col;
  for (int k = kq * 128; k < kq * 128 + 128; ++k) {
    const float wv = wp[(size_t)k * 6144];
#pragma unroll
    for (int v = 0; v < 5; ++v) a[v] += sS[v * 1024 + k] * wv;
  }
#pragma unroll
  for (int v = 0; v < 5; ++v) sR[(kq * 5 + v) * 64 + col] = a[v];
  __syncthreads();
  if (tid < 320) {
    const int v = tid >> 6;
    float s = P.ada_b[layer * 6144 + cb * 64 + col];
    for (int q = 0; q < 8; ++q) s += sR[(q * 5 + v) * 64 + col];
    P.mods[((size_t)(layer * 5 + v)) * 6144 + cb * 64 + col] = s;
  }
  __syncthreads();
}

constexpr int NPHASE = 22;
constexpr int GEMM_LDS = (256 + 256) * 2 * 72 * 2;

DI void run_phase(const Params& P, int ph, unsigned char* lds, int bid, int nblk) {
  bf16* smem = (bf16*)lds;
  float* fsm = (float*)lds;
  int* ism = (int*)lds;
  const int tid = threadIdx.x, wid = tid >> 6;
  const int gw = bid * 8 + wid, ngw = nblk * 8;
  const int nrep = 1 + ((P.pad0 >> ph) & 1);
#define REP for (int rep_ = 0; rep_ < nrep; ++rep_)
#define REPB(bit) for (int rep_ = 0, nr_ = 1 + ((P.pad0 >> (bit)) & 1); rep_ < nr_; ++rep_)
  switch (ph) {
    case 0: {
      if (bid == 0) {
        if (tid < 64) P.cnt[tid] = 0;
        for (int i = tid; i < 128 * 8; i += 512) {
          const int p = i >> 3, f = i & 7;
          float rev = (float)p * __builtin_amdgcn_exp2f(-(float)f * (13.287712379549449f / 8.f)) * 0.15915494309189535f;
          rev -= floorf(rev);
          P.ropeM[i * 2] = __builtin_amdgcn_cosf(rev); P.ropeM[i * 2 + 1] = __builtin_amdgcn_sinf(rev);
        }
        for (int i = tid; i < 128 * 16; i += 512) {
          const int p = i >> 4, f = i & 15;
          float rev = (float)p * __builtin_amdgcn_exp2f(-(float)f * (13.287712379549449f / 16.f)) * 0.15915494309189535f;
          rev -= floorf(rev);
          P.ropeS[i * 2] = __builtin_amdgcn_cosf(rev); P.ropeS[i * 2 + 1] = __builtin_amdgcn_sinf(rev);
        }
        if (tid == 0) {
          float gq = 0.f, gk = 0.f, sq = 0.f, sk = 0.f, sm = 0.f;
          for (int i = 0; i < 96; ++i) { gq = fmaxf(gq, fabsf(P.mla_q_head_g[i])); gk = fmaxf(gk, fabsf(P.mla_k_head_g[i])); }
          for (int i = 0; i < 64; ++i) { sq = fmaxf(sq, fabsf(P.swa_q_head_g[i])); sk = fmaxf(sk, fabsf(P.swa_k_head_g[i])); }
          for (int i = 0; i < 8; ++i) sm = fmaxf(sm, P.swa_sink[i]);
          P.msh[0] = 9.797958971132712f * gq * gk * LOG2E;
          P.msh[1] = fmaxf(8.f * sq * sk, sm) * LOG2E;
        }
      }
      for (int i = bid * 512 + tid; i < 64 * 1024; i += nblk * 512) {
        const int e = i >> 10, k = i & 1023;
        bf16 hi = 0, lo = 0;
        if (e < 32) { const float wv = P.router_w[k * 32 + e]; hi = f2bf(wv); lo = f2bf(wv - bf2f(hi)); }
        P.wrt[(size_t)e * 3072 + k] = hi; P.wrt[(size_t)e * 3072 + 1024 + k] = lo; P.wrt[(size_t)e * 3072 + 2048 + k] = hi;
      }
      for (int i = tid; i < 5 * 1024; i += 512) {
        const float v = i < 4096 ? P.c[i] : P.c_ctx[i - 4096];
        fsm[i] = siluf_(v);
      }
      __syncthreads();
      REPB(24) for (int it = bid; it < 2 * 96; it += nblk) mods_item(P, fsm, fsm + 5120, it / 96, it % 96);
      __syncthreads();
      REP for (int it = bid; it < NCONV_DENSE + 32 * 384; it += nblk) {
        if (it < NCONV_DENSE) conv_dense_tile(P, fsm, it); else conv_moe_tile(P, fsm, 0, it - NCONV_DENSE);
      }
    } break;
    case 1: {
      REP for (int tok = gw; tok < NT; tok += ngw) row_pass(P, 0, 0, tok, nullptr);
    } break;
    case 2: {
      REP for (int it = bid; it < 14 * 132; it += nblk) gemm_c1_item(P, smem, it % 14, it / 14);
    } break;
    case 3: {
      REP for (int it = bid; it < 264 * 8; it += nblk) {
        const int qt = it >> 3, u = it & 7;
        if (u < 4) gemm_q_item(P, smem, u, qt); else gemm_kv_item(P, smem, u - 4, qt);
      }
      __syncthreads();
      for (int i = tid; i < 2560; i += 512) fsm[i] = i < 2048 ? P.lru_conv_w[i] : P.lru_conv_b[i - 2048];
      __syncthreads();
      REPB(20) for (int it = gw; it < NB * 8 * NCH; it += ngw) lru_item(P, fsm, it / (8 * NCH), (it / NCH) & 7, it % NCH, 0);
    } break;
    case 4: {
      for (int i = tid; i < 2560; i += 512) fsm[i] = i < 2048 ? P.lru_conv_w[i] : P.lru_conv_b[i - 2048];
      __syncthreads();
      REPB(21) for (int it = gw; it < NB * 8 * NCH; it += ngw) lru_item(P, fsm, it / (8 * NCH), (it / NCH) & 7, it % NCH, 1);
      __syncthreads();
      const float negM = -P.msh[0];
      REP for (int it = bid; it < 32 + 512; it += nblk) {
        if (it < 32) {
          const int b = it >> 3, hd = it & 7;
          const size_t hb = (size_t)(b * 8 + hd) * NPOS;
          attn_item<96, false>(smem, P.qkv + QB_OFF + hb * 96, P.qkv + KB_OFF + hb * 96, P.qkv + VT_OFF + hb * 64, 0, 256, 4, 4, 0, 0, negM, 0.f,
                               P.ycat + (size_t)(NL + b * LC) * 1024 + hd * 64);
        } else {
          const int u = it - 32, qb = u & 15, hd = (u >> 4) & 7, b = u >> 7;
          const size_t hb = (size_t)(b * 8 + hd) * NPOS;
          attn_item<96, false>(smem, P.qkv + QB_OFF + hb * 96, P.qkv + KB_OFF + hb * 96, P.qkv + VT_OFF + hb * 64, LC + qb * 512, 512, 132, 132, 0, 0, negM, 0.f,
                               P.ycat + (size_t)(b * SEQ + qb * 512) * 1024 + hd * 64);
        }
      }
    } break;
    case 5: {
      REP for (int it = bid; it < 8 * 132; it += nblk) gemm_out_item(P, smem, 0, it & 7, it >> 3);
    } break;
    case 6: case 17: {
      const int layer = ph == 6 ? 0 : 1;
      const int ntok = layer == 0 ? NT : NL;
      REP for (int tok = gw; tok < ntok; tok += ngw) row_pass(P, 3, layer, tok, nullptr);
      if (layer == 1) {
        __syncthreads();
        for (int it = bid; it < 32 * 384; it += nblk) conv_moe_tile(P, fsm, 1, it);
      }
    } break;
    case 7: case 18: {
      const int layer = ph == 7 ? 0 : 1;
      const int nit = (layer == 0 ? NT : NL) / 128;
      for (int it = bid; it < nit; it += nblk) router_item(P, smem, layer, it);
    } break;
    case 8: case 9: case 19: case 20: {
      const int layer = ph >= 19 ? 1 : 0;
      const bool second = (ph == 9 || ph == 20);
      __syncthreads();
      if (tid == 0) {
        int off = 0, toff = 0;
        for (int e = 0; e < 32; ++e) { const int c = P.cnt[layer * 32 + e]; ism[e] = c; ism[32 + e] = off; ism[65 + e] = toff; off += c; toff += (c + 255) >> 8; }
        ism[64] = off; ism[97] = toff;
      }
      __syncthreads();
      const int ntile = ism[97], total = ism[64];
      REP for (int it = bid; it < ntile * 8; it += nblk) {
        const int mtg = it >> 3, pt = it & 7;
        int e = 0;
        while (e < 31 && ism[65 + e + 1] <= mtg) ++e;
        const int m0 = (mtg - ism[65 + e]) * 256, cnt_e = ism[e], off_e = ism[32 + e];
        bf16* gsm = smem + 256;
        if (!second) moe1_item(P, gsm, layer, e, m0, pt, cnt_e, off_e); else moe2_item(P, gsm, e, m0, pt, cnt_e, off_e, total);
      }
    } break;
    case 10: case 21: {
      const int layer = ph == 10 ? 0 : 1;
      __syncthreads();
      if (tid == 0) { int off = 0; for (int e = 0; e < 32; ++e) { ism[e] = off; off += P.cnt[layer * 32 + e]; } }
      __syncthreads();
      const int ntok = layer == 0 ? NT : NL;
      for (int tok = gw; tok < ntok; tok += ngw) row_pass(P, layer == 0 ? 1 : 2, 1, tok, ism);
    } break;
    case 11: {
      REP for (int it = bid; it < 19 * 132; it += nblk) gemm_c2_item(P, smem, it % 19, it / 19);
    } break;
    case 12: {
      REPB(22) for (int it = gw; it < NB * NCH; it += ngw) ssd_cumsum_item(P, it);
      REPB(23) for (int it = bid; it < NB * NCH * 4; it += nblk) ssd_conv_item(P, it >> 2, it & 3);
      __syncthreads();
      const float negM = -P.msh[1];
      REP for (int it = bid; it < 512; it += nblk) {
        const int qb = it & 15, hq = (it >> 4) & 7, b = it >> 7;
        const size_t hb = (size_t)(b * 8 + hq) * NPOS, kb = (size_t)(b * 2 + (hq >> 2)) * NPOS;
        const int k0 = qb * 512 - 128 < 0 ? 0 : qb * 512 - 128;
        const int k1 = qb * 512 + 640 > SEQ ? SEQ : qb * 512 + 640;
        const float sinkterm = __builtin_amdgcn_exp2f(P.swa_sink[hq] * LOG2E + negM);
        attn_item<64, true>(smem, P.qkv + Q2_OFF + hb * 64, P.qkv + K2_OFF + kb * 64, P.qkv + V2T_OFF + kb * 64, LC + qb * 512, 512, 4 + (k1 - k0) / 64, 4, k0, qb * 512,
                            negM, sinkterm, P.ycat + (size_t)(b * SEQ + qb * 512) * 1024 + hq * 64);
      }
    } break;
    case 13: {
      REP for (int it = gw; it < NB * NCH * 8 * 2 * 8; it += ngw) {
        const int tile = it & 7, dir = (it >> 3) & 1, hd = (it >> 4) & 7, gc = it >> 7;
        ssd_passA_item(P, gc, hd, dir, tile >> 2, tile & 3);
      }
    } break;
    case 14: ssd_passB(P, bid, nblk); break;
    case 15: {
      REP for (int it = gw; it < NB * 64 * 8 * 4; it += ngw) {
        const int lt = it & 3, hd = (it >> 2) & 7, c = (it >> 5) & 63, bi = it >> 11;
        ssd_passC_item(P, bi, c + 2, hd, lt);
      }
    } break;
    case 16: {
      for (int it = bid; it < 8 * 128; it += nblk) gemm_out_item(P, smem, 1, it & 7, it >> 3);
    } break;
    default: break;
  }
}
#define XB_TMO      128
#define XB_XCNT(j)  (256  + 64 * (j))
#define XB_XSUB(j)  (1280 + 64 * (j))
#define XB_XGEN(j)  (2304 + 64 * (j))
#define XB_TOP      3328
#define XB_TOPGEN   3392
#define XCD_BAR_WORDS 3456
#define XB_SPIN_CAP (1u << 22)
#define LAS __attribute__((address_space(3)))
DI unsigned xb_ld(unsigned* p) { return __hip_atomic_load(p, __ATOMIC_RELAXED, __HIP_MEMORY_SCOPE_AGENT); }
DI unsigned xb_add(unsigned* p, unsigned v) { return __hip_atomic_fetch_add(p, v, __ATOMIC_RELAXED, __HIP_MEMORY_SCOPE_AGENT); }
DI unsigned xb_xcc_id() { return (unsigned)__builtin_amdgcn_s_getreg((3 << 11) | 20) & 0xFu; }
#define XB_SPIN(cond, bar) do { unsigned _sp = 0; while (cond) { __builtin_amdgcn_s_sleep(1); \
    if ((++_sp & 255u) == 0u) { if (xb_ld(&(bar)[XB_TMO])) break; if (_sp > XB_SPIN_CAP) { atomicAdd(&(bar)[XB_TMO], 1u); break; } } } } while (0)
struct XcdBarrier { unsigned* bar; unsigned x; volatile LAS unsigned* st; };
DI XcdBarrier xcd_barrier_post(unsigned* bar, volatile LAS unsigned* st) {
  XcdBarrier b; b.bar = bar; b.x = xb_xcc_id(); b.st = st;
  if (threadIdx.x == 0) (void)xb_add(&bar[XB_XCNT(b.x)], 1u);
  return b;
}
DI void xcd_barrier_complete(unsigned* bar, unsigned x, unsigned& nloc, unsigned& nx) {
  const unsigned G = gridDim.x * gridDim.y * gridDim.z;
  unsigned sum, cnt, mine, sp = 0u;
  for (;;) {
    sum = 0u; cnt = 0u; mine = 0u;
#pragma unroll
    for (unsigned j = 0; j < 16; ++j) { const unsigned c = xb_ld(&bar[XB_XCNT(j)]); sum += c; cnt += (c > 0u) ? 1u : 0u; mine = (j == x) ? c : mine; }
    if (sum == G) break;
    __builtin_amdgcn_s_sleep(1);
    if ((++sp & 255u) == 0u) { if (xb_ld(&bar[XB_TMO])) break; if (sp > XB_SPIN_CAP) { atomicAdd(&bar[XB_TMO], 1u); break; } }
  }
  nloc = mine > 0u ? mine : 1u; nx = cnt > 0u ? cnt : 1u;
}
DI void xcd_barrier(const XcdBarrier& b) {
  asm volatile("s_waitcnt vmcnt(0)" ::: "memory");
  __syncthreads();
  if (threadIdx.x == 0) {
    unsigned* bar = b.bar;
    __builtin_amdgcn_s_waitcnt(0);
    unsigned nloc = b.st[0], nx = b.st[1];
    if (nloc == 0u) { xcd_barrier_complete(bar, b.x, nloc, nx); b.st[0] = nloc; b.st[1] = nx; }
    const unsigned old = xb_add(&bar[XB_XSUB(b.x)], 1u);
    const unsigned gen = old / nloc;
    if (old + 1u == (gen + 1u) * nloc) {
      __builtin_amdgcn_fence(__ATOMIC_RELEASE, "agent");
      asm volatile("s_waitcnt vmcnt(0)" ::: "memory");
      const unsigned og = xb_add(&bar[XB_TOP], 1u);
      const unsigned tg = og / nx;
      if (og + 1u == (tg + 1u) * nx) xb_add(&bar[XB_TOPGEN], 1u);
      else XB_SPIN(xb_ld(&bar[XB_TOPGEN]) == tg, bar);
      __builtin_amdgcn_fence(__ATOMIC_ACQUIRE, "agent");
      xb_add(&bar[XB_XGEN(b.x)], 1u);
      asm volatile("s_waitcnt vmcnt(0)" ::: "memory");
    } else {
      XB_SPIN(xb_ld(&bar[XB_XGEN(b.x)]) == gen, bar);
      __builtin_amdgcn_fence(__ATOMIC_ACQUIRE, "agent");
      asm volatile("s_waitcnt vmcnt(0)" ::: "memory");
    }
  }
  __syncthreads();
}

#ifndef PROBE_PH
#define PROBE_PH (-1)
#endif
#ifndef PROBE_K
#define PROBE_K 8
#endif
#ifndef REPMASK
#define REPMASK 0
#endif
#ifndef ONE_LAUNCH
#define ONE_LAUNCH 1
#endif
constexpr int LDS_BYTES = GEMM_LDS + 1024;

#if ONE_LAUNCH
#define BAR_ARG , const XcdBarrier& xb
#define BAR_PASS , xb
#else
#define BAR_ARG
#define BAR_PASS
#endif
template <int PH>
DI void phase_step(unsigned char* lds, int ph_lo, int ph_hi BAR_ARG) {
  if (PH >= ph_lo && PH < ph_hi) {
    const __attribute__((address_space(4))) Params* kp = (const __attribute__((address_space(4))) Params*)__builtin_amdgcn_kernarg_segment_ptr();
    asm volatile("" : "+s"(kp));
    run_phase(*(const Params*)kp, PH, lds, blockIdx.x, gridDim.x);
#if ONE_LAUNCH
    if (PROBE_PH >= 0 && PH + 1 == ph_hi) { asm volatile("s_waitcnt vmcnt(0)" ::: "memory"); __syncthreads(); }
    if (PROBE_PH >= 0 && threadIdx.x == 0 && blockIdx.x == 0 && PH + 1 == ph_hi) ((volatile unsigned long long*)(lds + GEMM_LDS + 528))[PH + 1] = __builtin_amdgcn_s_memrealtime();
    if (PH + 1 < ph_hi) {
      if (PH == 0) cg::this_grid().sync(); else xcd_barrier(xb);
      if ((REPMASK >> 25) & 1) xcd_barrier(xb);
      if (PROBE_PH >= 0 && threadIdx.x == 0 && blockIdx.x == 0) ((volatile unsigned long long*)(lds + GEMM_LDS + 528))[PH + 1] = __builtin_amdgcn_s_memrealtime();
    }
#endif
  }
}

__global__ void __launch_bounds__(512, 2) mega(Params P, int ph_lo, int ph_hi) {
  extern __shared__ __attribute__((aligned(16))) unsigned char lds[];
#if ONE_LAUNCH
  volatile LAS unsigned* st = (volatile LAS unsigned*)(lds + GEMM_LDS + 512);
  if (threadIdx.x < 2) st[threadIdx.x] = 0u;
  __syncthreads();
  XcdBarrier xb = xcd_barrier_post(P.bar, st);
#endif
#if ONE_LAUNCH
  if (PROBE_PH >= 0 && threadIdx.x == 0 && blockIdx.x == 0) ((volatile unsigned long long*)(lds + GEMM_LDS + 528))[0] = __builtin_amdgcn_s_memrealtime();
#endif
#define STEP(N) phase_step<N>(lds, ph_lo, ph_hi BAR_PASS);
  STEP(0) STEP(1) STEP(2) STEP(3) STEP(4) STEP(5) STEP(6) STEP(7) STEP(8) STEP(9)
  STEP(10) STEP(11) STEP(12) STEP(13) STEP(14) STEP(15) STEP(16) STEP(17) STEP(18) STEP(19) STEP(20) STEP(21)
#undef STEP
#if ONE_LAUNCH
  if (PROBE_PH >= 0 && threadIdx.x == 0 && blockIdx.x == 0) {
    volatile unsigned long long* ts = (volatile unsigned long long*)(lds + GEMM_LDS + 528);
    const unsigned long long dur = ts[PROBE_PH + 1] - ts[PROBE_PH];
    const unsigned long long until = ts[NPHASE] + (unsigned long long)PROBE_K * dur;
    while (__builtin_amdgcn_s_memrealtime() < until) __builtin_amdgcn_s_sleep(32);
  }
#endif
}

static size_t carve(size_t& off, size_t bytes) { size_t o = off; off = (off + bytes + 255) & ~(size_t)255; return o; }

extern "C" void kernel_launch(void* const* d_in, const int* in_sizes, int n_in, void* d_out, int out_size, void* d_ws, size_t ws_size, hipStream_t stream) {
  static int grid = 0;
  if (grid == 0) {
    int dev = 0, cus = 0, per_cu = 0;
    hipGetDevice(&dev);
    hipDeviceGetAttribute(&cus, hipDeviceAttributeMultiprocessorCount, dev);
    if (hipFuncSetAttribute((const void*)mega, hipFuncAttributeMaxDynamicSharedMemorySize, LDS_BYTES) != hipSuccess) { fprintf(stderr, "kernel_launch: hipFuncSetAttribute failed\n"); }
    hipOccupancyMaxActiveBlocksPerMultiprocessor(&per_cu, (const void*)mega, 512, LDS_BYTES);
    if (per_cu < 1) { fprintf(stderr, "kernel_launch: occupancy query says %d blocks per CU\n", per_cu); per_cu = 1; }
    (void)hipGetLastError();
    grid = cus;
  }
  Params P;
  memset(&P, 0, sizeof(P));
  P.pad0 = REPMASK;
  const float** in = (const float**)&P;
  for (int i = 0; i < 39 && i < n_in; ++i) in[i] = (const float*)d_in[i];
  P.out = (float*)d_out;
  char* ws = (char*)d_ws;
  size_t off = 0;
  P.bar = (unsigned*)(ws + carve(off, XCD_BAR_WORDS * 4));
  P.mods = (float*)(ws + carve(off, 2 * 5 * 6144 * 4));
  P.ropeM = (float*)(ws + carve(off, 128 * 8 * 2 * 4));
  P.ropeS = (float*)(ws + carve(off, 128 * 16 * 2 * 4));
  P.msh = (float*)(ws + carve(off, 64));
  P.win0t = (bf16*)(ws + carve(off, (size_t)1792 * 1024 * 2));
  P.wqt = (bf16*)(ws + carve(off, (size_t)768 * 384 * 2));
  P.wkvt = (bf16*)(ws + carve(off, (size_t)1024 * 256 * 2));
  P.wout0t = (bf16*)(ws + carve(off, (size_t)1024 * 1024 * 2));
  P.win1t = (bf16*)(ws + carve(off, (size_t)2432 * 1024 * 2));
  P.wout1t = (bf16*)(ws + carve(off, (size_t)1024 * 1024 * 2));
  P.wlrut = (bf16*)(ws + carve(off, (size_t)32 * 4096 * 2));
  P.wgut = (bf16*)(ws + carve(off, (size_t)32 * 1024 * 1024 * 2));
  P.wdt = (bf16*)(ws + carve(off, (size_t)32 * 1024 * 512 * 2));
  P.wrt = (bf16*)(ws + carve(off, (size_t)64 * 3072 * 2));
  P.ut = P.wgut;
  P.xc = (float*)(ws + carve(off, (size_t)NC * 1024 * 4));
  P.h = (bf16*)(ws + carve(off, (size_t)NT * 1024 * 2));
  P.cbuf = (bf16*)(ws + carve(off, (size_t)NT * C2LD * 2));
  P.qkv = (bf16*)(ws + carve(off, QKV_ELEMS * 2));
  P.ycat = (bf16*)(ws + carve(off, (size_t)NT * 1024 * 2));
  P.ssqc = (float*)(ws + carve(off, (size_t)NT * 16 * 4));
  P.ssqx = (float*)(ws + carve(off, (size_t)NT * 16 * 4));
  P.ssq2 = (float*)(ws + carve(off, (size_t)NT * 8 * 4));
  P.comp = (float*)(ws + carve(off, (size_t)NB * 2 * NCH * 512 * 2 * 4));
  P.dtr = (float*)(ws + carve(off, (size_t)NT * 16 * 4));
  P.dtv = (float*)(ws + carve(off, (size_t)NT * 16 * 4));
  P.acs = (float*)(ws + carve(off, (size_t)NT * 16 * 4));
  P.cnt = (int*)(ws + carve(off, 64 * 4));
  P.tokinfo = (int*)(ws + carve(off, (size_t)NT * 4 * 4));
  P.tokw = (float*)(ws + carve(off, (size_t)NT * 2 * 4));
  P.list = (int*)(ws + carve(off, (size_t)32 * NT * 4));
  if (off > ws_size || n_in != 39 || out_size != NL * 1024) {
    fprintf(stderr, "kernel_launch: needs %zu bytes of workspace (got %zu), 39 inputs (got %d), out %d (got %d); nothing launched\n", off, ws_size, n_in, NL * 1024, out_size);
    return;
  }
#if ONE_LAUNCH
  hipMemsetAsync(P.bar, 0, XCD_BAR_WORDS * 4, stream);
  int lo = 0, hi = NPHASE;
  void* args[] = {&P, &lo, &hi};
  hipError_t e = hipLaunchCooperativeKernel((const void*)mega, dim3(grid), dim3(512), args, LDS_BYTES, stream);
  if (e != hipSuccess) fprintf(stderr, "kernel_launch: cooperative launch failed: %s (grid %d)\n", hipGetErrorString(e), grid);
#else
  for (int ph = 0; ph < NPHASE; ++ph) hipLaunchKernelGGL(mega, dim3(grid), dim3(512), LDS_BYTES, stream, P, ph, ph + 1);
#endif
}
```

```cpp
#include <hip/hip_runtime.h>
#include <hip/hip_cooperative_groups.h>
#include <cstdio>
#include <cstdint>
#include <cstring>
namespace cg = cooperative_groups;

#define DI __device__ __forceinline__
typedef unsigned short bf16;
typedef __attribute__((ext_vector_type(8))) short bf16x8;
typedef __attribute__((ext_vector_type(16))) float f32x16;
typedef __attribute__((ext_vector_type(8))) float f32x8;
typedef __attribute__((ext_vector_type(4))) float f32x4;
typedef __attribute__((ext_vector_type(2))) float f32x2;
typedef __attribute__((ext_vector_type(4))) unsigned u32x4;
typedef __attribute__((ext_vector_type(2))) unsigned u32x2;
typedef __attribute__((ext_vector_type(2))) __bf16 bfx2;
typedef __attribute__((ext_vector_type(8))) __bf16 bfx8;

constexpr int D = 1024, NB = 4, SEQ = 8192, LC = 256;
constexpr int NL = NB * SEQ;
constexpr int NC = NB * LC;
constexpr int NT = NL + NC;
constexpr int NPOS = SEQ + LC;
constexpr int C1LD = 1696, C2LD = 2320;
constexpr int NCH = 66;
constexpr float EPS = 1e-6f;
constexpr float LOG2E = 1.4426950408889634f;
constexpr int NSLOT = 2 * NT;

DI int tidx() { int t = threadIdx.x; asm volatile("" : "+v"(t)); return t; }
DI float bf2f(bf16 u) { return __uint_as_float(((unsigned)u) << 16); }
DI float lo16(unsigned u) { return __uint_as_float(u << 16); }
DI float hi16(unsigned u) { return __uint_as_float(u & 0xffff0000u); }
DI unsigned pack2(float a, float b) { f32x2 v = {a, b}; bfx2 r = __builtin_convertvector(v, bfx2); return __builtin_bit_cast(unsigned, r); }
DI bf16 f2bf(float x) { return (bf16)(pack2(x, 0.f) & 0xffffu); }
DI bf16x8 pack8(const float (&v)[8]) { f32x8 t; for (int i = 0; i < 8; ++i) t[i] = v[i]; bfx8 r = __builtin_convertvector(t, bfx8); return __builtin_bit_cast(bf16x8, r); }
DI u32x2 pack4(float a, float b, float c, float d) { u32x2 r; r[0] = pack2(a, b); r[1] = pack2(c, d); return r; }
DI void unpack8(u32x4 raw, float (&v)[8]) { for (int i = 0; i < 4; ++i) { v[2 * i] = lo16(raw[i]); v[2 * i + 1] = hi16(raw[i]); } }
DI int crow(int i, int h) { return (i & 3) + 8 * (i >> 2) + 4 * h; }
DI int swap23(int p) { return (p & ~12) | ((p & 4) << 1) | ((p & 8) >> 1); }
DI f32x16 mfma32(bf16x8 a, bf16x8 b, f32x16 c) { return __builtin_amdgcn_mfma_f32_32x32x16_bf16(a, b, c, 0, 0, 0); }
DI f32x4 mfma16(bf16x8 a, bf16x8 b, f32x4 c) { return __builtin_amdgcn_mfma_f32_16x16x32_bf16(a, b, c, 0, 0, 0); }
DI float sigmoidf_(float x) { return 1.f / (1.f + __expf(-x)); }
DI float siluf_(float x) { return x / (1.f + __expf(-x)); }
DI float softplusf_(float x) { return x > 20.f ? x : log1pf(__expf(x)); }
DI float geluf_(float x) { float u = 0.7978845608028654f * (x + 0.044715f * x * x * x); float t = 1.f - 2.f / (1.f + __expf(2.f * u)); return 0.5f * x * (1.f + t); }
DI float xor32(float v) { return v + __shfl_xor(v, 32); }
DI float wave_sum(float v) { for (int o = 32; o >= 1; o >>= 1) v += __shfl_xor(v, o); return v; }

DI void tok_info(int tok, int& bmod, int& b, int& pos, bool& lat) {
  if (tok < NL) { b = tok >> 13; bmod = b; pos = LC + (tok & (SEQ - 1)); lat = true; }
  else { int t = tok - NL; b = t >> 8; bmod = 4; pos = t & (LC - 1); lat = false; }
}

struct Params {
  const float *x, *c, *ctx, *c_ctx, *ada_w, *ada_b, *norm1_g, *norm2_g;
  const float *ab_w_in, *ab_w_out, *mla_q_norm_g, *mla_w_q_up, *mla_kv_norm_g, *mla_w_kv_up, *mla_q_head_g, *mla_k_head_g;
  const float *lru_conv_w, *lru_conv_b, *lru_w_a, *lru_b_a, *lru_w_x, *lru_b_x, *lru_lambda;
  const float *cd_w_in, *cd_w_out, *swa_q_head_g, *swa_k_head_g, *swa_sink;
  const float *ssd_conv_w, *ssd_conv_b, *ssd_a_log, *ssd_dt_bias, *ssd_d, *ssd_norm_g;
  const float *router_w, *router_b, *moe_w_gate, *moe_w_up, *moe_w_down;
  float* out;
  float* mods;
  float* ropeM;
  float* ropeS;
  float* msh;
  bf16 *win0t, *wqt, *wkvt, *wout0t, *win1t, *wout1t, *wlrut, *wgut, *wdt, *wrt;
  float* xc;
  bf16* h;
  bf16* cbuf;
  bf16* qkv;
  bf16* ycat;
  bf16* ut;
  float *ssqc, *ssqx, *ssq2;
  float* comp;
  float* gcomp;
  float *dtr, *dtv, *acs;
  int* cnt;
  int* tokinfo;
  float* tokw;
  int* list;
  unsigned* bar;
  int pad0;
  int pad1;
};
constexpr size_t QB_OFF = 0, KB_OFF = (size_t)NB * 8 * NPOS * 96, VT_OFF = 2 * KB_OFF;
constexpr size_t Q2_OFF = 0, K2_OFF = (size_t)NB * 8 * NPOS * 64, V2T_OFF = K2_OFF + (size_t)NB * 2 * NPOS * 64,
                 ST_OFF = V2T_OFF + (size_t)NB * 2 * 64 * NPOS;
constexpr size_t QKV_ELEMS = (size_t)NSLOT * 1024;
static_assert(VT_OFF + (size_t)NB * 8 * 64 * NPOS <= QKV_ELEMS, "qkv region");
static_assert(ST_OFF + (size_t)NB * 2 * 8 * NCH * 64 * 128 <= QKV_ELEMS, "qkv region L1");
#define REPMASK 0
#define PROBE_PH (-1)
template <int WM, int WN, bool ZERO = true, class PRow, class QRow>
DI void gemm_core(bf16* smem, int K, int krot, PRow prow, QRow qrow, f32x16 (&acc)[WM][WN], int hook_kt, const float (&hs)[WN]) {
  constexpr int TP = 64 * WM, TQ = 128 * WN, LD = 72, NP = TP / 64, NQ = TQ / 64;
  const int tid = tidx(), lane = tid & 63, wid = tid >> 6, wr = wid >> 2, wc = wid & 3, r = lane & 31, h = lane >> 5;
  const int c8 = tid & 7, rr = tid >> 3;
  bf16* sP0 = smem;
  bf16* sQ0 = smem + 2 * TP * LD;
  const bf16* pP[NP];
  const bf16* pQ[NQ];
#pragma unroll
  for (int i = 0; i < NP; ++i) pP[i] = prow(rr + 64 * i) + c8 * 8;
#pragma unroll
  for (int i = 0; i < NQ; ++i) pQ[i] = qrow(rr + 64 * i) + c8 * 8;
  u32x4 rP[NP], rQ[NQ];
  const int nkt = K >> 6;
  if (ZERO) {
#pragma unroll
    for (int i = 0; i < WM; ++i)
#pragma unroll
      for (int j = 0; j < WN; ++j)
#pragma unroll
        for (int e = 0; e < 16; ++e) acc[i][j][e] = 0.f;
  }
  {
    const int ko = (krot % nkt) * 64;
#pragma unroll
    for (int i = 0; i < NP; ++i) rP[i] = *(const u32x4*)(pP[i] + ko);
#pragma unroll
    for (int i = 0; i < NQ; ++i) rQ[i] = *(const u32x4*)(pQ[i] + ko);
#pragma unroll
    for (int i = 0; i < NP; ++i) *(u32x4*)(sP0 + (rr + 64 * i) * LD + c8 * 8) = rP[i];
#pragma unroll
    for (int i = 0; i < NQ; ++i) *(u32x4*)(sQ0 + (rr + 64 * i) * LD + c8 * 8) = rQ[i];
  }
  __syncthreads();
  for (int kt = 0; kt < nkt; ++kt) {
    const int buf = kt & 1;
    if (kt + 1 < nkt) {
      const int ko = ((kt + 1 + krot) % nkt) * 64;
#pragma unroll
      for (int i = 0; i < NP; ++i) rP[i] = *(const u32x4*)(pP[i] + ko);
#pragma unroll
      for (int i = 0; i < NQ; ++i) rQ[i] = *(const u32x4*)(pQ[i] + ko);
    }
    if (kt == hook_kt) {
#pragma unroll
      for (int i = 0; i < WM; ++i)
#pragma unroll
        for (int j = 0; j < WN; ++j)
#pragma unroll
          for (int e = 0; e < 16; ++e) acc[i][j][e] *= hs[j];
    }
    const bf16* sP = sP0 + buf * TP * LD + (wr * WM * 32 + r) * LD + h * 8;
    const bf16* sQ = sQ0 + buf * TQ * LD + (wc * WN * 32 + r) * LD + h * 8;
#pragma unroll
    for (int ks = 0; ks < 4; ++ks) {
      bf16x8 a[WM], b[WN];
#pragma unroll
      for (int i = 0; i < WM; ++i) a[i] = *(const bf16x8*)(sP + i * 32 * LD + ks * 16);
#pragma unroll
      for (int j = 0; j < WN; ++j) b[j] = *(const bf16x8*)(sQ + j * 32 * LD + ks * 16);
#pragma unroll
      for (int i = 0; i < WM; ++i)
#pragma unroll
        for (int j = 0; j < WN; ++j) acc[i][j] = mfma32(a[i], b[j], acc[i][j]);
    }
    if (kt + 1 < nkt) {
      const int nb = buf ^ 1;
#pragma unroll
      for (int i = 0; i < NP; ++i) *(u32x4*)(sP0 + nb * TP * LD + (rr + 64 * i) * LD + c8 * 8) = rP[i];
#pragma unroll
      for (int i = 0; i < NQ; ++i) *(u32x4*)(sQ0 + nb * TQ * LD + (rr + 64 * i) * LD + c8 * 8) = rQ[i];
    }
    __syncthreads();
  }
}

struct WaveId { int lane, wid, wr, wc, r, h; };
DI WaveId wave_id() { WaveId w; w.lane = tidx() & 63; w.wid = tidx() >> 6; w.wr = w.wid >> 2; w.wc = w.wid & 3; w.r = w.lane & 31; w.h = w.lane >> 5; return w; }

DI void gemm_c1_item(const Params& P, bf16* smem, int pt, int qt) {
  f32x16 acc[4][2];
  const float hs[2] = {1.f, 1.f};
  const int p0 = pt * 256, q0 = qt * 256;
  gemm_core<4, 2>(smem, 1024, 0,
      [&](int rp) { return P.win0t + (size_t)(p0 + rp) * 1024; },
      [&](int rq) { return P.h + (size_t)(q0 + rq) * 1024; }, acc, -1, hs);
  const WaveId w = wave_id();
#pragma unroll
  for (int j = 0; j < 2; ++j) {
    const int tok = q0 + w.wc * 64 + j * 32 + w.r;
#pragma unroll
    for (int i2 = 0; i2 < 2; ++i2) {
      const int grp = (p0 + w.wr * 128 + i2 * 64) >> 6;
      float ss = 0.f;
#pragma unroll
      for (int ii = 0; ii < 2; ++ii)
#pragma unroll
        for (int g = 0; g < 4; ++g) {
          const int i = i2 * 2 + ii;
          const int f0 = p0 + w.wr * 128 + i * 32 + 8 * g + 4 * w.h;
          const float a0 = acc[i][j][4 * g], a1 = acc[i][j][4 * g + 1], a2 = acc[i][j][4 * g + 2], a3 = acc[i][j][4 * g + 3];
          ss += a0 * a0 + a1 * a1 + a2 * a2 + a3 * a3;
          if (f0 < C1LD) *(u32x2*)(P.cbuf + (size_t)tok * C1LD + f0) = pack4(a0, a1, a2, a3);
        }
      ss = xor32(ss);
      if (w.h == 0 && grp < 10) P.ssqc[tok * 16 + grp] = ss;
    }
  }
}

#define rope_pair(X1, X2, TAB) do { const float* tb_ = (TAB); const float cs_ = tb_[0], sn_ = tb_[1]; const float a_ = (X1) * cs_ - (X2) * sn_, b_ = (X1) * sn_ + (X2) * cs_; (X1) = a_; (X2) = b_; } while (0)

DI void gemm_q_item(const Params& P, bf16* smem, int pt, int qt) {
  f32x16 acc[3][1];
  const float hs[1] = {1.f};
  const int p0 = pt * 192, q0 = qt * 128;
  gemm_core<3, 1>(smem, 384, 0,
      [&](int rp) { return P.wqt + (size_t)(p0 + rp) * 384; },
      [&](int rq) { return P.cbuf + (size_t)(q0 + rq) * C1LD; }, acc, -1, hs);
  const WaveId w = wave_id();
  const int hd = pt * 2 + w.wr;
  const float qscale = 0.10206207261596575f * LOG2E;
#pragma unroll
  for (int j = 0; j < 1; ++j) {
    const int tok = q0 + w.wc * 32 + w.r;
    int bmod, b, pos; bool lat; tok_info(tok, bmod, b, pos, lat);
    float s6 = 0.f;
    for (int g = 0; g < 6; ++g) s6 += P.ssqc[tok * 16 + g];
    const float rstd = rsqrtf(s6 * (1.f / 384.f) + EPS);
    float ss = 0.f;
#pragma unroll
    for (int i = 0; i < 3; ++i)
#pragma unroll
      for (int e = 0; e < 16; ++e) { acc[i][j][e] *= rstd; ss += acc[i][j][e] * acc[i][j][e]; }
    ss = xor32(ss);
    const float r2 = rsqrtf(ss * (1.f / 96.f) + EPS);
#pragma unroll
    for (int i = 0; i < 3; ++i)
#pragma unroll
      for (int g = 0; g < 4; ++g) {
        const f32x4 gg = *(const f32x4*)(P.mla_q_head_g + i * 32 + 8 * g + 4 * w.h);
#pragma unroll
        for (int e = 0; e < 4; ++e) acc[i][j][4 * g + e] *= r2 * gg[e];
      }
    if (lat) {
      const int sq = tok & (SEQ - 1), rowp = sq >> 6, colp = sq & 63;
#pragma unroll
      for (int e = 0; e < 4; ++e) {
        rope_pair(acc[2][j][e], acc[2][j][4 + e], P.ropeM + (rowp * 8 + 4 * w.h + e) * 2);
        rope_pair(acc[2][j][8 + e], acc[2][j][12 + e], P.ropeM + (colp * 8 + 4 * w.h + e) * 2);
      }
    }
    bf16* dst = P.qkv + QB_OFF + ((size_t)(b * 8 + hd) * NPOS + pos) * 96;
#pragma unroll
    for (int i = 0; i < 3; ++i)
#pragma unroll
      for (int g = 0; g < 4; ++g)
        *(u32x2*)(dst + i * 32 + 8 * g + 4 * w.h) = pack4(acc[i][j][4 * g] * qscale, acc[i][j][4 * g + 1] * qscale, acc[i][j][4 * g + 2] * qscale, acc[i][j][4 * g + 3] * qscale);
  }
}

DI void gemm_kv_item(const Params& P, bf16* smem, int pt, int qt) {
  f32x16 acc[4][1];
  const float hs[1] = {1.f};
  const int p0 = pt * 256, q0 = qt * 128;
  gemm_core<4, 1>(smem, 256, 0,
      [&](int rp) { return P.wkvt + (size_t)(p0 + rp) * 256; },
      [&](int rq) { return P.cbuf + (size_t)(q0 + rq) * C1LD + 384; }, acc, -1, hs);
  const WaveId w = wave_id();
  const int hd = pt * 2 + w.wr;
#pragma unroll
  for (int j = 0; j < 1; ++j) {
    const int tok = q0 + w.wc * 32 + w.r;
    int bmod, b, pos; bool lat; tok_info(tok, bmod, b, pos, lat);
    float s4 = 0.f;
    for (int g = 6; g < 10; ++g) s4 += P.ssqc[tok * 16 + g];
    const float rstd = rsqrtf(s4 * (1.f / 256.f) + EPS);
    float kr[16];
    {
      const bf16* src = P.cbuf + (size_t)tok * C1LD + 640 + 16 * w.h;
      float t8[8];
      unpack8(*(const u32x4*)src, t8);
      for (int i = 0; i < 8; ++i) kr[i] = t8[i];
      unpack8(*(const u32x4*)(src + 8), t8);
      for (int i = 0; i < 8; ++i) kr[8 + i] = t8[i];
    }
    float ss = 0.f;
#pragma unroll
    for (int i = 0; i < 2; ++i)
#pragma unroll
      for (int e = 0; e < 16; ++e) { acc[i][j][e] *= rstd; ss += acc[i][j][e] * acc[i][j][e]; }
#pragma unroll
    for (int i = 0; i < 16; ++i) ss += kr[i] * kr[i];
    ss = xor32(ss);
    const float r2 = rsqrtf(ss * (1.f / 96.f) + EPS);
    bf16* dst = P.qkv + KB_OFF + ((size_t)(b * 8 + hd) * NPOS + pos) * 96;
#pragma unroll
    for (int i = 0; i < 2; ++i)
#pragma unroll
      for (int g = 0; g < 4; ++g) {
        const f32x4 gg = *(const f32x4*)(P.mla_k_head_g + i * 32 + 8 * g + 4 * w.h);
        *(u32x2*)(dst + i * 32 + 8 * g + 4 * w.h) = pack4(acc[i][j][4 * g] * r2 * gg[0], acc[i][j][4 * g + 1] * r2 * gg[1], acc[i][j][4 * g + 2] * r2 * gg[2], acc[i][j][4 * g + 3] * r2 * gg[3]);
      }
#pragma unroll
    for (int i = 0; i < 16; ++i) kr[i] *= r2 * P.mla_k_head_g[64 + 16 * w.h + i];
    if (lat) {
      const int sq = tok & (SEQ - 1);
      const int pp = w.h ? (sq & 63) : (sq >> 6);
#pragma unroll
      for (int i = 0; i < 8; ++i) rope_pair(kr[i], kr[8 + i], P.ropeM + (pp * 8 + i) * 2);
    }
    {
      u32x4 o0, o1;
      for (int i = 0; i < 4; ++i) { o0[i] = pack2(kr[2 * i], kr[2 * i + 1]); o1[i] = pack2(kr[8 + 2 * i], kr[8 + 2 * i + 1]); }
      *(u32x4*)(dst + 64 + 16 * w.h) = o0;
      *(u32x4*)(dst + 64 + 16 * w.h + 8) = o1;
    }
    const int posp = (pos & ~15) | swap23(pos & 15);
    bf16* vdst = P.qkv + VT_OFF + (size_t)(b * 8 + hd) * 64 * NPOS + posp;
#pragma unroll
    for (int i = 0; i < 2; ++i)
#pragma unroll
      for (int e = 0; e < 16; ++e) vdst[(size_t)(i * 32 + crow(e, w.h)) * NPOS] = f2bf(acc[2 + i][j][e] * rstd);
  }
}

template <int WM>
DI void gemm_out_item(const Params& P, bf16* smem, int layer, int pt, int qt) {
  f32x16 acc[WM][2];
  const int p0 = pt * 64 * WM, q0 = qt * 256;
  const WaveId w = wave_id();
  float hs[2] = {1.f, 1.f};
  if (layer == 1) {
#pragma unroll
    for (int j = 0; j < 2; ++j) {
      const int tok = q0 + w.wc * 64 + j * 32 + w.r;
      float s = 0.f;
      for (int g = 0; g < 8; ++g) s += P.ssq2[tok * 8 + g];
      hs[j] = rsqrtf(s * (1.f / 512.f) + EPS);
    }
  }
  const bf16* wt = layer ? P.wout1t : P.wout0t;
  gemm_core<WM, 2>(smem, 1024, layer ? 8 : 0,
      [&](int rp) { return wt + (size_t)(p0 + rp) * 1024; },
      [&](int rq) { return P.ycat + (size_t)(q0 + rq) * 1024; }, acc, layer ? 8 : -1, hs);
#pragma unroll
  for (int j = 0; j < 2; ++j) {
    const int tok = q0 + w.wc * 64 + j * 32 + w.r;
    int bmod, b, pos; bool lat; tok_info(tok, bmod, b, pos, lat);
    const float* src = layer ? (P.out + (size_t)tok * 1024) : (lat ? P.x + (size_t)tok * 1024 : P.ctx + (size_t)(tok - NL) * 1024);
    float* dst = lat ? P.out + (size_t)tok * 1024 : P.xc + (size_t)(tok - NL) * 1024;
    const float* m2 = P.mods + ((size_t)(layer * 5 + bmod) * 6 + 2) * 1024;
#pragma unroll
    for (int i = 0; i < WM; ++i)
#pragma unroll
      for (int g = 0; g < 4; ++g) {
        const int f0 = p0 + w.wr * 32 * WM + i * 32 + 8 * g + 4 * w.h;
        const f32x4 xv = *(const f32x4*)(src + f0);
        const f32x4 mv = *(const f32x4*)(m2 + f0);
        f32x4 o;
#pragma unroll
        for (int e = 0; e < 4; ++e) o[e] = xv[e] + mv[e] * acc[i][j][4 * g + e];
        *(f32x4*)(dst + f0) = o;
      }
  }
}

DI void moe1_item(const Params& P, bf16* smem, int layer, int e, int m0, int pt, int cnt_e, int off_e) {
  f32x16 acc[4][2];
  const float hs[2] = {1.f, 1.f};
  const int* lst = P.list + (size_t)e * NT;
  gemm_core<4, 2>(smem, 1024, 0,
      [&](int rp) { return P.wgut + ((size_t)e * 1024 + pt * 256 + rp) * 1024; },
      [&](int rq) { int m = m0 + rq; if (m > cnt_e - 1) m = cnt_e - 1; return P.h + (size_t)lst[m] * 1024; }, acc, -1, hs);
  const WaveId w = wave_id();
#pragma unroll
  for (int j = 0; j < 2; ++j) {
    const int m = m0 + w.wc * 64 + j * 32 + w.r;
    if (m < cnt_e) {
      bf16* dst = P.cbuf + (size_t)(off_e + m) * 512 + pt * 128 + w.wr * 64;
#pragma unroll
      for (int i2 = 0; i2 < 2; ++i2)
#pragma unroll
        for (int g = 0; g < 4; ++g) {
          float o[4];
#pragma unroll
          for (int k = 0; k < 4; ++k) o[k] = siluf_(acc[2 * i2][j][4 * g + k]) * acc[2 * i2 + 1][j][4 * g + k];
          *(u32x2*)(dst + i2 * 32 + 8 * g + 4 * w.h) = pack4(o[0], o[1], o[2], o[3]);
        }
    }
  }
}
DI void moe2_item(const Params& P, bf16* smem, int e, int m0, int pt, int cnt_e, int off_e, int total) {
  f32x16 acc[4][2];
  const float hs[2] = {1.f, 1.f};
  gemm_core<4, 2>(smem, 512, 0,
      [&](int rp) { return P.wdt + ((size_t)e * 1024 + pt * 256 + rp) * 512; },
      [&](int rq) { int s = off_e + m0 + rq; if (s > total - 1) s = total - 1; return P.cbuf + (size_t)s * 512; }, acc, -1, hs);
  const WaveId w = wave_id();
#pragma unroll
  for (int j = 0; j < 2; ++j) {
    const int m = m0 + w.wc * 64 + j * 32 + w.r;
    if (m < cnt_e) {
      bf16* dst = P.qkv + (size_t)(off_e + m) * 1024 + pt * 256 + w.wr * 128;
#pragma unroll
      for (int i = 0; i < 4; ++i)
#pragma unroll
        for (int g = 0; g < 4; ++g)
          *(u32x2*)(dst + i * 32 + 8 * g + 4 * w.h) = pack4(acc[i][j][4 * g], acc[i][j][4 * g + 1], acc[i][j][4 * g + 2], acc[i][j][4 * g + 3]);
    }
  }
}

DI void c2_block_epilogue(const Params& P, const WaveId& w, int fb, int tok, f32x16& a0, f32x16& a1) {
  int bmod, b, pos; bool lat; tok_info(tok, bmod, b, pos, lat);
  const float qscale = 0.125f * LOG2E;
  if (fb < 10) {
    const bool isq = fb < 8;
    const float* gain = isq ? P.swa_q_head_g : P.swa_k_head_g;
    float ss = 0.f;
#pragma unroll
    for (int e = 0; e < 16; ++e) ss += a0[e] * a0[e] + a1[e] * a1[e];
    ss = xor32(ss);
    const float r2 = rsqrtf(ss * (1.f / 64.f) + EPS);
#pragma unroll
    for (int g = 0; g < 4; ++g) {
      const f32x4 g0 = *(const f32x4*)(gain + 8 * g + 4 * w.h), g1 = *(const f32x4*)(gain + 32 + 8 * g + 4 * w.h);
#pragma unroll
      for (int e = 0; e < 4; ++e) { a0[4 * g + e] *= r2 * g0[e]; a1[4 * g + e] *= r2 * g1[e]; }
    }
    if (lat) {
      const int sq = tok & (SEQ - 1), rowp = sq >> 6, colp = sq & 63;
#pragma unroll
      for (int e = 0; e < 4; ++e) {
        rope_pair(a0[e], a0[8 + e], P.ropeS + (rowp * 16 + 4 * w.h + e) * 2);
        rope_pair(a0[4 + e], a0[12 + e], P.ropeS + (rowp * 16 + 8 + 4 * w.h + e) * 2);
        rope_pair(a1[e], a1[8 + e], P.ropeS + (colp * 16 + 4 * w.h + e) * 2);
        rope_pair(a1[4 + e], a1[12 + e], P.ropeS + (colp * 16 + 8 + 4 * w.h + e) * 2);
      }
    }
    if (isq && !lat) return;
    const float sc = isq ? qscale : 1.f;
    bf16* dst = isq ? P.qkv + Q2_OFF + ((size_t)(b * 8 + fb) * NPOS + pos) * 64
                    : P.qkv + K2_OFF + ((size_t)(b * 2 + (fb - 8)) * NPOS + pos) * 64;
#pragma unroll
    for (int g = 0; g < 4; ++g) {
      *(u32x2*)(dst + 8 * g + 4 * w.h) = pack4(a0[4 * g] * sc, a0[4 * g + 1] * sc, a0[4 * g + 2] * sc, a0[4 * g + 3] * sc);
      *(u32x2*)(dst + 32 + 8 * g + 4 * w.h) = pack4(a1[4 * g] * sc, a1[4 * g + 1] * sc, a1[4 * g + 2] * sc, a1[4 * g + 3] * sc);
    }
  } else if (fb < 12) {
    const int posp = (pos & ~15) | swap23(pos & 15);
    bf16* vdst = P.qkv + V2T_OFF + (size_t)(b * 2 + (fb - 10)) * 64 * NPOS + posp;
#pragma unroll
    for (int e = 0; e < 16; ++e) {
      vdst[(size_t)(crow(e, w.h)) * NPOS] = f2bf(a0[e]);
      vdst[(size_t)(32 + crow(e, w.h)) * NPOS] = f2bf(a1[e]);
    }
  } else if (fb < 36) {
    bf16* dst = P.cbuf + (size_t)tok * C2LD + fb * 64;
#pragma unroll
    for (int g = 0; g < 4; ++g) {
      *(u32x2*)(dst + 8 * g + 4 * w.h) = pack4(a0[4 * g], a0[4 * g + 1], a0[4 * g + 2], a0[4 * g + 3]);
      *(u32x2*)(dst + 32 + 8 * g + 4 * w.h) = pack4(a1[4 * g], a1[4 * g + 1], a1[4 * g + 2], a1[4 * g + 3]);
    }
  }
}
DI void gemm_c2_item(const Params& P, bf16* smem, int pt, int qt) {
  f32x16 acc[4][2];
  const float hs[2] = {1.f, 1.f};
  const int p0 = pt * 256, q0 = qt * 256;
  gemm_core<4, 2>(smem, 1024, 0,
      [&](int rp) { return P.win1t + (size_t)(p0 + rp) * 1024; },
      [&](int rq) { return P.h + (size_t)(q0 + rq) * 1024; }, acc, -1, hs);
  const WaveId w = wave_id();
#pragma unroll
  for (int j = 0; j < 2; ++j) {
    const int tok = q0 + w.wc * 64 + j * 32 + w.r;
#pragma unroll
    for (int i2 = 0; i2 < 2; ++i2) c2_block_epilogue(P, w, (p0 + w.wr * 128 + i2 * 64) >> 6, tok, acc[2 * i2][j], acc[2 * i2 + 1][j]);
  }
}
DI void gemm_c2dt_item(const Params& P, bf16* smem, int qt) {
  f32x16 acc[1][2];
  const float hs[2] = {1.f, 1.f};
  const int q0 = qt * 256;
  gemm_core<1, 2>(smem, 1024, 0,
      [&](int rp) { return P.win1t + (size_t)(2304 + rp) * 1024; },
      [&](int rq) { return P.h + (size_t)(q0 + rq) * 1024; }, acc, -1, hs);
  const WaveId w = wave_id();
  if (w.wr == 0) {
#pragma unroll
    for (int j = 0; j < 2; ++j) {
      const int tok = q0 + w.wc * 64 + j * 32 + w.r;
#pragma unroll
      for (int g = 0; g < 2; ++g) {
        f32x4 o = {acc[0][j][4 * g], acc[0][j][4 * g + 1], acc[0][j][4 * g + 2], acc[0][j][4 * g + 3]};
        *(f32x4*)(P.dtr + (size_t)tok * 16 + 8 * g + 4 * w.h) = o;
      }
    }
  }
}
template <int DQK, bool WIN>
DI void attn_item(bf16* smem, const bf16* Qp, const bf16* Kp, const bf16* Vtp, int qrow0, int nq, int ntiles, int nctx, int band_k0, int q_lat0,
                  float negM, float sinkterm, bf16* outp) {
  constexpr int KS = DQK / 16, LDK = DQK + 8, LDV = 72, CPR = DQK / 8, NCK = 64 * CPR;
  const int tid = tidx(), lane = tid & 63, w = tid >> 6, r = lane & 31, h = lane >> 5;
  bf16* sK = smem;
  bf16* sV = smem + 2 * 64 * LDK;
  bf16x8 qf[2][KS];
#pragma unroll
  for (int qt = 0; qt < 2; ++qt) {
    int qi = w * 64 + qt * 32 + r;
    if (qi > nq - 1) qi = nq - 1;
#pragma unroll
    for (int s = 0; s < KS; ++s) qf[qt][s] = *(const bf16x8*)(Qp + (size_t)(qrow0 + qi) * DQK + s * 16 + h * 8);
  }
  f32x16 O[2][2];
#pragma unroll
  for (int a = 0; a < 2; ++a)
#pragma unroll
    for (int b = 0; b < 2; ++b)
#pragma unroll
      for (int e = 0; e < 16; ++e) O[a][b][e] = 0.f;
  float lsum[2] = {0.f, 0.f};
  const int kr0 = tid / CPR, kc0 = tid % CPR;
  const int id1 = tid + 512;
  const bool has1 = id1 < NCK;
  const int kr1 = has1 ? id1 / CPR : 0, kc1 = has1 ? id1 % CPR : 0;
  const int vr = tid >> 3, vc = tid & 7;
  u32x4 rK0, rK1, rV;
  rK1 = rK0 = rV = u32x4{0, 0, 0, 0};
  auto tilepos = [&](int t) { return t < nctx ? t * 64 : LC + band_k0 + (t - nctx) * 64; };
  auto gload = [&](int t) {
    const int pos = tilepos(t);
    rK0 = *(const u32x4*)(Kp + (size_t)(pos + kr0) * DQK + kc0 * 8);
    if (has1) rK1 = *(const u32x4*)(Kp + (size_t)(pos + kr1) * DQK + kc1 * 8);
    rV = *(const u32x4*)(Vtp + (size_t)vr * NPOS + pos + vc * 8);
  };
  auto swrite = [&](int buf) {
    *(u32x4*)(sK + buf * 64 * LDK + kr0 * LDK + kc0 * 8) = rK0;
    if (has1) *(u32x4*)(sK + buf * 64 * LDK + kr1 * LDK + kc1 * 8) = rK1;
    *(u32x4*)(sV + buf * 64 * LDV + vr * LDV + vc * 8) = rV;
  };
  gload(0); swrite(0);
  __syncthreads();
  const int qw = q_lat0 + w * 64;
  for (int t = 0; t < ntiles; ++t) {
    const int buf = t & 1;
    if (t + 1 < ntiles) gload(t + 1);
    bool act = (w * 64 < nq);
    int kk0 = 0;
    const bool band = WIN && t >= nctx;
    if (band) { kk0 = band_k0 + (t - nctx) * 64; act = act && (kk0 + 63 >= qw - 128) && (kk0 <= qw + 191); }
    if (act) {
      const bf16* sKb = sK + buf * 64 * LDK;
      const bf16* sVb = sV + buf * 64 * LDV;
#pragma unroll 1
      for (int ksub = 0; ksub < 2; ++ksub) {
        bf16x8 pb[2][2];
        {
          const bf16* kfp = sKb + (ksub * 32 + r) * LDK + h * 8;
#pragma unroll
          for (int qt = 0; qt < 2; ++qt) {
            f32x16 sc;
#pragma unroll
            for (int e = 0; e < 16; ++e) sc[e] = negM;
#pragma unroll
            for (int s = 0; s < KS; ++s) sc = mfma32(*(const bf16x8*)(kfp + s * 16), qf[qt][s], sc);
            float p[16];
#pragma unroll
            for (int e = 0; e < 16; ++e) p[e] = __builtin_amdgcn_exp2f(sc[e]);
            if (band) {
              const int qi = qw + qt * 32 + r;
#pragma unroll
              for (int e = 0; e < 16; ++e) {
                const int dd = qi - (kk0 + ksub * 32 + crow(e, h));
                if (dd > 128 || dd < -128) p[e] = 0.f;
              }
            }
            float ps = 0.f;
#pragma unroll
            for (int e = 0; e < 16; ++e) ps += p[e];
            lsum[qt] += ps;
            float p0[8], p1[8];
#pragma unroll
            for (int e = 0; e < 8; ++e) { p0[e] = p[e]; p1[e] = p[8 + e]; }
            pb[qt][0] = pack8(p0); pb[qt][1] = pack8(p1);
          }
        }
#pragma unroll
        for (int dt = 0; dt < 2; ++dt)
#pragma unroll
          for (int st = 0; st < 2; ++st) {
            const bf16x8 vf = *(const bf16x8*)(sVb + (dt * 32 + r) * LDV + ksub * 32 + st * 16 + h * 8);
            O[0][dt] = mfma32(vf, pb[0][st], O[0][dt]);
            O[1][dt] = mfma32(vf, pb[1][st], O[1][dt]);
          }
      }
    }
    if (t + 1 < ntiles) swrite(buf ^ 1);
    __syncthreads();
  }
#pragma unroll
  for (int qt = 0; qt < 2; ++qt) {
    const float l = xor32(lsum[qt]) + sinkterm;
    const float inv = 1.f / l;
    const int qi = w * 64 + qt * 32 + r;
    if (qi < nq) {
      bf16* dst = outp + (size_t)qi * 1024;
#pragma unroll
      for (int dt = 0; dt < 2; ++dt)
#pragma unroll
        for (int g = 0; g < 4; ++g)
          *(u32x2*)(dst + dt * 32 + 8 * g + 4 * h) = pack4(O[qt][dt][4 * g] * inv, O[qt][dt][4 * g + 1] * inv, O[qt][dt][4 * g + 2] * inv, O[qt][dt][4 * g + 3] * inv);
    }
  }
}

constexpr int LCH = 80, LGR = 9;
DI void lru_apply(float (&h)[4], const float* base, int col, bool valid) {
#pragma unroll
  for (int n = 0; n < 4; ++n) {
    const f32x2 cm = *(const f32x2*)(base + (16 * n + col) * 2);
    h[n] = valid ? cm[0] * h[n] + cm[1] : h[n];
  }
}
DI void lru_chunk(const Params& P, const float* sGateBase, const float* sTaps, bf16* hfw, int bi, int j, int c, int pass, float* sComp) {
  const int lane = tidx() & 63, col = lane & 15, g = lane >> 4;
  const bool isctx = c < 16;
  const int L = isctx ? LC : SEQ;
  const int sp0 = isctx ? c * 16 : (c - 16) * 128;
  const int tokbase = isctx ? (NL + bi * LC + sp0) : (bi * SEQ + sp0);
  const int nsteps = isctx ? 1 : 8;
  const bf16* C1 = P.cbuf;
  bf16* XCV = P.h;
  if (pass == 0) {
    for (int st = 0; st < nsteps; ++st) {
      const int t = st * 16 + col;
      u32x4 raw[2][4];
#pragma unroll
      for (int s = 0; s < 2; ++s)
#pragma unroll
        for (int k = 0; k < 4; ++k) {
          const int tt = sp0 + t + k - 2;
          const bool ok = tt >= 0 && tt < L;
          const int row = ok ? (tokbase + t + k - 2) : tokbase + t;
          raw[s][k] = *(const u32x4*)(C1 + (size_t)row * C1LD + 672 + 64 * j + 32 * s + 8 * g);
        }
#pragma unroll
      for (int s = 0; s < 2; ++s) {
        const int c0 = 64 * j + 32 * s + 8 * g;
        float a8[8];
        {
          const f32x4 b0 = *(const f32x4*)(sTaps + 2048 + c0), b1 = *(const f32x4*)(sTaps + 2048 + c0 + 4);
          for (int i = 0; i < 4; ++i) { a8[i] = b0[i]; a8[4 + i] = b1[i]; }
        }
#pragma unroll
        for (int k = 0; k < 4; ++k) {
          const int tt = sp0 + t + k - 2;
          const float m = (tt >= 0 && tt < L) ? 1.f : 0.f;
          float x8[8];
          unpack8(raw[s][k], x8);
          const f32x4 w0 = *(const f32x4*)(sTaps + k * 512 + c0), w1 = *(const f32x4*)(sTaps + k * 512 + c0 + 4);
          for (int i = 0; i < 4; ++i) { a8[i] += m * w0[i] * x8[i]; a8[4 + i] += m * w1[i] * x8[4 + i]; }
        }
        *(bf16x8*)(XCV + (size_t)(tokbase + t) * 512 + c0) = pack8(a8);
      }
    }
  }
#pragma unroll 1
  for (int dir = 0; dir < 2; ++dir) {
    bf16x8 wb[8][2];
#pragma unroll
    for (int n = 0; n < 8; ++n)
#pragma unroll
      for (int s = 0; s < 2; ++s)
        wb[n][s] = *(const bf16x8*)(P.wlrut + ((size_t)(((dir * 2 + (n >> 2)) * 8 + j) * 64 + 16 * (n & 3) + col)) * 64 + 32 * s + 8 * g);
    bf16x8 idf[2];
#pragma unroll
    for (int n = 0; n < 2; ++n)
#pragma unroll
      for (int jj = 0; jj < 8; ++jj) idf[n][jj] = ((8 * g + jj) == 16 * n + col) ? (short)0x3F80 : (short)0;
    float hst[4], arun[4];
#pragma unroll
    for (int n = 0; n < 4; ++n) { hst[n] = 0.f; arun[n] = 1.f; }
    const float* sGate = sGateBase + dir * 1536 + 64 * j + col;
    if (pass == 1) {
      const float* cbase = P.comp + ((size_t)(bi * 2 + dir) * LCH) * 1024 + 128 * j;
      const float* gbase = P.gcomp + ((size_t)(bi * 2 + dir) * LGR) * 1024 + 128 * j;
      if (isctx) {
#pragma unroll
        for (int i = 0; i < 15; ++i) {
          const int cc = dir == 0 ? i : 15 - i;
          const bool valid = dir == 0 ? (i < c) : (15 - i > c);
          lru_apply(hst, cbase + (size_t)(valid ? cc : 0) * 1024, col, valid);
        }
      } else {
        const int q = (c - 16) >> 3;
        lru_apply(hst, gbase, col, true);
#pragma unroll
        for (int i = 0; i < 7; ++i) {
          const int qq = dir == 0 ? i : 7 - i;
          const bool valid = dir == 0 ? (i < q) : (7 - i > q);
          lru_apply(hst, gbase + (size_t)(1 + (valid ? qq : 0)) * 1024, col, valid);
        }
#pragma unroll
        for (int i = 0; i < 7; ++i) {
          const int cc = dir == 0 ? 16 + 8 * q + i : 16 + 8 * q + 7 - i;
          const bool valid = dir == 0 ? (cc < c) : (cc > c);
          lru_apply(hst, cbase + (size_t)(valid ? cc : 16) * 1024, col, valid);
        }
      }
    }
    bf16x8 afc[2];
    auto issue = [&](int st, bf16x8 (&af)[2]) {
      const int t = st * 16 + col;
#pragma unroll
      for (int s = 0; s < 2; ++s) af[s] = *(const bf16x8*)(XCV + (size_t)(tokbase + t) * 512 + 64 * j + 32 * s + 8 * g);
    };
    issue(dir ? nsteps - 1 : 0, afc);
    for (int step = 0; step < nsteps; ++step) {
      const int st = dir ? nsteps - 1 - step : step;
      const int t0 = st * 16;
      bf16x8 af[2];
      af[0] = afc[0]; af[1] = afc[1];
      if (step + 1 < nsteps) issue(dir ? st - 1 : st + 1, afc);
      f32x4 ag[8], xcC[4];
      const f32x4 z4 = {0.f, 0.f, 0.f, 0.f};
#pragma unroll
      for (int n = 0; n < 8; ++n) { ag[n] = mfma16(af[0], wb[n][0], z4); ag[n] = mfma16(af[1], wb[n][1], ag[n]); }
#pragma unroll
      for (int n = 0; n < 4; ++n) xcC[n] = mfma16(af[n >> 1], idf[n & 1], z4);
#pragma unroll
      for (int n = 0; n < 4; ++n) {
        float av[4], bv[4];
#pragma unroll
        for (int e = 0; e < 4; ++e) {
          const float rg = sigmoidf_(ag[n][e] + sGate[16 * n]);
          const float ig = sigmoidf_(ag[4 + n][e] + sGate[512 + 16 * n]);
          const float a = __expf(-sGate[1024 + 16 * n] * rg);
          av[e] = a;
          bv[e] = sqrtf(fmaxf(fmaf(-a, a, 1.f), 0.f)) * ig * xcC[n][e];
        }
        float A = 1.f, H = 0.f;
        if (dir == 0) { for (int e = 0; e < 4; ++e) { H = av[e] * H + bv[e]; A *= av[e]; } }
        else { for (int e = 3; e >= 0; --e) { H = av[e] * H + bv[e]; A *= av[e]; } }
        float A1, H1, Aex, Hex, At, Ht;
        if (dir == 0) {
          A1 = __shfl_up(A, 16); H1 = __shfl_up(H, 16);
          if (g >= 1) { H = A * H1 + H; A = A * A1; }
          A1 = __shfl_up(A, 32); H1 = __shfl_up(H, 32);
          if (g >= 2) { H = A * H1 + H; A = A * A1; }
          Aex = __shfl_up(A, 16); Hex = __shfl_up(H, 16);
          if (g == 0) { Aex = 1.f; Hex = 0.f; }
          At = __shfl(A, col + 48); Ht = __shfl(H, col + 48);
        } else {
          A1 = __shfl_down(A, 16); H1 = __shfl_down(H, 16);
          if (g <= 2) { H = A * H1 + H; A = A * A1; }
          A1 = __shfl_down(A, 32); H1 = __shfl_down(H, 32);
          if (g <= 1) { H = A * H1 + H; A = A * A1; }
          Aex = __shfl_down(A, 16); Hex = __shfl_down(H, 16);
          if (g == 3) { Aex = 1.f; Hex = 0.f; }
          At = __shfl(A, col); Ht = __shfl(H, col);
        }
        if (pass == 0) {
          hst[n] = At * hst[n] + Ht; arun[n] = At * arun[n];
        } else {
          float hc = Aex * hst[n] + Hex;
          hst[n] = At * hst[n] + Ht;
          float o[4];
          if (dir == 0) { for (int e = 0; e < 4; ++e) { hc = av[e] * hc + bv[e]; o[e] = hc; } }
          else { for (int e = 3; e >= 0; --e) { hc = av[e] * hc + bv[e]; o[e] = hc; } }
#pragma unroll
          for (int e = 0; e < 4; ++e) {
            bf16* yp = hfw + (t0 + 4 * g + e) * 64 + 16 * n + col;
            if (dir == 0) *yp = f2bf(o[e]); else *yp = f2bf(bf2f(*yp) + o[e]);
          }
        }
      }
    }
    if (pass == 0 && g == 0) {
#pragma unroll
      for (int n = 0; n < 4; ++n) {
        f32x2 cm = {arun[n], hst[n]};
        *(f32x2*)(P.comp + ((size_t)((bi * 2 + dir) * LCH + c) * 512 + 64 * j + 16 * n + col) * 2) = cm;
        *(f32x2*)(sComp + (dir * 64 + 16 * n + col) * 2) = cm;
      }
    }
  }
  if (pass == 1) {
    const int ntok = nsteps * 16;
    for (int i0 = 0; i0 < ntok * 8; i0 += 64 * 4) {
      u32x4 gr[4];
#pragma unroll
      for (int u = 0; u < 4; ++u) {
        const int id = i0 + u * 64 + lane;
        const int tk = id >> 3, cc = id & 7;
        gr[u] = u32x4{0, 0, 0, 0};
        if (tk < ntok) gr[u] = *(const u32x4*)(C1 + (size_t)(tokbase + tk) * C1LD + 1184 + 64 * j + cc * 8);
      }
#pragma unroll
      for (int u = 0; u < 4; ++u) {
        const int id = i0 + u * 64 + lane;
        const int tk = id >> 3, cc = id & 7;
        if (tk < ntok) {
          float hv[8], gv[8];
          unpack8(*(const u32x4*)(hfw + tk * 64 + cc * 8), hv);
          unpack8(gr[u], gv);
#pragma unroll
          for (int e = 0; e < 8; ++e) hv[e] *= geluf_(gv[e]);
          *(bf16x8*)(P.ycat + (size_t)(tokbase + tk) * 1024 + 512 + 64 * j + cc * 8) = pack8(hv);
        }
      }
    }
  }
}

DI void lru_block_item(const Params& P, float* fsm, int bi, int j, int grp, int pass) {
  const int tid = tidx(), wid = tid >> 6;
  const float* sGate = fsm;
  const float* sTaps = fsm + 3072;
  float* sComp = fsm + 5632;
  bf16* hfw = (bf16*)(fsm + 3072) + wid * 8192;
  if (grp == 0) {
    lru_chunk(P, sGate, sTaps, hfw, bi, j, 2 * wid, pass, sComp + (2 * wid) * 256);
    lru_chunk(P, sGate, sTaps, hfw, bi, j, 2 * wid + 1, pass, sComp + (2 * wid + 1) * 256);
  } else {
    lru_chunk(P, sGate, sTaps, hfw, bi, j, 16 + 8 * (grp - 1) + wid, pass, sComp + wid * 256);
  }
  if (pass == 0) {
    __syncthreads();
    if (tid < 128) {
      const int dir = tid >> 6, ch = tid & 63;
      const int n = grp == 0 ? 16 : 8;
      float A = 1.f, H = 0.f;
      for (int i = 0; i < n; ++i) {
        const int cc = dir == 0 ? i : n - 1 - i;
        const float a = sComp[cc * 256 + (dir * 64 + ch) * 2], hh = sComp[cc * 256 + (dir * 64 + ch) * 2 + 1];
        H = a * H + hh; A = a * A;
      }
      f32x2 cm = {A, H};
      *(f32x2*)(P.gcomp + ((size_t)((bi * 2 + dir) * LGR + grp) * 512 + 64 * j + ch) * 2) = cm;
    }
    __syncthreads();
  }
}
DI void chunk_geom(int bi, int ck, int& L, int& sp0, int& tokbase, int& pos0) {
  const bool isctx = ck < 2;
  L = isctx ? LC : SEQ;
  sp0 = isctx ? ck * 128 : (ck - 2) * 128;
  tokbase = isctx ? (NL + bi * LC + sp0) : (bi * SEQ + sp0);
  pos0 = isctx ? sp0 : LC + sp0;
}

DI void ssd_conv_item(const Params& P, int gc, int cr) {
  const int bi = gc / NCH, ck = gc % NCH;
  int L, sp0, tokbase, pos0; chunk_geom(bi, ck, L, sp0, tokbase, pos0);
  const int tid = tidx(), t = tid & 127, cg = tid >> 7;
  const int tok = tokbase + t, pos = pos0 + t, posp = (pos & ~15) | swap23(pos & 15);
  for (int i = 0; i < 8; ++i) {
    const int c0 = cr * 256 + cg * 64 + i * 8;
    float a8[8];
    {
      const f32x4 b0 = *(const f32x4*)(P.ssd_conv_b + c0), b1 = *(const f32x4*)(P.ssd_conv_b + c0 + 4);
      for (int e = 0; e < 4; ++e) { a8[e] = b0[e]; a8[4 + e] = b1[e]; }
    }
#pragma unroll
    for (int k = 0; k < 4; ++k) {
      const int tt = sp0 + t + k - 2;
      if (tt >= 0 && tt < L) {
        float x8[8];
        unpack8(*(const u32x4*)(P.cbuf + (size_t)(tok + k - 2) * C2LD + 1280 + c0), x8);
        const f32x4 w0 = *(const f32x4*)(P.ssd_conv_w + k * 1024 + c0), w1 = *(const f32x4*)(P.ssd_conv_w + k * 1024 + c0 + 4);
        for (int e = 0; e < 4; ++e) { a8[e] += w0[e] * x8[e]; a8[4 + e] += w1[e] * x8[4 + e]; }
      }
    }
#pragma unroll
    for (int e = 0; e < 8; ++e) a8[e] = siluf_(a8[e]);
    const bf16x8 o = pack8(a8);
    *(bf16x8*)(P.h + (size_t)tok * 1024 + c0) = o;
#pragma unroll
    for (int e = 0; e < 8; ++e) P.ut[((size_t)(bi * 1024 + c0 + e)) * NPOS + posp] = (bf16)o[e];
  }
}

DI void ssd_cumsum_item(const Params& P, int gc) {
  const int bi = gc / NCH, ck = gc % NCH;
  int L, sp0, tokbase, pos0; chunk_geom(bi, ck, L, sp0, tokbase, pos0);
  const int lane = tidx() & 63;
  if (lane < 16) {
    const float A = -__expf(P.ssd_a_log[lane]);
    const float bias = P.ssd_dt_bias[lane];
    float cs = 0.f;
    for (int t = 0; t < 128; ++t) {
      const size_t o = (size_t)(tokbase + t) * 16 + lane;
      const float dt = softplusf_(P.dtr[o] + bias);
      cs += dt * A;
      P.dtv[o] = dt;
      P.acs[o] = cs;
    }
  }
}

DI void ssd_passA_item(const Params& P, int gc, int hd, int dir, int pt, int nt) {
  const int bi = gc / NCH, ck = gc % NCH;
  int L, sp0, tokbase, pos0; chunk_geom(bi, ck, L, sp0, tokbase, pos0);
  const int lane = tidx() & 63, r = lane & 31, h = lane >> 5;
  const int idx = dir * 8 + hd, grp = hd >> 2;
  const float total = P.acs[(size_t)(tokbase + 127) * 16 + idx];
  const float Ah = -__expf(P.ssd_a_log[idx]);
  const bf16* xrow = P.ut + ((size_t)(bi * 1024 + hd * 64 + 32 * pt + r)) * NPOS + pos0;
  const bf16* brow = P.ut + ((size_t)(bi * 1024 + 512 + grp * 128 + 32 * nt + r)) * NPOS + pos0;
  f32x16 acc;
#pragma unroll
  for (int e = 0; e < 16; ++e) acc[e] = 0.f;
#pragma unroll
  for (int ks = 0; ks < 8; ++ks) {
    const bf16x8 af = *(const bf16x8*)(xrow + 16 * ks + 8 * h);
    float b8[8];
    unpack8(*(const u32x4*)(brow + 16 * ks + 8 * h), b8);
#pragma unroll
    for (int jj = 0; jj < 8; ++jj) {
      const int l = 16 * ks + 8 * (jj >> 2) + 4 * h + (jj & 3);
      const size_t o = (size_t)(tokbase + l) * 16 + idx;
      const float dt = P.dtv[o], cs = P.acs[o];
      const float wgt = dir == 0 ? dt * __expf(total - cs) : dt * __expf(cs - dt * Ah);
      b8[jj] *= wgt;
    }
    acc = mfma32(af, pack8(b8), acc);
  }
  bf16* dst = P.qkv + ST_OFF + ((size_t)(((bi * 2 + dir) * 8 + hd) * NCH + ck)) * 8192 + 32 * nt + r;
#pragma unroll
  for (int e = 0; e < 16; ++e) dst[(32 * pt + crow(e, h)) * 128] = f2bf(acc[e]);
}

DI void ssd_passB(const Params& P, int bid, int nblk) {
  const int nthr = nblk * 512;
  for (int id = bid * 512 + tidx(); id < NB * 2 * 8 * 2048; id += nthr) {
    const int e4 = id & 2047, hd = (id >> 11) & 7, dir = (id >> 14) & 1, bi = id >> 15;
    bf16* base = P.qkv + ST_OFF + ((size_t)((bi * 2 + dir) * 8 + hd)) * NCH * 8192 + e4 * 4;
    const int idx = dir * 8 + hd;
    float S0 = 0.f, S1 = 0.f, S2 = 0.f, S3 = 0.f;
    for (int i0 = 0; i0 < NCH; i0 += 6) {
      u32x2 raw[6]; float dec[6]; int cks[6];
#pragma unroll
      for (int u = 0; u < 6; ++u) {
        const int i = i0 + u;
        const int ck = dir == 0 ? i : (i == 0 ? 1 : (i == 1 ? 0 : 67 - i));
        cks[u] = ck;
        int L, sp0, tokbase, pos0; chunk_geom(bi, ck, L, sp0, tokbase, pos0);
        raw[u] = *(const u32x2*)(base + (size_t)ck * 8192);
        dec[u] = __expf(P.acs[(size_t)(tokbase + 127) * 16 + idx]);
      }
#pragma unroll
      for (int u = 0; u < 6; ++u) {
        *(u32x2*)(base + (size_t)cks[u] * 8192) = pack4(S0, S1, S2, S3);
        S0 = dec[u] * S0 + lo16(raw[u][0]); S1 = dec[u] * S1 + hi16(raw[u][0]);
        S2 = dec[u] * S2 + lo16(raw[u][1]); S3 = dec[u] * S3 + hi16(raw[u][1]);
      }
    }
  }
}

DI void ssd_passC_item(const Params& P, int bi, int ck, int hd, int lt) {
  int L, sp0, tokbase, pos0; chunk_geom(bi, ck, L, sp0, tokbase, pos0);
  const int lane = tidx() & 63, r = lane & 31, h = lane >> 5;
  const int grp = hd >> 2;
  const int l = lt * 32 + r;
  const size_t tok = tokbase + l;
  const bf16* U = P.h;
  bf16x8 cfr[8];
#pragma unroll
  for (int ks = 0; ks < 8; ++ks) cfr[ks] = *(const bf16x8*)(U + tok * 1024 + 768 + grp * 128 + 16 * ks + 8 * h);
  f32x16 acc[2];
#pragma unroll
  for (int pt = 0; pt < 2; ++pt)
#pragma unroll
    for (int e = 0; e < 16; ++e) acc[pt][e] = 0.f;
  for (int dir = 0; dir < 2; ++dir) {
    const int idx = dir * 8 + hd;
    const float Ah = -__expf(P.ssd_a_log[idx]);
    const float csl = P.acs[tok * 16 + idx], dtl = P.dtv[tok * 16 + idx];
    const float exl = csl - dtl * Ah;
    const float total = P.acs[(size_t)(tokbase + 127) * 16 + idx];
    const float fac = dir == 0 ? __expf(csl) : __expf(total - exl);
#pragma unroll
    for (int pt = 0; pt < 2; ++pt) {
      f32x16 yo;
#pragma unroll
      for (int e = 0; e < 16; ++e) yo[e] = 0.f;
      const bf16* srow = P.qkv + ST_OFF + ((size_t)(((bi * 2 + dir) * 8 + hd) * NCH + ck)) * 8192 + (32 * pt + r) * 128;
#pragma unroll
      for (int ks = 0; ks < 8; ++ks) yo = mfma32(*(const bf16x8*)(srow + 16 * ks + 8 * h), cfr[ks], yo);
#pragma unroll
      for (int e = 0; e < 16; ++e) acc[pt][e] += fac * yo[e];
    }
    const int st_lo = dir == 0 ? 0 : lt, st_hi = dir == 0 ? lt : 3;
    for (int st = st_lo; st <= st_hi; ++st) {
      f32x16 G;
#pragma unroll
      for (int e = 0; e < 16; ++e) G[e] = 0.f;
      const bf16* brow = U + (size_t)(tokbase + st * 32 + r) * 1024 + 512 + grp * 128;
#pragma unroll
      for (int ks = 0; ks < 8; ++ks) G = mfma32(*(const bf16x8*)(brow + 16 * ks + 8 * h), cfr[ks], G);
      float m[16];
#pragma unroll
      for (int e = 0; e < 16; ++e) {
        const int s = st * 32 + crow(e, h);
        const size_t o = (size_t)(tokbase + s) * 16 + idx;
        const float cs_s = P.acs[o], dt_s = P.dtv[o];
        float v;
        if (dir == 0) v = (s <= l) ? G[e] * __expf(csl - cs_s) * dt_s : 0.f;
        else v = (s >= l) ? G[e] * __expf((cs_s - dt_s * Ah) - exl) * dt_s : 0.f;
        m[e] = v;
      }
      float m0[8], m1[8];
#pragma unroll
      for (int e = 0; e < 8; ++e) { m0[e] = m[e]; m1[e] = m[8 + e]; }
      const bf16x8 pb0 = pack8(m0), pb1 = pack8(m1);
#pragma unroll
      for (int pt = 0; pt < 2; ++pt) {
        const bf16* xrow = P.ut + ((size_t)(bi * 1024 + hd * 64 + 32 * pt + r)) * NPOS + pos0 + st * 32;
        acc[pt] = mfma32(*(const bf16x8*)(xrow + 8 * h), pb0, acc[pt]);
        acc[pt] = mfma32(*(const bf16x8*)(xrow + 16 + 8 * h), pb1, acc[pt]);
      }
    }
  }
  const float dsk = P.ssd_d[hd] + P.ssd_d[8 + hd];
  float ss = 0.f;
#pragma unroll
  for (int pt = 0; pt < 2; ++pt)
#pragma unroll
    for (int g = 0; g < 4; ++g) {
      const int p0 = 32 * pt + 8 * g + 4 * h;
      const u32x2 xr = *(const u32x2*)(U + tok * 1024 + hd * 64 + p0);
      const u32x2 zr = *(const u32x2*)(P.cbuf + tok * C2LD + 768 + hd * 64 + p0);
      const float xs[4] = {lo16(xr[0]), hi16(xr[0]), lo16(xr[1]), hi16(xr[1])};
      const float zz[4] = {lo16(zr[0]), hi16(zr[0]), lo16(zr[1]), hi16(zr[1])};
      float o[4];
#pragma unroll
      for (int e = 0; e < 4; ++e) { o[e] = (acc[pt][4 * g + e] + dsk * xs[e]) * siluf_(zz[e]); ss += o[e] * o[e]; }
      *(u32x2*)(P.ycat + tok * 1024 + 512 + hd * 64 + p0) = pack4(o[0], o[1], o[2], o[3]);
    }
  ss = xor32(ss);
  if (h == 0) P.ssq2[tok * 8 + hd] = ss;
}

DI void row_pass(const Params& P, int mode, int layer, int tok, const int* sOff) {
  const int lane = tidx() & 63;
  int bmod, b, pos; bool lat; tok_info(tok, bmod, b, pos, lat);
  const float* src = mode == 0 ? (lat ? P.x + (size_t)tok * 1024 : P.ctx + (size_t)(tok - NL) * 1024)
                               : (lat ? P.out + (size_t)tok * 1024 : P.xc + (size_t)(tok - NL) * 1024);
  f32x4 v[4];
#pragma unroll
  for (int i = 0; i < 4; ++i) v[i] = *(const f32x4*)(src + 4 * lane + 256 * i);
  if (mode == 1 || mode == 2) {
    const int* ti = P.tokinfo + (size_t)tok * 4;
    const int s0 = sOff[ti[0]] + ti[1], s1 = sOff[ti[2]] + ti[3];
    const float w0 = P.tokw[tok * 2], w1 = P.tokw[tok * 2 + 1];
    const float* m5 = P.mods + ((size_t)((mode - 1) * 5 + bmod) * 6 + 5) * 1024;
    float* dst = lat ? P.out + (size_t)tok * 1024 : P.xc + (size_t)(tok - NL) * 1024;
#pragma unroll
    for (int i = 0; i < 4; ++i) {
      const int k = 4 * lane + 256 * i;
      const u32x2 y0 = *(const u32x2*)(P.qkv + (size_t)s0 * 1024 + k), y1 = *(const u32x2*)(P.qkv + (size_t)s1 * 1024 + k);
      const f32x4 mv = *(const f32x4*)(m5 + k);
      v[i][0] += mv[0] * (w0 * lo16(y0[0]) + w1 * lo16(y1[0]));
      v[i][1] += mv[1] * (w0 * hi16(y0[0]) + w1 * hi16(y1[0]));
      v[i][2] += mv[2] * (w0 * lo16(y0[1]) + w1 * lo16(y1[1]));
      v[i][3] += mv[3] * (w0 * hi16(y0[1]) + w1 * hi16(y1[1]));
      *(f32x4*)(dst + k) = v[i];
    }
    if (mode == 2) return;
  }
  float ss = 0.f;
#pragma unroll
  for (int i = 0; i < 4; ++i) ss += v[i][0] * v[i][0] + v[i][1] * v[i][1] + v[i][2] * v[i][2] + v[i][3] * v[i][3];
  ss = wave_sum(ss);
  const float rstd = rsqrtf(ss * (1.f / 1024.f) + EPS);
  const bool n2 = mode == 3;
  const float* g1 = (n2 ? P.norm2_g : P.norm1_g) + layer * 1024;
  const float* sh = P.mods + ((size_t)(layer * 5 + bmod) * 6 + (n2 ? 3 : 0)) * 1024;
  const float* sc = P.mods + ((size_t)(layer * 5 + bmod) * 6 + (n2 ? 4 : 1)) * 1024;
#pragma unroll
  for (int i = 0; i < 4; ++i) {
    const int k = 4 * lane + 256 * i;
    const f32x4 gv = *(const f32x4*)(g1 + k), sv = *(const f32x4*)(sc + k), hv = *(const f32x4*)(sh + k);
    float o[4];
#pragma unroll
    for (int e = 0; e < 4; ++e) o[e] = v[i][e] * rstd * gv[e] * (1.f + sv[e]) + hv[e];
    const u32x2 hi = pack4(o[0], o[1], o[2], o[3]);
    *(u32x2*)(P.h + (size_t)tok * 1024 + k) = hi;
    if (n2) {
      const float r0 = o[0] - lo16(hi[0]), r1 = o[1] - hi16(hi[0]), r2 = o[2] - lo16(hi[1]), r3 = o[3] - hi16(hi[1]);
      *(u32x2*)(P.ycat + (size_t)tok * 1024 + k) = pack4(r0, r1, r2, r3);
    }
  }
}

DI void router_topk(const Params& P, int layer, int tok, const f32x16& acc, int kk, bool active, int* sCnt) {
  float lo[16], hi[16];
#pragma unroll
  for (int i = 0; i < 16; ++i) { const float oth = __shfl_xor(acc[i], 32); lo[i] = kk == 0 ? acc[i] : oth; hi[i] = kk == 0 ? oth : acc[i]; }
  float bestg = -3.0e38f, bu0 = 0.f, bu1 = 0.f;
  int be0 = 0, be1 = 0;
#pragma unroll
  for (int q = 0; q < 4; ++q) {
    float v1 = -3.0e38f, v2 = -3.0e38f, u1 = 0.f, u2 = 0.f;
    int i1 = 0, i2 = 0;
#pragma unroll
    for (int m = 0; m < 8; ++m) {
      const float lg = m < 4 ? lo[4 * q + (m & 3)] : hi[4 * q + (m & 3)];
      const float u = 1.f / (1.f + expf(-lg));
      const float xb = u + P.router_b[8 * q + m];
      if (xb > v1) { v2 = v1; i2 = i1; u2 = u1; v1 = xb; i1 = m; u1 = u; }
      else if (xb > v2) { v2 = xb; i2 = m; u2 = u; }
    }
    const float gs = v1 + v2;
    if (gs > bestg) { bestg = gs; be0 = 8 * q + i1; be1 = 8 * q + i2; bu0 = u1; bu1 = u2; }
  }
  const int tid = tidx();
  if (tid < 32) sCnt[tid] = 0;
  __syncthreads();
  int r0 = 0, r1 = 0;
  if (active && kk == 0) { r0 = atomicAdd(&sCnt[be0], 1); r1 = atomicAdd(&sCnt[be1], 1); }
  __syncthreads();
  if (tid < 32) sCnt[32 + tid] = atomicAdd(P.cnt + layer * 32 + tid, sCnt[tid]);
  __syncthreads();
  if (active && kk == 0) {
    const float inv = 1.f / (bu0 + bu1);
    const int p0 = sCnt[32 + be0] + r0, p1 = sCnt[32 + be1] + r1;
    int* ti = P.tokinfo + (size_t)tok * 4;
    ti[0] = be0; ti[1] = p0; ti[2] = be1; ti[3] = p1;
    P.tokw[tok * 2] = bu0 * inv; P.tokw[tok * 2 + 1] = bu1 * inv;
    P.list[(size_t)be0 * NT + p0] = tok;
    P.list[(size_t)be1 * NT + p1] = tok;
  }
  __syncthreads();
}
DI void router_item(const Params& P, bf16* smem, int layer, int qt) {
  f32x16 acc[1][1];
  const float hs[1] = {1.f};
  const int q0 = qt * 128;
  gemm_core<1, 1, true>(smem, 1024, 0, [&](int rp) { return P.wrt + (size_t)rp * 3072; }, [&](int rq) { return P.h + (size_t)(q0 + rq) * 1024; }, acc, -1, hs);
  gemm_core<1, 1, false>(smem, 1024, 0, [&](int rp) { return P.wrt + (size_t)rp * 3072 + 1024; }, [&](int rq) { return P.h + (size_t)(q0 + rq) * 1024; }, acc, -1, hs);
  gemm_core<1, 1, false>(smem, 1024, 0, [&](int rp) { return P.wrt + (size_t)rp * 3072 + 2048; }, [&](int rq) { return P.ycat + (size_t)(q0 + rq) * 1024; }, acc, -1, hs);
  const WaveId w = wave_id();
  router_topk(P, layer, q0 + w.wc * 32 + w.r, acc[0][0], w.h, w.wr == 0, (int*)(smem + 32768));
}
DI void conv_tile(float* sT, const float* src, int K, int N, bf16* dst, int dld, int rmode, const float* scale, int koff, int tk, int tn) {
  const int tid = tidx();
  const int k0 = tk * 64, n0 = tn * 64;
  {
    const int kk = tid >> 4, n4 = (tid & 15) * 4;
#pragma unroll
    for (int p = 0; p < 2; ++p) {
      const int k = k0 + kk + 32 * p;
      f32x4 v = {0.f, 0.f, 0.f, 0.f};
      if (n0 + n4 < N) v = *(const f32x4*)(src + (size_t)k * N + n0 + n4);
      float s = 1.f;
      if (scale != nullptr && k >= koff) s = scale[k - koff];
#pragma unroll
      for (int e = 0; e < 4; ++e) sT[(kk + 32 * p) * 65 + n4 + e] = v[e] * s;
    }
  }
  __syncthreads();
  {
    const int n = tid >> 3, kc = (tid & 7) * 8;
    if (n0 + n < N) {
      float v8[8];
#pragma unroll
      for (int e = 0; e < 8; ++e) v8[e] = sT[(kc + e) * 65 + n];
      const int nn = n0 + n;
      const int row = rmode == 0 ? nn : (64 * (nn >> 5) + (nn & 31) + (rmode == 2 ? 32 : 0));
      *(bf16x8*)(dst + (size_t)row * dld + k0 + kc) = pack8(v8);
    }
  }
  __syncthreads();
}

DI void conv_moe_tile(const Params& P, float* sT, int layer, int t) {
  const int e = t / 384, u = t % 384;
  if (u < 128) conv_tile(sT, P.moe_w_gate + ((size_t)(layer * 32 + e)) * 1024 * 512, 1024, 512, P.wgut + (size_t)e * 1024 * 1024, 1024, 1, nullptr, 0, u >> 3, u & 7);
  else if (u < 256) conv_tile(sT, P.moe_w_up + ((size_t)(layer * 32 + e)) * 1024 * 512, 1024, 512, P.wgut + (size_t)e * 1024 * 1024, 1024, 2, nullptr, 0, (u - 128) >> 3, (u - 128) & 7);
  else conv_tile(sT, P.moe_w_down + ((size_t)(layer * 32 + e)) * 512 * 1024, 512, 1024, P.wdt + (size_t)e * 1024 * 512, 512, 0, nullptr, 0, (u - 256) >> 4, (u - 256) & 15);
}

constexpr int NCONV_DENSE = 432 + 72 + 64 + 256 + 592 + 256 + 32;
DI void conv_dense_tile(const Params& P, float* sT, int t) {
  if (t < 432) { conv_tile(sT, P.ab_w_in, 1024, 1696, P.win0t, 1024, 0, nullptr, 0, t / 27, t % 27); return; }
  t -= 432;
  if (t < 72) { conv_tile(sT, P.mla_w_q_up, 384, 768, P.wqt, 384, 0, P.mla_q_norm_g, 0, t / 12, t % 12); return; }
  t -= 72;
  if (t < 64) { conv_tile(sT, P.mla_w_kv_up, 256, 1024, P.wkvt, 256, 0, P.mla_kv_norm_g, 0, t / 16, t % 16); return; }
  t -= 64;
  if (t < 256) { conv_tile(sT, P.ab_w_out, 1024, 1024, P.wout0t, 1024, 0, nullptr, 0, t / 16, t % 16); return; }
  t -= 256;
  if (t < 592) { conv_tile(sT, P.cd_w_in, 1024, 2320, P.win1t, 1024, 0, nullptr, 0, t / 37, t % 37); return; }
  t -= 592;
  if (t < 256) { conv_tile(sT, P.cd_w_out, 1024, 1024, P.wout1t, 1024, 0, P.ssd_norm_g, 512, t / 16, t % 16); return; }
  t -= 256;
  {
    const int blk = t & 7, gate = (t >> 3) & 1, dir = t >> 4;
    const float* src = (gate ? P.lru_w_x : P.lru_w_a) + ((size_t)(dir * 8 + blk)) * 4096;
    conv_tile(sT, src, 64, 64, P.wlrut + ((size_t)((dir * 2 + gate) * 8 + blk)) * 4096, 64, 0, nullptr, 0, 0, 0);
  }
}

DI void mods_item(const Params& P, float* sS, float* sR, int layer, int cb) {
  const int tid = tidx(), col = tid & 63, kq = tid >> 6;
  float a[5] = {0.f, 0.f, 0.f, 0.f, 0.f};
  const float* wp = P.ada_w + (size_t)layer * 1024 * 6144 + cb * 64 + col;
  for (int k = kq * 128; k < kq * 128 + 128; ++k) {
    const float wv = wp[(size_t)k * 6144];
#pragma unroll
    for (int v = 0; v < 5; ++v) a[v] += sS[v * 1024 + k] * wv;
  }
#pragma unroll
  for (int v = 0; v < 5; ++v) sR[(kq * 5 + v) * 64 + col] = a[v];
  __syncthreads();
  if (tid < 320) {
    const int v = tid >> 6;
    float s = P.ada_b[layer * 6144 + cb * 64 + col];
    for (int q = 0; q < 8; ++q) s += sR[(q * 5 + v) * 64 + col];
    P.mods[((size_t)(layer * 5 + v)) * 6144 + cb * 64 + col] = s;
  }
  __syncthreads();
}

constexpr int NPHASE = 22;
constexpr int GEMM_LDS = (256 + 256) * 2 * 72 * 2;

DI void run_phase(const Params& P, int ph, unsigned char* lds, int bid, int nblk) {
  bf16* smem = (bf16*)lds;
  float* fsm = (float*)lds;
  int* ism = (int*)lds;
  const int tid = tidx(), wid = tid >> 6;
  const int gw = bid * 8 + wid, ngw = nblk * 8;
  const int nrep = 1 + ((P.pad0 >> ph) & 1);
#define REP for (int rep_ = 0; rep_ < nrep; ++rep_)
#define REPB(bit) for (int rep_ = 0, nr_ = 1 + ((P.pad0 >> (bit)) & 1); rep_ < nr_; ++rep_)
  switch (ph) {
    case 0: {
      if (bid == 0) {
        if (tid < 64) P.cnt[tid] = 0;
        for (int i = tid; i < 128 * 8; i += 512) {
          const int p = i >> 3, f = i & 7;
          float rev = (float)p * __builtin_amdgcn_exp2f(-(float)f * (13.287712379549449f / 8.f)) * 0.15915494309189535f;
          rev -= floorf(rev);
          P.ropeM[i * 2] = __builtin_amdgcn_cosf(rev); P.ropeM[i * 2 + 1] = __builtin_amdgcn_sinf(rev);
        }
        for (int i = tid; i < 128 * 16; i += 512) {
          const int p = i >> 4, f = i & 15;
          float rev = (float)p * __builtin_amdgcn_exp2f(-(float)f * (13.287712379549449f / 16.f)) * 0.15915494309189535f;
          rev -= floorf(rev);
          P.ropeS[i * 2] = __builtin_amdgcn_cosf(rev); P.ropeS[i * 2 + 1] = __builtin_amdgcn_sinf(rev);
        }
        if (tid == 0) {
          float gq = 0.f, gk = 0.f, sq = 0.f, sk = 0.f, sm = 0.f;
          for (int i = 0; i < 96; ++i) { gq = fmaxf(gq, fabsf(P.mla_q_head_g[i])); gk = fmaxf(gk, fabsf(P.mla_k_head_g[i])); }
          for (int i = 0; i < 64; ++i) { sq = fmaxf(sq, fabsf(P.swa_q_head_g[i])); sk = fmaxf(sk, fabsf(P.swa_k_head_g[i])); }
          for (int i = 0; i < 8; ++i) sm = fmaxf(sm, P.swa_sink[i]);
          P.msh[0] = 9.797958971132712f * gq * gk * LOG2E;
          P.msh[1] = fmaxf(8.f * sq * sk, sm) * LOG2E;
        }
      }
      for (int i = bid * 512 + tid; i < 64 * 1024; i += nblk * 512) {
        const int e = i >> 10, k = i & 1023;
        bf16 hi = 0, lo = 0;
        if (e < 32) { const float wv = P.router_w[k * 32 + e]; hi = f2bf(wv); lo = f2bf(wv - bf2f(hi)); }
        P.wrt[(size_t)e * 3072 + k] = hi; P.wrt[(size_t)e * 3072 + 1024 + k] = lo; P.wrt[(size_t)e * 3072 + 2048 + k] = hi;
      }
      for (int i = tid; i < 5 * 1024; i += 512) {
        const float v = i < 4096 ? P.c[i] : P.c_ctx[i - 4096];
        fsm[i] = siluf_(v);
      }
      __syncthreads();
      REPB(24) for (int it = bid; it < 2 * 96; it += nblk) mods_item(P, fsm, fsm + 5120, it / 96, it % 96);
      __syncthreads();
      REP for (int it = bid; it < NCONV_DENSE + 32 * 384; it += nblk) {
        if (it < NCONV_DENSE) conv_dense_tile(P, fsm, it); else conv_moe_tile(P, fsm, 0, it - NCONV_DENSE);
      }
    } break;
    case 1: {
      REP for (int tok = gw; tok < NT; tok += ngw) row_pass(P, 0, 0, tok, nullptr);
    } break;
    case 2: {
      REP for (int it = bid; it < 7 * 132; it += nblk) gemm_c1_item(P, smem, it % 7, it / 7);
    } break;
    case 3: {
      REP for (int it = bid; it < 264 * 8; it += nblk) {
        const int qt = it >> 3, u = it & 7;
        if (u < 4) gemm_q_item(P, smem, u, qt); else gemm_kv_item(P, smem, u - 4, qt);
      }
      __syncthreads();
      for (int i = tid; i < 2560; i += 512) fsm[3072 + i] = i < 2048 ? P.lru_conv_w[i] : P.lru_conv_b[i - 2048];
      for (int i = tid; i < 3072; i += 512) { const int d = i / 1536, u = i % 1536, k = u >> 9, ch = u & 511; fsm[i] = k == 0 ? P.lru_b_a[d * 512 + ch] : (k == 1 ? P.lru_b_x[d * 512 + ch] : 8.f * softplusf_(-P.lru_lambda[d * 512 + ch])); }
      __syncthreads();
      REPB(20) for (int it = bid; it < NB * 8 * LGR; it += nblk) { const int u = it < 256 ? it : it - 256; lru_block_item(P, fsm, it < 256 ? (u >> 6) : (u >> 3), it < 256 ? ((u >> 3) & 7) : (u & 7), it < 256 ? 1 + (u & 7) : 0, 0); }
    } break;
    case 4: {
      for (int i = tid; i < 2560; i += 512) fsm[3072 + i] = i < 2048 ? P.lru_conv_w[i] : P.lru_conv_b[i - 2048];
      for (int i = tid; i < 3072; i += 512) { const int d = i / 1536, u = i % 1536, k = u >> 9, ch = u & 511; fsm[i] = k == 0 ? P.lru_b_a[d * 512 + ch] : (k == 1 ? P.lru_b_x[d * 512 + ch] : 8.f * softplusf_(-P.lru_lambda[d * 512 + ch])); }
      __syncthreads();
      REPB(21) for (int it = bid; it < NB * 8 * LGR; it += nblk) { const int u = it < 256 ? it : it - 256; lru_block_item(P, fsm, it < 256 ? (u >> 6) : (u >> 3), it < 256 ? ((u >> 3) & 7) : (u & 7), it < 256 ? 1 + (u & 7) : 0, 1); }
      __syncthreads();
      const float negM = -P.msh[0];
      REP for (int it = bid; it < 32 + 512; it += nblk) {
        if (it < 32) {
          const int b = it >> 3, hd = it & 7;
          const size_t hb = (size_t)(b * 8 + hd) * NPOS;
          attn_item<96, false>(smem, P.qkv + QB_OFF + hb * 96, P.qkv + KB_OFF + hb * 96, P.qkv + VT_OFF + hb * 64, 0, 256, 4, 4, 0, 0, negM, 0.f,
                               P.ycat + (size_t)(NL + b * LC) * 1024 + hd * 64);
        } else {
          const int u = it - 32, qb = u & 15, hd = (u >> 4) & 7, b = u >> 7;
          const size_t hb = (size_t)(b * 8 + hd) * NPOS;
          attn_item<96, false>(smem, P.qkv + QB_OFF + hb * 96, P.qkv + KB_OFF + hb * 96, P.qkv + VT_OFF + hb * 64, LC + qb * 512, 512, 132, 132, 0, 0, negM, 0.f,
                               P.ycat + (size_t)(b * SEQ + qb * 512) * 1024 + hd * 64);
        }
      }
    } break;
    case 5: {
      REP for (int it = bid; it < 512 + 32; it += nblk) { if (it < 512) gemm_out_item<4>(P, smem, 0, it & 3, it >> 2); else gemm_out_item<2>(P, smem, 0, (it - 512) & 7, 128 + ((it - 512) >> 3)); }
    } break;
    case 6: case 17: {
      const int layer = ph == 6 ? 0 : 1;
      const int ntok = layer == 0 ? NT : NL;
      REP for (int tok = gw; tok < ntok; tok += ngw) row_pass(P, 3, layer, tok, nullptr);
      if (layer == 1) {
        __syncthreads();
        for (int it = bid; it < 32 * 384; it += nblk) conv_moe_tile(P, fsm, 1, it);
      }
    } break;
    case 7: case 18: {
      const int layer = ph == 7 ? 0 : 1;
      const int nit = (layer == 0 ? NT : NL) / 128;
      for (int it = bid; it < nit; it += nblk) router_item(P, smem, layer, it);
    } break;
    case 8: case 9: case 19: case 20: {
      const int layer = ph >= 19 ? 1 : 0;
      const bool second = (ph == 9 || ph == 20);
      __syncthreads();
      if (tid == 0) {
        int off = 0, toff = 0;
        for (int e = 0; e < 32; ++e) { const int c = P.cnt[layer * 32 + e]; ism[e] = c; ism[32 + e] = off; ism[65 + e] = toff; off += c; toff += (c + 255) >> 8; }
        ism[64] = off; ism[97] = toff;
      }
      __syncthreads();
      const int ntile = ism[97], total = ism[64];
      REP for (int it = bid; it < ntile * 4; it += nblk) {
        const int mtg = it >> 2, pt = it & 3;
        int e = 0;
        while (e < 31 && ism[65 + e + 1] <= mtg) ++e;
        const int m0 = (mtg - ism[65 + e]) * 256, cnt_e = ism[e], off_e = ism[32 + e];
        bf16* gsm = smem + 256;
        if (!second) moe1_item(P, gsm, layer, e, m0, pt, cnt_e, off_e); else moe2_item(P, gsm, e, m0, pt, cnt_e, off_e, total);
      }
    } break;
    case 10: case 21: {
      const int layer = ph == 10 ? 0 : 1;
      __syncthreads();
      if (tid == 0) { int off = 0; for (int e = 0; e < 32; ++e) { ism[e] = off; off += P.cnt[layer * 32 + e]; } }
      __syncthreads();
      const int ntok = layer == 0 ? NT : NL;
      for (int tok = gw; tok < ntok; tok += ngw) row_pass(P, layer == 0 ? 1 : 2, 1, tok, ism);
    } break;
    case 11: {
      REP for (int it = bid; it < 10 * 132; it += nblk) { if (it < 9 * 132) gemm_c2_item(P, smem, it % 9, it / 9); else gemm_c2dt_item(P, smem, it - 9 * 132); }
    } break;
    case 12: {
      REPB(22) for (int it = gw; it < NB * NCH; it += ngw) ssd_cumsum_item(P, it);
      REPB(23) for (int it = bid; it < NB * NCH * 4; it += nblk) ssd_conv_item(P, it >> 2, it & 3);
      __syncthreads();
      const float negM = -P.msh[1];
      REP for (int it = bid; it < 512; it += nblk) {
        const int qb = it & 15, hq = (it >> 4) & 7, b = it >> 7;
        const size_t hb = (size_t)(b * 8 + hq) * NPOS, kb = (size_t)(b * 2 + (hq >> 2)) * NPOS;
        const int k0 = qb * 512 - 128 < 0 ? 0 : qb * 512 - 128;
        const int k1 = qb * 512 + 640 > SEQ ? SEQ : qb * 512 + 640;
        const float sinkterm = __builtin_amdgcn_exp2f(P.swa_sink[hq] * LOG2E + negM);
        attn_item<64, true>(smem, P.qkv + Q2_OFF + hb * 64, P.qkv + K2_OFF + kb * 64, P.qkv + V2T_OFF + kb * 64, LC + qb * 512, 512, 4 + (k1 - k0) / 64, 4, k0, qb * 512,
                            negM, sinkterm, P.ycat + (size_t)(b * SEQ + qb * 512) * 1024 + hq * 64);
      }
    } break;
    case 13: {
      REP for (int it = gw; it < NB * NCH * 8 * 2 * 8; it += ngw) {
        const int tile = it & 7, dir = (it >> 3) & 1, hd = (it >> 4) & 7, gc = it >> 7;
        ssd_passA_item(P, gc, hd, dir, tile >> 2, tile & 3);
      }
    } break;
    case 14: ssd_passB(P, bid, nblk); break;
    case 15: {
      REP for (int it = gw; it < NB * 64 * 8 * 4; it += ngw) {
        const int lt = it & 3, hd = (it >> 2) & 7, c = (it >> 5) & 63, bi = it >> 11;
        ssd_passC_item(P, bi, c + 2, hd, lt);
      }
    } break;
    case 16: {
      for (int it = bid; it < 512; it += nblk) gemm_out_item<4>(P, smem, 1, it & 3, it >> 2);
    } break;
    default: break;
  }
}
#define XB_TMO      128
#define XB_XCNT(j)  (256  + 64 * (j))
#define XB_XSUB(j)  (1280 + 64 * (j))
#define XB_XGEN(j)  (2304 + 64 * (j))
#define XB_TOP      3328
#define XB_TOPGEN   3392
#define XCD_BAR_WORDS 3456
#define XB_SPIN_CAP (1u << 22)
#define LAS __attribute__((address_space(3)))
DI unsigned xb_ld(unsigned* p) { return __hip_atomic_load(p, __ATOMIC_RELAXED, __HIP_MEMORY_SCOPE_AGENT); }
DI unsigned xb_add(unsigned* p, unsigned v) { return __hip_atomic_fetch_add(p, v, __ATOMIC_RELAXED, __HIP_MEMORY_SCOPE_AGENT); }
DI unsigned xb_xcc_id() { return (unsigned)__builtin_amdgcn_s_getreg((3 << 11) | 20) & 0xFu; }
#define XB_SPIN(cond, bar) do { unsigned _sp = 0; while (cond) { __builtin_amdgcn_s_sleep(1); \
    if ((++_sp & 255u) == 0u) { if (xb_ld(&(bar)[XB_TMO])) break; if (_sp > XB_SPIN_CAP) { atomicAdd(&(bar)[XB_TMO], 1u); break; } } } } while (0)
struct XcdBarrier { unsigned* bar; unsigned x; volatile LAS unsigned* st; };
DI XcdBarrier xcd_barrier_post(unsigned* bar, volatile LAS unsigned* st) {
  XcdBarrier b; b.bar = bar; b.x = xb_xcc_id(); b.st = st;
  if (tidx() == 0) (void)xb_add(&bar[XB_XCNT(b.x)], 1u);
  return b;
}
DI void xcd_barrier_complete(unsigned* bar, unsigned x, unsigned& nloc, unsigned& nx) {
  const unsigned G = gridDim.x * gridDim.y * gridDim.z;
  unsigned sum, cnt, mine, sp = 0u;
  for (;;) {
    sum = 0u; cnt = 0u; mine = 0u;
#pragma unroll
    for (unsigned j = 0; j < 16; ++j) { const unsigned c = xb_ld(&bar[XB_XCNT(j)]); sum += c; cnt += (c > 0u) ? 1u : 0u; mine = (j == x) ? c : mine; }
    if (sum == G) break;
    __builtin_amdgcn_s_sleep(1);
    if ((++sp & 255u) == 0u) { if (xb_ld(&bar[XB_TMO])) break; if (sp > XB_SPIN_CAP) { atomicAdd(&bar[XB_TMO], 1u); break; } }
  }
  nloc = mine > 0u ? mine : 1u; nx = cnt > 0u ? cnt : 1u;
}
DI void xcd_barrier(const XcdBarrier& b) {
  asm volatile("s_waitcnt vmcnt(0)" ::: "memory");
  __syncthreads();
  if (tidx() == 0) {
    unsigned* bar = b.bar;
    __builtin_amdgcn_s_waitcnt(0);
    unsigned nloc = b.st[0], nx = b.st[1];
    if (nloc == 0u) { xcd_barrier_complete(bar, b.x, nloc, nx); b.st[0] = nloc; b.st[1] = nx; }
    const unsigned old = xb_add(&bar[XB_XSUB(b.x)], 1u);
    const unsigned gen = old / nloc;
    if (old + 1u == (gen + 1u) * nloc) {
      __builtin_amdgcn_fence(__ATOMIC_RELEASE, "agent");
      asm volatile("s_waitcnt vmcnt(0)" ::: "memory");
      const unsigned og = xb_add(&bar[XB_TOP], 1u);
      const unsigned tg = og / nx;
      if (og + 1u == (tg + 1u) * nx) xb_add(&bar[XB_TOPGEN], 1u);
      else XB_SPIN(xb_ld(&bar[XB_TOPGEN]) == tg, bar);
      __builtin_amdgcn_fence(__ATOMIC_ACQUIRE, "agent");
      xb_add(&bar[XB_XGEN(b.x)], 1u);
      asm volatile("s_waitcnt vmcnt(0)" ::: "memory");
    } else {
      XB_SPIN(xb_ld(&bar[XB_XGEN(b.x)]) == gen, bar);
      __builtin_amdgcn_fence(__ATOMIC_ACQUIRE, "agent");
      asm volatile("s_waitcnt vmcnt(0)" ::: "memory");
    }
  }
  __syncthreads();
}

#ifndef PROBE_PH
#define PROBE_PH (-1)
#endif
#ifndef PROBE_K
#define PROBE_K 8
#endif
#ifndef REPMASK
#define REPMASK 0
#endif
#ifndef ONE_LAUNCH
#define ONE_LAUNCH 1
#endif
constexpr int LDS_BYTES = GEMM_LDS + 1024;

#if ONE_LAUNCH
#define BAR_ARG , const XcdBarrier& xb
#define BAR_PASS , xb
#else
#define BAR_ARG
#define BAR_PASS
#endif
template <int PH>
DI void phase_step(unsigned char* lds, int ph_lo, int ph_hi BAR_ARG) {
  if (PH >= ph_lo && PH < ph_hi) {
    const __attribute__((address_space(4))) Params* kp = (const __attribute__((address_space(4))) Params*)__builtin_amdgcn_kernarg_segment_ptr();
    asm volatile("" : "+s"(kp));
    run_phase(*(const Params*)kp, PH, lds, blockIdx.x, gridDim.x);
#if ONE_LAUNCH
    if (PROBE_PH >= 0 && PH + 1 == ph_hi) { asm volatile("s_waitcnt vmcnt(0)" ::: "memory"); __syncthreads(); }
    if (PROBE_PH >= 0 && tidx() == 0 && blockIdx.x == 0 && PH + 1 == ph_hi) ((volatile unsigned long long*)(lds + GEMM_LDS + 528))[PH + 1] = __builtin_amdgcn_s_memrealtime();
    if (PH + 1 < ph_hi) {
      if (PH == 0) cg::this_grid().sync(); else xcd_barrier(xb);
      if ((REPMASK >> 25) & 1) xcd_barrier(xb);
      if (PROBE_PH >= 0 && tidx() == 0 && blockIdx.x == 0) ((volatile unsigned long long*)(lds + GEMM_LDS + 528))[PH + 1] = __builtin_amdgcn_s_memrealtime();
    }
#endif
  }
}

__global__ void __launch_bounds__(512, 2) mega(Params P, int ph_lo, int ph_hi) {
  extern __shared__ __attribute__((aligned(16))) unsigned char lds[];
#if ONE_LAUNCH
  volatile LAS unsigned* st = (volatile LAS unsigned*)(lds + GEMM_LDS + 512);
  if (tidx() < 2) st[tidx()] = 0u;
  __syncthreads();
  XcdBarrier xb = xcd_barrier_post(P.bar, st);
#endif
#if ONE_LAUNCH
  if (PROBE_PH >= 0 && tidx() == 0 && blockIdx.x == 0) ((volatile unsigned long long*)(lds + GEMM_LDS + 528))[0] = __builtin_amdgcn_s_memrealtime();
#endif
#define STEP(N) phase_step<N>(lds, ph_lo, ph_hi BAR_PASS);
  STEP(0) STEP(1) STEP(2) STEP(3) STEP(4) STEP(5) STEP(6) STEP(7) STEP(8) STEP(9)
  STEP(10) STEP(11) STEP(12) STEP(13) STEP(14) STEP(15) STEP(16) STEP(17) STEP(18) STEP(19) STEP(20) STEP(21)
#undef STEP
#if ONE_LAUNCH
  if (PROBE_PH >= 0 && tidx() == 0 && blockIdx.x == 0) {
    volatile unsigned long long* ts = (volatile unsigned long long*)(lds + GEMM_LDS + 528);
    const unsigned long long dur = ts[PROBE_PH + 1] - ts[PROBE_PH];
    const unsigned long long until = ts[NPHASE] + (unsigned long long)PROBE_K * dur;
    while (__builtin_amdgcn_s_memrealtime() < until) __builtin_amdgcn_s_sleep(32);
  }
#endif
}

static size_t carve(size_t& off, size_t bytes) { size_t o = off; off = (off + bytes + 255) & ~(size_t)255; return o; }

extern "C" void kernel_launch(void* const* d_in, const int* in_sizes, int n_in, void* d_out, int out_size, void* d_ws, size_t ws_size, hipStream_t stream) {
  static int grid = 0;
  if (grid == 0) {
    int dev = 0, cus = 0, per_cu = 0;
    hipGetDevice(&dev);
    hipDeviceGetAttribute(&cus, hipDeviceAttributeMultiprocessorCount, dev);
    if (hipFuncSetAttribute((const void*)mega, hipFuncAttributeMaxDynamicSharedMemorySize, LDS_BYTES) != hipSuccess) { fprintf(stderr, "kernel_launch: hipFuncSetAttribute failed\n"); }
    hipOccupancyMaxActiveBlocksPerMultiprocessor(&per_cu, (const void*)mega, 512, LDS_BYTES);
    if (per_cu < 1) { fprintf(stderr, "kernel_launch: occupancy query says %d blocks per CU\n", per_cu); per_cu = 1; }
    (void)hipGetLastError();
    grid = cus;
  }
  Params P;
  memset(&P, 0, sizeof(P));
  P.pad0 = REPMASK;
  const float** in = (const float**)&P;
  for (int i = 0; i < 39 && i < n_in; ++i) in[i] = (const float*)d_in[i];
  P.out = (float*)d_out;
  char* ws = (char*)d_ws;
  size_t off = 0;
  P.bar = (unsigned*)(ws + carve(off, XCD_BAR_WORDS * 4));
  P.mods = (float*)(ws + carve(off, 2 * 5 * 6144 * 4));
  P.ropeM = (float*)(ws + carve(off, 128 * 8 * 2 * 4));
  P.ropeS = (float*)(ws + carve(off, 128 * 16 * 2 * 4));
  P.msh = (float*)(ws + carve(off, 64));
  P.win0t = (bf16*)(ws + carve(off, (size_t)1792 * 1024 * 2));
  P.wqt = (bf16*)(ws + carve(off, (size_t)768 * 384 * 2));
  P.wkvt = (bf16*)(ws + carve(off, (size_t)1024 * 256 * 2));
  P.wout0t = (bf16*)(ws + carve(off, (size_t)1024 * 1024 * 2));
  P.win1t = (bf16*)(ws + carve(off, (size_t)2432 * 1024 * 2));
  P.wout1t = (bf16*)(ws + carve(off, (size_t)1024 * 1024 * 2));
  P.wlrut = (bf16*)(ws + carve(off, (size_t)32 * 4096 * 2));
  P.wgut = (bf16*)(ws + carve(off, (size_t)32 * 1024 * 1024 * 2));
  P.wdt = (bf16*)(ws + carve(off, (size_t)32 * 1024 * 512 * 2));
  P.wrt = (bf16*)(ws + carve(off, (size_t)64 * 3072 * 2));
  P.ut = P.wgut;
  P.xc = (float*)(ws + carve(off, (size_t)NC * 1024 * 4));
  P.h = (bf16*)(ws + carve(off, (size_t)NT * 1024 * 2));
  P.cbuf = (bf16*)(ws + carve(off, (size_t)NT * C2LD * 2));
  P.qkv = (bf16*)(ws + carve(off, QKV_ELEMS * 2));
  P.ycat = (bf16*)(ws + carve(off, (size_t)NT * 1024 * 2));
  P.ssqc = (float*)(ws + carve(off, (size_t)NT * 16 * 4));
  P.ssqx = (float*)(ws + carve(off, (size_t)NT * 16 * 4));
  P.ssq2 = (float*)(ws + carve(off, (size_t)NT * 8 * 4));
  P.comp = (float*)(ws + carve(off, (size_t)NB * 2 * LCH * 512 * 2 * 4));
  P.gcomp = (float*)(ws + carve(off, (size_t)NB * 2 * LGR * 512 * 2 * 4));
  P.dtr = (float*)(ws + carve(off, (size_t)NT * 16 * 4));
  P.dtv = (float*)(ws + carve(off, (size_t)NT * 16 * 4));
  P.acs = (float*)(ws + carve(off, (size_t)NT * 16 * 4));
  P.cnt = (int*)(ws + carve(off, 64 * 4));
  P.tokinfo = (int*)(ws + carve(off, (size_t)NT * 4 * 4));
  P.tokw = (float*)(ws + carve(off, (size_t)NT * 2 * 4));
  P.list = (int*)(ws + carve(off, (size_t)32 * NT * 4));
  if (off > ws_size || n_in != 39 || out_size != NL * 1024) {
    fprintf(stderr, "kernel_launch: needs %zu bytes of workspace (got %zu), 39 inputs (got %d), out %d (got %d); nothing launched\n", off, ws_size, n_in, NL * 1024, out_size);
    return;
  }
#if ONE_LAUNCH
  hipMemsetAsync(P.bar, 0, XCD_BAR_WORDS * 4, stream);
  int lo = 0, hi = NPHASE;
  void* args[] = {&P, &lo, &hi};
  hipError_t e = hipLaunchCooperativeKernel((const void*)mega, dim3(grid), dim3(512), args, LDS_BYTES, stream);
  if (e != hipSuccess) fprintf(stderr, "kernel_launch: cooperative launch failed: %s (grid %d)\n", hipGetErrorString(e), grid);
#else
  for (int ph = 0; ph < NPHASE; ++ph) hipLaunchKernelGGL(mega, dim3(grid), dim3(512), LDS_BYTES, stream, P, ph, ph + 1);
#endif
}
```

```cpp
#define REPMASK 0
#define PROBE_PH (-1)
#define PROBE_SEC 0
#include <hip/hip_runtime.h>
#include <hip/hip_cooperative_groups.h>
#include <cstdio>
#include <cstdint>
#include <cstring>
namespace cg = cooperative_groups;

#define DI __device__ __forceinline__
typedef unsigned short bf16;
typedef __attribute__((ext_vector_type(8))) short bf16x8;
typedef __attribute__((ext_vector_type(16))) float f32x16;
typedef __attribute__((ext_vector_type(8))) float f32x8;
typedef __attribute__((ext_vector_type(4))) float f32x4;
typedef __attribute__((ext_vector_type(2))) float f32x2;
typedef __attribute__((ext_vector_type(4))) unsigned u32x4;
typedef __attribute__((ext_vector_type(2))) unsigned u32x2;
typedef __attribute__((ext_vector_type(2))) __bf16 bfx2;
typedef __attribute__((ext_vector_type(8))) __bf16 bfx8;

constexpr int D = 1024, NB = 4, SEQ = 8192, LC = 256;
constexpr int NL = NB * SEQ;
constexpr int NC = NB * LC;
constexpr int NT = NL + NC;
constexpr int NPOS = SEQ + LC;
constexpr int C1LD = 1696, C2LD = 2320;
constexpr int NCH = 66;
constexpr float EPS = 1e-6f;
constexpr float LOG2E = 1.4426950408889634f;
constexpr int NSLOT = 2 * NT;

#ifndef PROBE_PH
#define PROBE_PH (-1)
#endif
#ifndef PROBE_SEC
#define PROBE_SEC 0
#endif
#define PROBE_LDS_OFF (147456 + 800)
#define PB_BEGIN(SEC, lds_) unsigned long long pb_t0_##SEC = 0; if (PROBE_PH == -2 && PROBE_SEC == SEC && blockIdx.x == 0) { __syncthreads(); pb_t0_##SEC = __builtin_amdgcn_s_memrealtime(); }
#define PB_END(SEC, lds_) if (PROBE_PH == -2 && PROBE_SEC == SEC && blockIdx.x == 0) { __syncthreads(); if (threadIdx.x == 0) *(volatile unsigned long long*)((unsigned char*)(lds_) + PROBE_LDS_OFF) += __builtin_amdgcn_s_memrealtime() - pb_t0_##SEC; }
#define PBW_BEGIN(SEC, lds_) unsigned long long pbw_t0_##SEC = 0; if (PROBE_PH == -2 && PROBE_SEC == SEC && blockIdx.x == 0 && threadIdx.x < 64) { pbw_t0_##SEC = __builtin_amdgcn_s_memrealtime(); }
#define PBW_END(SEC, lds_) if (PROBE_PH == -2 && PROBE_SEC == SEC && blockIdx.x == 0 && threadIdx.x == 0) { *(volatile unsigned long long*)((unsigned char*)(lds_) + PROBE_LDS_OFF) += __builtin_amdgcn_s_memrealtime() - pbw_t0_##SEC; }
DI int tidx() { int t = threadIdx.x; asm volatile("" : "+v"(t)); return t; }
DI float bf2f(bf16 u) { return __uint_as_float(((unsigned)u) << 16); }
DI float lo16(unsigned u) { return __uint_as_float(u << 16); }
DI float hi16(unsigned u) { return __uint_as_float(u & 0xffff0000u); }
DI unsigned pack2(float a, float b) { f32x2 v = {a, b}; bfx2 r = __builtin_convertvector(v, bfx2); return __builtin_bit_cast(unsigned, r); }
DI bf16 f2bf(float x) { return (bf16)(pack2(x, 0.f) & 0xffffu); }
DI bf16x8 pack8(const float (&v)[8]) { f32x8 t; for (int i = 0; i < 8; ++i) t[i] = v[i]; bfx8 r = __builtin_convertvector(t, bfx8); return __builtin_bit_cast(bf16x8, r); }
DI u32x2 pack4(float a, float b, float c, float d) { u32x2 r; r[0] = pack2(a, b); r[1] = pack2(c, d); return r; }
DI void unpack8(u32x4 raw, float (&v)[8]) { for (int i = 0; i < 4; ++i) { v[2 * i] = lo16(raw[i]); v[2 * i + 1] = hi16(raw[i]); } }
DI int crow(int i, int h) { return (i & 3) + 8 * (i >> 2) + 4 * h; }
DI int swap23(int p) { return (p & ~12) | ((p & 4) << 1) | ((p & 8) >> 1); }
DI f32x16 mfma32(bf16x8 a, bf16x8 b, f32x16 c) { return __builtin_amdgcn_mfma_f32_32x32x16_bf16(a, b, c, 0, 0, 0); }
DI f32x4 mfma16(bf16x8 a, bf16x8 b, f32x4 c) { return __builtin_amdgcn_mfma_f32_16x16x32_bf16(a, b, c, 0, 0, 0); }
DI float sigmoidf_(float x) { return 1.f / (1.f + __expf(-x)); }
DI float siluf_(float x) { return x / (1.f + __expf(-x)); }
DI float softplusf_(float x) { return x > 20.f ? x : log1pf(__expf(x)); }
DI float geluf_(float x) { float u = 0.7978845608028654f * (x + 0.044715f * x * x * x); float t = 1.f - 2.f / (1.f + __expf(2.f * u)); return 0.5f * x * (1.f + t); }
DI float xor32(float v) { return v + __shfl_xor(v, 32); }
DI float wave_sum(float v) { for (int o = 32; o >= 1; o >>= 1) v += __shfl_xor(v, o); return v; }

DI void tok_info(int tok, int& bmod, int& b, int& pos, bool& lat) {
  if (tok < NL) { b = tok >> 13; bmod = b; pos = LC + (tok & (SEQ - 1)); lat = true; }
  else { int t = tok - NL; b = t >> 8; bmod = 4; pos = t & (LC - 1); lat = false; }
}

struct Params {
  const float *x, *c, *ctx, *c_ctx, *ada_w, *ada_b, *norm1_g, *norm2_g;
  const float *ab_w_in, *ab_w_out, *mla_q_norm_g, *mla_w_q_up, *mla_kv_norm_g, *mla_w_kv_up, *mla_q_head_g, *mla_k_head_g;
  const float *lru_conv_w, *lru_conv_b, *lru_w_a, *lru_b_a, *lru_w_x, *lru_b_x, *lru_lambda;
  const float *cd_w_in, *cd_w_out, *swa_q_head_g, *swa_k_head_g, *swa_sink;
  const float *ssd_conv_w, *ssd_conv_b, *ssd_a_log, *ssd_dt_bias, *ssd_d, *ssd_norm_g;
  const float *router_w, *router_b, *moe_w_gate, *moe_w_up, *moe_w_down;
  float* out;
  float* mods;
  float* ropeM;
  float* ropeS;
  float* msh;
  bf16 *win0t, *wqt, *wkvt, *wout0t, *win1t, *wout1t, *wlrut, *wgut, *wdt, *wrt;
  float* xc;
  bf16* h;
  bf16* cbuf;
  bf16* qkv;
  bf16* ycat;
  bf16* ut;
  float *ssqc, *ssqx, *ssq2;
  float* comp;
  float* gcomp;
  float* dtr;
  float *cst, *dtt, *wgp;
  int* cnt;
  int* cntt;
  int* tokinfo;
  float* tokw;
  int* list;
  unsigned* bar;
  int pad0;
  int pad1;
};
constexpr size_t QB_OFF = 0, KB_OFF = (size_t)NB * 8 * NPOS * 96, VT_OFF = 2 * KB_OFF;
constexpr size_t Q2_OFF = 0, K2_OFF = (size_t)NB * 8 * NPOS * 64, V2T_OFF = K2_OFF + (size_t)NB * 2 * NPOS * 64,
                 ST_OFF = V2T_OFF + (size_t)NB * 2 * 64 * NPOS;
constexpr size_t QKV_ELEMS = (size_t)NSLOT * 1024;
static_assert(VT_OFF + (size_t)NB * 8 * 64 * NPOS <= QKV_ELEMS, "qkv region");
static_assert(ST_OFF + (size_t)NB * 2 * 8 * NCH * 64 * 128 <= QKV_ELEMS, "qkv region L1");
template <int WM, int WN, bool ZERO = true, class PRow, class QRow>
DI void gemm_core(bf16* smem, int K, int krot, PRow prow, QRow qrow, f32x16 (&acc)[WM][WN], int hook_kt, const float (&hs)[WN]) {
  constexpr int TP = 64 * WM, TQ = 128 * WN, LD = 72, NP = TP / 64, NQ = TQ / 64;
  const int tid = tidx(), lane = tid & 63, wid = tid >> 6, wr = wid >> 2, wc = wid & 3, r = lane & 31, h = lane >> 5;
  const int c8 = tid & 7, rr = tid >> 3;
  bf16* sP0 = smem;
  bf16* sQ0 = smem + 2 * TP * LD;
  const bf16* pP[NP];
  const bf16* pQ[NQ];
#pragma unroll
  for (int i = 0; i < NP; ++i) pP[i] = prow(rr + 64 * i) + c8 * 8;
#pragma unroll
  for (int i = 0; i < NQ; ++i) pQ[i] = qrow(rr + 64 * i) + c8 * 8;
  u32x4 rP[NP], rQ[NQ];
  const int nkt = K >> 6;
  if (ZERO) {
#pragma unroll
    for (int i = 0; i < WM; ++i)
#pragma unroll
      for (int j = 0; j < WN; ++j)
#pragma unroll
        for (int e = 0; e < 16; ++e) acc[i][j][e] = 0.f;
  }
  {
    const int ko = (krot % nkt) * 64;
#pragma unroll
    for (int i = 0; i < NP; ++i) rP[i] = *(const u32x4*)(pP[i] + ko);
#pragma unroll
    for (int i = 0; i < NQ; ++i) rQ[i] = *(const u32x4*)(pQ[i] + ko);
#pragma unroll
    for (int i = 0; i < NP; ++i) *(u32x4*)(sP0 + (rr + 64 * i) * LD + c8 * 8) = rP[i];
#pragma unroll
    for (int i = 0; i < NQ; ++i) *(u32x4*)(sQ0 + (rr + 64 * i) * LD + c8 * 8) = rQ[i];
  }
  __syncthreads();
  for (int kt = 0; kt < nkt; ++kt) {
    const int buf = kt & 1;
    if (kt + 1 < nkt) {
      const int ko = ((kt + 1 + krot) % nkt) * 64;
#pragma unroll
      for (int i = 0; i < NP; ++i) rP[i] = *(const u32x4*)(pP[i] + ko);
#pragma unroll
      for (int i = 0; i < NQ; ++i) rQ[i] = *(const u32x4*)(pQ[i] + ko);
    }
    if (kt == hook_kt) {
#pragma unroll
      for (int i = 0; i < WM; ++i)
#pragma unroll
        for (int j = 0; j < WN; ++j)
#pragma unroll
          for (int e = 0; e < 16; ++e) acc[i][j][e] *= hs[j];
    }
    const bf16* sP = sP0 + buf * TP * LD + (wr * WM * 32 + r) * LD + h * 8;
    const bf16* sQ = sQ0 + buf * TQ * LD + (wc * WN * 32 + r) * LD + h * 8;
#pragma unroll
    for (int ks = 0; ks < 4; ++ks) {
      bf16x8 a[WM], b[WN];
#pragma unroll
      for (int i = 0; i < WM; ++i) a[i] = *(const bf16x8*)(sP + i * 32 * LD + ks * 16);
#pragma unroll
      for (int j = 0; j < WN; ++j) b[j] = *(const bf16x8*)(sQ + j * 32 * LD + ks * 16);
#pragma unroll
      for (int i = 0; i < WM; ++i)
#pragma unroll
        for (int j = 0; j < WN; ++j) acc[i][j] = mfma32(a[i], b[j], acc[i][j]);
    }
    if (kt + 1 < nkt) {
      const int nb = buf ^ 1;
#pragma unroll
      for (int i = 0; i < NP; ++i) *(u32x4*)(sP0 + nb * TP * LD + (rr + 64 * i) * LD + c8 * 8) = rP[i];
#pragma unroll
      for (int i = 0; i < NQ; ++i) *(u32x4*)(sQ0 + nb * TQ * LD + (rr + 64 * i) * LD + c8 * 8) = rQ[i];
    }
    __syncthreads();
  }
}

struct WaveId { int lane, wid, wr, wc, r, h; };
DI WaveId wave_id() { WaveId w; w.lane = tidx() & 63; w.wid = tidx() >> 6; w.wr = w.wid >> 2; w.wc = w.wid & 3; w.r = w.lane & 31; w.h = w.lane >> 5; return w; }

DI void gemm_c1_item(const Params& P, bf16* smem, int pt, int qt) {
  f32x16 acc[4][2];
  const float hs[2] = {1.f, 1.f};
  const int p0 = pt * 256, q0 = qt * 256;
  gemm_core<4, 2>(smem, 1024, 0,
      [&](int rp) { return P.win0t + (size_t)(p0 + rp) * 1024; },
      [&](int rq) { return P.h + (size_t)(q0 + rq) * 1024; }, acc, -1, hs);
  const WaveId w = wave_id();
#pragma unroll
  for (int j = 0; j < 2; ++j) {
    const int tok = q0 + w.wc * 64 + j * 32 + w.r;
#pragma unroll
    for (int i2 = 0; i2 < 2; ++i2) {
      const int grp = (p0 + w.wr * 128 + i2 * 64) >> 6;
      float ss = 0.f;
#pragma unroll
      for (int ii = 0; ii < 2; ++ii)
#pragma unroll
        for (int g = 0; g < 4; ++g) {
          const int i = i2 * 2 + ii;
          const int f0 = p0 + w.wr * 128 + i * 32 + 8 * g + 4 * w.h;
          const float a0 = acc[i][j][4 * g], a1 = acc[i][j][4 * g + 1], a2 = acc[i][j][4 * g + 2], a3 = acc[i][j][4 * g + 3];
          ss += a0 * a0 + a1 * a1 + a2 * a2 + a3 * a3;
          if (f0 < C1LD) *(u32x2*)(P.cbuf + (size_t)tok * C1LD + f0) = pack4(a0, a1, a2, a3);
        }
      ss = xor32(ss);
      if (w.h == 0 && grp < 10) P.ssqc[tok * 16 + grp] = ss;
    }
  }
}

#define rope_pair(X1, X2, TAB) do { const float* tb_ = (TAB); const float cs_ = tb_[0], sn_ = tb_[1]; const float a_ = (X1) * cs_ - (X2) * sn_, b_ = (X1) * sn_ + (X2) * cs_; (X1) = a_; (X2) = b_; } while (0)

DI void gemm_q_item(const Params& P, bf16* smem, int pt, int qt) {
  f32x16 acc[3][1];
  const float hs[1] = {1.f};
  const int p0 = pt * 192, q0 = qt * 128;
  gemm_core<3, 1>(smem, 384, 0,
      [&](int rp) { return P.wqt + (size_t)(p0 + rp) * 384; },
      [&](int rq) { return P.cbuf + (size_t)(q0 + rq) * C1LD; }, acc, -1, hs);
  const WaveId w = wave_id();
  const int hd = pt * 2 + w.wr;
  const float qscale = 0.10206207261596575f * LOG2E;
#pragma unroll
  for (int j = 0; j < 1; ++j) {
    const int tok = q0 + w.wc * 32 + w.r;
    int bmod, b, pos; bool lat; tok_info(tok, bmod, b, pos, lat);
    float s6 = 0.f;
    for (int g = 0; g < 6; ++g) s6 += P.ssqc[tok * 16 + g];
    const float rstd = rsqrtf(s6 * (1.f / 384.f) + EPS);
    float ss = 0.f;
#pragma unroll
    for (int i = 0; i < 3; ++i)
#pragma unroll
      for (int e = 0; e < 16; ++e) { acc[i][j][e] *= rstd; ss += acc[i][j][e] * acc[i][j][e]; }
    ss = xor32(ss);
    const float r2 = rsqrtf(ss * (1.f / 96.f) + EPS);
#pragma unroll
    for (int i = 0; i < 3; ++i)
#pragma unroll
      for (int g = 0; g < 4; ++g) {
        const f32x4 gg = *(const f32x4*)(P.mla_q_head_g + i * 32 + 8 * g + 4 * w.h);
#pragma unroll
        for (int e = 0; e < 4; ++e) acc[i][j][4 * g + e] *= r2 * gg[e];
      }
    if (lat) {
      const int sq = tok & (SEQ - 1), rowp = sq >> 6, colp = sq & 63;
#pragma unroll
      for (int e = 0; e < 4; ++e) {
        rope_pair(acc[2][j][e], acc[2][j][4 + e], P.ropeM + (rowp * 8 + 4 * w.h + e) * 2);
        rope_pair(acc[2][j][8 + e], acc[2][j][12 + e], P.ropeM + (colp * 8 + 4 * w.h + e) * 2);
      }
    }
    bf16* dst = P.qkv + QB_OFF + ((size_t)(b * 8 + hd) * NPOS + pos) * 96;
#pragma unroll
    for (int i = 0; i < 3; ++i)
#pragma unroll
      for (int g = 0; g < 4; ++g)
        *(u32x2*)(dst + i * 32 + 8 * g + 4 * w.h) = pack4(acc[i][j][4 * g] * qscale, acc[i][j][4 * g + 1] * qscale, acc[i][j][4 * g + 2] * qscale, acc[i][j][4 * g + 3] * qscale);
  }
}

DI void gemm_kv_item(const Params& P, bf16* smem, int pt, int qt) {
  f32x16 acc[4][1];
  const float hs[1] = {1.f};
  const int p0 = pt * 256, q0 = qt * 128;
  gemm_core<4, 1>(smem, 256, 0,
      [&](int rp) { return P.wkvt + (size_t)(p0 + rp) * 256; },
      [&](int rq) { return P.cbuf + (size_t)(q0 + rq) * C1LD + 384; }, acc, -1, hs);
  const WaveId w = wave_id();
  const int hd = pt * 2 + w.wr;
#pragma unroll
  for (int j = 0; j < 1; ++j) {
    const int tok = q0 + w.wc * 32 + w.r;
    int bmod, b, pos; bool lat; tok_info(tok, bmod, b, pos, lat);
    float s4 = 0.f;
    for (int g = 6; g < 10; ++g) s4 += P.ssqc[tok * 16 + g];
    const float rstd = rsqrtf(s4 * (1.f / 256.f) + EPS);
    float kr[16];
    {
      const bf16* src = P.cbuf + (size_t)tok * C1LD + 640 + 16 * w.h;
      float t8[8];
      unpack8(*(const u32x4*)src, t8);
      for (int i = 0; i < 8; ++i) kr[i] = t8[i];
      unpack8(*(const u32x4*)(src + 8), t8);
      for (int i = 0; i < 8; ++i) kr[8 + i] = t8[i];
    }
    float ss = 0.f;
#pragma unroll
    for (int i = 0; i < 2; ++i)
#pragma unroll
      for (int e = 0; e < 16; ++e) { acc[i][j][e] *= rstd; ss += acc[i][j][e] * acc[i][j][e]; }
#pragma unroll
    for (int i = 0; i < 16; ++i) ss += kr[i] * kr[i];
    ss = xor32(ss);
    const float r2 = rsqrtf(ss * (1.f / 96.f) + EPS);
    bf16* dst = P.qkv + KB_OFF + ((size_t)(b * 8 + hd) * NPOS + pos) * 96;
#pragma unroll
    for (int i = 0; i < 2; ++i)
#pragma unroll
      for (int g = 0; g < 4; ++g) {
        const f32x4 gg = *(const f32x4*)(P.mla_k_head_g + i * 32 + 8 * g + 4 * w.h);
        *(u32x2*)(dst + i * 32 + 8 * g + 4 * w.h) = pack4(acc[i][j][4 * g] * r2 * gg[0], acc[i][j][4 * g + 1] * r2 * gg[1], acc[i][j][4 * g + 2] * r2 * gg[2], acc[i][j][4 * g + 3] * r2 * gg[3]);
      }
#pragma unroll
    for (int i = 0; i < 16; ++i) kr[i] *= r2 * P.mla_k_head_g[64 + 16 * w.h + i];
    if (lat) {
      const int sq = tok & (SEQ - 1);
      const int pp = w.h ? (sq & 63) : (sq >> 6);
#pragma unroll
      for (int i = 0; i < 8; ++i) rope_pair(kr[i], kr[8 + i], P.ropeM + (pp * 8 + i) * 2);
    }
    {
      u32x4 o0, o1;
      for (int i = 0; i < 4; ++i) { o0[i] = pack2(kr[2 * i], kr[2 * i + 1]); o1[i] = pack2(kr[8 + 2 * i], kr[8 + 2 * i + 1]); }
      *(u32x4*)(dst + 64 + 16 * w.h) = o0;
      *(u32x4*)(dst + 64 + 16 * w.h + 8) = o1;
    }
    const int posp = (pos & ~15) | swap23(pos & 15);
    bf16* vdst = P.qkv + VT_OFF + (size_t)(b * 8 + hd) * 64 * NPOS + posp;
#pragma unroll
    for (int i = 0; i < 2; ++i)
#pragma unroll
      for (int e = 0; e < 16; ++e) vdst[(size_t)(i * 32 + crow(e, w.h)) * NPOS] = f2bf(acc[2 + i][j][e] * rstd);
  }
}

template <int WM>
DI void gemm_out_item(const Params& P, bf16* smem, int layer, int pt, int qt) {
  f32x16 acc[WM][2];
  const int p0 = pt * 64 * WM, q0 = qt * 256;
  const WaveId w = wave_id();
  float hs[2] = {1.f, 1.f};
  if (layer == 1) {
#pragma unroll
    for (int j = 0; j < 2; ++j) {
      const int tok = q0 + w.wc * 64 + j * 32 + w.r;
      float s = 0.f;
      for (int g = 0; g < 8; ++g) s += P.ssq2[tok * 8 + g];
      hs[j] = rsqrtf(s * (1.f / 512.f) + EPS);
    }
  }
  const bf16* wt = layer ? P.wout1t : P.wout0t;
  gemm_core<WM, 2>(smem, 1024, layer ? 8 : 0,
      [&](int rp) { return wt + (size_t)(p0 + rp) * 1024; },
      [&](int rq) { return P.ycat + (size_t)(q0 + rq) * 1024; }, acc, layer ? 8 : -1, hs);
#pragma unroll
  for (int j = 0; j < 2; ++j) {
    const int tok = q0 + w.wc * 64 + j * 32 + w.r;
    int bmod, b, pos; bool lat; tok_info(tok, bmod, b, pos, lat);
    const float* src = layer ? (P.out + (size_t)tok * 1024) : (lat ? P.x + (size_t)tok * 1024 : P.ctx + (size_t)(tok - NL) * 1024);
    float* dst = lat ? P.out + (size_t)tok * 1024 : P.xc + (size_t)(tok - NL) * 1024;
    const float* m2 = P.mods + ((size_t)(layer * 5 + bmod) * 6 + 2) * 1024;
#pragma unroll
    for (int i = 0; i < WM; ++i)
#pragma unroll
      for (int g = 0; g < 4; ++g) {
        const int f0 = p0 + w.wr * 32 * WM + i * 32 + 8 * g + 4 * w.h;
        const f32x4 xv = *(const f32x4*)(src + f0);
        const f32x4 mv = *(const f32x4*)(m2 + f0);
        f32x4 o;
#pragma unroll
        for (int e = 0; e < 4; ++e) o[e] = xv[e] + mv[e] * acc[i][j][4 * g + e];
        *(f32x4*)(dst + f0) = o;
      }
  }
}

DI void moe1_item(const Params& P, bf16* smem, int layer, int e, int m0, int pt, int cnt_e, int off_e) {
  f32x16 acc[4][2];
  const float hs[2] = {1.f, 1.f};
  const int* lst = P.list + (size_t)e * NT;
  gemm_core<4, 2>(smem, 1024, 0,
      [&](int rp) { return P.wgut + ((size_t)e * 1024 + pt * 256 + rp) * 1024; },
      [&](int rq) { int m = m0 + rq; if (m > cnt_e - 1) m = cnt_e - 1; return P.h + (size_t)lst[m] * 1024; }, acc, -1, hs);
  const WaveId w = wave_id();
#pragma unroll
  for (int j = 0; j < 2; ++j) {
    const int m = m0 + w.wc * 64 + j * 32 + w.r;
    if (m < cnt_e) {
      bf16* dst = P.cbuf + (size_t)(off_e + m) * 512 + pt * 128 + w.wr * 64;
#pragma unroll
      for (int i2 = 0; i2 < 2; ++i2)
#pragma unroll
        for (int g = 0; g < 4; ++g) {
          float o[4];
#pragma unroll
          for (int k = 0; k < 4; ++k) o[k] = siluf_(acc[2 * i2][j][4 * g + k]) * acc[2 * i2 + 1][j][4 * g + k];
          *(u32x2*)(dst + i2 * 32 + 8 * g + 4 * w.h) = pack4(o[0], o[1], o[2], o[3]);
        }
    }
  }
}
DI void moe2_item(const Params& P, bf16* smem, int e, int m0, int pt, int cnt_e, int off_e, int total) {
  f32x16 acc[4][2];
  const float hs[2] = {1.f, 1.f};
  gemm_core<4, 2>(smem, 512, 0,
      [&](int rp) { return P.wdt + ((size_t)e * 1024 + pt * 256 + rp) * 512; },
      [&](int rq) { int s = off_e + m0 + rq; if (s > total - 1) s = total - 1; return P.cbuf + (size_t)s * 512; }, acc, -1, hs);
  const WaveId w = wave_id();
#pragma unroll
  for (int j = 0; j < 2; ++j) {
    const int m = m0 + w.wc * 64 + j * 32 + w.r;
    if (m < cnt_e) {
      bf16* dst = P.qkv + (size_t)(off_e + m) * 1024 + pt * 256 + w.wr * 128;
#pragma unroll
      for (int i = 0; i < 4; ++i)
#pragma unroll
        for (int g = 0; g < 4; ++g)
          *(u32x2*)(dst + i * 32 + 8 * g + 4 * w.h) = pack4(acc[i][j][4 * g], acc[i][j][4 * g + 1], acc[i][j][4 * g + 2], acc[i][j][4 * g + 3]);
    }
  }
}

DI void c2_block_epilogue(const Params& P, const WaveId& w, int fb, int tok, f32x16& a0, f32x16& a1) {
  int bmod, b, pos; bool lat; tok_info(tok, bmod, b, pos, lat);
  const float qscale = 0.125f * LOG2E;
  if (fb < 10) {
    const bool isq = fb < 8;
    const float* gain = isq ? P.swa_q_head_g : P.swa_k_head_g;
    float ss = 0.f;
#pragma unroll
    for (int e = 0; e < 16; ++e) ss += a0[e] * a0[e] + a1[e] * a1[e];
    ss = xor32(ss);
    const float r2 = rsqrtf(ss * (1.f / 64.f) + EPS);
#pragma unroll
    for (int g = 0; g < 4; ++g) {
      const f32x4 g0 = *(const f32x4*)(gain + 8 * g + 4 * w.h), g1 = *(const f32x4*)(gain + 32 + 8 * g + 4 * w.h);
#pragma unroll
      for (int e = 0; e < 4; ++e) { a0[4 * g + e] *= r2 * g0[e]; a1[4 * g + e] *= r2 * g1[e]; }
    }
    if (lat) {
      const int sq = tok & (SEQ - 1), rowp = sq >> 6, colp = sq & 63;
#pragma unroll
      for (int e = 0; e < 4; ++e) {
        rope_pair(a0[e], a0[8 + e], P.ropeS + (rowp * 16 + 4 * w.h + e) * 2);
        rope_pair(a0[4 + e], a0[12 + e], P.ropeS + (rowp * 16 + 8 + 4 * w.h + e) * 2);
        rope_pair(a1[e], a1[8 + e], P.ropeS + (colp * 16 + 4 * w.h + e) * 2);
        rope_pair(a1[4 + e], a1[12 + e], P.ropeS + (colp * 16 + 8 + 4 * w.h + e) * 2);
      }
    }
    if (isq && !lat) return;
    const float sc = isq ? qscale : 1.f;
    bf16* dst = isq ? P.qkv + Q2_OFF + ((size_t)(b * 8 + fb) * NPOS + pos) * 64
                    : P.qkv + K2_OFF + ((size_t)(b * 2 + (fb - 8)) * NPOS + pos) * 64;
#pragma unroll
    for (int g = 0; g < 4; ++g) {
      *(u32x2*)(dst + 8 * g + 4 * w.h) = pack4(a0[4 * g] * sc, a0[4 * g + 1] * sc, a0[4 * g + 2] * sc, a0[4 * g + 3] * sc);
      *(u32x2*)(dst + 32 + 8 * g + 4 * w.h) = pack4(a1[4 * g] * sc, a1[4 * g + 1] * sc, a1[4 * g + 2] * sc, a1[4 * g + 3] * sc);
    }
  } else if (fb < 12) {
    const int posp = (pos & ~15) | swap23(pos & 15);
    bf16* vdst = P.qkv + V2T_OFF + (size_t)(b * 2 + (fb - 10)) * 64 * NPOS + posp;
#pragma unroll
    for (int e = 0; e < 16; ++e) {
      vdst[(size_t)(crow(e, w.h)) * NPOS] = f2bf(a0[e]);
      vdst[(size_t)(32 + crow(e, w.h)) * NPOS] = f2bf(a1[e]);
    }
  } else if (fb < 36) {
    bf16* dst = P.cbuf + (size_t)tok * C2LD + fb * 64;
#pragma unroll
    for (int g = 0; g < 4; ++g) {
      *(u32x2*)(dst + 8 * g + 4 * w.h) = pack4(a0[4 * g], a0[4 * g + 1], a0[4 * g + 2], a0[4 * g + 3]);
      *(u32x2*)(dst + 32 + 8 * g + 4 * w.h) = pack4(a1[4 * g], a1[4 * g + 1], a1[4 * g + 2], a1[4 * g + 3]);
    }
  }
}
DI void gemm_c2_item(const Params& P, bf16* smem, int pt, int qt) {
  f32x16 acc[4][2];
  const float hs[2] = {1.f, 1.f};
  const int p0 = pt * 256, q0 = qt * 256;
  gemm_core<4, 2>(smem, 1024, 0,
      [&](int rp) { return P.win1t + (size_t)(p0 + rp) * 1024; },
      [&](int rq) { return P.h + (size_t)(q0 + rq) * 1024; }, acc, -1, hs);
  const WaveId w = wave_id();
#pragma unroll
  for (int j = 0; j < 2; ++j) {
    const int tok = q0 + w.wc * 64 + j * 32 + w.r;
#pragma unroll
    for (int i2 = 0; i2 < 2; ++i2) c2_block_epilogue(P, w, (p0 + w.wr * 128 + i2 * 64) >> 6, tok, acc[2 * i2][j], acc[2 * i2 + 1][j]);
  }
}
DI void gemm_c2dt_item(const Params& P, bf16* smem, int qt) {
  f32x16 acc[1][2];
  const float hs[2] = {1.f, 1.f};
  const int q0 = qt * 256;
  gemm_core<1, 2>(smem, 1024, 0,
      [&](int rp) { return P.win1t + (size_t)(2304 + rp) * 1024; },
      [&](int rq) { return P.h + (size_t)(q0 + rq) * 1024; }, acc, -1, hs);
  const WaveId w = wave_id();
  if (w.wr == 0) {
#pragma unroll
    for (int j = 0; j < 2; ++j) {
      const int tok = q0 + w.wc * 64 + j * 32 + w.r;
#pragma unroll
      for (int g = 0; g < 2; ++g) {
        f32x4 o = {acc[0][j][4 * g], acc[0][j][4 * g + 1], acc[0][j][4 * g + 2], acc[0][j][4 * g + 3]};
        *(f32x4*)(P.dtr + (size_t)tok * 16 + 8 * g + 4 * w.h) = o;
      }
    }
  }
}
template <int DQK, bool WIN>
DI void attn_item(bf16* smem, const bf16* Qp, const bf16* Kp, const bf16* Vtp, int qrow0, int nq, int ntiles, int nctx, int band_k0, int q_lat0,
                  float negM, float sinkterm, bf16* outp) {
  constexpr int KS = DQK / 16, LDK = DQK + 8, LDV = 72, CPR = DQK / 8, NCK = 64 * CPR;
  const int tid = tidx(), lane = tid & 63, w = tid >> 6, r = lane & 31, h = lane >> 5;
  bf16* sK = smem;
  bf16* sV = smem + 2 * 64 * LDK;
  bf16x8 qf[2][KS];
#pragma unroll
  for (int qt = 0; qt < 2; ++qt) {
    int qi = w * 64 + qt * 32 + r;
    if (qi > nq - 1) qi = nq - 1;
#pragma unroll
    for (int s = 0; s < KS; ++s) qf[qt][s] = *(const bf16x8*)(Qp + (size_t)(qrow0 + qi) * DQK + s * 16 + h * 8);
  }
  f32x16 O[2][2];
#pragma unroll
  for (int a = 0; a < 2; ++a)
#pragma unroll
    for (int b = 0; b < 2; ++b)
#pragma unroll
      for (int e = 0; e < 16; ++e) O[a][b][e] = 0.f;
  float lsum[2] = {0.f, 0.f};
  const int kr0 = tid / CPR, kc0 = tid % CPR;
  const int id1 = tid + 512;
  const bool has1 = id1 < NCK;
  const int kr1 = has1 ? id1 / CPR : 0, kc1 = has1 ? id1 % CPR : 0;
  const int vr = tid >> 3, vc = tid & 7;
  u32x4 rK0, rK1, rV;
  rK1 = rK0 = rV = u32x4{0, 0, 0, 0};
  auto tilepos = [&](int t) { return t < nctx ? t * 64 : LC + band_k0 + (t - nctx) * 64; };
  auto gload = [&](int t) {
    const int pos = tilepos(t);
    rK0 = *(const u32x4*)(Kp + (size_t)(pos + kr0) * DQK + kc0 * 8);
    if (has1) rK1 = *(const u32x4*)(Kp + (size_t)(pos + kr1) * DQK + kc1 * 8);
    rV = *(const u32x4*)(Vtp + (size_t)vr * NPOS + pos + vc * 8);
  };
  auto swrite = [&](int buf) {
    *(u32x4*)(sK + buf * 64 * LDK + kr0 * LDK + kc0 * 8) = rK0;
    if (has1) *(u32x4*)(sK + buf * 64 * LDK + kr1 * LDK + kc1 * 8) = rK1;
    *(u32x4*)(sV + buf * 64 * LDV + vr * LDV + vc * 8) = rV;
  };
  gload(0); swrite(0);
  __syncthreads();
  const int qw = q_lat0 + w * 64;
  for (int t = 0; t < ntiles; ++t) {
    const int buf = t & 1;
    if (t + 1 < ntiles) gload(t + 1);
    bool act = (w * 64 < nq);
    int kk0 = 0;
    const bool band = WIN && t >= nctx;
    if (band) { kk0 = band_k0 + (t - nctx) * 64; act = act && (kk0 + 63 >= qw - 128) && (kk0 <= qw + 191); }
    if (act) {
      const bf16* sKb = sK + buf * 64 * LDK;
      const bf16* sVb = sV + buf * 64 * LDV;
#pragma unroll 1
      for (int ksub = 0; ksub < 2; ++ksub) {
        bf16x8 pb[2][2];
        {
          const bf16* kfp = sKb + (ksub * 32 + r) * LDK + h * 8;
#pragma unroll
          for (int qt = 0; qt < 2; ++qt) {
            f32x16 sc;
#pragma unroll
            for (int e = 0; e < 16; ++e) sc[e] = negM;
#pragma unroll
            for (int s = 0; s < KS; ++s) sc = mfma32(*(const bf16x8*)(kfp + s * 16), qf[qt][s], sc);
            float p[16];
#pragma unroll
            for (int e = 0; e < 16; ++e) p[e] = __builtin_amdgcn_exp2f(sc[e]);
            if (band) {
              const int qi = qw + qt * 32 + r;
#pragma unroll
              for (int e = 0; e < 16; ++e) {
                const int dd = qi - (kk0 + ksub * 32 + crow(e, h));
                if (dd > 128 || dd < -128) p[e] = 0.f;
              }
            }
            float ps = 0.f;
#pragma unroll
            for (int e = 0; e < 16; ++e) ps += p[e];
            lsum[qt] += ps;
            float p0[8], p1[8];
#pragma unroll
            for (int e = 0; e < 8; ++e) { p0[e] = p[e]; p1[e] = p[8 + e]; }
            pb[qt][0] = pack8(p0); pb[qt][1] = pack8(p1);
          }
        }
#pragma unroll
        for (int dt = 0; dt < 2; ++dt)
#pragma unroll
          for (int st = 0; st < 2; ++st) {
            const bf16x8 vf = *(const bf16x8*)(sVb + (dt * 32 + r) * LDV + ksub * 32 + st * 16 + h * 8);
            O[0][dt] = mfma32(vf, pb[0][st], O[0][dt]);
            O[1][dt] = mfma32(vf, pb[1][st], O[1][dt]);
          }
      }
    }
    if (t + 1 < ntiles) swrite(buf ^ 1);
    __syncthreads();
  }
#pragma unroll
  for (int qt = 0; qt < 2; ++qt) {
    const float l = xor32(lsum[qt]) + sinkterm;
    const float inv = 1.f / l;
    const int qi = w * 64 + qt * 32 + r;
    if (qi < nq) {
      bf16* dst = outp + (size_t)qi * 1024;
#pragma unroll
      for (int dt = 0; dt < 2; ++dt)
#pragma unroll
        for (int g = 0; g < 4; ++g)
          *(u32x2*)(dst + dt * 32 + 8 * g + 4 * h) = pack4(O[qt][dt][4 * g] * inv, O[qt][dt][4 * g + 1] * inv, O[qt][dt][4 * g + 2] * inv, O[qt][dt][4 * g + 3] * inv);
    }
  }
}

constexpr int LCH = 80, LGR = 9;
DI void lru_apply(float (&h)[4], const float* base, int col, bool valid) {
#pragma unroll
  for (int n = 0; n < 4; ++n) {
    const f32x2 cm = *(const f32x2*)(base + (16 * n + col) * 2);
    h[n] = valid ? cm[0] * h[n] + cm[1] : h[n];
  }
}
DI void lru_chunk(const Params& P, const float* sGateBase, const float* sTaps, bf16* hfw, int bi, int j, int c, int pass, float* sComp) {
  const int lane = tidx() & 63, col = lane & 15, g = lane >> 4;
  const bool isctx = c < 16;
  const int L = isctx ? LC : SEQ;
  const int sp0 = isctx ? c * 16 : (c - 16) * 128;
  const int tokbase = isctx ? (NL + bi * LC + sp0) : (bi * SEQ + sp0);
  const int nsteps = isctx ? 1 : 8;
  const bf16* C1 = P.cbuf;
  bf16* XCV = P.h;
  if (pass == 0) {
    for (int st = 0; st < nsteps; ++st) {
      const int t = st * 16 + col;
      u32x4 raw[2][4];
#pragma unroll
      for (int s = 0; s < 2; ++s)
#pragma unroll
        for (int k = 0; k < 4; ++k) {
          const int tt = sp0 + t + k - 2;
          const bool ok = tt >= 0 && tt < L;
          const int row = ok ? (tokbase + t + k - 2) : tokbase + t;
          raw[s][k] = *(const u32x4*)(C1 + (size_t)row * C1LD + 672 + 64 * j + 32 * s + 8 * g);
        }
#pragma unroll
      for (int s = 0; s < 2; ++s) {
        const int c0 = 64 * j + 32 * s + 8 * g;
        float a8[8];
        {
          const f32x4 b0 = *(const f32x4*)(sTaps + 2048 + c0), b1 = *(const f32x4*)(sTaps + 2048 + c0 + 4);
          for (int i = 0; i < 4; ++i) { a8[i] = b0[i]; a8[4 + i] = b1[i]; }
        }
#pragma unroll
        for (int k = 0; k < 4; ++k) {
          const int tt = sp0 + t + k - 2;
          const float m = (tt >= 0 && tt < L) ? 1.f : 0.f;
          float x8[8];
          unpack8(raw[s][k], x8);
          const f32x4 w0 = *(const f32x4*)(sTaps + k * 512 + c0), w1 = *(const f32x4*)(sTaps + k * 512 + c0 + 4);
          for (int i = 0; i < 4; ++i) { a8[i] += m * w0[i] * x8[i]; a8[4 + i] += m * w1[i] * x8[4 + i]; }
        }
        *(bf16x8*)(XCV + (size_t)(tokbase + t) * 512 + c0) = pack8(a8);
      }
    }
  }
#pragma unroll 1
  for (int dir = 0; dir < 2; ++dir) {
    bf16x8 wb[8][2];
#pragma unroll
    for (int n = 0; n < 8; ++n)
#pragma unroll
      for (int s = 0; s < 2; ++s)
        wb[n][s] = *(const bf16x8*)(P.wlrut + ((size_t)(((dir * 2 + (n >> 2)) * 8 + j) * 64 + 16 * (n & 3) + col)) * 64 + 32 * s + 8 * g);
    bf16x8 idf[2];
#pragma unroll
    for (int n = 0; n < 2; ++n)
#pragma unroll
      for (int jj = 0; jj < 8; ++jj) idf[n][jj] = ((8 * g + jj) == 16 * n + col) ? (short)0x3F80 : (short)0;
    float hst[4], arun[4];
#pragma unroll
    for (int n = 0; n < 4; ++n) { hst[n] = 0.f; arun[n] = 1.f; }
    const float* sGate = sGateBase + dir * 1536 + 64 * j + col;
    if (pass == 1) {
      const float* cbase = P.comp + ((size_t)(bi * 2 + dir) * LCH) * 1024 + 128 * j;
      const float* gbase = P.gcomp + ((size_t)(bi * 2 + dir) * LGR) * 1024 + 128 * j;
      if (isctx) {
#pragma unroll
        for (int i = 0; i < 15; ++i) {
          const int cc = dir == 0 ? i : 15 - i;
          const bool valid = dir == 0 ? (i < c) : (15 - i > c);
          lru_apply(hst, cbase + (size_t)(valid ? cc : 0) * 1024, col, valid);
        }
      } else {
        const int q = (c - 16) >> 3;
        lru_apply(hst, gbase, col, true);
#pragma unroll
        for (int i = 0; i < 7; ++i) {
          const int qq = dir == 0 ? i : 7 - i;
          const bool valid = dir == 0 ? (i < q) : (7 - i > q);
          lru_apply(hst, gbase + (size_t)(1 + (valid ? qq : 0)) * 1024, col, valid);
        }
#pragma unroll
        for (int i = 0; i < 7; ++i) {
          const int cc = dir == 0 ? 16 + 8 * q + i : 16 + 8 * q + 7 - i;
          const bool valid = dir == 0 ? (cc < c) : (cc > c);
          lru_apply(hst, cbase + (size_t)(valid ? cc : 16) * 1024, col, valid);
        }
      }
    }
    bf16x8 afc[2];
    auto issue = [&](int st, bf16x8 (&af)[2]) {
      const int t = st * 16 + col;
#pragma unroll
      for (int s = 0; s < 2; ++s) af[s] = *(const bf16x8*)(XCV + (size_t)(tokbase + t) * 512 + 64 * j + 32 * s + 8 * g);
    };
    issue(dir ? nsteps - 1 : 0, afc);
    for (int step = 0; step < nsteps; ++step) {
      const int st = dir ? nsteps - 1 - step : step;
      const int t0 = st * 16;
      bf16x8 af[2];
      af[0] = afc[0]; af[1] = afc[1];
      if (step + 1 < nsteps) issue(dir ? st - 1 : st + 1, afc);
      f32x4 ag[8], xcC[4];
      const f32x4 z4 = {0.f, 0.f, 0.f, 0.f};
#pragma unroll
      for (int n = 0; n < 8; ++n) { ag[n] = mfma16(af[0], wb[n][0], z4); ag[n] = mfma16(af[1], wb[n][1], ag[n]); }
#pragma unroll
      for (int n = 0; n < 4; ++n) xcC[n] = mfma16(af[n >> 1], idf[n & 1], z4);
#pragma unroll
      for (int n = 0; n < 4; ++n) {
        float av[4], bv[4];
#pragma unroll
        for (int e = 0; e < 4; ++e) {
          const float rg = sigmoidf_(ag[n][e] + sGate[16 * n]);
          const float ig = sigmoidf_(ag[4 + n][e] + sGate[512 + 16 * n]);
          const float a = __expf(-sGate[1024 + 16 * n] * rg);
          av[e] = a;
          bv[e] = sqrtf(fmaxf(fmaf(-a, a, 1.f), 0.f)) * ig * xcC[n][e];
        }
        float A = 1.f, H = 0.f;
        if (dir == 0) { for (int e = 0; e < 4; ++e) { H = av[e] * H + bv[e]; A *= av[e]; } }
        else { for (int e = 3; e >= 0; --e) { H = av[e] * H + bv[e]; A *= av[e]; } }
        float A1, H1, Aex, Hex, At, Ht;
        if (dir == 0) {
          A1 = __shfl_up(A, 16); H1 = __shfl_up(H, 16);
          if (g >= 1) { H = A * H1 + H; A = A * A1; }
          A1 = __shfl_up(A, 32); H1 = __shfl_up(H, 32);
          if (g >= 2) { H = A * H1 + H; A = A * A1; }
          Aex = __shfl_up(A, 16); Hex = __shfl_up(H, 16);
          if (g == 0) { Aex = 1.f; Hex = 0.f; }
          At = __shfl(A, col + 48); Ht = __shfl(H, col + 48);
        } else {
          A1 = __shfl_down(A, 16); H1 = __shfl_down(H, 16);
          if (g <= 2) { H = A * H1 + H; A = A * A1; }
          A1 = __shfl_down(A, 32); H1 = __shfl_down(H, 32);
          if (g <= 1) { H = A * H1 + H; A = A * A1; }
          Aex = __shfl_down(A, 16); Hex = __shfl_down(H, 16);
          if (g == 3) { Aex = 1.f; Hex = 0.f; }
          At = __shfl(A, col); Ht = __shfl(H, col);
        }
        if (pass == 0) {
          hst[n] = At * hst[n] + Ht; arun[n] = At * arun[n];
        } else {
          float hc = Aex * hst[n] + Hex;
          hst[n] = At * hst[n] + Ht;
          float o[4];
          if (dir == 0) { for (int e = 0; e < 4; ++e) { hc = av[e] * hc + bv[e]; o[e] = hc; } }
          else { for (int e = 3; e >= 0; --e) { hc = av[e] * hc + bv[e]; o[e] = hc; } }
#pragma unroll
          for (int e = 0; e < 4; ++e) {
            bf16* yp = hfw + (t0 + 4 * g + e) * 64 + 16 * n + col;
            if (dir == 0) *yp = f2bf(o[e]); else *yp = f2bf(bf2f(*yp) + o[e]);
          }
        }
      }
    }
    if (pass == 0 && g == 0) {
#pragma unroll
      for (int n = 0; n < 4; ++n) {
        f32x2 cm = {arun[n], hst[n]};
        *(f32x2*)(P.comp + ((size_t)((bi * 2 + dir) * LCH + c) * 512 + 64 * j + 16 * n + col) * 2) = cm;
        *(f32x2*)(sComp + (dir * 64 + 16 * n + col) * 2) = cm;
      }
    }
  }
  if (pass == 1) {
    const int ntok = nsteps * 16;
    for (int i0 = 0; i0 < ntok * 8; i0 += 64 * 4) {
      u32x4 gr[4];
#pragma unroll
      for (int u = 0; u < 4; ++u) {
        const int id = i0 + u * 64 + lane;
        const int tk = id >> 3, cc = id & 7;
        gr[u] = u32x4{0, 0, 0, 0};
        if (tk < ntok) gr[u] = *(const u32x4*)(C1 + (size_t)(tokbase + tk) * C1LD + 1184 + 64 * j + cc * 8);
      }
#pragma unroll
      for (int u = 0; u < 4; ++u) {
        const int id = i0 + u * 64 + lane;
        const int tk = id >> 3, cc = id & 7;
        if (tk < ntok) {
          float hv[8], gv[8];
          unpack8(*(const u32x4*)(hfw + tk * 64 + cc * 8), hv);
          unpack8(gr[u], gv);
#pragma unroll
          for (int e = 0; e < 8; ++e) hv[e] *= geluf_(gv[e]);
          *(bf16x8*)(P.ycat + (size_t)(tokbase + tk) * 1024 + 512 + 64 * j + cc * 8) = pack8(hv);
        }
      }
    }
  }
}

DI void lru_block_item(const Params& P, float* fsm, int bi, int j, int grp, int pass) {
  const int tid = tidx(), wid = tid >> 6;
  const float* sGate = fsm;
  const float* sTaps = fsm + 3072;
  float* sComp = fsm + 5632;
  bf16* hfw = (bf16*)(fsm + 3072) + wid * 8192;
  if (grp == 0) {
    lru_chunk(P, sGate, sTaps, hfw, bi, j, 2 * wid, pass, sComp + (2 * wid) * 256);
    lru_chunk(P, sGate, sTaps, hfw, bi, j, 2 * wid + 1, pass, sComp + (2 * wid + 1) * 256);
  } else {
    lru_chunk(P, sGate, sTaps, hfw, bi, j, 16 + 8 * (grp - 1) + wid, pass, sComp + wid * 256);
  }
  if (pass == 0) {
    __syncthreads();
    if (tid < 128) {
      const int dir = tid >> 6, ch = tid & 63;
      const int n = grp == 0 ? 16 : 8;
      float A = 1.f, H = 0.f;
      for (int i = 0; i < n; ++i) {
        const int cc = dir == 0 ? i : n - 1 - i;
        const float a = sComp[cc * 256 + (dir * 64 + ch) * 2], hh = sComp[cc * 256 + (dir * 64 + ch) * 2 + 1];
        H = a * H + hh; A = a * A;
      }
      f32x2 cm = {A, H};
      *(f32x2*)(P.gcomp + ((size_t)((bi * 2 + dir) * LGR + grp) * 512 + 64 * j + ch) * 2) = cm;
    }
    __syncthreads();
  }
}
DI void chunk_geom(int bi, int ck, int& L, int& sp0, int& tokbase, int& pos0) {
  const bool isctx = ck < 2;
  L = isctx ? LC : SEQ;
  sp0 = isctx ? ck * 128 : (ck - 2) * 128;
  tokbase = isctx ? (NL + bi * LC + sp0) : (bi * SEQ + sp0);
  pos0 = isctx ? sp0 : LC + sp0;
}

DI void ssd_conv_item(const Params& P, bf16* smem, int gc, int cr) {
  const int bi = gc / NCH, ck = gc % NCH;
  int L, sp0, tokbase, pos0; chunk_geom(bi, ck, L, sp0, tokbase, pos0);
  const int tid = tidx();
  constexpr int LDT = 257;
  {
    const int cc = tid & 31, tg = tid >> 5;
    const int c0 = cr * 256 + cc * 8;
    f32x4 wv[4][2], bv[2];
#pragma unroll
    for (int k = 0; k < 4; ++k) { wv[k][0] = *(const f32x4*)(P.ssd_conv_w + k * 1024 + c0); wv[k][1] = *(const f32x4*)(P.ssd_conv_w + k * 1024 + c0 + 4); }
    bv[0] = *(const f32x4*)(P.ssd_conv_b + c0); bv[1] = *(const f32x4*)(P.ssd_conv_b + c0 + 4);
    u32x4 raw[11];
#pragma unroll
    for (int i = 0; i < 11; ++i) {
      const int t = tg * 8 + i - 2, tt = sp0 + t;
      const bool ok = tt >= 0 && tt < L;
      raw[i] = u32x4{0, 0, 0, 0};
      if (ok) raw[i] = *(const u32x4*)(P.cbuf + (size_t)(tokbase + t) * C2LD + 1280 + c0);
    }
#pragma unroll
    for (int i = 0; i < 8; ++i) {
      float a8[8];
#pragma unroll
      for (int e = 0; e < 4; ++e) { a8[e] = bv[0][e]; a8[4 + e] = bv[1][e]; }
#pragma unroll
      for (int k = 0; k < 4; ++k) {
        float x8[8];
        unpack8(raw[i + k], x8);
#pragma unroll
        for (int e = 0; e < 4; ++e) { a8[e] += wv[k][0][e] * x8[e]; a8[4 + e] += wv[k][1][e] * x8[4 + e]; }
      }
#pragma unroll
      for (int e = 0; e < 8; ++e) a8[e] = siluf_(a8[e]);
      const bf16x8 o = pack8(a8);
      const int t = tg * 8 + i;
      *(bf16x8*)(P.h + (size_t)(tokbase + t) * 1024 + c0) = o;
#pragma unroll
      for (int e = 0; e < 8; ++e) smem[t * LDT + cc * 8 + e] = (bf16)o[e];
    }
  }
  __syncthreads();
  {
    const int o = tid & 15, cb = tid >> 4;
#pragma unroll
    for (int i = 0; i < 8; ++i) {
      const int c = cb + 32 * i;
      float v8[8];
#pragma unroll
      for (int e = 0; e < 8; ++e) {
        const int pp = 8 * o + e;
        const int t = (pp & ~15) | swap23(pp & 15);
        v8[e] = bf2f(smem[t * LDT + c]);
      }
      *(bf16x8*)(P.ut + ((size_t)(bi * 1024 + cr * 256 + c)) * NPOS + pos0 + 8 * o) = pack8(v8);
    }
  }
  __syncthreads();
}

DI void ssd_cumsum_item(const Params& P, int gc) {
  const int bi = gc / NCH, ck = gc % NCH;
  int L, sp0, tokbase, pos0; chunk_geom(bi, ck, L, sp0, tokbase, pos0);
  const int lane = tidx() & 63;
  f32x4 raw[2][4];
#pragma unroll
  for (int u = 0; u < 2; ++u)
#pragma unroll
    for (int q = 0; q < 4; ++q) raw[u][q] = *(const f32x4*)(P.dtr + (size_t)(tokbase + 64 * u + lane) * 16 + 4 * q);
  const int perm = (lane & ~15) | swap23(lane & 15);
#pragma unroll
  for (int idx = 0; idx < 16; ++idx) {
    const float A = -__expf(P.ssd_a_log[idx]);
    const float bias = P.ssd_dt_bias[idx];
    const float dt0 = softplusf_(raw[0][idx >> 2][idx & 3] + bias), dt1 = softplusf_(raw[1][idx >> 2][idx & 3] + bias);
    const float a0 = dt0 * A, a1 = dt1 * A;
    float c0 = a0, c1 = a1;
#pragma unroll
    for (int d = 1; d < 64; d <<= 1) {
      const float v0 = __shfl_up(c0, d), v1 = __shfl_up(c1, d);
      if (lane >= d) { c0 += v0; c1 += v1; }
    }
    c1 += __shfl(c0, 63);
    const float total = __shfl(c1, 63);
    const size_t rowb = (size_t)(bi * 16 + idx) * NPOS + pos0;
    P.dtt[rowb + lane] = dt0; P.dtt[rowb + 64 + lane] = dt1;
    P.cst[rowb + lane] = c0; P.cst[rowb + 64 + lane] = c1;
    const float w0 = idx < 8 ? dt0 * __expf(total - c0) : dt0 * __expf(c0 - a0);
    const float w1 = idx < 8 ? dt1 * __expf(total - c1) : dt1 * __expf(c1 - a1);
    P.wgp[rowb + perm] = w0; P.wgp[rowb + 64 + perm] = w1;
  }
}

DI void ssd_passA_item(const Params& P, int gc, int hd, int dir, int pt) {
  const int bi = gc / NCH, ck = gc % NCH;
  int L, sp0, tokbase, pos0; chunk_geom(bi, ck, L, sp0, tokbase, pos0);
  const int lane = tidx() & 63, r = lane & 31, h = lane >> 5;
  const int idx = dir * 8 + hd, grp = hd >> 2;
  const bf16* xrow = P.ut + ((size_t)(bi * 1024 + hd * 64 + 32 * pt + r)) * NPOS + pos0 + 8 * h;
  const float* wrow = P.wgp + (size_t)(bi * 16 + idx) * NPOS + pos0 + 8 * h;
  const bf16* brow = P.ut + ((size_t)(bi * 1024 + 512 + grp * 128 + r)) * NPOS + pos0 + 8 * h;
  bf16x8 xs[8];
  {
    u32x4 xr[8]; f32x4 w0[8], w1[8];
#pragma unroll
    for (int ks = 0; ks < 8; ++ks) { xr[ks] = *(const u32x4*)(xrow + 16 * ks); w0[ks] = *(const f32x4*)(wrow + 16 * ks); w1[ks] = *(const f32x4*)(wrow + 16 * ks + 4); }
#pragma unroll
    for (int ks = 0; ks < 8; ++ks) {
      float x8[8];
      unpack8(xr[ks], x8);
#pragma unroll
      for (int e = 0; e < 4; ++e) { x8[e] *= w0[ks][e]; x8[4 + e] *= w1[ks][e]; }
      xs[ks] = pack8(x8);
    }
  }
  f32x16 acc[4];
#pragma unroll
  for (int nt = 0; nt < 4; ++nt)
#pragma unroll
    for (int e = 0; e < 16; ++e) acc[nt][e] = 0.f;
#pragma unroll
  for (int ks = 0; ks < 8; ++ks)
#pragma unroll
    for (int nt = 0; nt < 4; ++nt) acc[nt] = mfma32(*(const bf16x8*)(brow + (size_t)(32 * nt) * NPOS + 16 * ks), xs[ks], acc[nt]);
  bf16* dst = P.qkv + ST_OFF + ((size_t)(((bi * 2 + dir) * 8 + hd) * NCH + ck)) * 8192 + (32 * pt + r) * 128 + 4 * h;
#pragma unroll
  for (int nt = 0; nt < 4; ++nt)
#pragma unroll
    for (int g = 0; g < 4; ++g) *(u32x2*)(dst + 32 * nt + 8 * g) = pack4(acc[nt][4 * g], acc[nt][4 * g + 1], acc[nt][4 * g + 2], acc[nt][4 * g + 3]);
}

DI void ssd_passB(const Params& P, int bid, int nblk) {
  const int nthr = nblk * 512;
  for (int id = bid * 512 + tidx(); id < NB * 2 * 8 * 2048; id += nthr) {
    const int e4 = id & 2047, hd = (id >> 11) & 7, dir = (id >> 14) & 1, bi = id >> 15;
    bf16* base = P.qkv + ST_OFF + ((size_t)((bi * 2 + dir) * 8 + hd)) * NCH * 8192 + e4 * 4;
    const float* crow_ = P.cst + (size_t)(bi * 16 + dir * 8 + hd) * NPOS;
    float S0 = 0.f, S1 = 0.f, S2 = 0.f, S3 = 0.f;
    for (int i0 = 0; i0 < NCH; i0 += 6) {
      u32x2 raw[6]; float dec[6]; int cks[6];
#pragma unroll
      for (int u = 0; u < 6; ++u) {
        const int i = i0 + u;
        const int ck = dir == 0 ? i : (i == 0 ? 1 : (i == 1 ? 0 : 67 - i));
        cks[u] = ck;
        raw[u] = *(const u32x2*)(base + (size_t)ck * 8192);
        dec[u] = __expf(crow_[ck * 128 + 127]);
      }
#pragma unroll
      for (int u = 0; u < 6; ++u) {
        *(u32x2*)(base + (size_t)cks[u] * 8192) = pack4(S0, S1, S2, S3);
        S0 = dec[u] * S0 + lo16(raw[u][0]); S1 = dec[u] * S1 + hi16(raw[u][0]);
        S2 = dec[u] * S2 + lo16(raw[u][1]); S3 = dec[u] * S3 + hi16(raw[u][1]);
      }
    }
  }
}

DI void ssd_passC_item(const Params& P, bf16* smem, int bi, int ck, int grp) {
  int L, sp0, tokbase, pos0; chunk_geom(bi, ck, L, sp0, tokbase, pos0);
  const int tid = tidx(), lane = tid & 63, wid = tid >> 6, r = lane & 31, h = lane >> 5;
  constexpr int LDB = 136;
  bf16* sB = smem;
  bf16* sC = smem + 128 * LDB;
  bf16* sX = smem + 256 * LDB;
  float* sCS = (float*)(smem + 512 * LDB);
  float* sDT = sCS + 1024;
  const bf16* U = P.h;
  {
    u32x4 tb[4], tc[4], tx[8];
#pragma unroll
    for (int i = 0; i < 4; ++i) {
      const int id = tid + 512 * i, row = id >> 4, c = id & 15;
      tb[i] = *(const u32x4*)(U + (size_t)(tokbase + row) * 1024 + 512 + grp * 128 + c * 8);
      tc[i] = *(const u32x4*)(U + (size_t)(tokbase + row) * 1024 + 768 + grp * 128 + c * 8);
    }
#pragma unroll
    for (int i = 0; i < 8; ++i) {
      const int id = tid + 512 * i, row = id >> 4, c = id & 15;
      tx[i] = *(const u32x4*)(P.ut + ((size_t)(bi * 1024 + grp * 256 + row)) * NPOS + pos0 + c * 8);
    }
    float cv[2], dv[2];
#pragma unroll
    for (int i = 0; i < 2; ++i) {
      const int id = tid + 512 * i, dir = id >> 9, hl = (id >> 7) & 3, t = id & 127;
      const size_t o = (size_t)(bi * 16 + dir * 8 + grp * 4 + hl) * NPOS + pos0 + t;
      cv[i] = P.cst[o]; dv[i] = P.dtt[o];
    }
#pragma unroll
    for (int i = 0; i < 4; ++i) {
      const int id = tid + 512 * i, row = id >> 4, c = id & 15;
      *(u32x4*)(sB + row * LDB + c * 8) = tb[i];
      *(u32x4*)(sC + row * LDB + c * 8) = tc[i];
    }
#pragma unroll
    for (int i = 0; i < 8; ++i) {
      const int id = tid + 512 * i, row = id >> 4, c = id & 15;
      *(u32x4*)(sX + row * LDB + c * 8) = tx[i];
    }
#pragma unroll
    for (int i = 0; i < 2; ++i) { sCS[tid + 512 * i] = cv[i]; sDT[tid + 512 * i] = dv[i]; }
  }
  __syncthreads();
  const int hl = wid >> 1, hd = grp * 4 + hl;
  const float Ah0 = -__expf(P.ssd_a_log[hd]), Ah1 = -__expf(P.ssd_a_log[8 + hd]);
  const float dsk = P.ssd_d[hd] + P.ssd_d[8 + hd];
  const float* csF = sCS + hl * 128;
  const float* csR = sCS + 512 + hl * 128;
  const float* dtF = sDT + hl * 128;
  const float* dtR = sDT + 512 + hl * 128;
#pragma unroll 1
  for (int lq = 0; lq < 2; ++lq) {
    const int lt = 2 * (wid & 1) + lq;
    const int l = lt * 32 + r;
    const size_t tok = tokbase + l;
    bf16x8 cfr[8];
#pragma unroll
    for (int ks = 0; ks < 8; ++ks) cfr[ks] = *(const bf16x8*)(sC + l * LDB + 16 * ks + 8 * h);
    f32x16 acc[2];
#pragma unroll
    for (int pt = 0; pt < 2; ++pt)
#pragma unroll
      for (int e = 0; e < 16; ++e) acc[pt][e] = 0.f;
    const float cslF = csF[l], cslR = csR[l];
    const float exlR = cslR - dtR[l] * Ah1;
#pragma unroll
    for (int dir = 0; dir < 2; ++dir) {
      const float fac = dir == 0 ? __expf(cslF) : __expf(csR[127] - exlR);
#pragma unroll
      for (int pt = 0; pt < 2; ++pt) {
        f32x16 yo;
#pragma unroll
        for (int e = 0; e < 16; ++e) yo[e] = 0.f;
        const bf16* srow = P.qkv + ST_OFF + ((size_t)(((bi * 2 + dir) * 8 + hd) * NCH + ck)) * 8192 + (32 * pt + r) * 128 + 8 * h;
#pragma unroll
        for (int ks = 0; ks < 8; ++ks) yo = mfma32(*(const bf16x8*)(srow + 16 * ks), cfr[ks], yo);
#pragma unroll
        for (int e = 0; e < 16; ++e) acc[pt][e] += fac * yo[e];
      }
    }
#pragma unroll 1
    for (int st = 0; st < 4; ++st) {
      f32x16 G;
#pragma unroll
      for (int e = 0; e < 16; ++e) G[e] = 0.f;
#pragma unroll
      for (int ks = 0; ks < 8; ++ks) G = mfma32(*(const bf16x8*)(sB + (st * 32 + r) * LDB + 16 * ks + 8 * h), cfr[ks], G);
      const bf16* x0p = sX + (hl * 64 + r) * LDB + st * 32 + 8 * h;
      const bf16x8 x00 = *(const bf16x8*)(x0p), x01 = *(const bf16x8*)(x0p + 16);
      const bf16x8 x10 = *(const bf16x8*)(x0p + 32 * LDB), x11 = *(const bf16x8*)(x0p + 32 * LDB + 16);
      if (st <= lt) {
        float m[16];
#pragma unroll
        for (int g = 0; g < 4; ++g) {
          const int sb = st * 32 + 8 * g + 4 * h;
          const f32x4 cs4 = *(const f32x4*)(csF + sb), dt4 = *(const f32x4*)(dtF + sb);
#pragma unroll
          for (int e = 0; e < 4; ++e) m[4 * g + e] = (sb + e <= l) ? G[4 * g + e] * __expf(cslF - cs4[e]) * dt4[e] : 0.f;
        }
        float t0[8], t1[8];
#pragma unroll
        for (int e = 0; e < 8; ++e) { t0[e] = m[e]; t1[e] = m[8 + e]; }
        const bf16x8 p0 = pack8(t0), p1 = pack8(t1);
        acc[0] = mfma32(x00, p0, acc[0]); acc[0] = mfma32(x01, p1, acc[0]);
        acc[1] = mfma32(x10, p0, acc[1]); acc[1] = mfma32(x11, p1, acc[1]);
      }
      if (st >= lt) {
        float m[16];
#pragma unroll
        for (int g = 0; g < 4; ++g) {
          const int sb = st * 32 + 8 * g + 4 * h;
          const f32x4 cs4 = *(const f32x4*)(csR + sb), dt4 = *(const f32x4*)(dtR + sb);
#pragma unroll
          for (int e = 0; e < 4; ++e) m[4 * g + e] = (sb + e >= l) ? G[4 * g + e] * __expf((cs4[e] - dt4[e] * Ah1) - exlR) * dt4[e] : 0.f;
        }
        float t0[8], t1[8];
#pragma unroll
        for (int e = 0; e < 8; ++e) { t0[e] = m[e]; t1[e] = m[8 + e]; }
        const bf16x8 p0 = pack8(t0), p1 = pack8(t1);
        acc[0] = mfma32(x00, p0, acc[0]); acc[0] = mfma32(x01, p1, acc[0]);
        acc[1] = mfma32(x10, p0, acc[1]); acc[1] = mfma32(x11, p1, acc[1]);
      }
    }
    (void)Ah0;
    float ss = 0.f;
#pragma unroll
    for (int pt = 0; pt < 2; ++pt)
#pragma unroll
      for (int g = 0; g < 4; ++g) {
        const int p0 = 32 * pt + 8 * g + 4 * h;
        const u32x2 xr = *(const u32x2*)(U + tok * 1024 + hd * 64 + p0);
        const u32x2 zr = *(const u32x2*)(P.cbuf + tok * C2LD + 768 + hd * 64 + p0);
        const float xs[4] = {lo16(xr[0]), hi16(xr[0]), lo16(xr[1]), hi16(xr[1])};
        const float zz[4] = {lo16(zr[0]), hi16(zr[0]), lo16(zr[1]), hi16(zr[1])};
        float o[4];
#pragma unroll
        for (int e = 0; e < 4; ++e) { o[e] = (acc[pt][4 * g + e] + dsk * xs[e]) * siluf_(zz[e]); ss += o[e] * o[e]; }
        *(u32x2*)(P.ycat + tok * 1024 + 512 + hd * 64 + p0) = pack4(o[0], o[1], o[2], o[3]);
      }
    ss = xor32(ss);
    if (h == 0) P.ssq2[tok * 8 + hd] = ss;
  }
  __syncthreads();
}

DI void row_pass(const Params& P, int mode, int layer, int tok, const int* sOff) {
  const int lane = tidx() & 63;
  int bmod, b, pos; bool lat; tok_info(tok, bmod, b, pos, lat);
  const float* src = mode == 0 ? (lat ? P.x + (size_t)tok * 1024 : P.ctx + (size_t)(tok - NL) * 1024)
                               : (lat ? P.out + (size_t)tok * 1024 : P.xc + (size_t)(tok - NL) * 1024);
  f32x4 v[4];
#pragma unroll
  for (int i = 0; i < 4; ++i) v[i] = *(const f32x4*)(src + 4 * lane + 256 * i);
  if (mode == 1 || mode == 2) {
    const int* ti = P.tokinfo + (size_t)tok * 4;
    const int s0 = sOff[ti[0]] + ti[1], s1 = sOff[ti[2]] + ti[3];
    const float w0 = P.tokw[tok * 2], w1 = P.tokw[tok * 2 + 1];
    const float* m5 = P.mods + ((size_t)((mode - 1) * 5 + bmod) * 6 + 5) * 1024;
    float* dst = lat ? P.out + (size_t)tok * 1024 : P.xc + (size_t)(tok - NL) * 1024;
#pragma unroll
    for (int i = 0; i < 4; ++i) {
      const int k = 4 * lane + 256 * i;
      const u32x2 y0 = *(const u32x2*)(P.qkv + (size_t)s0 * 1024 + k), y1 = *(const u32x2*)(P.qkv + (size_t)s1 * 1024 + k);
      const f32x4 mv = *(const f32x4*)(m5 + k);
      v[i][0] += mv[0] * (w0 * lo16(y0[0]) + w1 * lo16(y1[0]));
      v[i][1] += mv[1] * (w0 * hi16(y0[0]) + w1 * hi16(y1[0]));
      v[i][2] += mv[2] * (w0 * lo16(y0[1]) + w1 * lo16(y1[1]));
      v[i][3] += mv[3] * (w0 * hi16(y0[1]) + w1 * hi16(y1[1]));
      *(f32x4*)(dst + k) = v[i];
    }
    if (mode == 2) return;
  }
  float ss = 0.f;
#pragma unroll
  for (int i = 0; i < 4; ++i) ss += v[i][0] * v[i][0] + v[i][1] * v[i][1] + v[i][2] * v[i][2] + v[i][3] * v[i][3];
  ss = wave_sum(ss);
  const float rstd = rsqrtf(ss * (1.f / 1024.f) + EPS);
  const bool n2 = mode == 3;
  const float* g1 = (n2 ? P.norm2_g : P.norm1_g) + layer * 1024;
  const float* sh = P.mods + ((size_t)(layer * 5 + bmod) * 6 + (n2 ? 3 : 0)) * 1024;
  const float* sc = P.mods + ((size_t)(layer * 5 + bmod) * 6 + (n2 ? 4 : 1)) * 1024;
#pragma unroll
  for (int i = 0; i < 4; ++i) {
    const int k = 4 * lane + 256 * i;
    const f32x4 gv = *(const f32x4*)(g1 + k), sv = *(const f32x4*)(sc + k), hv = *(const f32x4*)(sh + k);
    float o[4];
#pragma unroll
    for (int e = 0; e < 4; ++e) o[e] = v[i][e] * rstd * gv[e] * (1.f + sv[e]) + hv[e];
    const u32x2 hi = pack4(o[0], o[1], o[2], o[3]);
    *(u32x2*)(P.h + (size_t)tok * 1024 + k) = hi;
    if (n2) {
      const float r0 = o[0] - lo16(hi[0]), r1 = o[1] - hi16(hi[0]), r2 = o[2] - lo16(hi[1]), r3 = o[3] - hi16(hi[1]);
      *(u32x2*)(P.ycat + (size_t)tok * 1024 + k) = pack4(r0, r1, r2, r3);
    }
  }
}

DI void route_tokens(const Params& P, int layer, float* sW, int item, int tok_lo, int tok_hi) {
  const int tid = tidx(), lane = tid & 63, wid = tid >> 6;
  int* sCnt = (int*)sW;
  if (tid < 32) sCnt[tid * 36 + 32] = 0;
  __syncthreads();
  const float* g2 = P.norm2_g + layer * 1024;
  const float rb = P.router_b[lane >> 1];
  float gm[16], sh[16], xn[16];
  int cur_b = -1;
  auto xsrc = [&](int tok) { return tok < NL ? P.out + (size_t)tok * 1024 : P.xc + (size_t)(tok - NL) * 1024; };
  int t0 = tok_lo + wid;
  if (t0 < tok_hi) {
    const float* src = xsrc(t0);
#pragma unroll
    for (int i = 0; i < 16; ++i) xn[i] = src[lane + 64 * i];
  }
  for (; t0 < tok_hi; t0 += 8) {
    const int tok = t0;
    float v[16];
    float ss = 0.f;
#pragma unroll
    for (int i = 0; i < 16; ++i) { v[i] = xn[i]; ss += v[i] * v[i]; }
    if (t0 + 8 < tok_hi) {
      const float* src = xsrc(t0 + 8);
#pragma unroll
      for (int i = 0; i < 16; ++i) xn[i] = src[lane + 64 * i];
    }
    const int bmod = tok < NL ? (tok >> 13) : 4;
    if (bmod != cur_b) {
      cur_b = bmod;
      const float* shp = P.mods + ((size_t)(layer * 5 + bmod) * 6 + 3) * 1024;
      const float* scp = P.mods + ((size_t)(layer * 5 + bmod) * 6 + 4) * 1024;
#pragma unroll
      for (int i = 0; i < 16; ++i) { const int k = lane + 64 * i; gm[i] = g2[k] * (1.f + scp[k]); sh[i] = shp[k]; }
    }
    ss = wave_sum(ss);
    const float rstd = rsqrtf(ss * (1.f / 1024.f) + EPS);
#pragma unroll
    for (int i = 0; i < 16; ++i) {
      v[i] = v[i] * rstd * gm[i] + sh[i];
      P.h[(size_t)tok * 1024 + lane + 64 * i] = f2bf(v[i]);
    }
    float acc[32];
#pragma unroll
    for (int e = 0; e < 32; ++e) acc[e] = 0.f;
#pragma unroll
    for (int i = 0; i < 16; ++i) {
      const float* wr = sW + (lane + 64 * i) * 36;
#pragma unroll
      for (int c = 0; c < 8; ++c) {
        const f32x4 w4 = *(const f32x4*)(wr + 4 * c);
#pragma unroll
        for (int e = 0; e < 4; ++e) acc[4 * c + e] += v[i] * w4[e];
      }
      if ((i & 3) == 3) asm volatile("" ::: "memory");
    }
    float a16[16], a8[8], a4[4], a2[2], a1;
    {
      const bool up = (lane & 32) != 0;
#pragma unroll
      for (int i = 0; i < 16; ++i) { const float keep = up ? acc[16 + i] : acc[i], send = up ? acc[i] : acc[16 + i]; a16[i] = keep + __shfl_xor(send, 32); }
    }
    {
      const bool up = (lane & 16) != 0;
#pragma unroll
      for (int i = 0; i < 8; ++i) { const float keep = up ? a16[8 + i] : a16[i], send = up ? a16[i] : a16[8 + i]; a8[i] = keep + __shfl_xor(send, 16); }
    }
    {
      const bool up = (lane & 8) != 0;
#pragma unroll
      for (int i = 0; i < 4; ++i) { const float keep = up ? a8[4 + i] : a8[i], send = up ? a8[i] : a8[4 + i]; a4[i] = keep + __shfl_xor(send, 8); }
    }
    {
      const bool up = (lane & 4) != 0;
#pragma unroll
      for (int i = 0; i < 2; ++i) { const float keep = up ? a4[2 + i] : a4[i], send = up ? a4[i] : a4[2 + i]; a2[i] = keep + __shfl_xor(send, 4); }
    }
    {
      const bool up = (lane & 2) != 0;
      const float keep = up ? a2[1] : a2[0], send = up ? a2[0] : a2[1];
      a1 = keep + __shfl_xor(send, 2);
    }
    a1 += __shfl_xor(a1, 1);
    const float us = 1.f / (1.f + expf(-a1));
    const float xbs = us + rb;
    float bestg = -3.0e38f, bu0 = 0.f, bu1 = 0.f;
    int be0 = 0, be1 = 0;
#pragma unroll
    for (int q = 0; q < 4; ++q) {
      float m1 = -3.0e38f, m2 = -3.0e38f, u1 = 0.f, u2 = 0.f;
      int i1 = 0, i2 = 0;
#pragma unroll
      for (int m = 0; m < 8; ++m) {
        const float uu = __shfl(us, 2 * (8 * q + m)), xb = __shfl(xbs, 2 * (8 * q + m));
        if (xb > m1) { m2 = m1; i2 = i1; u2 = u1; m1 = xb; i1 = m; u1 = uu; }
        else if (xb > m2) { m2 = xb; i2 = m; u2 = uu; }
      }
      const float gs = m1 + m2;
      if (gs > bestg) { bestg = gs; be0 = 8 * q + i1; be1 = 8 * q + i2; bu0 = u1; bu1 = u2; }
    }
    if (lane == 0) {
      const int r0 = atomicAdd(&sCnt[be0 * 36 + 32], 1), r1 = atomicAdd(&sCnt[be1 * 36 + 32], 1);
      const float inv = 1.f / (bu0 + bu1);
      int* ti = P.tokinfo + (size_t)tok * 4;
      ti[0] = be0; ti[1] = r0; ti[2] = be1; ti[3] = r1;
      P.tokw[tok * 2] = bu0 * inv; P.tokw[tok * 2 + 1] = bu1 * inv;
    }
  }
  __syncthreads();
  if (tid < 32) P.cntt[item * 32 + tid] = sCnt[tid * 36 + 32];
  __syncthreads();
}
DI void conv_tile(float* sT, const float* src, int K, int N, bf16* dst, int dld, int rmode, const float* scale, int koff, int tk, int tn) {
  const int tid = tidx();
  const int k0 = tk * 64, n0 = tn * 64;
  {
    const int kk = tid >> 4, n4 = (tid & 15) * 4;
#pragma unroll
    for (int p = 0; p < 2; ++p) {
      const int k = k0 + kk + 32 * p;
      f32x4 v = {0.f, 0.f, 0.f, 0.f};
      if (n0 + n4 < N) v = *(const f32x4*)(src + (size_t)k * N + n0 + n4);
      float s = 1.f;
      if (scale != nullptr && k >= koff) s = scale[k - koff];
#pragma unroll
      for (int e = 0; e < 4; ++e) sT[(kk + 32 * p) * 65 + n4 + e] = v[e] * s;
    }
  }
  __syncthreads();
  {
    const int n = tid >> 3, kc = (tid & 7) * 8;
    if (n0 + n < N) {
      float v8[8];
#pragma unroll
      for (int e = 0; e < 8; ++e) v8[e] = sT[(kc + e) * 65 + n];
      const int nn = n0 + n;
      const int row = rmode == 0 ? nn : (64 * (nn >> 5) + (nn & 31) + (rmode == 2 ? 32 : 0));
      *(bf16x8*)(dst + (size_t)row * dld + k0 + kc) = pack8(v8);
    }
  }
  __syncthreads();
}

DI void conv_moe_tile(const Params& P, float* sT, int layer, int t) {
  const int e = t / 384, u = t % 384;
  if (u < 128) conv_tile(sT, P.moe_w_gate + ((size_t)(layer * 32 + e)) * 1024 * 512, 1024, 512, P.wgut + (size_t)e * 1024 * 1024, 1024, 1, nullptr, 0, u >> 3, u & 7);
  else if (u < 256) conv_tile(sT, P.moe_w_up + ((size_t)(layer * 32 + e)) * 1024 * 512, 1024, 512, P.wgut + (size_t)e * 1024 * 1024, 1024, 2, nullptr, 0, (u - 128) >> 3, (u - 128) & 7);
  else conv_tile(sT, P.moe_w_down + ((size_t)(layer * 32 + e)) * 512 * 1024, 512, 1024, P.wdt + (size_t)e * 1024 * 512, 512, 0, nullptr, 0, (u - 256) >> 4, (u - 256) & 15);
}

constexpr int NCONV_DENSE = 432 + 72 + 64 + 256 + 592 + 256 + 32;
DI void conv_dense_tile(const Params& P, float* sT, int t) {
  if (t < 432) { conv_tile(sT, P.ab_w_in, 1024, 1696, P.win0t, 1024, 0, nullptr, 0, t / 27, t % 27); return; }
  t -= 432;
  if (t < 72) { conv_tile(sT, P.mla_w_q_up, 384, 768, P.wqt, 384, 0, P.mla_q_norm_g, 0, t / 12, t % 12); return; }
  t -= 72;
  if (t < 64) { conv_tile(sT, P.mla_w_kv_up, 256, 1024, P.wkvt, 256, 0, P.mla_kv_norm_g, 0, t / 16, t % 16); return; }
  t -= 64;
  if (t < 256) { conv_tile(sT, P.ab_w_out, 1024, 1024, P.wout0t, 1024, 0, nullptr, 0, t / 16, t % 16); return; }
  t -= 256;
  if (t < 592) { conv_tile(sT, P.cd_w_in, 1024, 2320, P.win1t, 1024, 0, nullptr, 0, t / 37, t % 37); return; }
  t -= 592;
  if (t < 256) { conv_tile(sT, P.cd_w_out, 1024, 1024, P.wout1t, 1024, 0, P.ssd_norm_g, 512, t / 16, t % 16); return; }
  t -= 256;
  {
    const int blk = t & 7, gate = (t >> 3) & 1, dir = t >> 4;
    const float* src = (gate ? P.lru_w_x : P.lru_w_a) + ((size_t)(dir * 8 + blk)) * 4096;
    conv_tile(sT, src, 64, 64, P.wlrut + ((size_t)((dir * 2 + gate) * 8 + blk)) * 4096, 64, 0, nullptr, 0, 0, 0);
  }
}

DI void mods_item(const Params& P, float* sS, float* sR, int layer, int cb) {
  const int tid = tidx(), col = tid & 63, kq = tid >> 6;
  float a[5] = {0.f, 0.f, 0.f, 0.f, 0.f};
  const float* wp = P.ada_w + (size_t)layer * 1024 * 6144 + cb * 64 + col;
  for (int k = kq * 128; k < kq * 128 + 128; ++k) {
    const float wv = wp[(size_t)k * 6144];
#pragma unroll
    for (int v = 0; v < 5; ++v) a[v] += sS[v * 1024 + k] * wv;
  }
#pragma unroll
  for (int v = 0; v < 5; ++v) sR[(kq * 5 + v) * 64 + col] = a[v];
  __syncthreads();
  if (tid < 320) {
    const int v = tid >> 6;
    float s = P.ada_b[layer * 6144 + cb * 64 + col];
    for (int q = 0; q < 8; ++q) s += sR[(q * 5 + v) * 64 + col];
    P.mods[((size_t)(layer * 5 + v)) * 6144 + cb * 64 + col] = s;
  }
  __syncthreads();
}

enum { PH_PREP, PH_NORM1_0, PH_C1, PH_QKV, PH_ATTN0, PH_OUT0, PH_NORM2_0, PH_SCAT0, PH_MOE1_0, PH_MOE2_0, PH_COMB0, PH_C2, PH_SSDPREP, PH_SSDA, PH_SSDB, PH_SSDC, PH_OUT1, PH_NORM2_1, PH_SCAT1, PH_MOE1_1, PH_MOE2_1, PH_FINAL, NPHASE };
constexpr int GEMM_LDS = (256 + 256) * 2 * 72 * 2;

DI void run_phase(const Params& P, int ph, unsigned char* lds, int bid, int nblk) {
  bf16* smem = (bf16*)lds;
  float* fsm = (float*)lds;
  int* ism = (int*)lds;
  const int tid = tidx(), wid = tid >> 6;
  const int gw = bid * 8 + wid, ngw = nblk * 8;
  const int nrep = 1 + ((P.pad0 >> ph) & 1);
#define REP for (int rep_ = 0; rep_ < nrep; ++rep_)
#define REPB(bit) for (int rep_ = 0, nr_ = 1 + ((P.pad0 >> (bit)) & 1); rep_ < nr_; ++rep_)
  switch (ph) {
    case PH_PREP: {
      if (bid == 0) {
        for (int i = tid; i < 128 * 8; i += 512) {
          const int p = i >> 3, f = i & 7;
          float rev = (float)p * __builtin_amdgcn_exp2f(-(float)f * (13.287712379549449f / 8.f)) * 0.15915494309189535f;
          rev -= floorf(rev);
          P.ropeM[i * 2] = __builtin_amdgcn_cosf(rev); P.ropeM[i * 2 + 1] = __builtin_amdgcn_sinf(rev);
        }
        for (int i = tid; i < 128 * 16; i += 512) {
          const int p = i >> 4, f = i & 15;
          float rev = (float)p * __builtin_amdgcn_exp2f(-(float)f * (13.287712379549449f / 16.f)) * 0.15915494309189535f;
          rev -= floorf(rev);
          P.ropeS[i * 2] = __builtin_amdgcn_cosf(rev); P.ropeS[i * 2 + 1] = __builtin_amdgcn_sinf(rev);
        }
        if (tid == 0) {
          float gq = 0.f, gk = 0.f, sq = 0.f, sk = 0.f, sm = 0.f;
          for (int i = 0; i < 96; ++i) { gq = fmaxf(gq, fabsf(P.mla_q_head_g[i])); gk = fmaxf(gk, fabsf(P.mla_k_head_g[i])); }
          for (int i = 0; i < 64; ++i) { sq = fmaxf(sq, fabsf(P.swa_q_head_g[i])); sk = fmaxf(sk, fabsf(P.swa_k_head_g[i])); }
          for (int i = 0; i < 8; ++i) sm = fmaxf(sm, P.swa_sink[i]);
          P.msh[0] = 9.797958971132712f * gq * gk * LOG2E;
          P.msh[1] = fmaxf(8.f * sq * sk, sm) * LOG2E;
        }
      }
      for (int i = tid; i < 5 * 1024; i += 512) {
        const float v = i < 4096 ? P.c[i] : P.c_ctx[i - 4096];
        fsm[i] = siluf_(v);
      }
      __syncthreads();
      REPB(30) for (int it = bid; it < 2 * 96; it += nblk) mods_item(P, fsm, fsm + 5120, it / 96, it % 96);
      __syncthreads();
      REP for (int it = bid; it < NCONV_DENSE + 32 * 384; it += nblk) {
        if (it < NCONV_DENSE) conv_dense_tile(P, fsm, it); else conv_moe_tile(P, fsm, 0, it - NCONV_DENSE);
      }
    } break;
    case PH_NORM1_0: {
      REP for (int tok = gw; tok < NT; tok += ngw) row_pass(P, 0, 0, tok, nullptr);
    } break;
    case PH_C1: {
      REP for (int it = bid; it < 7 * 132; it += nblk) gemm_c1_item(P, smem, it % 7, it / 7);
    } break;
    case PH_QKV: {
      REP for (int it = bid; it < 264 * 8; it += nblk) {
        const int qt = it >> 3, u = it & 7;
        if (u < 4) gemm_q_item(P, smem, u, qt); else gemm_kv_item(P, smem, u - 4, qt);
      }
      __syncthreads();
      for (int i = tid; i < 2560; i += 512) fsm[3072 + i] = i < 2048 ? P.lru_conv_w[i] : P.lru_conv_b[i - 2048];
      for (int i = tid; i < 3072; i += 512) { const int d = i / 1536, u = i % 1536, k = u >> 9, ch = u & 511; fsm[i] = k == 0 ? P.lru_b_a[d * 512 + ch] : (k == 1 ? P.lru_b_x[d * 512 + ch] : 8.f * softplusf_(-P.lru_lambda[d * 512 + ch])); }
      __syncthreads();
      REPB(26) for (int it = bid; it < NB * 8 * LGR; it += nblk) { const int u = it < 256 ? it : it - 256; lru_block_item(P, fsm, it < 256 ? (u >> 6) : (u >> 3), it < 256 ? ((u >> 3) & 7) : (u & 7), it < 256 ? 1 + (u & 7) : 0, 0); }
    } break;
    case PH_ATTN0: {
      for (int i = tid; i < 2560; i += 512) fsm[3072 + i] = i < 2048 ? P.lru_conv_w[i] : P.lru_conv_b[i - 2048];
      for (int i = tid; i < 3072; i += 512) { const int d = i / 1536, u = i % 1536, k = u >> 9, ch = u & 511; fsm[i] = k == 0 ? P.lru_b_a[d * 512 + ch] : (k == 1 ? P.lru_b_x[d * 512 + ch] : 8.f * softplusf_(-P.lru_lambda[d * 512 + ch])); }
      __syncthreads();
      REPB(27) for (int it = bid; it < NB * 8 * LGR; it += nblk) { const int u = it < 256 ? it : it - 256; lru_block_item(P, fsm, it < 256 ? (u >> 6) : (u >> 3), it < 256 ? ((u >> 3) & 7) : (u & 7), it < 256 ? 1 + (u & 7) : 0, 1); }
      __syncthreads();
      const float negM = -P.msh[0];
      REP for (int it = bid; it < 32 + 512; it += nblk) {
        if (it < 32) {
          const int b = it >> 3, hd = it & 7;
          const size_t hb = (size_t)(b * 8 + hd) * NPOS;
          attn_item<96, false>(smem, P.qkv + QB_OFF + hb * 96, P.qkv + KB_OFF + hb * 96, P.qkv + VT_OFF + hb * 64, 0, 256, 4, 4, 0, 0, negM, 0.f,
                               P.ycat + (size_t)(NL + b * LC) * 1024 + hd * 64);
        } else {
          const int u = it - 32, qb = u & 15, hd = (u >> 4) & 7, b = u >> 7;
          const size_t hb = (size_t)(b * 8 + hd) * NPOS;
          attn_item<96, false>(smem, P.qkv + QB_OFF + hb * 96, P.qkv + KB_OFF + hb * 96, P.qkv + VT_OFF + hb * 64, LC + qb * 512, 512, 132, 132, 0, 0, negM, 0.f,
                               P.ycat + (size_t)(b * SEQ + qb * 512) * 1024 + hd * 64);
        }
      }
    } break;
    case PH_OUT0: {
      REP for (int it = bid; it < 512 + 32; it += nblk) { if (it < 512) gemm_out_item<4>(P, smem, 0, it & 3, it >> 2); else gemm_out_item<2>(P, smem, 0, (it - 512) & 7, 128 + ((it - 512) >> 3)); }
    } break;
    case PH_NORM2_0: case PH_NORM2_1: {
      const int layer = ph == PH_NORM2_0 ? 0 : 1;
      const int ntok = layer == 0 ? NT : NL;
      const int T = (ntok + nblk - 1) / nblk;
      __syncthreads();
      for (int i = tid; i < 32768; i += 512) fsm[(i >> 5) * 36 + (i & 31)] = P.router_w[i];
      __syncthreads();
      { const int lo_ = bid * T, hi_ = lo_ + T < ntok ? lo_ + T : ntok; route_tokens(P, layer, fsm, bid, lo_ < ntok ? lo_ : ntok, hi_ > lo_ ? hi_ : lo_); }
      if (layer == 1) {
        __syncthreads();
        for (int it = bid; it < 32 * 384; it += nblk) conv_moe_tile(P, fsm, 1, it);
      }
    } break;
    case PH_SCAT0: case PH_SCAT1: {
      const int layer = ph == PH_SCAT0 ? 0 : 1;
      const int ntok = layer == 0 ? NT : NL;
      const int T = (ntok + nblk - 1) / nblk;
      const int nit = nblk;
      __syncthreads();
      for (int i = tid; i < nit * 32; i += 512) ism[i] = P.cntt[i];
      __syncthreads();
      if (tid < 32) {
        int run = 0;
        for (int i = 0; i < nit; ++i) { const int c = ism[i * 32 + tid]; ism[i * 32 + tid] = run; run += c; }
        if (bid == 0) P.cnt[layer * 32 + tid] = run;
      }
      __syncthreads();
      {
        const int lo_ = bid * T, hi_ = lo_ + T < ntok ? lo_ + T : ntok;
        for (int tok = lo_ + tid; tok < hi_; tok += 512) {
          int* ti = P.tokinfo + (size_t)tok * 4;
          const int e0 = ti[0], e1 = ti[2];
          const int p0 = ism[bid * 32 + e0] + ti[1], p1 = ism[bid * 32 + e1] + ti[3];
          ti[1] = p0; ti[3] = p1;
          P.list[(size_t)e0 * NT + p0] = tok;
          P.list[(size_t)e1 * NT + p1] = tok;
        }
      }
    } break;
    case PH_MOE1_0: case PH_MOE2_0: case PH_MOE1_1: case PH_MOE2_1: {
      const int layer = ph >= PH_MOE1_1 ? 1 : 0;
      const bool second = (ph == PH_MOE2_0 || ph == PH_MOE2_1);
      __syncthreads();
      if (tid == 0) {
        int off = 0, toff = 0;
        for (int e = 0; e < 32; ++e) { const int c = P.cnt[layer * 32 + e]; ism[e] = c; ism[32 + e] = off; ism[65 + e] = toff; off += c; toff += (c + 255) >> 8; }
        ism[64] = off; ism[97] = toff;
      }
      __syncthreads();
      const int ntile = ism[97], total = ism[64];
      REP for (int it = bid; it < ntile * 4; it += nblk) {
        const int mtg = it >> 2, pt = it & 3;
        int e = 0;
        while (e < 31 && ism[65 + e + 1] <= mtg) ++e;
        const int m0 = (mtg - ism[65 + e]) * 256, cnt_e = ism[e], off_e = ism[32 + e];
        bf16* gsm = smem + 256;
        if (!second) moe1_item(P, gsm, layer, e, m0, pt, cnt_e, off_e); else moe2_item(P, gsm, e, m0, pt, cnt_e, off_e, total);
      }
    } break;
    case PH_COMB0: case PH_FINAL: {
      const int layer = ph == PH_COMB0 ? 0 : 1;
      __syncthreads();
      if (tid == 0) { int off = 0; for (int e = 0; e < 32; ++e) { ism[e] = off; off += P.cnt[layer * 32 + e]; } }
      __syncthreads();
      const int ntok = layer == 0 ? NT : NL;
      for (int tok = gw; tok < ntok; tok += ngw) row_pass(P, layer == 0 ? 1 : 2, 1, tok, ism);
    } break;
    case PH_C2: {
      REP for (int it = bid; it < 10 * 132; it += nblk) { if (it < 9 * 132) gemm_c2_item(P, smem, it % 9, it / 9); else gemm_c2dt_item(P, smem, it - 9 * 132); }
    } break;
    case PH_SSDPREP: {
      REPB(28) for (int it = gw; it < NB * NCH; it += ngw) ssd_cumsum_item(P, it);
      REPB(29) for (int it = bid; it < NB * NCH * 4; it += nblk) ssd_conv_item(P, smem, it >> 2, it & 3);
      __syncthreads();
      const float negM = -P.msh[1];
      REP for (int it = bid; it < 512; it += nblk) {
        const int qb = it & 15, hq = (it >> 4) & 7, b = it >> 7;
        const size_t hb = (size_t)(b * 8 + hq) * NPOS, kb = (size_t)(b * 2 + (hq >> 2)) * NPOS;
        const int k0 = qb * 512 - 128 < 0 ? 0 : qb * 512 - 128;
        const int k1 = qb * 512 + 640 > SEQ ? SEQ : qb * 512 + 640;
        const float sinkterm = __builtin_amdgcn_exp2f(P.swa_sink[hq] * LOG2E + negM);
        attn_item<64, true>(smem, P.qkv + Q2_OFF + hb * 64, P.qkv + K2_OFF + kb * 64, P.qkv + V2T_OFF + kb * 64, LC + qb * 512, 512, 4 + (k1 - k0) / 64, 4, k0, qb * 512,
                            negM, sinkterm, P.ycat + (size_t)(b * SEQ + qb * 512) * 1024 + hq * 64);
      }
    } break;
    case PH_SSDA: {
      REP for (int it = gw; it < NB * NCH * 8 * 2 * 2; it += ngw) {
        const int pt = it & 1, dir = (it >> 1) & 1, hd = (it >> 2) & 7, gc = it >> 5;
        ssd_passA_item(P, gc, hd, dir, pt);
      }
    } break;
    case PH_SSDB: ssd_passB(P, bid, nblk); break;
    case PH_SSDC: {
      REP for (int it = bid; it < NB * 64 * 2; it += nblk) ssd_passC_item(P, smem, it >> 7, 2 + ((it >> 1) & 63), it & 1);
    } break;
    case PH_OUT1: {
      for (int it = bid; it < 512; it += nblk) gemm_out_item<4>(P, smem, 1, it & 3, it >> 2);
    } break;
    default: break;
  }
}
#define XB_TMO      128
#define XB_XCNT(j)  (256  + 64 * (j))
#define XB_XSUB(j)  (1280 + 64 * (j))
#define XB_XGEN(j)  (2304 + 64 * (j))
#define XB_TOP      3328
#define XB_TOPGEN   3392
#define XCD_BAR_WORDS 3456
#define XB_SPIN_CAP (1u << 22)
#define LAS __attribute__((address_space(3)))
DI unsigned xb_ld(unsigned* p) { return __hip_atomic_load(p, __ATOMIC_RELAXED, __HIP_MEMORY_SCOPE_AGENT); }
DI unsigned xb_add(unsigned* p, unsigned v) { return __hip_atomic_fetch_add(p, v, __ATOMIC_RELAXED, __HIP_MEMORY_SCOPE_AGENT); }
DI unsigned xb_xcc_id() { return (unsigned)__builtin_amdgcn_s_getreg((3 << 11) | 20) & 0xFu; }
#define XB_SPIN(cond, bar) do { unsigned _sp = 0; while (cond) { __builtin_amdgcn_s_sleep(1); \
    if ((++_sp & 255u) == 0u) { if (xb_ld(&(bar)[XB_TMO])) break; if (_sp > XB_SPIN_CAP) { atomicAdd(&(bar)[XB_TMO], 1u); break; } } } } while (0)
struct XcdBarrier { unsigned* bar; unsigned x; volatile LAS unsigned* st; };
DI XcdBarrier xcd_barrier_post(unsigned* bar, volatile LAS unsigned* st) {
  XcdBarrier b; b.bar = bar; b.x = xb_xcc_id(); b.st = st;
  if (tidx() == 0) (void)xb_add(&bar[XB_XCNT(b.x)], 1u);
  return b;
}
DI void xcd_barrier_complete(unsigned* bar, unsigned x, unsigned& nloc, unsigned& nx) {
  const unsigned G = gridDim.x * gridDim.y * gridDim.z;
  unsigned sum, cnt, mine, sp = 0u;
  for (;;) {
    sum = 0u; cnt = 0u; mine = 0u;
#pragma unroll
    for (unsigned j = 0; j < 16; ++j) { const unsigned c = xb_ld(&bar[XB_XCNT(j)]); sum += c; cnt += (c > 0u) ? 1u : 0u; mine = (j == x) ? c : mine; }
    if (sum == G) break;
    __builtin_amdgcn_s_sleep(1);
    if ((++sp & 255u) == 0u) { if (xb_ld(&bar[XB_TMO])) break; if (sp > XB_SPIN_CAP) { atomicAdd(&bar[XB_TMO], 1u); break; } }
  }
  nloc = mine > 0u ? mine : 1u; nx = cnt > 0u ? cnt : 1u;
}
DI void xcd_barrier(const XcdBarrier& b) {
  asm volatile("s_waitcnt vmcnt(0)" ::: "memory");
  __syncthreads();
  if (tidx() == 0) {
    unsigned* bar = b.bar;
    __builtin_amdgcn_s_waitcnt(0);
    unsigned nloc = b.st[0], nx = b.st[1];
    if (nloc == 0u) { xcd_barrier_complete(bar, b.x, nloc, nx); b.st[0] = nloc; b.st[1] = nx; }
    const unsigned old = xb_add(&bar[XB_XSUB(b.x)], 1u);
    const unsigned gen = old / nloc;
    if (old + 1u == (gen + 1u) * nloc) {
      __builtin_amdgcn_fence(__ATOMIC_RELEASE, "agent");
      asm volatile("s_waitcnt vmcnt(0)" ::: "memory");
      const unsigned og = xb_add(&bar[XB_TOP], 1u);
      const unsigned tg = og / nx;
      if (og + 1u == (tg + 1u) * nx) xb_add(&bar[XB_TOPGEN], 1u);
      else XB_SPIN(xb_ld(&bar[XB_TOPGEN]) == tg, bar);
      __builtin_amdgcn_fence(__ATOMIC_ACQUIRE, "agent");
      xb_add(&bar[XB_XGEN(b.x)], 1u);
      asm volatile("s_waitcnt vmcnt(0)" ::: "memory");
    } else {
      XB_SPIN(xb_ld(&bar[XB_XGEN(b.x)]) == gen, bar);
      __builtin_amdgcn_fence(__ATOMIC_ACQUIRE, "agent");
      asm volatile("s_waitcnt vmcnt(0)" ::: "memory");
    }
  }
  __syncthreads();
}

#ifndef PROBE_K
#define PROBE_K 8
#endif
#ifndef REPMASK
#define REPMASK 0
#endif
#ifndef ONE_LAUNCH
#define ONE_LAUNCH 1
#endif
constexpr int LDS_BYTES = GEMM_LDS + 1024;

#if ONE_LAUNCH
#define BAR_ARG , const XcdBarrier& xb
#define BAR_PASS , xb
#else
#define BAR_ARG
#define BAR_PASS
#endif
template <int PH>
DI void phase_step(unsigned char* lds, int ph_lo, int ph_hi BAR_ARG) {
  if (PH >= ph_lo && PH < ph_hi) {
    const __attribute__((address_space(4))) Params* kp = (const __attribute__((address_space(4))) Params*)__builtin_amdgcn_kernarg_segment_ptr();
    asm volatile("" : "+s"(kp));
    run_phase(*(const Params*)kp, PH, lds, blockIdx.x, gridDim.x);
#if ONE_LAUNCH
    if (PROBE_PH >= 0 && PH + 1 == ph_hi) { asm volatile("s_waitcnt vmcnt(0)" ::: "memory"); __syncthreads(); }
    if (PROBE_PH >= 0 && tidx() == 0 && blockIdx.x == 0 && PH + 1 == ph_hi) ((volatile unsigned long long*)(lds + GEMM_LDS + 528))[PH + 1] = __builtin_amdgcn_s_memrealtime();
    if (PH + 1 < ph_hi) {
      if (PH == 0) cg::this_grid().sync(); else xcd_barrier(xb);
      if ((REPMASK >> 25) & 1) xcd_barrier(xb);
      if (PROBE_PH >= 0 && tidx() == 0 && blockIdx.x == 0) ((volatile unsigned long long*)(lds + GEMM_LDS + 528))[PH + 1] = __builtin_amdgcn_s_memrealtime();
    }
#endif
  }
}

__global__ void __launch_bounds__(512, 2) mega(Params P, int ph_lo, int ph_hi) {
  extern __shared__ __attribute__((aligned(16))) unsigned char lds[];
#if ONE_LAUNCH
  volatile LAS unsigned* st = (volatile LAS unsigned*)(lds + GEMM_LDS + 512);
  if (tidx() < 2) st[tidx()] = 0u;
  __syncthreads();
  XcdBarrier xb = xcd_barrier_post(P.bar, st);
  if (PROBE_PH == -2 && tidx() == 0) *(volatile unsigned long long*)(lds + PROBE_LDS_OFF) = 0ull;
#endif
#if ONE_LAUNCH
  if (PROBE_PH >= 0 && tidx() == 0 && blockIdx.x == 0) ((volatile unsigned long long*)(lds + GEMM_LDS + 528))[0] = __builtin_amdgcn_s_memrealtime();
#endif
#define STEP(N) phase_step<N>(lds, ph_lo, ph_hi BAR_PASS);
  STEP(0) STEP(1) STEP(2) STEP(3) STEP(4) STEP(5) STEP(6) STEP(7) STEP(8) STEP(9)
  STEP(10) STEP(11) STEP(12) STEP(13) STEP(14) STEP(15) STEP(16) STEP(17) STEP(18) STEP(19) STEP(20) STEP(21)
#undef STEP
#if ONE_LAUNCH
  if (PROBE_PH == -2 && tidx() == 0 && blockIdx.x == 0) {
    const unsigned long long dur = *(volatile unsigned long long*)(lds + PROBE_LDS_OFF);
    const unsigned long long until = __builtin_amdgcn_s_memrealtime() + (unsigned long long)PROBE_K * dur;
    while (__builtin_amdgcn_s_memrealtime() < until) __builtin_amdgcn_s_sleep(32);
  }
  if (PROBE_PH >= 0 && tidx() == 0 && blockIdx.x == 0) {
    volatile unsigned long long* ts = (volatile unsigned long long*)(lds + GEMM_LDS + 528);
    const unsigned long long dur = ts[PROBE_PH + 1] - ts[PROBE_PH];
    const unsigned long long until = ts[NPHASE] + (unsigned long long)PROBE_K * dur;
    while (__builtin_amdgcn_s_memrealtime() < until) __builtin_amdgcn_s_sleep(32);
  }
#endif
}

static size_t carve(size_t& off, size_t bytes) { size_t o = off; off = (off + bytes + 255) & ~(size_t)255; return o; }

extern "C" void kernel_launch(void* const* d_in, const int* in_sizes, int n_in, void* d_out, int out_size, void* d_ws, size_t ws_size, hipStream_t stream) {
  static int grid = 0;
  if (grid == 0) {
    int dev = 0, cus = 0, per_cu = 0;
    hipGetDevice(&dev);
    hipDeviceGetAttribute(&cus, hipDeviceAttributeMultiprocessorCount, dev);
    if (hipFuncSetAttribute((const void*)mega, hipFuncAttributeMaxDynamicSharedMemorySize, LDS_BYTES) != hipSuccess) { fprintf(stderr, "kernel_launch: hipFuncSetAttribute failed\n"); }
    hipOccupancyMaxActiveBlocksPerMultiprocessor(&per_cu, (const void*)mega, 512, LDS_BYTES);
    if (per_cu < 1) { fprintf(stderr, "kernel_launch: occupancy query says %d blocks per CU\n", per_cu); per_cu = 1; }
    (void)hipGetLastError();
    grid = cus;
  }
  Params P;
  memset(&P, 0, sizeof(P));
  P.pad0 = REPMASK;
  const float** in = (const float**)&P;
  for (int i = 0; i < 39 && i < n_in; ++i) in[i] = (const float*)d_in[i];
  P.out = (float*)d_out;
  char* ws = (char*)d_ws;
  size_t off = 0;
  P.bar = (unsigned*)(ws + carve(off, XCD_BAR_WORDS * 4));
  P.mods = (float*)(ws + carve(off, 2 * 5 * 6144 * 4));
  P.ropeM = (float*)(ws + carve(off, 128 * 8 * 2 * 4));
  P.ropeS = (float*)(ws + carve(off, 128 * 16 * 2 * 4));
  P.msh = (float*)(ws + carve(off, 64));
  P.win0t = (bf16*)(ws + carve(off, (size_t)1792 * 1024 * 2));
  P.wqt = (bf16*)(ws + carve(off, (size_t)768 * 384 * 2));
  P.wkvt = (bf16*)(ws + carve(off, (size_t)1024 * 256 * 2));
  P.wout0t = (bf16*)(ws + carve(off, (size_t)1024 * 1024 * 2));
  P.win1t = (bf16*)(ws + carve(off, (size_t)2432 * 1024 * 2));
  P.wout1t = (bf16*)(ws + carve(off, (size_t)1024 * 1024 * 2));
  P.wlrut = (bf16*)(ws + carve(off, (size_t)32 * 4096 * 2));
  P.wgut = (bf16*)(ws + carve(off, (size_t)32 * 1024 * 1024 * 2));
  P.wdt = (bf16*)(ws + carve(off, (size_t)32 * 1024 * 512 * 2));
  P.wrt = (bf16*)(ws + carve(off, (size_t)64 * 3072 * 2));
  P.ut = P.wgut;
  P.xc = (float*)(ws + carve(off, (size_t)NC * 1024 * 4));
  P.h = (bf16*)(ws + carve(off, (size_t)NT * 1024 * 2));
  P.cbuf = (bf16*)(ws + carve(off, (size_t)NT * C2LD * 2));
  P.qkv = (bf16*)(ws + carve(off, QKV_ELEMS * 2));
  P.ycat = (bf16*)(ws + carve(off, (size_t)NT * 1024 * 2));
  P.ssqc = (float*)(ws + carve(off, (size_t)NT * 16 * 4));
  P.ssqx = (float*)(ws + carve(off, (size_t)NT * 16 * 4));
  P.ssq2 = (float*)(ws + carve(off, (size_t)NT * 8 * 4));
  P.comp = (float*)(ws + carve(off, (size_t)NB * 2 * LCH * 512 * 2 * 4));
  P.gcomp = (float*)(ws + carve(off, (size_t)NB * 2 * LGR * 512 * 2 * 4));
  P.dtr = (float*)(ws + carve(off, (size_t)NT * 16 * 4));
  P.cst = (float*)(ws + carve(off, (size_t)NB * 16 * NPOS * 4));
  P.dtt = (float*)(ws + carve(off, (size_t)NB * 16 * NPOS * 4));
  P.wgp = (float*)(ws + carve(off, (size_t)NB * 16 * NPOS * 4));
  P.cnt = (int*)(ws + carve(off, 64 * 4));
  P.cntt = (int*)(ws + carve(off, (size_t)2048 * 32 * 4));
  P.tokinfo = (int*)(ws + carve(off, (size_t)NT * 4 * 4));
  P.tokw = (float*)(ws + carve(off, (size_t)NT * 2 * 4));
  P.list = (int*)(ws + carve(off, (size_t)32 * NT * 4));
  if (off > ws_size || n_in != 39 || out_size != NL * 1024) {
    fprintf(stderr, "kernel_launch: needs %zu bytes of workspace (got %zu), 39 inputs (got %d), out %d (got %d); nothing launched\n", off, ws_size, n_in, NL * 1024, out_size);
    return;
  }
#if ONE_LAUNCH
  hipMemsetAsync(P.bar, 0, XCD_BAR_WORDS * 4, stream);
  int lo = 0, hi = NPHASE;
  void* args[] = {&P, &lo, &hi};
  hipError_t e = hipLaunchCooperativeKernel((const void*)mega, dim3(grid), dim3(512), args, LDS_BYTES, stream);
  if (e != hipSuccess) fprintf(stderr, "kernel_launch: cooperative launch failed: %s (grid %d)\n", hipGetErrorString(e), grid);
#else
  for (int ph = 0; ph < NPHASE; ++ph) hipLaunchKernelGGL(mega, dim3(grid), dim3(512), LDS_BYTES, stream, P, ph, ph + 1);
#endif
}
```

```cpp
#define REPMASK 0
#define PROBE_PH (-1)
#define PROBE_SEC 0
#include <hip/hip_runtime.h>
#include <hip/hip_cooperative_groups.h>
#include <cstdio>
#include <cstdint>
#include <cstring>
namespace cg = cooperative_groups;

#define DI __device__ __forceinline__
typedef unsigned short bf16;
typedef __attribute__((ext_vector_type(8))) short bf16x8;
typedef __attribute__((ext_vector_type(16))) float f32x16;
typedef __attribute__((ext_vector_type(8))) float f32x8;
typedef __attribute__((ext_vector_type(4))) float f32x4;
typedef __attribute__((ext_vector_type(2))) float f32x2;
typedef __attribute__((ext_vector_type(4))) unsigned u32x4;
typedef __attribute__((ext_vector_type(2))) unsigned u32x2;
typedef __attribute__((ext_vector_type(2))) __bf16 bfx2;
typedef __attribute__((ext_vector_type(8))) __bf16 bfx8;

constexpr int D = 1024, NB = 4, SEQ = 8192, LC = 256;
constexpr int NL = NB * SEQ;
constexpr int NC = NB * LC;
constexpr int NT = NL + NC;
constexpr int NPOS = SEQ + LC;
constexpr int C1LD = 1696, C2LD = 2320;
constexpr int NCH = 66;
constexpr float EPS = 1e-6f;
constexpr float LOG2E = 1.4426950408889634f;
constexpr int NSLOT = 2 * NT;

#ifndef PROBE_PH
#define PROBE_PH (-1)
#endif
#ifndef PROBE_SEC
#define PROBE_SEC 0
#endif
#define PROBE_LDS_OFF (147456 + 800)
#define PB_BEGIN(SEC, lds_) unsigned long long pb_t0_##SEC = 0; if (PROBE_PH == -2 && PROBE_SEC == SEC && blockIdx.x == 0) { __syncthreads(); pb_t0_##SEC = __builtin_amdgcn_s_memrealtime(); }
#define PB_END(SEC, lds_) if (PROBE_PH == -2 && PROBE_SEC == SEC && blockIdx.x == 0) { __syncthreads(); if (threadIdx.x == 0) *(volatile unsigned long long*)((unsigned char*)(lds_) + PROBE_LDS_OFF) += __builtin_amdgcn_s_memrealtime() - pb_t0_##SEC; }
#define PBW_BEGIN(SEC, lds_) unsigned long long pbw_t0_##SEC = 0; if (PROBE_PH == -2 && PROBE_SEC == SEC && blockIdx.x == 0 && threadIdx.x < 64) { pbw_t0_##SEC = __builtin_amdgcn_s_memrealtime(); }
#define PBW_END(SEC, lds_) if (PROBE_PH == -2 && PROBE_SEC == SEC && blockIdx.x == 0 && threadIdx.x == 0) { *(volatile unsigned long long*)((unsigned char*)(lds_) + PROBE_LDS_OFF) += __builtin_amdgcn_s_memrealtime() - pbw_t0_##SEC; }
DI int tidx() { int t = threadIdx.x; asm volatile("" : "+v"(t)); return t; }
DI float bf2f(bf16 u) { return __uint_as_float(((unsigned)u) << 16); }
DI float lo16(unsigned u) { return __uint_as_float(u << 16); }
DI float hi16(unsigned u) { return __uint_as_float(u & 0xffff0000u); }
DI unsigned pack2(float a, float b) { f32x2 v = {a, b}; bfx2 r = __builtin_convertvector(v, bfx2); return __builtin_bit_cast(unsigned, r); }
DI bf16 f2bf(float x) { return (bf16)(pack2(x, 0.f) & 0xffffu); }
DI bf16x8 pack8(const float (&v)[8]) { f32x8 t; for (int i = 0; i < 8; ++i) t[i] = v[i]; bfx8 r = __builtin_convertvector(t, bfx8); return __builtin_bit_cast(bf16x8, r); }
DI u32x2 pack4(float a, float b, float c, float d) { u32x2 r; r[0] = pack2(a, b); r[1] = pack2(c, d); return r; }
DI void unpack8(u32x4 raw, float (&v)[8]) { for (int i = 0; i < 4; ++i) { v[2 * i] = lo16(raw[i]); v[2 * i + 1] = hi16(raw[i]); } }
DI int crow(int i, int h) { return (i & 3) + 8 * (i >> 2) + 4 * h; }
DI int swap23(int p) { return (p & ~12) | ((p & 4) << 1) | ((p & 8) >> 1); }
DI f32x16 mfma32(bf16x8 a, bf16x8 b, f32x16 c) { return __builtin_amdgcn_mfma_f32_32x32x16_bf16(a, b, c, 0, 0, 0); }
DI f32x4 mfma16(bf16x8 a, bf16x8 b, f32x4 c) { return __builtin_amdgcn_mfma_f32_16x16x32_bf16(a, b, c, 0, 0, 0); }
DI float sigmoidf_(float x) { return 1.f / (1.f + __expf(-x)); }
DI float siluf_(float x) { return x / (1.f + __expf(-x)); }
DI float softplusf_(float x) { return x > 20.f ? x : log1pf(__expf(x)); }
DI float geluf_(float x) { float u = 0.7978845608028654f * (x + 0.044715f * x * x * x); float t = 1.f - 2.f / (1.f + __expf(2.f * u)); return 0.5f * x * (1.f + t); }
DI float xor32(float v) { return v + __shfl_xor(v, 32); }
DI float wave_sum(float v) { for (int o = 32; o >= 1; o >>= 1) v += __shfl_xor(v, o); return v; }

DI void tok_info(int tok, int& bmod, int& b, int& pos, bool& lat) {
  if (tok < NL) { b = tok >> 13; bmod = b; pos = LC + (tok & (SEQ - 1)); lat = true; }
  else { int t = tok - NL; b = t >> 8; bmod = 4; pos = t & (LC - 1); lat = false; }
}

struct Params {
  const float *x, *c, *ctx, *c_ctx, *ada_w, *ada_b, *norm1_g, *norm2_g;
  const float *ab_w_in, *ab_w_out, *mla_q_norm_g, *mla_w_q_up, *mla_kv_norm_g, *mla_w_kv_up, *mla_q_head_g, *mla_k_head_g;
  const float *lru_conv_w, *lru_conv_b, *lru_w_a, *lru_b_a, *lru_w_x, *lru_b_x, *lru_lambda;
  const float *cd_w_in, *cd_w_out, *swa_q_head_g, *swa_k_head_g, *swa_sink;
  const float *ssd_conv_w, *ssd_conv_b, *ssd_a_log, *ssd_dt_bias, *ssd_d, *ssd_norm_g;
  const float *router_w, *router_b, *moe_w_gate, *moe_w_up, *moe_w_down;
  float* out;
  float* mods;
  float* ropeM;
  float* ropeS;
  float* msh;
  bf16 *win0t, *wqt, *wkvt, *wout0t, *win1t, *wout1t, *wlrut, *wgut, *wdt, *wrt;
  float* xc;
  bf16* h;
  bf16* cbuf;
  bf16* qkv;
  bf16* ycat;
  bf16* ut;
  float *ssqc, *ssqx, *ssq2;
  float* comp;
  float* gcomp;
  float* dtr;
  float *cst, *dtt, *wgp;
  int* cnt;
  int* cntt;
  int* tokinfo;
  float* tokw;
  int* list;
  unsigned* bar;
  int pad0;
  int pad1;
};
constexpr size_t QB_OFF = 0, KB_OFF = (size_t)NB * 8 * NPOS * 96, VT_OFF = 2 * KB_OFF;
constexpr size_t Q2_OFF = 0, K2_OFF = (size_t)NB * 8 * NPOS * 64, V2T_OFF = K2_OFF + (size_t)NB * 2 * NPOS * 64,
                 ST_OFF = V2T_OFF + (size_t)NB * 2 * 64 * NPOS;
constexpr size_t QKV_ELEMS = (size_t)NSLOT * 1024;
static_assert(VT_OFF + (size_t)NB * 8 * 64 * NPOS <= QKV_ELEMS, "qkv region");
static_assert(ST_OFF + (size_t)NB * 2 * 8 * NCH * 64 * 128 <= QKV_ELEMS, "qkv region L1");
#define LAS3 __attribute__((address_space(3)))
template <int WM, int WN, bool ZERO = true, class PRow, class QRow>
DI void gemm_core(bf16* smem, int K, int krot, PRow prow, QRow qrow, f32x16 (&acc)[WM][WN], int hook_kt, const float (&hs)[WN]) {
  constexpr int TP = 64 * WM, TQ = 128 * WN, NR = TP + TQ, NCHK = NR / 64, STAGE = NR * 64;
  const int tid = tidx(), lane = tid & 63, wid = tid >> 6, wr = wid >> 2, wc = wid & 3, r = lane & 31, h = lane >> 5;
  const bf16* ps[NCHK];
#pragma unroll
  for (int j = 0; j < NCHK; ++j) {
    const int R = j * 64 + (tid >> 3);
    const int cs = (tid & 7) ^ ((R >> 1) & 7);
    ps[j] = (j < WM ? prow(R) : qrow(R - TP)) + cs * 8;
  }
  const int nkt = K >> 6;
  if (ZERO) {
#pragma unroll
    for (int i = 0; i < WM; ++i)
#pragma unroll
      for (int j = 0; j < WN; ++j)
#pragma unroll
        for (int e = 0; e < 16; ++e) acc[i][j][e] = 0.f;
  }
  {
    const int ko = (krot % nkt) * 64;
#pragma unroll
    for (int j = 0; j < NCHK; ++j)
      __builtin_amdgcn_global_load_lds((const unsigned*)(ps[j] + ko), (LAS3 unsigned*)(smem + (j * 512 + wid * 64) * 8), 16, 0, 0);
  }
  asm volatile("s_waitcnt vmcnt(0)" ::: "memory");
  __syncthreads();
  const int sw = (r >> 1) & 7;
  for (int kt = 0; kt < nkt; ++kt) {
    const int buf = kt & 1;
    if (kt + 1 < nkt) {
      const int ko = ((kt + 1 + krot) % nkt) * 64;
#pragma unroll
      for (int j = 0; j < NCHK; ++j)
        __builtin_amdgcn_global_load_lds((const unsigned*)(ps[j] + ko), (LAS3 unsigned*)(smem + (buf ^ 1) * STAGE + (j * 512 + wid * 64) * 8), 16, 0, 0);
    }
    if (kt == hook_kt) {
#pragma unroll
      for (int i = 0; i < WM; ++i)
#pragma unroll
        for (int j = 0; j < WN; ++j)
#pragma unroll
          for (int e = 0; e < 16; ++e) acc[i][j][e] *= hs[j];
    }
    const bf16* sP = smem + buf * STAGE + (wr * WM * 32 + r) * 64;
    const bf16* sQ = smem + buf * STAGE + (TP + wc * WN * 32 + r) * 64;
    bf16x8 a[2][WM], b[2][WN];
    {
      const int co = (h ^ sw) * 8;
#pragma unroll
      for (int i = 0; i < WM; ++i) a[0][i] = *(const bf16x8*)(sP + i * 32 * 64 + co);
#pragma unroll
      for (int j = 0; j < WN; ++j) b[0][j] = *(const bf16x8*)(sQ + j * 32 * 64 + co);
    }
#pragma unroll
    for (int ks = 0; ks < 4; ++ks) {
      if (ks < 3) {
        const int co = (((ks + 1) * 2 + h) ^ sw) * 8;
#pragma unroll
        for (int i = 0; i < WM; ++i) a[(ks + 1) & 1][i] = *(const bf16x8*)(sP + i * 32 * 64 + co);
#pragma unroll
        for (int j = 0; j < WN; ++j) b[(ks + 1) & 1][j] = *(const bf16x8*)(sQ + j * 32 * 64 + co);
      }
#pragma unroll
      for (int i = 0; i < WM; ++i)
#pragma unroll
        for (int j = 0; j < WN; ++j) acc[i][j] = mfma32(a[ks & 1][i], b[ks & 1][j], acc[i][j]);
      if (ks < 3) {
#pragma unroll
        for (int n = 0; n < WM + WN; ++n) { __builtin_amdgcn_sched_group_barrier(0x008, 1, 0); __builtin_amdgcn_sched_group_barrier(0x100, 1, 0); }
        __builtin_amdgcn_sched_group_barrier(0x008, WM * WN - (WM + WN), 0);
      }
    }
    asm volatile("s_waitcnt vmcnt(0)" ::: "memory");
    __syncthreads();
  }
}

struct WaveId { int lane, wid, wr, wc, r, h; };
DI WaveId wave_id() { WaveId w; w.lane = tidx() & 63; w.wid = tidx() >> 6; w.wr = w.wid >> 2; w.wc = w.wid & 3; w.r = w.lane & 31; w.h = w.lane >> 5; return w; }

DI void gemm_c1_item(const Params& P, bf16* smem, int pt, int qt) {
  f32x16 acc[4][2];
  const float hs[2] = {1.f, 1.f};
  const int p0 = pt * 256, q0 = qt * 256;
  gemm_core<4, 2>(smem, 1024, 0,
      [&](int rp) { return P.win0t + (size_t)(p0 + rp) * 1024; },
      [&](int rq) { return P.h + (size_t)(q0 + rq) * 1024; }, acc, -1, hs);
  const WaveId w = wave_id();
#pragma unroll
  for (int j = 0; j < 2; ++j) {
    const int tok = q0 + w.wc * 64 + j * 32 + w.r;
#pragma unroll
    for (int i2 = 0; i2 < 2; ++i2) {
      const int grp = (p0 + w.wr * 128 + i2 * 64) >> 6;
      float ss = 0.f;
#pragma unroll
      for (int ii = 0; ii < 2; ++ii)
#pragma unroll
        for (int g = 0; g < 4; ++g) {
          const int i = i2 * 2 + ii;
          const int f0 = p0 + w.wr * 128 + i * 32 + 8 * g + 4 * w.h;
          const float a0 = acc[i][j][4 * g], a1 = acc[i][j][4 * g + 1], a2 = acc[i][j][4 * g + 2], a3 = acc[i][j][4 * g + 3];
          ss += a0 * a0 + a1 * a1 + a2 * a2 + a3 * a3;
          if (f0 < C1LD) *(u32x2*)(P.cbuf + (size_t)tok * C1LD + f0) = pack4(a0, a1, a2, a3);
        }
      ss = xor32(ss);
      if (w.h == 0 && grp < 10) P.ssqc[tok * 16 + grp] = ss;
    }
  }
}

#define rope_pair(X1, X2, TAB) do { const float* tb_ = (TAB); const float cs_ = tb_[0], sn_ = tb_[1]; const float a_ = (X1) * cs_ - (X2) * sn_, b_ = (X1) * sn_ + (X2) * cs_; (X1) = a_; (X2) = b_; } while (0)

DI void gemm_q_item(const Params& P, bf16* smem, int pt, int qt) {
  f32x16 acc[3][1];
  const float hs[1] = {1.f};
  const int p0 = pt * 192, q0 = qt * 128;
  gemm_core<3, 1>(smem, 384, 0,
      [&](int rp) { return P.wqt + (size_t)(p0 + rp) * 384; },
      [&](int rq) { return P.cbuf + (size_t)(q0 + rq) * C1LD; }, acc, -1, hs);
  const WaveId w = wave_id();
  const int hd = pt * 2 + w.wr;
  const float qscale = 0.10206207261596575f * LOG2E;
#pragma unroll
  for (int j = 0; j < 1; ++j) {
    const int tok = q0 + w.wc * 32 + w.r;
    int bmod, b, pos; bool lat; tok_info(tok, bmod, b, pos, lat);
    float s6 = 0.f;
    for (int g = 0; g < 6; ++g) s6 += P.ssqc[tok * 16 + g];
    const float rstd = rsqrtf(s6 * (1.f / 384.f) + EPS);
    float ss = 0.f;
#pragma unroll
    for (int i = 0; i < 3; ++i)
#pragma unroll
      for (int e = 0; e < 16; ++e) { acc[i][j][e] *= rstd; ss += acc[i][j][e] * acc[i][j][e]; }
    ss = xor32(ss);
    const float r2 = rsqrtf(ss * (1.f / 96.f) + EPS);
#pragma unroll
    for (int i = 0; i < 3; ++i)
#pragma unroll
      for (int g = 0; g < 4; ++g) {
        const f32x4 gg = *(const f32x4*)(P.mla_q_head_g + i * 32 + 8 * g + 4 * w.h);
#pragma unroll
        for (int e = 0; e < 4; ++e) acc[i][j][4 * g + e] *= r2 * gg[e];
      }
    if (lat) {
      const int sq = tok & (SEQ - 1), rowp = sq >> 6, colp = sq & 63;
#pragma unroll
      for (int e = 0; e < 4; ++e) {
        rope_pair(acc[2][j][e], acc[2][j][4 + e], P.ropeM + (rowp * 8 + 4 * w.h + e) * 2);
        rope_pair(acc[2][j][8 + e], acc[2][j][12 + e], P.ropeM + (colp * 8 + 4 * w.h + e) * 2);
      }
    }
    bf16* dst = P.qkv + QB_OFF + ((size_t)(b * 8 + hd) * NPOS + pos) * 96;
#pragma unroll
    for (int i = 0; i < 3; ++i)
#pragma unroll
      for (int g = 0; g < 4; ++g)
        *(u32x2*)(dst + i * 32 + 8 * g + 4 * w.h) = pack4(acc[i][j][4 * g] * qscale, acc[i][j][4 * g + 1] * qscale, acc[i][j][4 * g + 2] * qscale, acc[i][j][4 * g + 3] * qscale);
  }
}

DI void gemm_kv_item(const Params& P, bf16* smem, int pt, int qt) {
  f32x16 acc[4][1];
  const float hs[1] = {1.f};
  const int p0 = pt * 256, q0 = qt * 128;
  gemm_core<4, 1>(smem, 256, 0,
      [&](int rp) { return P.wkvt + (size_t)(p0 + rp) * 256; },
      [&](int rq) { return P.cbuf + (size_t)(q0 + rq) * C1LD + 384; }, acc, -1, hs);
  const WaveId w = wave_id();
  const int hd = pt * 2 + w.wr;
#pragma unroll
  for (int j = 0; j < 1; ++j) {
    const int tok = q0 + w.wc * 32 + w.r;
    int bmod, b, pos; bool lat; tok_info(tok, bmod, b, pos, lat);
    float s4 = 0.f;
    for (int g = 6; g < 10; ++g) s4 += P.ssqc[tok * 16 + g];
    const float rstd = rsqrtf(s4 * (1.f / 256.f) + EPS);
    float kr[16];
    {
      const bf16* src = P.cbuf + (size_t)tok * C1LD + 640 + 16 * w.h;
      float t8[8];
      unpack8(*(const u32x4*)src, t8);
      for (int i = 0; i < 8; ++i) kr[i] = t8[i];
      unpack8(*(const u32x4*)(src + 8), t8);
      for (int i = 0; i < 8; ++i) kr[8 + i] = t8[i];
    }
    float ss = 0.f;
#pragma unroll
    for (int i = 0; i < 2; ++i)
#pragma unroll
      for (int e = 0; e < 16; ++e) { acc[i][j][e] *= rstd; ss += acc[i][j][e] * acc[i][j][e]; }
#pragma unroll
    for (int i = 0; i < 16; ++i) ss += kr[i] * kr[i];
    ss = xor32(ss);
    const float r2 = rsqrtf(ss * (1.f / 96.f) + EPS);
    bf16* dst = P.qkv + KB_OFF + ((size_t)(b * 8 + hd) * NPOS + pos) * 96;
#pragma unroll
    for (int i = 0; i < 2; ++i)
#pragma unroll
      for (int g = 0; g < 4; ++g) {
        const f32x4 gg = *(const f32x4*)(P.mla_k_head_g + i * 32 + 8 * g + 4 * w.h);
        *(u32x2*)(dst + i * 32 + 8 * g + 4 * w.h) = pack4(acc[i][j][4 * g] * r2 * gg[0], acc[i][j][4 * g + 1] * r2 * gg[1], acc[i][j][4 * g + 2] * r2 * gg[2], acc[i][j][4 * g + 3] * r2 * gg[3]);
      }
#pragma unroll
    for (int i = 0; i < 16; ++i) kr[i] *= r2 * P.mla_k_head_g[64 + 16 * w.h + i];
    if (lat) {
      const int sq = tok & (SEQ - 1);
      const int pp = w.h ? (sq & 63) : (sq >> 6);
#pragma unroll
      for (int i = 0; i < 8; ++i) rope_pair(kr[i], kr[8 + i], P.ropeM + (pp * 8 + i) * 2);
    }
    {
      u32x4 o0, o1;
      for (int i = 0; i < 4; ++i) { o0[i] = pack2(kr[2 * i], kr[2 * i + 1]); o1[i] = pack2(kr[8 + 2 * i], kr[8 + 2 * i + 1]); }
      *(u32x4*)(dst + 64 + 16 * w.h) = o0;
      *(u32x4*)(dst + 64 + 16 * w.h + 8) = o1;
    }
    const int posp = (pos & ~15) | swap23(pos & 15);
    bf16* vdst = P.qkv + VT_OFF + (size_t)(b * 8 + hd) * 64 * NPOS + posp;
#pragma unroll
    for (int i = 0; i < 2; ++i)
#pragma unroll
      for (int e = 0; e < 16; ++e) vdst[(size_t)(i * 32 + crow(e, w.h)) * NPOS] = f2bf(acc[2 + i][j][e] * rstd);
  }
}

template <int WM>
DI void gemm_out_item(const Params& P, bf16* smem, int layer, int pt, int qt) {
  f32x16 acc[WM][2];
  const int p0 = pt * 64 * WM, q0 = qt * 256;
  const WaveId w = wave_id();
  float hs[2] = {1.f, 1.f};
  if (layer == 1) {
#pragma unroll
    for (int j = 0; j < 2; ++j) {
      const int tok = q0 + w.wc * 64 + j * 32 + w.r;
      float s = 0.f;
      for (int g = 0; g < 8; ++g) s += P.ssq2[tok * 8 + g];
      hs[j] = rsqrtf(s * (1.f / 512.f) + EPS);
    }
  }
  const bf16* wt = layer ? P.wout1t : P.wout0t;
  gemm_core<WM, 2>(smem, 1024, layer ? 8 : 0,
      [&](int rp) { return wt + (size_t)(p0 + rp) * 1024; },
      [&](int rq) { return P.ycat + (size_t)(q0 + rq) * 1024; }, acc, layer ? 8 : -1, hs);
#pragma unroll
  for (int j = 0; j < 2; ++j) {
    const int tok = q0 + w.wc * 64 + j * 32 + w.r;
    int bmod, b, pos; bool lat; tok_info(tok, bmod, b, pos, lat);
    const float* src = layer ? (P.out + (size_t)tok * 1024) : (lat ? P.x + (size_t)tok * 1024 : P.ctx + (size_t)(tok - NL) * 1024);
    float* dst = lat ? P.out + (size_t)tok * 1024 : P.xc + (size_t)(tok - NL) * 1024;
    const float* m2 = P.mods + ((size_t)(layer * 5 + bmod) * 6 + 2) * 1024;
#pragma unroll
    for (int i = 0; i < WM; ++i)
#pragma unroll
      for (int g = 0; g < 4; ++g) {
        const int f0 = p0 + w.wr * 32 * WM + i * 32 + 8 * g + 4 * w.h;
        const f32x4 xv = *(const f32x4*)(src + f0);
        const f32x4 mv = *(const f32x4*)(m2 + f0);
        f32x4 o;
#pragma unroll
        for (int e = 0; e < 4; ++e) o[e] = xv[e] + mv[e] * acc[i][j][4 * g + e];
        *(f32x4*)(dst + f0) = o;
        if (g == 3) __builtin_amdgcn_sched_barrier(0);
      }
  }
}

DI void moe1_item(const Params& P, bf16* smem, int layer, int e, int m0, int pt, int cnt_e, int off_e) {
  f32x16 acc[4][2];
  const float hs[2] = {1.f, 1.f};
  const int* lst = P.list + (size_t)e * NT;
  gemm_core<4, 2>(smem, 1024, 0,
      [&](int rp) { return P.wgut + ((size_t)e * 1024 + pt * 256 + rp) * 1024; },
      [&](int rq) { int m = m0 + rq; if (m > cnt_e - 1) m = cnt_e - 1; return P.h + (size_t)lst[m] * 1024; }, acc, -1, hs);
  const WaveId w = wave_id();
#pragma unroll
  for (int j = 0; j < 2; ++j) {
    const int m = m0 + w.wc * 64 + j * 32 + w.r;
    if (m < cnt_e) {
      bf16* dst = P.cbuf + (size_t)(off_e + m) * 512 + pt * 128 + w.wr * 64;
#pragma unroll
      for (int i2 = 0; i2 < 2; ++i2)
#pragma unroll
        for (int g = 0; g < 4; ++g) {
          float o[4];
#pragma unroll
          for (int k = 0; k < 4; ++k) o[k] = siluf_(acc[2 * i2][j][4 * g + k]) * acc[2 * i2 + 1][j][4 * g + k];
          *(u32x2*)(dst + i2 * 32 + 8 * g + 4 * w.h) = pack4(o[0], o[1], o[2], o[3]);
        }
    }
  }
}
DI void moe2_item(const Params& P, bf16* smem, int e, int m0, int pt, int cnt_e, int off_e, int total) {
  f32x16 acc[4][2];
  const float hs[2] = {1.f, 1.f};
  gemm_core<4, 2>(smem, 512, 0,
      [&](int rp) { return P.wdt + ((size_t)e * 1024 + pt * 256 + rp) * 512; },
      [&](int rq) { int s = off_e + m0 + rq; if (s > total - 1) s = total - 1; return P.cbuf + (size_t)s * 512; }, acc, -1, hs);
  const WaveId w = wave_id();
#pragma unroll
  for (int j = 0; j < 2; ++j) {
    const int m = m0 + w.wc * 64 + j * 32 + w.r;
    if (m < cnt_e) {
      bf16* dst = P.qkv + (size_t)(off_e + m) * 1024 + pt * 256 + w.wr * 128;
#pragma unroll
      for (int i = 0; i < 4; ++i)
#pragma unroll
        for (int g = 0; g < 4; ++g)
          *(u32x2*)(dst + i * 32 + 8 * g + 4 * w.h) = pack4(acc[i][j][4 * g], acc[i][j][4 * g + 1], acc[i][j][4 * g + 2], acc[i][j][4 * g + 3]);
    }
  }
}

DI void c2_block_epilogue(const Params& P, const WaveId& w, int fb, int tok, f32x16& a0, f32x16& a1) {
  int bmod, b, pos; bool lat; tok_info(tok, bmod, b, pos, lat);
  const float qscale = 0.125f * LOG2E;
  if (fb < 10) {
    const bool isq = fb < 8;
    const float* gain = isq ? P.swa_q_head_g : P.swa_k_head_g;
    float ss = 0.f;
#pragma unroll
    for (int e = 0; e < 16; ++e) ss += a0[e] * a0[e] + a1[e] * a1[e];
    ss = xor32(ss);
    const float r2 = rsqrtf(ss * (1.f / 64.f) + EPS);
#pragma unroll
    for (int g = 0; g < 4; ++g) {
      const f32x4 g0 = *(const f32x4*)(gain + 8 * g + 4 * w.h), g1 = *(const f32x4*)(gain + 32 + 8 * g + 4 * w.h);
#pragma unroll
      for (int e = 0; e < 4; ++e) { a0[4 * g + e] *= r2 * g0[e]; a1[4 * g + e] *= r2 * g1[e]; }
    }
    if (lat) {
      const int sq = tok & (SEQ - 1), rowp = sq >> 6, colp = sq & 63;
#pragma unroll
      for (int e = 0; e < 4; ++e) {
        rope_pair(a0[e], a0[8 + e], P.ropeS + (rowp * 16 + 4 * w.h + e) * 2);
        rope_pair(a0[4 + e], a0[12 + e], P.ropeS + (rowp * 16 + 8 + 4 * w.h + e) * 2);
        rope_pair(a1[e], a1[8 + e], P.ropeS + (colp * 16 + 4 * w.h + e) * 2);
        rope_pair(a1[4 + e], a1[12 + e], P.ropeS + (colp * 16 + 8 + 4 * w.h + e) * 2);
      }
    }
    if (isq && !lat) return;
    const float sc = isq ? qscale : 1.f;
    bf16* dst = isq ? P.qkv + Q2_OFF + ((size_t)(b * 8 + fb) * NPOS + pos) * 64
                    : P.qkv + K2_OFF + ((size_t)(b * 2 + (fb - 8)) * NPOS + pos) * 64;
#pragma unroll
    for (int g = 0; g < 4; ++g) {
      *(u32x2*)(dst + 8 * g + 4 * w.h) = pack4(a0[4 * g] * sc, a0[4 * g + 1] * sc, a0[4 * g + 2] * sc, a0[4 * g + 3] * sc);
      *(u32x2*)(dst + 32 + 8 * g + 4 * w.h) = pack4(a1[4 * g] * sc, a1[4 * g + 1] * sc, a1[4 * g + 2] * sc, a1[4 * g + 3] * sc);
    }
  } else if (fb < 12) {
    const int posp = (pos & ~15) | swap23(pos & 15);
    bf16* vdst = P.qkv + V2T_OFF + (size_t)(b * 2 + (fb - 10)) * 64 * NPOS + posp;
#pragma unroll
    for (int e = 0; e < 16; ++e) {
      vdst[(size_t)(crow(e, w.h)) * NPOS] = f2bf(a0[e]);
      vdst[(size_t)(32 + crow(e, w.h)) * NPOS] = f2bf(a1[e]);
    }
  } else if (fb < 36) {
    bf16* dst = P.cbuf + (size_t)tok * C2LD + fb * 64;
#pragma unroll
    for (int g = 0; g < 4; ++g) {
      *(u32x2*)(dst + 8 * g + 4 * w.h) = pack4(a0[4 * g], a0[4 * g + 1], a0[4 * g + 2], a0[4 * g + 3]);
      *(u32x2*)(dst + 32 + 8 * g + 4 * w.h) = pack4(a1[4 * g], a1[4 * g + 1], a1[4 * g + 2], a1[4 * g + 3]);
    }
  }
}
DI void gemm_c2_item(const Params& P, bf16* smem, int pt, int qt) {
  f32x16 acc[4][2];
  const float hs[2] = {1.f, 1.f};
  const int p0 = pt * 256, q0 = qt * 256;
  gemm_core<4, 2>(smem, 1024, 0,
      [&](int rp) { return P.win1t + (size_t)(p0 + rp) * 1024; },
      [&](int rq) { return P.h + (size_t)(q0 + rq) * 1024; }, acc, -1, hs);
  const WaveId w = wave_id();
#pragma unroll
  for (int j = 0; j < 2; ++j) {
    const int tok = q0 + w.wc * 64 + j * 32 + w.r;
#pragma unroll
    for (int i2 = 0; i2 < 2; ++i2) c2_block_epilogue(P, w, (p0 + w.wr * 128 + i2 * 64) >> 6, tok, acc[2 * i2][j], acc[2 * i2 + 1][j]);
  }
}
DI void gemm_c2dt_item(const Params& P, bf16* smem, int qt) {
  f32x16 acc[1][2];
  const float hs[2] = {1.f, 1.f};
  const int q0 = qt * 256;
  gemm_core<1, 2>(smem, 1024, 0,
      [&](int rp) { return P.win1t + (size_t)(2304 + rp) * 1024; },
      [&](int rq) { return P.h + (size_t)(q0 + rq) * 1024; }, acc, -1, hs);
  const WaveId w = wave_id();
  if (w.wr == 0) {
#pragma unroll
    for (int j = 0; j < 2; ++j) {
      const int tok = q0 + w.wc * 64 + j * 32 + w.r;
#pragma unroll
      for (int g = 0; g < 2; ++g) {
        f32x4 o = {acc[0][j][4 * g], acc[0][j][4 * g + 1], acc[0][j][4 * g + 2], acc[0][j][4 * g + 3]};
        *(f32x4*)(P.dtr + (size_t)tok * 16 + 8 * g + 4 * w.h) = o;
      }
    }
  }
}
template <int DQK, bool WIN>
DI void attn_item(bf16* smem, const bf16* Qp, const bf16* Kp, const bf16* Vtp, int qrow0, int nq, int ntiles, int nctx, int band_k0, int q_lat0,
                  float negM, float sinkterm, bf16* outp) {
  constexpr int KS = DQK / 16, LDK = DQK + 8, LDV = 72, CPR = DQK / 8, NCK = 64 * CPR;
  const int tid = tidx(), lane = tid & 63, w = tid >> 6, r = lane & 31, h = lane >> 5;
  bf16* sK = smem;
  bf16* sV = smem + 2 * 64 * LDK;
  bf16x8 qf[2][KS];
#pragma unroll
  for (int qt = 0; qt < 2; ++qt) {
    int qi = w * 64 + qt * 32 + r;
    if (qi > nq - 1) qi = nq - 1;
#pragma unroll
    for (int s = 0; s < KS; ++s) qf[qt][s] = *(const bf16x8*)(Qp + (size_t)(qrow0 + qi) * DQK + s * 16 + h * 8);
  }
  f32x16 O[2][2];
#pragma unroll
  for (int a = 0; a < 2; ++a)
#pragma unroll
    for (int b = 0; b < 2; ++b)
#pragma unroll
      for (int e = 0; e < 16; ++e) O[a][b][e] = 0.f;
  float lsum[2] = {0.f, 0.f};
  const int kr0 = tid / CPR, kc0 = tid % CPR;
  const int id1 = tid + 512;
  const bool has1 = id1 < NCK;
  const int kr1 = has1 ? id1 / CPR : 0, kc1 = has1 ? id1 % CPR : 0;
  const int vr = tid >> 3, vc = tid & 7;
  u32x4 rK0, rK1, rV;
  rK1 = rK0 = rV = u32x4{0, 0, 0, 0};
  auto tilepos = [&](int t) { return t < nctx ? t * 64 : LC + band_k0 + (t - nctx) * 64; };
  auto gload = [&](int t) {
    const int pos = tilepos(t);
    rK0 = *(const u32x4*)(Kp + (size_t)(pos + kr0) * DQK + kc0 * 8);
    if (has1) rK1 = *(const u32x4*)(Kp + (size_t)(pos + kr1) * DQK + kc1 * 8);
    rV = *(const u32x4*)(Vtp + (size_t)vr * NPOS + pos + vc * 8);
  };
  auto swrite = [&](int buf) {
    *(u32x4*)(sK + buf * 64 * LDK + kr0 * LDK + kc0 * 8) = rK0;
    if (has1) *(u32x4*)(sK + buf * 64 * LDK + kr1 * LDK + kc1 * 8) = rK1;
    *(u32x4*)(sV + buf * 64 * LDV + vr * LDV + vc * 8) = rV;
  };
  gload(0); swrite(0);
  __syncthreads();
  const int qw = q_lat0 + w * 64;
  for (int t = 0; t < ntiles; ++t) {
    const int buf = t & 1;
    if (t + 1 < ntiles) gload(t + 1);
    bool act = (w * 64 < nq);
    int kk0 = 0;
    const bool band = WIN && t >= nctx;
    if (band) { kk0 = band_k0 + (t - nctx) * 64; act = act && (kk0 + 63 >= qw - 128) && (kk0 <= qw + 191); }
    if (act) {
      const bf16* sKb = sK + buf * 64 * LDK;
      const bf16* sVb = sV + buf * 64 * LDV;
#pragma unroll 1
      for (int ksub = 0; ksub < 2; ++ksub) {
        bf16x8 pb[2][2];
        {
          const bf16* kfp = sKb + (ksub * 32 + r) * LDK + h * 8;
#pragma unroll
          for (int qt = 0; qt < 2; ++qt) {
            f32x16 sc;
#pragma unroll
            for (int e = 0; e < 16; ++e) sc[e] = negM;
#pragma unroll
            for (int s = 0; s < KS; ++s) sc = mfma32(*(const bf16x8*)(kfp + s * 16), qf[qt][s], sc);
            float p[16];
#pragma unroll
            for (int e = 0; e < 16; ++e) p[e] = __builtin_amdgcn_exp2f(sc[e]);
            if (band) {
              const int qi = qw + qt * 32 + r;
#pragma unroll
              for (int e = 0; e < 16; ++e) {
                const int dd = qi - (kk0 + ksub * 32 + crow(e, h));
                if (dd > 128 || dd < -128) p[e] = 0.f;
              }
            }
            float ps = 0.f;
#pragma unroll
            for (int e = 0; e < 16; ++e) ps += p[e];
            lsum[qt] += ps;
            float p0[8], p1[8];
#pragma unroll
            for (int e = 0; e < 8; ++e) { p0[e] = p[e]; p1[e] = p[8 + e]; }
            pb[qt][0] = pack8(p0); pb[qt][1] = pack8(p1);
          }
        }
#pragma unroll
        for (int dt = 0; dt < 2; ++dt)
#pragma unroll
          for (int st = 0; st < 2; ++st) {
            const bf16x8 vf = *(const bf16x8*)(sVb + (dt * 32 + r) * LDV + ksub * 32 + st * 16 + h * 8);
            O[0][dt] = mfma32(vf, pb[0][st], O[0][dt]);
            O[1][dt] = mfma32(vf, pb[1][st], O[1][dt]);
          }
      }
    }
    if (t + 1 < ntiles) swrite(buf ^ 1);
    __syncthreads();
  }
#pragma unroll
  for (int qt = 0; qt < 2; ++qt) {
    const float l = xor32(lsum[qt]) + sinkterm;
    const float inv = 1.f / l;
    const int qi = w * 64 + qt * 32 + r;
    if (qi < nq) {
      bf16* dst = outp + (size_t)qi * 1024;
#pragma unroll
      for (int dt = 0; dt < 2; ++dt)
#pragma unroll
        for (int g = 0; g < 4; ++g)
          *(u32x2*)(dst + dt * 32 + 8 * g + 4 * h) = pack4(O[qt][dt][4 * g] * inv, O[qt][dt][4 * g + 1] * inv, O[qt][dt][4 * g + 2] * inv, O[qt][dt][4 * g + 3] * inv);
    }
  }
}

constexpr int LCH = 80, LGR = 9;
DI void lru_apply(float (&h)[4], const float* base, int col, bool valid) {
#pragma unroll
  for (int n = 0; n < 4; ++n) {
    const f32x2 cm = *(const f32x2*)(base + (16 * n + col) * 2);
    h[n] = valid ? cm[0] * h[n] + cm[1] : h[n];
  }
}
DI void lru_chunk(const Params& P, const float* sGateBase, const float* sTaps, bf16* hfw, int bi, int j, int c, int pass, float* sComp) {
  const int lane = tidx() & 63, col = lane & 15, g = lane >> 4;
  const bool isctx = c < 16;
  const int L = isctx ? LC : SEQ;
  const int sp0 = isctx ? c * 16 : (c - 16) * 128;
  const int tokbase = isctx ? (NL + bi * LC + sp0) : (bi * SEQ + sp0);
  const int nsteps = isctx ? 1 : 8;
  const bf16* C1 = P.cbuf;
  bf16* XCV = P.h;
  if (pass == 0) {
    for (int st = 0; st < nsteps; ++st) {
      const int t = st * 16 + col;
      u32x4 raw[2][4];
#pragma unroll
      for (int s = 0; s < 2; ++s)
#pragma unroll
        for (int k = 0; k < 4; ++k) {
          const int tt = sp0 + t + k - 2;
          const bool ok = tt >= 0 && tt < L;
          const int row = ok ? (tokbase + t + k - 2) : tokbase + t;
          raw[s][k] = *(const u32x4*)(C1 + (size_t)row * C1LD + 672 + 64 * j + 32 * s + 8 * g);
        }
#pragma unroll
      for (int s = 0; s < 2; ++s) {
        const int c0 = 64 * j + 32 * s + 8 * g;
        float a8[8];
        {
          const f32x4 b0 = *(const f32x4*)(sTaps + 2048 + c0), b1 = *(const f32x4*)(sTaps + 2048 + c0 + 4);
          for (int i = 0; i < 4; ++i) { a8[i] = b0[i]; a8[4 + i] = b1[i]; }
        }
#pragma unroll
        for (int k = 0; k < 4; ++k) {
          const int tt = sp0 + t + k - 2;
          const float m = (tt >= 0 && tt < L) ? 1.f : 0.f;
          float x8[8];
          unpack8(raw[s][k], x8);
          const f32x4 w0 = *(const f32x4*)(sTaps + k * 512 + c0), w1 = *(const f32x4*)(sTaps + k * 512 + c0 + 4);
          for (int i = 0; i < 4; ++i) { a8[i] += m * w0[i] * x8[i]; a8[4 + i] += m * w1[i] * x8[4 + i]; }
        }
        *(bf16x8*)(XCV + (size_t)(tokbase + t) * 512 + c0) = pack8(a8);
      }
    }
  }
#pragma unroll 1
  for (int dir = 0; dir < 2; ++dir) {
    bf16x8 wb[8][2];
#pragma unroll
    for (int n = 0; n < 8; ++n)
#pragma unroll
      for (int s = 0; s < 2; ++s)
        wb[n][s] = *(const bf16x8*)(P.wlrut + ((size_t)(((dir * 2 + (n >> 2)) * 8 + j) * 64 + 16 * (n & 3) + col)) * 64 + 32 * s + 8 * g);
    bf16x8 idf[2];
#pragma unroll
    for (int n = 0; n < 2; ++n)
#pragma unroll
      for (int jj = 0; jj < 8; ++jj) idf[n][jj] = ((8 * g + jj) == 16 * n + col) ? (short)0x3F80 : (short)0;
    float hst[4], arun[4];
#pragma unroll
    for (int n = 0; n < 4; ++n) { hst[n] = 0.f; arun[n] = 1.f; }
    const float* sGate = sGateBase + dir * 1536 + 64 * j + col;
    if (pass == 1) {
      const float* cbase = P.comp + ((size_t)(bi * 2 + dir) * LCH) * 1024 + 128 * j;
      const float* gbase = P.gcomp + ((size_t)(bi * 2 + dir) * LGR) * 1024 + 128 * j;
      if (isctx) {
#pragma unroll
        for (int i = 0; i < 15; ++i) {
          const int cc = dir == 0 ? i : 15 - i;
          const bool valid = dir == 0 ? (i < c) : (15 - i > c);
          lru_apply(hst, cbase + (size_t)(valid ? cc : 0) * 1024, col, valid);
        }
      } else {
        const int q = (c - 16) >> 3;
        lru_apply(hst, gbase, col, true);
#pragma unroll
        for (int i = 0; i < 7; ++i) {
          const int qq = dir == 0 ? i : 7 - i;
          const bool valid = dir == 0 ? (i < q) : (7 - i > q);
          lru_apply(hst, gbase + (size_t)(1 + (valid ? qq : 0)) * 1024, col, valid);
        }
#pragma unroll
        for (int i = 0; i < 7; ++i) {
          const int cc = dir == 0 ? 16 + 8 * q + i : 16 + 8 * q + 7 - i;
          const bool valid = dir == 0 ? (cc < c) : (cc > c);
          lru_apply(hst, cbase + (size_t)(valid ? cc : 16) * 1024, col, valid);
        }
      }
    }
    bf16x8 afc[2];
    auto issue = [&](int st, bf16x8 (&af)[2]) {
      const int t = st * 16 + col;
#pragma unroll
      for (int s = 0; s < 2; ++s) af[s] = *(const bf16x8*)(XCV + (size_t)(tokbase + t) * 512 + 64 * j + 32 * s + 8 * g);
    };
    issue(dir ? nsteps - 1 : 0, afc);
    for (int step = 0; step < nsteps; ++step) {
      const int st = dir ? nsteps - 1 - step : step;
      const int t0 = st * 16;
      bf16x8 af[2];
      af[0] = afc[0]; af[1] = afc[1];
      if (step + 1 < nsteps) issue(dir ? st - 1 : st + 1, afc);
      f32x4 ag[8], xcC[4];
      const f32x4 z4 = {0.f, 0.f, 0.f, 0.f};
#pragma unroll
      for (int n = 0; n < 8; ++n) { ag[n] = mfma16(af[0], wb[n][0], z4); ag[n] = mfma16(af[1], wb[n][1], ag[n]); }
#pragma unroll
      for (int n = 0; n < 4; ++n) xcC[n] = mfma16(af[n >> 1], idf[n & 1], z4);
#pragma unroll
      for (int n = 0; n < 4; ++n) {
        float av[4], bv[4];
#pragma unroll
        for (int e = 0; e < 4; ++e) {
          const float rg = sigmoidf_(ag[n][e] + sGate[16 * n]);
          const float ig = sigmoidf_(ag[4 + n][e] + sGate[512 + 16 * n]);
          const float a = __expf(-sGate[1024 + 16 * n] * rg);
          av[e] = a;
          bv[e] = sqrtf(fmaxf(fmaf(-a, a, 1.f), 0.f)) * ig * xcC[n][e];
        }
        float A = 1.f, H = 0.f;
        if (dir == 0) { for (int e = 0; e < 4; ++e) { H = av[e] * H + bv[e]; A *= av[e]; } }
        else { for (int e = 3; e >= 0; --e) { H = av[e] * H + bv[e]; A *= av[e]; } }
        float A1, H1, Aex, Hex, At, Ht;
        if (dir == 0) {
          A1 = __shfl_up(A, 16); H1 = __shfl_up(H, 16);
          if (g >= 1) { H = A * H1 + H; A = A * A1; }
          A1 = __shfl_up(A, 32); H1 = __shfl_up(H, 32);
          if (g >= 2) { H = A * H1 + H; A = A * A1; }
          Aex = __shfl_up(A, 16); Hex = __shfl_up(H, 16);
          if (g == 0) { Aex = 1.f; Hex = 0.f; }
          At = __shfl(A, col + 48); Ht = __shfl(H, col + 48);
        } else {
          A1 = __shfl_down(A, 16); H1 = __shfl_down(H, 16);
          if (g <= 2) { H = A * H1 + H; A = A * A1; }
          A1 = __shfl_down(A, 32); H1 = __shfl_down(H, 32);
          if (g <= 1) { H = A * H1 + H; A = A * A1; }
          Aex = __shfl_down(A, 16); Hex = __shfl_down(H, 16);
          if (g == 3) { Aex = 1.f; Hex = 0.f; }
          At = __shfl(A, col); Ht = __shfl(H, col);
        }
        if (pass == 0) {
          hst[n] = At * hst[n] + Ht; arun[n] = At * arun[n];
        } else {
          float hc = Aex * hst[n] + Hex;
          hst[n] = At * hst[n] + Ht;
          float o[4];
          if (dir == 0) { for (int e = 0; e < 4; ++e) { hc = av[e] * hc + bv[e]; o[e] = hc; } }
          else { for (int e = 3; e >= 0; --e) { hc = av[e] * hc + bv[e]; o[e] = hc; } }
#pragma unroll
          for (int e = 0; e < 4; ++e) {
            bf16* yp = hfw + (t0 + 4 * g + e) * 64 + 16 * n + col;
            if (dir == 0) *yp = f2bf(o[e]); else *yp = f2bf(bf2f(*yp) + o[e]);
          }
        }
      }
    }
    if (pass == 0 && g == 0) {
#pragma unroll
      for (int n = 0; n < 4; ++n) {
        f32x2 cm = {arun[n], hst[n]};
        *(f32x2*)(P.comp + ((size_t)((bi * 2 + dir) * LCH + c) * 512 + 64 * j + 16 * n + col) * 2) = cm;
        *(f32x2*)(sComp + (dir * 64 + 16 * n + col) * 2) = cm;
      }
    }
  }
  if (pass == 1) {
    const int ntok = nsteps * 16;
    for (int i0 = 0; i0 < ntok * 8; i0 += 64 * 4) {
      u32x4 gr[4];
#pragma unroll
      for (int u = 0; u < 4; ++u) {
        const int id = i0 + u * 64 + lane;
        const int tk = id >> 3, cc = id & 7;
        gr[u] = u32x4{0, 0, 0, 0};
        if (tk < ntok) gr[u] = *(const u32x4*)(C1 + (size_t)(tokbase + tk) * C1LD + 1184 + 64 * j + cc * 8);
      }
#pragma unroll
      for (int u = 0; u < 4; ++u) {
        const int id = i0 + u * 64 + lane;
        const int tk = id >> 3, cc = id & 7;
        if (tk < ntok) {
          float hv[8], gv[8];
          unpack8(*(const u32x4*)(hfw + tk * 64 + cc * 8), hv);
          unpack8(gr[u], gv);
#pragma unroll
          for (int e = 0; e < 8; ++e) hv[e] *= geluf_(gv[e]);
          *(bf16x8*)(P.ycat + (size_t)(tokbase + tk) * 1024 + 512 + 64 * j + cc * 8) = pack8(hv);
        }
      }
    }
  }
}

DI void lru_block_item(const Params& P, float* fsm, int bi, int j, int grp, int pass) {
  const int tid = tidx(), wid = tid >> 6;
  const float* sGate = fsm;
  const float* sTaps = fsm + 3072;
  float* sComp = fsm + 5632;
  bf16* hfw = (bf16*)(fsm + 3072) + wid * 8192;
  if (grp == 0) {
    lru_chunk(P, sGate, sTaps, hfw, bi, j, 2 * wid, pass, sComp + (2 * wid) * 256);
    lru_chunk(P, sGate, sTaps, hfw, bi, j, 2 * wid + 1, pass, sComp + (2 * wid + 1) * 256);
  } else {
    lru_chunk(P, sGate, sTaps, hfw, bi, j, 16 + 8 * (grp - 1) + wid, pass, sComp + wid * 256);
  }
  if (pass == 0) {
    __syncthreads();
    if (tid < 128) {
      const int dir = tid >> 6, ch = tid & 63;
      const int n = grp == 0 ? 16 : 8;
      float A = 1.f, H = 0.f;
      for (int i = 0; i < n; ++i) {
        const int cc = dir == 0 ? i : n - 1 - i;
        const float a = sComp[cc * 256 + (dir * 64 + ch) * 2], hh = sComp[cc * 256 + (dir * 64 + ch) * 2 + 1];
        H = a * H + hh; A = a * A;
      }
      f32x2 cm = {A, H};
      *(f32x2*)(P.gcomp + ((size_t)((bi * 2 + dir) * LGR + grp) * 512 + 64 * j + ch) * 2) = cm;
    }
    __syncthreads();
  }
}
DI void chunk_geom(int bi, int ck, int& L, int& sp0, int& tokbase, int& pos0) {
  const bool isctx = ck < 2;
  L = isctx ? LC : SEQ;
  sp0 = isctx ? ck * 128 : (ck - 2) * 128;
  tokbase = isctx ? (NL + bi * LC + sp0) : (bi * SEQ + sp0);
  pos0 = isctx ? sp0 : LC + sp0;
}

DI void ssd_conv_item(const Params& P, bf16* smem, int gc, int cr) {
  const int bi = gc / NCH, ck = gc % NCH;
  int L, sp0, tokbase, pos0; chunk_geom(bi, ck, L, sp0, tokbase, pos0);
  const int tid = tidx();
  constexpr int LDT = 257;
  {
    const int cc = tid & 31, tg = tid >> 5;
    const int c0 = cr * 256 + cc * 8;
    f32x4 wv[4][2], bv[2];
#pragma unroll
    for (int k = 0; k < 4; ++k) { wv[k][0] = *(const f32x4*)(P.ssd_conv_w + k * 1024 + c0); wv[k][1] = *(const f32x4*)(P.ssd_conv_w + k * 1024 + c0 + 4); }
    bv[0] = *(const f32x4*)(P.ssd_conv_b + c0); bv[1] = *(const f32x4*)(P.ssd_conv_b + c0 + 4);
    u32x4 raw[11];
#pragma unroll
    for (int i = 0; i < 11; ++i) {
      const int t = tg * 8 + i - 2, tt = sp0 + t;
      const bool ok = tt >= 0 && tt < L;
      raw[i] = u32x4{0, 0, 0, 0};
      if (ok) raw[i] = *(const u32x4*)(P.cbuf + (size_t)(tokbase + t) * C2LD + 1280 + c0);
    }
#pragma unroll
    for (int i = 0; i < 8; ++i) {
      float a8[8];
#pragma unroll
      for (int e = 0; e < 4; ++e) { a8[e] = bv[0][e]; a8[4 + e] = bv[1][e]; }
#pragma unroll
      for (int k = 0; k < 4; ++k) {
        float x8[8];
        unpack8(raw[i + k], x8);
#pragma unroll
        for (int e = 0; e < 4; ++e) { a8[e] += wv[k][0][e] * x8[e]; a8[4 + e] += wv[k][1][e] * x8[4 + e]; }
      }
#pragma unroll
      for (int e = 0; e < 8; ++e) a8[e] = siluf_(a8[e]);
      const bf16x8 o = pack8(a8);
      const int t = tg * 8 + i;
      *(bf16x8*)(P.h + (size_t)(tokbase + t) * 1024 + c0) = o;
#pragma unroll
      for (int e = 0; e < 8; ++e) smem[t * LDT + cc * 8 + e] = (bf16)o[e];
    }
  }
  __syncthreads();
  {
    const int o = tid & 15, cb = tid >> 4;
#pragma unroll
    for (int i = 0; i < 8; ++i) {
      const int c = cb + 32 * i;
      float v8[8];
#pragma unroll
      for (int e = 0; e < 8; ++e) {
        const int pp = 8 * o + e;
        const int t = (pp & ~15) | swap23(pp & 15);
        v8[e] = bf2f(smem[t * LDT + c]);
      }
      *(bf16x8*)(P.ut + ((size_t)(bi * 1024 + cr * 256 + c)) * NPOS + pos0 + 8 * o) = pack8(v8);
    }
  }
  __syncthreads();
}

DI void ssd_cumsum_item(const Params& P, int gc) {
  const int bi = gc / NCH, ck = gc % NCH;
  int L, sp0, tokbase, pos0; chunk_geom(bi, ck, L, sp0, tokbase, pos0);
  const int lane = tidx() & 63;
  f32x4 raw[2][4];
#pragma unroll
  for (int u = 0; u < 2; ++u)
#pragma unroll
    for (int q = 0; q < 4; ++q) raw[u][q] = *(const f32x4*)(P.dtr + (size_t)(tokbase + 64 * u + lane) * 16 + 4 * q);
  const int perm = (lane & ~15) | swap23(lane & 15);
#pragma unroll
  for (int idx = 0; idx < 16; ++idx) {
    const float A = -__expf(P.ssd_a_log[idx]);
    const float bias = P.ssd_dt_bias[idx];
    const float dt0 = softplusf_(raw[0][idx >> 2][idx & 3] + bias), dt1 = softplusf_(raw[1][idx >> 2][idx & 3] + bias);
    const float a0 = dt0 * A, a1 = dt1 * A;
    float c0 = a0, c1 = a1;
#pragma unroll
    for (int d = 1; d < 64; d <<= 1) {
      const float v0 = __shfl_up(c0, d), v1 = __shfl_up(c1, d);
      if (lane >= d) { c0 += v0; c1 += v1; }
    }
    c1 += __shfl(c0, 63);
    const float total = __shfl(c1, 63);
    const size_t rowb = (size_t)(bi * 16 + idx) * NPOS + pos0;
    P.dtt[rowb + lane] = dt0; P.dtt[rowb + 64 + lane] = dt1;
    P.cst[rowb + lane] = c0; P.cst[rowb + 64 + lane] = c1;
    const float w0 = idx < 8 ? dt0 * __expf(total - c0) : dt0 * __expf(c0 - a0);
    const float w1 = idx < 8 ? dt1 * __expf(total - c1) : dt1 * __expf(c1 - a1);
    P.wgp[rowb + perm] = w0; P.wgp[rowb + 64 + perm] = w1;
  }
}

DI void ssd_passA_item(const Params& P, int gc, int hd, int dir, int pt) {
  const int bi = gc / NCH, ck = gc % NCH;
  int L, sp0, tokbase, pos0; chunk_geom(bi, ck, L, sp0, tokbase, pos0);
  const int lane = tidx() & 63, r = lane & 31, h = lane >> 5;
  const int idx = dir * 8 + hd, grp = hd >> 2;
  const bf16* xrow = P.ut + ((size_t)(bi * 1024 + hd * 64 + 32 * pt + r)) * NPOS + pos0 + 8 * h;
  const float* wrow = P.wgp + (size_t)(bi * 16 + idx) * NPOS + pos0 + 8 * h;
  const bf16* brow = P.ut + ((size_t)(bi * 1024 + 512 + grp * 128 + r)) * NPOS + pos0 + 8 * h;
  bf16x8 xs[8];
  {
    u32x4 xr[8]; f32x4 w0[8], w1[8];
#pragma unroll
    for (int ks = 0; ks < 8; ++ks) { xr[ks] = *(const u32x4*)(xrow + 16 * ks); w0[ks] = *(const f32x4*)(wrow + 16 * ks); w1[ks] = *(const f32x4*)(wrow + 16 * ks + 4); }
#pragma unroll
    for (int ks = 0; ks < 8; ++ks) {
      float x8[8];
      unpack8(xr[ks], x8);
#pragma unroll
      for (int e = 0; e < 4; ++e) { x8[e] *= w0[ks][e]; x8[4 + e] *= w1[ks][e]; }
      xs[ks] = pack8(x8);
    }
  }
  f32x16 acc[4];
#pragma unroll
  for (int nt = 0; nt < 4; ++nt)
#pragma unroll
    for (int e = 0; e < 16; ++e) acc[nt][e] = 0.f;
#pragma unroll
  for (int ks = 0; ks < 8; ++ks)
#pragma unroll
    for (int nt = 0; nt < 4; ++nt) acc[nt] = mfma32(*(const bf16x8*)(brow + (size_t)(32 * nt) * NPOS + 16 * ks), xs[ks], acc[nt]);
  bf16* dst = P.qkv + ST_OFF + ((size_t)(((bi * 2 + dir) * 8 + hd) * NCH + ck)) * 8192 + (32 * pt + r) * 128 + 4 * h;
#pragma unroll
  for (int nt = 0; nt < 4; ++nt)
#pragma unroll
    for (int g = 0; g < 4; ++g) *(u32x2*)(dst + 32 * nt + 8 * g) = pack4(acc[nt][4 * g], acc[nt][4 * g + 1], acc[nt][4 * g + 2], acc[nt][4 * g + 3]);
}

DI void ssd_passB(const Params& P, int bid, int nblk) {
  const int nthr = nblk * 512;
  for (int id = bid * 512 + tidx(); id < NB * 2 * 8 * 2048; id += nthr) {
    const int e4 = id & 2047, hd = (id >> 11) & 7, dir = (id >> 14) & 1, bi = id >> 15;
    bf16* base = P.qkv + ST_OFF + ((size_t)((bi * 2 + dir) * 8 + hd)) * NCH * 8192 + e4 * 4;
    const float* crow_ = P.cst + (size_t)(bi * 16 + dir * 8 + hd) * NPOS;
    float S0 = 0.f, S1 = 0.f, S2 = 0.f, S3 = 0.f;
    for (int i0 = 0; i0 < NCH; i0 += 6) {
      u32x2 raw[6]; float dec[6]; int cks[6];
#pragma unroll
      for (int u = 0; u < 6; ++u) {
        const int i = i0 + u;
        const int ck = dir == 0 ? i : (i == 0 ? 1 : (i == 1 ? 0 : 67 - i));
        cks[u] = ck;
        raw[u] = *(const u32x2*)(base + (size_t)ck * 8192);
        dec[u] = __expf(crow_[ck * 128 + 127]);
      }
#pragma unroll
      for (int u = 0; u < 6; ++u) {
        *(u32x2*)(base + (size_t)cks[u] * 8192) = pack4(S0, S1, S2, S3);
        S0 = dec[u] * S0 + lo16(raw[u][0]); S1 = dec[u] * S1 + hi16(raw[u][0]);
        S2 = dec[u] * S2 + lo16(raw[u][1]); S3 = dec[u] * S3 + hi16(raw[u][1]);
      }
    }
  }
}

DI void ssd_passC_item(const Params& P, bf16* smem, int bi, int ck, int grp) {
  int L, sp0, tokbase, pos0; chunk_geom(bi, ck, L, sp0, tokbase, pos0);
  const int tid = tidx(), lane = tid & 63, wid = tid >> 6, r = lane & 31, h = lane >> 5;
  constexpr int LDB = 136;
  bf16* sB = smem;
  bf16* sC = smem + 128 * LDB;
  bf16* sX = smem + 256 * LDB;
  float* sCS = (float*)(smem + 512 * LDB);
  float* sDT = sCS + 1024;
  const bf16* U = P.h;
  {
    u32x4 tb[4], tc[4], tx[8];
#pragma unroll
    for (int i = 0; i < 4; ++i) {
      const int id = tid + 512 * i, row = id >> 4, c = id & 15;
      tb[i] = *(const u32x4*)(U + (size_t)(tokbase + row) * 1024 + 512 + grp * 128 + c * 8);
      tc[i] = *(const u32x4*)(U + (size_t)(tokbase + row) * 1024 + 768 + grp * 128 + c * 8);
    }
#pragma unroll
    for (int i = 0; i < 8; ++i) {
      const int id = tid + 512 * i, row = id >> 4, c = id & 15;
      tx[i] = *(const u32x4*)(P.ut + ((size_t)(bi * 1024 + grp * 256 + row)) * NPOS + pos0 + c * 8);
    }
    float cv[2], dv[2];
#pragma unroll
    for (int i = 0; i < 2; ++i) {
      const int id = tid + 512 * i, dir = id >> 9, hl = (id >> 7) & 3, t = id & 127;
      const size_t o = (size_t)(bi * 16 + dir * 8 + grp * 4 + hl) * NPOS + pos0 + t;
      cv[i] = P.cst[o]; dv[i] = P.dtt[o];
    }
#pragma unroll
    for (int i = 0; i < 4; ++i) {
      const int id = tid + 512 * i, row = id >> 4, c = id & 15;
      *(u32x4*)(sB + row * LDB + c * 8) = tb[i];
      *(u32x4*)(sC + row * LDB + c * 8) = tc[i];
    }
#pragma unroll
    for (int i = 0; i < 8; ++i) {
      const int id = tid + 512 * i, row = id >> 4, c = id & 15;
      *(u32x4*)(sX + row * LDB + c * 8) = tx[i];
    }
#pragma unroll
    for (int i = 0; i < 2; ++i) { sCS[tid + 512 * i] = cv[i]; sDT[tid + 512 * i] = dv[i]; }
  }
  __syncthreads();
  const int hl = wid >> 1, hd = grp * 4 + hl;
  const float Ah0 = -__expf(P.ssd_a_log[hd]), Ah1 = -__expf(P.ssd_a_log[8 + hd]);
  const float dsk = P.ssd_d[hd] + P.ssd_d[8 + hd];
  const float* csF = sCS + hl * 128;
  const float* csR = sCS + 512 + hl * 128;
  const float* dtF = sDT + hl * 128;
  const float* dtR = sDT + 512 + hl * 128;
#pragma unroll 1
  for (int lq = 0; lq < 2; ++lq) {
    const int lt = 2 * (wid & 1) + lq;
    const int l = lt * 32 + r;
    const size_t tok = tokbase + l;
    bf16x8 cfr[8];
#pragma unroll
    for (int ks = 0; ks < 8; ++ks) cfr[ks] = *(const bf16x8*)(sC + l * LDB + 16 * ks + 8 * h);
    f32x16 acc[2];
#pragma unroll
    for (int pt = 0; pt < 2; ++pt)
#pragma unroll
      for (int e = 0; e < 16; ++e) acc[pt][e] = 0.f;
    const float cslF = csF[l], cslR = csR[l];
    const float exlR = cslR - dtR[l] * Ah1;
#pragma unroll
    for (int dir = 0; dir < 2; ++dir) {
      const float fac = dir == 0 ? __expf(cslF) : __expf(csR[127] - exlR);
#pragma unroll
      for (int pt = 0; pt < 2; ++pt) {
        f32x16 yo;
#pragma unroll
        for (int e = 0; e < 16; ++e) yo[e] = 0.f;
        const bf16* srow = P.qkv + ST_OFF + ((size_t)(((bi * 2 + dir) * 8 + hd) * NCH + ck)) * 8192 + (32 * pt + r) * 128 + 8 * h;
#pragma unroll
        for (int ks = 0; ks < 8; ++ks) yo = mfma32(*(const bf16x8*)(srow + 16 * ks), cfr[ks], yo);
#pragma unroll
        for (int e = 0; e < 16; ++e) acc[pt][e] += fac * yo[e];
      }
    }
#pragma unroll 1
    for (int st = 0; st < 4; ++st) {
      f32x16 G;
#pragma unroll
      for (int e = 0; e < 16; ++e) G[e] = 0.f;
#pragma unroll
      for (int ks = 0; ks < 8; ++ks) G = mfma32(*(const bf16x8*)(sB + (st * 32 + r) * LDB + 16 * ks + 8 * h), cfr[ks], G);
      const bf16* x0p = sX + (hl * 64 + r) * LDB + st * 32 + 8 * h;
      const bf16x8 x00 = *(const bf16x8*)(x0p), x01 = *(const bf16x8*)(x0p + 16);
      const bf16x8 x10 = *(const bf16x8*)(x0p + 32 * LDB), x11 = *(const bf16x8*)(x0p + 32 * LDB + 16);
      if (st <= lt) {
        float m[16];
#pragma unroll
        for (int g = 0; g < 4; ++g) {
          const int sb = st * 32 + 8 * g + 4 * h;
          const f32x4 cs4 = *(const f32x4*)(csF + sb), dt4 = *(const f32x4*)(dtF + sb);
#pragma unroll
          for (int e = 0; e < 4; ++e) m[4 * g + e] = (sb + e <= l) ? G[4 * g + e] * __expf(cslF - cs4[e]) * dt4[e] : 0.f;
        }
        float t0[8], t1[8];
#pragma unroll
        for (int e = 0; e < 8; ++e) { t0[e] = m[e]; t1[e] = m[8 + e]; }
        const bf16x8 p0 = pack8(t0), p1 = pack8(t1);
        acc[0] = mfma32(x00, p0, acc[0]); acc[0] = mfma32(x01, p1, acc[0]);
        acc[1] = mfma32(x10, p0, acc[1]); acc[1] = mfma32(x11, p1, acc[1]);
      }
      if (st >= lt) {
        float m[16];
#pragma unroll
        for (int g = 0; g < 4; ++g) {
          const int sb = st * 32 + 8 * g + 4 * h;
          const f32x4 cs4 = *(const f32x4*)(csR + sb), dt4 = *(const f32x4*)(dtR + sb);
#pragma unroll
          for (int e = 0; e < 4; ++e) m[4 * g + e] = (sb + e >= l) ? G[4 * g + e] * __expf((cs4[e] - dt4[e] * Ah1) - exlR) * dt4[e] : 0.f;
        }
        float t0[8], t1[8];
#pragma unroll
        for (int e = 0; e < 8; ++e) { t0[e] = m[e]; t1[e] = m[8 + e]; }
        const bf16x8 p0 = pack8(t0), p1 = pack8(t1);
        acc[0] = mfma32(x00, p0, acc[0]); acc[0] = mfma32(x01, p1, acc[0]);
        acc[1] = mfma32(x10, p0, acc[1]); acc[1] = mfma32(x11, p1, acc[1]);
      }
    }
    (void)Ah0;
    float ss = 0.f;
#pragma unroll
    for (int pt = 0; pt < 2; ++pt)
#pragma unroll
      for (int g = 0; g < 4; ++g) {
        const int p0 = 32 * pt + 8 * g + 4 * h;
        const u32x2 xr = *(const u32x2*)(U + tok * 1024 + hd * 64 + p0);
        const u32x2 zr = *(const u32x2*)(P.cbuf + tok * C2LD + 768 + hd * 64 + p0);
        const float xs[4] = {lo16(xr[0]), hi16(xr[0]), lo16(xr[1]), hi16(xr[1])};
        const float zz[4] = {lo16(zr[0]), hi16(zr[0]), lo16(zr[1]), hi16(zr[1])};
        float o[4];
#pragma unroll
        for (int e = 0; e < 4; ++e) { o[e] = (acc[pt][4 * g + e] + dsk * xs[e]) * siluf_(zz[e]); ss += o[e] * o[e]; }
        *(u32x2*)(P.ycat + tok * 1024 + 512 + hd * 64 + p0) = pack4(o[0], o[1], o[2], o[3]);
      }
    ss = xor32(ss);
    if (h == 0) P.ssq2[tok * 8 + hd] = ss;
  }
  __syncthreads();
}

DI void row_pass(const Params& P, int mode, int layer, int tok, const int* sOff) {
  const int lane = tidx() & 63;
  int bmod, b, pos; bool lat; tok_info(tok, bmod, b, pos, lat);
  const float* src = mode == 0 ? (lat ? P.x + (size_t)tok * 1024 : P.ctx + (size_t)(tok - NL) * 1024)
                               : (lat ? P.out + (size_t)tok * 1024 : P.xc + (size_t)(tok - NL) * 1024);
  f32x4 v[4];
#pragma unroll
  for (int i = 0; i < 4; ++i) v[i] = *(const f32x4*)(src + 4 * lane + 256 * i);
  if (mode == 1 || mode == 2) {
    const int* ti = P.tokinfo + (size_t)tok * 4;
    const int s0 = sOff[ti[0]] + ti[1], s1 = sOff[ti[2]] + ti[3];
    const float w0 = P.tokw[tok * 2], w1 = P.tokw[tok * 2 + 1];
    const float* m5 = P.mods + ((size_t)((mode - 1) * 5 + bmod) * 6 + 5) * 1024;
    float* dst = lat ? P.out + (size_t)tok * 1024 : P.xc + (size_t)(tok - NL) * 1024;
#pragma unroll
    for (int i = 0; i < 4; ++i) {
      const int k = 4 * lane + 256 * i;
      const u32x2 y0 = *(const u32x2*)(P.qkv + (size_t)s0 * 1024 + k), y1 = *(const u32x2*)(P.qkv + (size_t)s1 * 1024 + k);
      const f32x4 mv = *(const f32x4*)(m5 + k);
      v[i][0] += mv[0] * (w0 * lo16(y0[0]) + w1 * lo16(y1[0]));
      v[i][1] += mv[1] * (w0 * hi16(y0[0]) + w1 * hi16(y1[0]));
      v[i][2] += mv[2] * (w0 * lo16(y0[1]) + w1 * lo16(y1[1]));
      v[i][3] += mv[3] * (w0 * hi16(y0[1]) + w1 * hi16(y1[1]));
      *(f32x4*)(dst + k) = v[i];
    }
    if (mode == 2) return;
  }
  float ss = 0.f;
#pragma unroll
  for (int i = 0; i < 4; ++i) ss += v[i][0] * v[i][0] + v[i][1] * v[i][1] + v[i][2] * v[i][2] + v[i][3] * v[i][3];
  ss = wave_sum(ss);
  const float rstd = rsqrtf(ss * (1.f / 1024.f) + EPS);
  const bool n2 = mode == 3;
  const float* g1 = (n2 ? P.norm2_g : P.norm1_g) + layer * 1024;
  const float* sh = P.mods + ((size_t)(layer * 5 + bmod) * 6 + (n2 ? 3 : 0)) * 1024;
  const float* sc = P.mods + ((size_t)(layer * 5 + bmod) * 6 + (n2 ? 4 : 1)) * 1024;
#pragma unroll
  for (int i = 0; i < 4; ++i) {
    const int k = 4 * lane + 256 * i;
    const f32x4 gv = *(const f32x4*)(g1 + k), sv = *(const f32x4*)(sc + k), hv = *(const f32x4*)(sh + k);
    float o[4];
#pragma unroll
    for (int e = 0; e < 4; ++e) o[e] = v[i][e] * rstd * gv[e] * (1.f + sv[e]) + hv[e];
    const u32x2 hi = pack4(o[0], o[1], o[2], o[3]);
    *(u32x2*)(P.h + (size_t)tok * 1024 + k) = hi;
    if (n2) {
      const float r0 = o[0] - lo16(hi[0]), r1 = o[1] - hi16(hi[0]), r2 = o[2] - lo16(hi[1]), r3 = o[3] - hi16(hi[1]);
      *(u32x2*)(P.ycat + (size_t)tok * 1024 + k) = pack4(r0, r1, r2, r3);
    }
  }
}

DI void route_tokens(const Params& P, int layer, float* sW, int item, int tok_lo, int tok_hi) {
  const int tid = tidx(), lane = tid & 63, wid = tid >> 6;
  int* sCnt = (int*)sW;
  if (tid < 32) sCnt[tid * 36 + 32] = 0;
  __syncthreads();
  const float* g2 = P.norm2_g + layer * 1024;
  const float rb = P.router_b[lane >> 1];
  float gm[16], sh[16], xn[16];
  int cur_b = -1;
  auto xsrc = [&](int tok) { return tok < NL ? P.out + (size_t)tok * 1024 : P.xc + (size_t)(tok - NL) * 1024; };
  int t0 = tok_lo + wid;
  if (t0 < tok_hi) {
    const float* src = xsrc(t0);
#pragma unroll
    for (int i = 0; i < 16; ++i) xn[i] = src[lane + 64 * i];
  }
  for (; t0 < tok_hi; t0 += 8) {
    const int tok = t0;
    float v[16];
    float ss = 0.f;
#pragma unroll
    for (int i = 0; i < 16; ++i) { v[i] = xn[i]; ss += v[i] * v[i]; }
    if (t0 + 8 < tok_hi) {
      const float* src = xsrc(t0 + 8);
#pragma unroll
      for (int i = 0; i < 16; ++i) xn[i] = src[lane + 64 * i];
    }
    const int bmod = tok < NL ? (tok >> 13) : 4;
    if (bmod != cur_b) {
      cur_b = bmod;
      const float* shp = P.mods + ((size_t)(layer * 5 + bmod) * 6 + 3) * 1024;
      const float* scp = P.mods + ((size_t)(layer * 5 + bmod) * 6 + 4) * 1024;
#pragma unroll
      for (int i = 0; i < 16; ++i) { const int k = lane + 64 * i; gm[i] = g2[k] * (1.f + scp[k]); sh[i] = shp[k]; }
    }
    ss = wave_sum(ss);
    const float rstd = rsqrtf(ss * (1.f / 1024.f) + EPS);
#pragma unroll
    for (int i = 0; i < 16; ++i) {
      v[i] = v[i] * rstd * gm[i] + sh[i];
      P.h[(size_t)tok * 1024 + lane + 64 * i] = f2bf(v[i]);
    }
    float acc[32];
#pragma unroll
    for (int e = 0; e < 32; ++e) acc[e] = 0.f;
#pragma unroll
    for (int i = 0; i < 16; ++i) {
      const float* wr = sW + (lane + 64 * i) * 36;
#pragma unroll
      for (int c = 0; c < 8; ++c) {
        const f32x4 w4 = *(const f32x4*)(wr + 4 * c);
#pragma unroll
        for (int e = 0; e < 4; ++e) acc[4 * c + e] += v[i] * w4[e];
      }
      if ((i & 3) == 3) asm volatile("" ::: "memory");
    }
    float a16[16], a8[8], a4[4], a2[2], a1;
    {
      const bool up = (lane & 32) != 0;
#pragma unroll
      for (int i = 0; i < 16; ++i) { const float keep = up ? acc[16 + i] : acc[i], send = up ? acc[i] : acc[16 + i]; a16[i] = keep + __shfl_xor(send, 32); }
    }
    {
      const bool up = (lane & 16) != 0;
#pragma unroll
      for (int i = 0; i < 8; ++i) { const float keep = up ? a16[8 + i] : a16[i], send = up ? a16[i] : a16[8 + i]; a8[i] = keep + __shfl_xor(send, 16); }
    }
    {
      const bool up = (lane & 8) != 0;
#pragma unroll
      for (int i = 0; i < 4; ++i) { const float keep = up ? a8[4 + i] : a8[i], send = up ? a8[i] : a8[4 + i]; a4[i] = keep + __shfl_xor(send, 8); }
    }
    {
      const bool up = (lane & 4) != 0;
#pragma unroll
      for (int i = 0; i < 2; ++i) { const float keep = up ? a4[2 + i] : a4[i], send = up ? a4[i] : a4[2 + i]; a2[i] = keep + __shfl_xor(send, 4); }
    }
    {
      const bool up = (lane & 2) != 0;
      const float keep = up ? a2[1] : a2[0], send = up ? a2[0] : a2[1];
      a1 = keep + __shfl_xor(send, 2);
    }
    a1 += __shfl_xor(a1, 1);
    const float us = 1.f / (1.f + expf(-a1));
    const float xbs = us + rb;
    float bestg = -3.0e38f, bu0 = 0.f, bu1 = 0.f;
    int be0 = 0, be1 = 0;
#pragma unroll
    for (int q = 0; q < 4; ++q) {
      float m1 = -3.0e38f, m2 = -3.0e38f, u1 = 0.f, u2 = 0.f;
      int i1 = 0, i2 = 0;
#pragma unroll
      for (int m = 0; m < 8; ++m) {
        const float uu = __shfl(us, 2 * (8 * q + m)), xb = __shfl(xbs, 2 * (8 * q + m));
        if (xb > m1) { m2 = m1; i2 = i1; u2 = u1; m1 = xb; i1 = m; u1 = uu; }
        else if (xb > m2) { m2 = xb; i2 = m; u2 = uu; }
      }
      const float gs = m1 + m2;
      if (gs > bestg) { bestg = gs; be0 = 8 * q + i1; be1 = 8 * q + i2; bu0 = u1; bu1 = u2; }
    }
    if (lane == 0) {
      const int r0 = atomicAdd(&sCnt[be0 * 36 + 32], 1), r1 = atomicAdd(&sCnt[be1 * 36 + 32], 1);
      const float inv = 1.f / (bu0 + bu1);
      int* ti = P.tokinfo + (size_t)tok * 4;
      ti[0] = be0; ti[1] = r0; ti[2] = be1; ti[3] = r1;
      P.tokw[tok * 2] = bu0 * inv; P.tokw[tok * 2 + 1] = bu1 * inv;
    }
  }
  __syncthreads();
  if (tid < 32) P.cntt[item * 32 + tid] = sCnt[tid * 36 + 32];
  __syncthreads();
}
DI void conv_tile(float* sT, const float* src, int K, int N, bf16* dst, int dld, int rmode, const float* scale, int koff, int tk, int tn) {
  const int tid = tidx();
  const int k0 = tk * 64, n0 = tn * 256;
  {
    const int n4 = (tid & 63) * 4, kk = tid >> 6;
    f32x4 v[8];
#pragma unroll
    for (int p = 0; p < 8; ++p) {
      v[p] = f32x4{0.f, 0.f, 0.f, 0.f};
      if (n0 + n4 < N) v[p] = *(const f32x4*)(src + (size_t)(k0 + kk + 8 * p) * N + n0 + n4);
    }
#pragma unroll
    for (int p = 0; p < 8; ++p) {
      const int k = k0 + kk + 8 * p;
      float s = 1.f;
      if (scale != nullptr && k >= koff) s = scale[k - koff];
#pragma unroll
      for (int e = 0; e < 4; ++e) sT[(kk + 8 * p) * 257 + n4 + e] = v[p][e] * s;
    }
  }
  __syncthreads();
  {
    const int kc = (tid & 7) * 8;
#pragma unroll
    for (int q = 0; q < 4; ++q) {
      const int n = (tid >> 3) + 64 * q;
      if (n0 + n < N) {
        float v8[8];
#pragma unroll
        for (int e = 0; e < 8; ++e) v8[e] = sT[(kc + e) * 257 + n];
        const int nn = n0 + n;
        const int row = rmode == 0 ? nn : (64 * (nn >> 5) + (nn & 31) + (rmode == 2 ? 32 : 0));
        *(bf16x8*)(dst + (size_t)row * dld + k0 + kc) = pack8(v8);
      }
    }
  }
  __syncthreads();
}

DI void conv_moe_tile(const Params& P, float* sT, int layer, int t) {
  const int e = t / 96, u = t % 96;
  if (u < 32) conv_tile(sT, P.moe_w_gate + ((size_t)(layer * 32 + e)) * 1024 * 512, 1024, 512, P.wgut + (size_t)e * 1024 * 1024, 1024, 1, nullptr, 0, u >> 1, u & 1);
  else if (u < 64) conv_tile(sT, P.moe_w_up + ((size_t)(layer * 32 + e)) * 1024 * 512, 1024, 512, P.wgut + (size_t)e * 1024 * 1024, 1024, 2, nullptr, 0, (u - 32) >> 1, (u - 32) & 1);
  else conv_tile(sT, P.moe_w_down + ((size_t)(layer * 32 + e)) * 512 * 1024, 512, 1024, P.wdt + (size_t)e * 1024 * 512, 512, 0, nullptr, 0, (u - 64) >> 2, (u - 64) & 3);
}
constexpr int NCONV_MOE = 32 * 96;

constexpr int NCONV_DENSE = 112 + 18 + 16 + 64 + 160 + 64 + 32;
DI void conv_dense_tile(const Params& P, float* sT, int t) {
  if (t < 112) { conv_tile(sT, P.ab_w_in, 1024, 1696, P.win0t, 1024, 0, nullptr, 0, t / 7, t % 7); return; }
  t -= 112;
  if (t < 18) { conv_tile(sT, P.mla_w_q_up, 384, 768, P.wqt, 384, 0, P.mla_q_norm_g, 0, t / 3, t % 3); return; }
  t -= 18;
  if (t < 16) { conv_tile(sT, P.mla_w_kv_up, 256, 1024, P.wkvt, 256, 0, P.mla_kv_norm_g, 0, t / 4, t % 4); return; }
  t -= 16;
  if (t < 64) { conv_tile(sT, P.ab_w_out, 1024, 1024, P.wout0t, 1024, 0, nullptr, 0, t / 4, t % 4); return; }
  t -= 64;
  if (t < 160) { conv_tile(sT, P.cd_w_in, 1024, 2320, P.win1t, 1024, 0, nullptr, 0, t / 10, t % 10); return; }
  t -= 160;
  if (t < 64) { conv_tile(sT, P.cd_w_out, 1024, 1024, P.wout1t, 1024, 0, P.ssd_norm_g, 512, t / 4, t % 4); return; }
  t -= 64;
  {
    const int blk = t & 7, gate = (t >> 3) & 1, dir = t >> 4;
    const float* src = (gate ? P.lru_w_x : P.lru_w_a) + ((size_t)(dir * 8 + blk)) * 4096;
    conv_tile(sT, src, 64, 64, P.wlrut + ((size_t)((dir * 2 + gate) * 8 + blk)) * 4096, 64, 0, nullptr, 0, 0, 0);
  }
}

DI void mods_item(const Params& P, float* sS, float* sR, int layer, int cb) {
  const int tid = tidx(), col = tid & 63, kq = tid >> 6;
  float a[5] = {0.f, 0.f, 0.f, 0.f, 0.f};
  const float* wp = P.ada_w + (size_t)layer * 1024 * 6144 + cb * 64 + col;
  for (int k = kq * 128; k < kq * 128 + 128; ++k) {
    const float wv = wp[(size_t)k * 6144];
#pragma unroll
    for (int v = 0; v < 5; ++v) a[v] += sS[v * 1024 + k] * wv;
  }
#pragma unroll
  for (int v = 0; v < 5; ++v) sR[(kq * 5 + v) * 64 + col] = a[v];
  __syncthreads();
  if (tid < 320) {
    const int v = tid >> 6;
    float s = P.ada_b[layer * 6144 + cb * 64 + col];
    for (int q = 0; q < 8; ++q) s += sR[(q * 5 + v) * 64 + col];
    P.mods[((size_t)(layer * 5 + v)) * 6144 + cb * 64 + col] = s;
  }
  __syncthreads();
}

enum { PH_PREP, PH_NORM1_0, PH_C1, PH_QKV, PH_ATTN0, PH_OUT0, PH_NORM2_0, PH_SCAT0, PH_MOE1_0, PH_MOE2_0, PH_COMB0, PH_C2, PH_SSDPREP, PH_SSDA, PH_SSDB, PH_SSDC, PH_OUT1, PH_NORM2_1, PH_SCAT1, PH_MOE1_1, PH_MOE2_1, PH_FINAL, NPHASE };
constexpr int GEMM_LDS = (256 + 256) * 2 * 72 * 2;

DI void run_phase(const Params& P, int ph, unsigned char* lds, int bid, int nblk) {
  bf16* smem = (bf16*)lds;
  float* fsm = (float*)lds;
  int* ism = (int*)lds;
  const int tid = tidx(), wid = tid >> 6;
  const int gw = bid * 8 + wid, ngw = nblk * 8;
  const int nrep = 1 + ((P.pad0 >> ph) & 1);
#define REP for (int rep_ = 0; rep_ < nrep; ++rep_)
#define REPB(bit) for (int rep_ = 0, nr_ = 1 + ((P.pad0 >> (bit)) & 1); rep_ < nr_; ++rep_)
  switch (ph) {
    case PH_PREP: {
      if (bid == 0) {
        for (int i = tid; i < 128 * 8; i += 512) {
          const int p = i >> 3, f = i & 7;
          float rev = (float)p * __builtin_amdgcn_exp2f(-(float)f * (13.287712379549449f / 8.f)) * 0.15915494309189535f;
          rev -= floorf(rev);
          P.ropeM[i * 2] = __builtin_amdgcn_cosf(rev); P.ropeM[i * 2 + 1] = __builtin_amdgcn_sinf(rev);
        }
        for (int i = tid; i < 128 * 16; i += 512) {
          const int p = i >> 4, f = i & 15;
          float rev = (float)p * __builtin_amdgcn_exp2f(-(float)f * (13.287712379549449f / 16.f)) * 0.15915494309189535f;
          rev -= floorf(rev);
          P.ropeS[i * 2] = __builtin_amdgcn_cosf(rev); P.ropeS[i * 2 + 1] = __builtin_amdgcn_sinf(rev);
        }
        if (tid == 0) {
          float gq = 0.f, gk = 0.f, sq = 0.f, sk = 0.f, sm = 0.f;
          for (int i = 0; i < 96; ++i) { gq = fmaxf(gq, fabsf(P.mla_q_head_g[i])); gk = fmaxf(gk, fabsf(P.mla_k_head_g[i])); }
          for (int i = 0; i < 64; ++i) { sq = fmaxf(sq, fabsf(P.swa_q_head_g[i])); sk = fmaxf(sk, fabsf(P.swa_k_head_g[i])); }
          for (int i = 0; i < 8; ++i) sm = fmaxf(sm, P.swa_sink[i]);
          P.msh[0] = 9.797958971132712f * gq * gk * LOG2E;
          P.msh[1] = fmaxf(8.f * sq * sk, sm) * LOG2E;
        }
      }
      for (int i = tid; i < 5 * 1024; i += 512) {
        const float v = i < 4096 ? P.c[i] : P.c_ctx[i - 4096];
        fsm[i] = siluf_(v);
      }
      __syncthreads();
      REPB(30) for (int it = bid; it < 2 * 96; it += nblk) mods_item(P, fsm, fsm + 5120, it / 96, it % 96);
      __syncthreads();
      REP for (int it = bid; it < NCONV_DENSE + NCONV_MOE; it += nblk) {
        if (it < NCONV_DENSE) conv_dense_tile(P, fsm, it); else conv_moe_tile(P, fsm, 0, it - NCONV_DENSE);
      }
    } break;
    case PH_NORM1_0: {
      REP for (int tok = gw; tok < NT; tok += ngw) row_pass(P, 0, 0, tok, nullptr);
    } break;
    case PH_C1: {
      REP for (int it = bid; it < 7 * 132; it += nblk) gemm_c1_item(P, smem, it % 7, it / 7);
    } break;
    case PH_QKV: {
      REP for (int it = bid; it < 264 * 8; it += nblk) {
        const int qt = it >> 3, u = it & 7;
        if (u < 4) gemm_q_item(P, smem, u, qt); else gemm_kv_item(P, smem, u - 4, qt);
      }
      __syncthreads();
      for (int i = tid; i < 2560; i += 512) fsm[3072 + i] = i < 2048 ? P.lru_conv_w[i] : P.lru_conv_b[i - 2048];
      for (int i = tid; i < 3072; i += 512) { const int d = i / 1536, u = i % 1536, k = u >> 9, ch = u & 511; fsm[i] = k == 0 ? P.lru_b_a[d * 512 + ch] : (k == 1 ? P.lru_b_x[d * 512 + ch] : 8.f * softplusf_(-P.lru_lambda[d * 512 + ch])); }
      __syncthreads();
      REPB(26) for (int it = bid; it < NB * 8 * LGR; it += nblk) { const int u = it < 256 ? it : it - 256; lru_block_item(P, fsm, it < 256 ? (u >> 6) : (u >> 3), it < 256 ? ((u >> 3) & 7) : (u & 7), it < 256 ? 1 + (u & 7) : 0, 0); }
    } break;
    case PH_ATTN0: {
      for (int i = tid; i < 2560; i += 512) fsm[3072 + i] = i < 2048 ? P.lru_conv_w[i] : P.lru_conv_b[i - 2048];
      for (int i = tid; i < 3072; i += 512) { const int d = i / 1536, u = i % 1536, k = u >> 9, ch = u & 511; fsm[i] = k == 0 ? P.lru_b_a[d * 512 + ch] : (k == 1 ? P.lru_b_x[d * 512 + ch] : 8.f * softplusf_(-P.lru_lambda[d * 512 + ch])); }
      __syncthreads();
      REPB(27) for (int it = bid; it < NB * 8 * LGR; it += nblk) { const int u = it < 256 ? it : it - 256; lru_block_item(P, fsm, it < 256 ? (u >> 6) : (u >> 3), it < 256 ? ((u >> 3) & 7) : (u & 7), it < 256 ? 1 + (u & 7) : 0, 1); }
      __syncthreads();
      const float negM = -P.msh[0];
      REP for (int it = bid; it < 32 + 512; it += nblk) {
        if (it < 32) {
          const int b = it >> 3, hd = it & 7;
          const size_t hb = (size_t)(b * 8 + hd) * NPOS;
          attn_item<96, false>(smem, P.qkv + QB_OFF + hb * 96, P.qkv + KB_OFF + hb * 96, P.qkv + VT_OFF + hb * 64, 0, 256, 4, 4, 0, 0, negM, 0.f,
                               P.ycat + (size_t)(NL + b * LC) * 1024 + hd * 64);
        } else {
          const int u = it - 32, qb = u & 15, hd = (u >> 4) & 7, b = u >> 7;
          const size_t hb = (size_t)(b * 8 + hd) * NPOS;
          attn_item<96, false>(smem, P.qkv + QB_OFF + hb * 96, P.qkv + KB_OFF + hb * 96, P.qkv + VT_OFF + hb * 64, LC + qb * 512, 512, 132, 132, 0, 0, negM, 0.f,
                               P.ycat + (size_t)(b * SEQ + qb * 512) * 1024 + hd * 64);
        }
      }
    } break;
    case PH_OUT0: {
      REP for (int it = bid; it < 512 + 32; it += nblk) { if (it < 512) gemm_out_item<4>(P, smem, 0, it & 3, it >> 2); else gemm_out_item<2>(P, smem, 0, (it - 512) & 7, 128 + ((it - 512) >> 3)); }
    } break;
    case PH_NORM2_0: case PH_NORM2_1: {
      const int layer = ph == PH_NORM2_0 ? 0 : 1;
      const int ntok = layer == 0 ? NT : NL;
      const int T = (ntok + nblk - 1) / nblk;
      __syncthreads();
      for (int i = tid; i < 32768; i += 512) fsm[(i >> 5) * 36 + (i & 31)] = P.router_w[i];
      __syncthreads();
      { const int lo_ = bid * T, hi_ = lo_ + T < ntok ? lo_ + T : ntok; route_tokens(P, layer, fsm, bid, lo_ < ntok ? lo_ : ntok, hi_ > lo_ ? hi_ : lo_); }
      if (layer == 1) {
        __syncthreads();
        for (int it = bid; it < NCONV_MOE; it += nblk) conv_moe_tile(P, fsm, 1, it);
      }
    } break;
    case PH_SCAT0: case PH_SCAT1: {
      const int layer = ph == PH_SCAT0 ? 0 : 1;
      const int ntok = layer == 0 ? NT : NL;
      const int T = (ntok + nblk - 1) / nblk;
      const int nit = nblk;
      __syncthreads();
      for (int i = tid; i < nit * 32; i += 512) ism[i] = P.cntt[i];
      __syncthreads();
      if (tid < 32) {
        int run = 0;
        for (int i = 0; i < nit; ++i) { const int c = ism[i * 32 + tid]; ism[i * 32 + tid] = run; run += c; }
        if (bid == 0) P.cnt[layer * 32 + tid] = run;
      }
      __syncthreads();
      {
        const int lo_ = bid * T, hi_ = lo_ + T < ntok ? lo_ + T : ntok;
        for (int tok = lo_ + tid; tok < hi_; tok += 512) {
          int* ti = P.tokinfo + (size_t)tok * 4;
          const int e0 = ti[0], e1 = ti[2];
          const int p0 = ism[bid * 32 + e0] + ti[1], p1 = ism[bid * 32 + e1] + ti[3];
          ti[1] = p0; ti[3] = p1;
          P.list[(size_t)e0 * NT + p0] = tok;
          P.list[(size_t)e1 * NT + p1] = tok;
        }
      }
    } break;
    case PH_MOE1_0: case PH_MOE2_0: case PH_MOE1_1: case PH_MOE2_1: {
      const int layer = ph >= PH_MOE1_1 ? 1 : 0;
      const bool second = (ph == PH_MOE2_0 || ph == PH_MOE2_1);
      __syncthreads();
      if (tid == 0) {
        int off = 0, toff = 0;
        for (int e = 0; e < 32; ++e) { const int c = P.cnt[layer * 32 + e]; ism[e] = c; ism[32 + e] = off; ism[65 + e] = toff; off += c; toff += (c + 255) >> 8; }
        ism[64] = off; ism[97] = toff;
      }
      __syncthreads();
      const int ntile = ism[97], total = ism[64];
      REP for (int it = bid; it < ntile * 4; it += nblk) {
        const int mtg = it >> 2, pt = it & 3;
        int e = 0;
        while (e < 31 && ism[65 + e + 1] <= mtg) ++e;
        const int m0 = (mtg - ism[65 + e]) * 256, cnt_e = ism[e], off_e = ism[32 + e];
        bf16* gsm = smem + 256;
        if (!second) moe1_item(P, gsm, layer, e, m0, pt, cnt_e, off_e); else moe2_item(P, gsm, e, m0, pt, cnt_e, off_e, total);
      }
    } break;
    case PH_COMB0: case PH_FINAL: {
      const int layer = ph == PH_COMB0 ? 0 : 1;
      __syncthreads();
      if (tid == 0) { int off = 0; for (int e = 0; e < 32; ++e) { ism[e] = off; off += P.cnt[layer * 32 + e]; } }
      __syncthreads();
      const int ntok = layer == 0 ? NT : NL;
      for (int tok = gw; tok < ntok; tok += ngw) row_pass(P, layer == 0 ? 1 : 2, 1, tok, ism);
    } break;
    case PH_C2: {
      REP for (int it = bid; it < 10 * 132; it += nblk) { if (it < 9 * 132) gemm_c2_item(P, smem, it % 9, it / 9); else gemm_c2dt_item(P, smem, it - 9 * 132); }
    } break;
    case PH_SSDPREP: {
      REPB(28) for (int it = gw; it < NB * NCH; it += ngw) ssd_cumsum_item(P, it);
      REPB(29) for (int it = bid; it < NB * NCH * 4; it += nblk) ssd_conv_item(P, smem, it >> 2, it & 3);
      __syncthreads();
      const float negM = -P.msh[1];
      REP for (int it = bid; it < 512; it += nblk) {
        const int qb = it & 15, hq = (it >> 4) & 7, b = it >> 7;
        const size_t hb = (size_t)(b * 8 + hq) * NPOS, kb = (size_t)(b * 2 + (hq >> 2)) * NPOS;
        const int k0 = qb * 512 - 128 < 0 ? 0 : qb * 512 - 128;
        const int k1 = qb * 512 + 640 > SEQ ? SEQ : qb * 512 + 640;
        const float sinkterm = __builtin_amdgcn_exp2f(P.swa_sink[hq] * LOG2E + negM);
        attn_item<64, true>(smem, P.qkv + Q2_OFF + hb * 64, P.qkv + K2_OFF + kb * 64, P.qkv + V2T_OFF + kb * 64, LC + qb * 512, 512, 4 + (k1 - k0) / 64, 4, k0, qb * 512,
                            negM, sinkterm, P.ycat + (size_t)(b * SEQ + qb * 512) * 1024 + hq * 64);
      }
    } break;
    case PH_SSDA: {
      REP for (int it = gw; it < NB * NCH * 8 * 2 * 2; it += ngw) {
        const int pt = it & 1, dir = (it >> 1) & 1, hd = (it >> 2) & 7, gc = it >> 5;
        ssd_passA_item(P, gc, hd, dir, pt);
      }
    } break;
    case PH_SSDB: ssd_passB(P, bid, nblk); break;
    case PH_SSDC: {
      REP for (int it = bid; it < NB * 64 * 2; it += nblk) ssd_passC_item(P, smem, it >> 7, 2 + ((it >> 1) & 63), it & 1);
    } break;
    case PH_OUT1: {
      for (int it = bid; it < 512; it += nblk) gemm_out_item<4>(P, smem, 1, it & 3, it >> 2);
    } break;
    default: break;
  }
}
#define XB_TMO      128
#define XB_XCNT(j)  (256  + 64 * (j))
#define XB_XSUB(j)  (1280 + 64 * (j))
#define XB_XGEN(j)  (2304 + 64 * (j))
#define XB_TOP      3328
#define XB_TOPGEN   3392
#define XCD_BAR_WORDS 3456
#define XB_SPIN_CAP (1u << 22)
#define LAS __attribute__((address_space(3)))
DI unsigned xb_ld(unsigned* p) { return __hip_atomic_load(p, __ATOMIC_RELAXED, __HIP_MEMORY_SCOPE_AGENT); }
DI unsigned xb_add(unsigned* p, unsigned v) { return __hip_atomic_fetch_add(p, v, __ATOMIC_RELAXED, __HIP_MEMORY_SCOPE_AGENT); }
DI unsigned xb_xcc_id() { return (unsigned)__builtin_amdgcn_s_getreg((3 << 11) | 20) & 0xFu; }
#define XB_SPIN(cond, bar) do { unsigned _sp = 0; while (cond) { __builtin_amdgcn_s_sleep(1); \
    if ((++_sp & 255u) == 0u) { if (xb_ld(&(bar)[XB_TMO])) break; if (_sp > XB_SPIN_CAP) { atomicAdd(&(bar)[XB_TMO], 1u); break; } } } } while (0)
struct XcdBarrier { unsigned* bar; unsigned x; volatile LAS unsigned* st; };
DI XcdBarrier xcd_barrier_post(unsigned* bar, volatile LAS unsigned* st) {
  XcdBarrier b; b.bar = bar; b.x = xb_xcc_id(); b.st = st;
  if (tidx() == 0) (void)xb_add(&bar[XB_XCNT(b.x)], 1u);
  return b;
}
DI void xcd_barrier_complete(unsigned* bar, unsigned x, unsigned& nloc, unsigned& nx) {
  const unsigned G = gridDim.x * gridDim.y * gridDim.z;
  unsigned sum, cnt, mine, sp = 0u;
  for (;;) {
    sum = 0u; cnt = 0u; mine = 0u;
#pragma unroll
    for (unsigned j = 0; j < 16; ++j) { const unsigned c = xb_ld(&bar[XB_XCNT(j)]); sum += c; cnt += (c > 0u) ? 1u : 0u; mine = (j == x) ? c : mine; }
    if (sum == G) break;
    __builtin_amdgcn_s_sleep(1);
    if ((++sp & 255u) == 0u) { if (xb_ld(&bar[XB_TMO])) break; if (sp > XB_SPIN_CAP) { atomicAdd(&bar[XB_TMO], 1u); break; } }
  }
  nloc = mine > 0u ? mine : 1u; nx = cnt > 0u ? cnt : 1u;
}
DI void xcd_barrier(const XcdBarrier& b) {
  asm volatile("s_waitcnt vmcnt(0)" ::: "memory");
  __syncthreads();
  if (tidx() == 0) {
    unsigned* bar = b.bar;
    __builtin_amdgcn_s_waitcnt(0);
    unsigned nloc = b.st[0], nx = b.st[1];
    if (nloc == 0u) { xcd_barrier_complete(bar, b.x, nloc, nx); b.st[0] = nloc; b.st[1] = nx; }
    const unsigned old = xb_add(&bar[XB_XSUB(b.x)], 1u);
    const unsigned gen = old / nloc;
    if (old + 1u == (gen + 1u) * nloc) {
      __builtin_amdgcn_fence(__ATOMIC_RELEASE, "agent");
      asm volatile("s_waitcnt vmcnt(0)" ::: "memory");
      const unsigned og = xb_add(&bar[XB_TOP], 1u);
      const unsigned tg = og / nx;
      if (og + 1u == (tg + 1u) * nx) xb_add(&bar[XB_TOPGEN], 1u);
      else XB_SPIN(xb_ld(&bar[XB_TOPGEN]) == tg, bar);
      __builtin_amdgcn_fence(__ATOMIC_ACQUIRE, "agent");
      xb_add(&bar[XB_XGEN(b.x)], 1u);
      asm volatile("s_waitcnt vmcnt(0)" ::: "memory");
    } else {
      XB_SPIN(xb_ld(&bar[XB_XGEN(b.x)]) == gen, bar);
      __builtin_amdgcn_fence(__ATOMIC_ACQUIRE, "agent");
      asm volatile("s_waitcnt vmcnt(0)" ::: "memory");
    }
  }
  __syncthreads();
}

#ifndef PROBE_K
#define PROBE_K 8
#endif
#ifndef REPMASK
#define REPMASK 0
#endif
#ifndef ONE_LAUNCH
#define ONE_LAUNCH 1
#endif
constexpr int LDS_BYTES = GEMM_LDS + 1024;

#if ONE_LAUNCH
#define BAR_ARG , const XcdBarrier& xb
#define BAR_PASS , xb
#else
#define BAR_ARG
#define BAR_PASS
#endif
template <int PH>
DI void phase_step(unsigned char* lds, int ph_lo, int ph_hi BAR_ARG) {
  if (PH >= ph_lo && PH < ph_hi) {
    const __attribute__((address_space(4))) Params* kp = (const __attribute__((address_space(4))) Params*)__builtin_amdgcn_kernarg_segment_ptr();
    asm volatile("" : "+s"(kp));
    run_phase(*(const Params*)kp, PH, lds, blockIdx.x, gridDim.x);
#if ONE_LAUNCH
    if (PROBE_PH >= 0 && PH + 1 == ph_hi) { asm volatile("s_waitcnt vmcnt(0)" ::: "memory"); __syncthreads(); }
    if (PROBE_PH >= 0 && tidx() == 0 && blockIdx.x == 0 && PH + 1 == ph_hi) ((volatile unsigned long long*)(lds + GEMM_LDS + 528))[PH + 1] = __builtin_amdgcn_s_memrealtime();
    if (PH + 1 < ph_hi) {
      if (PH == 0) cg::this_grid().sync(); else xcd_barrier(xb);
      if ((REPMASK >> 25) & 1) xcd_barrier(xb);
      if (PROBE_PH >= 0 && tidx() == 0 && blockIdx.x == 0) ((volatile unsigned long long*)(lds + GEMM_LDS + 528))[PH + 1] = __builtin_amdgcn_s_memrealtime();
    }
#endif
  }
}

__global__ void __launch_bounds__(512, 2) mega(Params P, int ph_lo, int ph_hi) {
  extern __shared__ __attribute__((aligned(16))) unsigned char lds[];
#if ONE_LAUNCH
  volatile LAS unsigned* st = (volatile LAS unsigned*)(lds + GEMM_LDS + 512);
  if (tidx() < 2) st[tidx()] = 0u;
  __syncthreads();
  XcdBarrier xb = xcd_barrier_post(P.bar, st);
  if (PROBE_PH == -2 && tidx() == 0) *(volatile unsigned long long*)(lds + PROBE_LDS_OFF) = 0ull;
#endif
#if ONE_LAUNCH
  if (PROBE_PH >= 0 && tidx() == 0 && blockIdx.x == 0) ((volatile unsigned long long*)(lds + GEMM_LDS + 528))[0] = __builtin_amdgcn_s_memrealtime();
#endif
#define STEP(N) phase_step<N>(lds, ph_lo, ph_hi BAR_PASS);
  STEP(0) STEP(1) STEP(2) STEP(3) STEP(4) STEP(5) STEP(6) STEP(7) STEP(8) STEP(9)
  STEP(10) STEP(11) STEP(12) STEP(13) STEP(14) STEP(15) STEP(16) STEP(17) STEP(18) STEP(19) STEP(20) STEP(21)
#undef STEP
#if ONE_LAUNCH
  if (PROBE_PH == -2 && tidx() == 0 && blockIdx.x == 0) {
    const unsigned long long dur = *(volatile unsigned long long*)(lds + PROBE_LDS_OFF);
    const unsigned long long until = __builtin_amdgcn_s_memrealtime() + (unsigned long long)PROBE_K * dur;
    while (__builtin_amdgcn_s_memrealtime() < until) __builtin_amdgcn_s_sleep(32);
  }
  if (PROBE_PH >= 0 && tidx() == 0 && blockIdx.x == 0) {
    volatile unsigned long long* ts = (volatile unsigned long long*)(lds + GEMM_LDS + 528);
    const unsigned long long dur = ts[PROBE_PH + 1] - ts[PROBE_PH];
    const unsigned long long until = ts[NPHASE] + (unsigned long long)PROBE_K * dur;
    while (__builtin_amdgcn_s_memrealtime() < until) __builtin_amdgcn_s_sleep(32);
  }
#endif
}

static size_t carve(size_t& off, size_t bytes) { size_t o = off; off = (off + bytes + 255) & ~(size_t)255; return o; }

extern "C" void kernel_launch(void* const* d_in, const int* in_sizes, int n_in, void* d_out, int out_size, void* d_ws, size_t ws_size, hipStream_t stream) {
  static int grid = 0;
  if (grid == 0) {
    int dev = 0, cus = 0, per_cu = 0;
    hipGetDevice(&dev);
    hipDeviceGetAttribute(&cus, hipDeviceAttributeMultiprocessorCount, dev);
    if (hipFuncSetAttribute((const void*)mega, hipFuncAttributeMaxDynamicSharedMemorySize, LDS_BYTES) != hipSuccess) { fprintf(stderr, "kernel_launch: hipFuncSetAttribute failed\n"); }
    hipOccupancyMaxActiveBlocksPerMultiprocessor(&per_cu, (const void*)mega, 512, LDS_BYTES);
    if (per_cu < 1) { fprintf(stderr, "kernel_launch: occupancy query says %d blocks per CU\n", per_cu); per_cu = 1; }
    (void)hipGetLastError();
    grid = cus;
  }
  Params P;
  memset(&P, 0, sizeof(P));
  P.pad0 = REPMASK;
  const float** in = (const float**)&P;
  for (int i = 0; i < 39 && i < n_in; ++i) in[i] = (const float*)d_in[i];
  P.out = (float*)d_out;
  char* ws = (char*)d_ws;
  size_t off = 0;
  P.bar = (unsigned*)(ws + carve(off, XCD_BAR_WORDS * 4));
  P.mods = (float*)(ws + carve(off, 2 * 5 * 6144 * 4));
  P.ropeM = (float*)(ws + carve(off, 128 * 8 * 2 * 4));
  P.ropeS = (float*)(ws + carve(off, 128 * 16 * 2 * 4));
  P.msh = (float*)(ws + carve(off, 64));
  P.win0t = (bf16*)(ws + carve(off, (size_t)1792 * 1024 * 2));
  P.wqt = (bf16*)(ws + carve(off, (size_t)768 * 384 * 2));
  P.wkvt = (bf16*)(ws + carve(off, (size_t)1024 * 256 * 2));
  P.wout0t = (bf16*)(ws + carve(off, (size_t)1024 * 1024 * 2));
  P.win1t = (bf16*)(ws + carve(off, (size_t)2432 * 1024 * 2));
  P.wout1t = (bf16*)(ws + carve(off, (size_t)1024 * 1024 * 2));
  P.wlrut = (bf16*)(ws + carve(off, (size_t)32 * 4096 * 2));
  P.wgut = (bf16*)(ws + carve(off, (size_t)32 * 1024 * 1024 * 2));
  P.wdt = (bf16*)(ws + carve(off, (size_t)32 * 1024 * 512 * 2));
  P.wrt = (bf16*)(ws + carve(off, (size_t)64 * 3072 * 2));
  P.ut = P.wgut;
  P.xc = (float*)(ws + carve(off, (size_t)NC * 1024 * 4));
  P.h = (bf16*)(ws + carve(off, (size_t)NT * 1024 * 2));
  P.cbuf = (bf16*)(ws + carve(off, (size_t)NT * C2LD * 2));
  P.qkv = (bf16*)(ws + carve(off, QKV_ELEMS * 2));
  P.ycat = (bf16*)(ws + carve(off, (size_t)NT * 1024 * 2));
  P.ssqc = (float*)(ws + carve(off, (size_t)NT * 16 * 4));
  P.ssqx = (float*)(ws + carve(off, (size_t)NT * 16 * 4));
  P.ssq2 = (float*)(ws + carve(off, (size_t)NT * 8 * 4));
  P.comp = (float*)(ws + carve(off, (size_t)NB * 2 * LCH * 512 * 2 * 4));
  P.gcomp = (float*)(ws + carve(off, (size_t)NB * 2 * LGR * 512 * 2 * 4));
  P.dtr = (float*)(ws + carve(off, (size_t)NT * 16 * 4));
  P.cst = (float*)(ws + carve(off, (size_t)NB * 16 * NPOS * 4));
  P.dtt = (float*)(ws + carve(off, (size_t)NB * 16 * NPOS * 4));
  P.wgp = (float*)(ws + carve(off, (size_t)NB * 16 * NPOS * 4));
  P.cnt = (int*)(ws + carve(off, 64 * 4));
  P.cntt = (int*)(ws + carve(off, (size_t)2048 * 32 * 4));
  P.tokinfo = (int*)(ws + carve(off, (size_t)NT * 4 * 4));
  P.tokw = (float*)(ws + carve(off, (size_t)NT * 2 * 4));
  P.list = (int*)(ws + carve(off, (size_t)32 * NT * 4));
  if (off > ws_size || n_in != 39 || out_size != NL * 1024) {
    fprintf(stderr, "kernel_launch: needs %zu bytes of workspace (got %zu), 39 inputs (got %d), out %d (got %d); nothing launched\n", off, ws_size, n_in, NL * 1024, out_size);
    return;
  }
#if ONE_LAUNCH
  hipMemsetAsync(P.bar, 0, XCD_BAR_WORDS * 4, stream);
  int lo = 0, hi = NPHASE;
  void* args[] = {&P, &lo, &hi};
  hipError_t e = hipLaunchCooperativeKernel((const void*)mega, dim3(grid), dim3(512), args, LDS_BYTES, stream);
  if (e != hipSuccess) fprintf(stderr, "kernel_launch: cooperative launch failed: %s (grid %d)\n", hipGetErrorString(e), grid);
#else
  for (int ph = 0; ph < NPHASE; ++ph) hipLaunchKernelGGL(mega, dim3(grid), dim3(512), LDS_BYTES, stream, P, ph, ph + 1);
#endif
}
```

```cpp
#define REPMASK 0
#define PROBE_PH (-1)
#define PROBE_SEC 0
#include <hip/hip_runtime.h>
#include <hip/hip_cooperative_groups.h>
#include <cstdio>
#include <cstdint>
#include <cstring>
namespace cg = cooperative_groups;

#define DI __device__ __forceinline__
typedef unsigned short bf16;
typedef __attribute__((ext_vector_type(8))) short bf16x8;
typedef __attribute__((ext_vector_type(16))) float f32x16;
typedef __attribute__((ext_vector_type(8))) float f32x8;
typedef __attribute__((ext_vector_type(4))) float f32x4;
typedef __attribute__((ext_vector_type(2))) float f32x2;
typedef __attribute__((ext_vector_type(4))) unsigned u32x4;
typedef __attribute__((ext_vector_type(2))) unsigned u32x2;
typedef __attribute__((ext_vector_type(2))) __bf16 bfx2;
typedef __attribute__((ext_vector_type(8))) __bf16 bfx8;

constexpr int D = 1024, NB = 4, SEQ = 8192, LC = 256;
constexpr int NL = NB * SEQ;
constexpr int NC = NB * LC;
constexpr int NT = NL + NC;
constexpr int NPOS = SEQ + LC;
constexpr int C1LD = 1696, C2LD = 2320;
constexpr int NCH = 66;
constexpr float EPS = 1e-6f;
constexpr float LOG2E = 1.4426950408889634f;
constexpr int NSLOT = 2 * NT;

#ifndef PROBE_PH
#define PROBE_PH (-1)
#endif
#ifndef PROBE_SEC
#define PROBE_SEC 0
#endif
#define PROBE_LDS_OFF (147456 + 800)
#define PB_BEGIN(SEC, lds_) unsigned long long pb_t0_##SEC = 0; if (PROBE_PH == -2 && PROBE_SEC == SEC && blockIdx.x == 0) { __syncthreads(); pb_t0_##SEC = __builtin_amdgcn_s_memrealtime(); }
#define PB_END(SEC, lds_) if (PROBE_PH == -2 && PROBE_SEC == SEC && blockIdx.x == 0) { __syncthreads(); if (threadIdx.x == 0) *(volatile unsigned long long*)((unsigned char*)(lds_) + PROBE_LDS_OFF) += __builtin_amdgcn_s_memrealtime() - pb_t0_##SEC; }
#define PBW_BEGIN(SEC, lds_) unsigned long long pbw_t0_##SEC = 0; if (PROBE_PH == -2 && PROBE_SEC == SEC && blockIdx.x == 0 && threadIdx.x < 64) { pbw_t0_##SEC = __builtin_amdgcn_s_memrealtime(); }
#define PBW_END(SEC, lds_) if (PROBE_PH == -2 && PROBE_SEC == SEC && blockIdx.x == 0 && threadIdx.x == 0) { *(volatile unsigned long long*)((unsigned char*)(lds_) + PROBE_LDS_OFF) += __builtin_amdgcn_s_memrealtime() - pbw_t0_##SEC; }
DI int tidx() { int t = threadIdx.x; asm volatile("" : "+v"(t)); return t; }
DI float bf2f(bf16 u) { return __uint_as_float(((unsigned)u) << 16); }
DI float lo16(unsigned u) { return __uint_as_float(u << 16); }
DI float hi16(unsigned u) { return __uint_as_float(u & 0xffff0000u); }
DI unsigned pack2(float a, float b) { f32x2 v = {a, b}; bfx2 r = __builtin_convertvector(v, bfx2); return __builtin_bit_cast(unsigned, r); }
DI bf16 f2bf(float x) { return (bf16)(pack2(x, 0.f) & 0xffffu); }
DI bf16x8 pack8(const float (&v)[8]) { f32x8 t; for (int i = 0; i < 8; ++i) t[i] = v[i]; bfx8 r = __builtin_convertvector(t, bfx8); return __builtin_bit_cast(bf16x8, r); }
DI u32x2 pack4(float a, float b, float c, float d) { u32x2 r; r[0] = pack2(a, b); r[1] = pack2(c, d); return r; }
DI void unpack8(u32x4 raw, float (&v)[8]) { for (int i = 0; i < 4; ++i) { v[2 * i] = lo16(raw[i]); v[2 * i + 1] = hi16(raw[i]); } }
DI int crow(int i, int h) { return (i & 3) + 8 * (i >> 2) + 4 * h; }
DI int swap23(int p) { return (p & ~12) | ((p & 4) << 1) | ((p & 8) >> 1); }
DI f32x16 mfma32(bf16x8 a, bf16x8 b, f32x16 c) { return __builtin_amdgcn_mfma_f32_32x32x16_bf16(a, b, c, 0, 0, 0); }
DI f32x4 mfma16(bf16x8 a, bf16x8 b, f32x4 c) { return __builtin_amdgcn_mfma_f32_16x16x32_bf16(a, b, c, 0, 0, 0); }
DI float rcpf_(float x) { return __builtin_amdgcn_rcpf(x); }
DI float sigmoidf_(float x) { return rcpf_(1.f + __expf(-x)); }
DI float siluf_(float x) { return x * rcpf_(1.f + __expf(-x)); }
DI float softplusf_(float x) { return x > 20.f ? x : log1pf(__expf(x)); }
DI float geluf_(float x) { float u = 0.7978845608028654f * (x + 0.044715f * x * x * x); float t = 1.f - 2.f * rcpf_(1.f + __expf(2.f * u)); return 0.5f * x * (1.f + t); }
DI float xor32(float v) { return v + __shfl_xor(v, 32); }
DI float wave_sum(float v) { for (int o = 32; o >= 1; o >>= 1) v += __shfl_xor(v, o); return v; }

DI void tok_info(int tok, int& bmod, int& b, int& pos, bool& lat) {
  if (tok < NL) { b = tok >> 13; bmod = b; pos = LC + (tok & (SEQ - 1)); lat = true; }
  else { int t = tok - NL; b = t >> 8; bmod = 4; pos = t & (LC - 1); lat = false; }
}

struct Params {
  const float *x, *c, *ctx, *c_ctx, *ada_w, *ada_b, *norm1_g, *norm2_g;
  const float *ab_w_in, *ab_w_out, *mla_q_norm_g, *mla_w_q_up, *mla_kv_norm_g, *mla_w_kv_up, *mla_q_head_g, *mla_k_head_g;
  const float *lru_conv_w, *lru_conv_b, *lru_w_a, *lru_b_a, *lru_w_x, *lru_b_x, *lru_lambda;
  const float *cd_w_in, *cd_w_out, *swa_q_head_g, *swa_k_head_g, *swa_sink;
  const float *ssd_conv_w, *ssd_conv_b, *ssd_a_log, *ssd_dt_bias, *ssd_d, *ssd_norm_g;
  const float *router_w, *router_b, *moe_w_gate, *moe_w_up, *moe_w_down;
  float* out;
  float* mods;
  float* ropeM;
  float* ropeS;
  float* msh;
  bf16 *win0t, *wqt, *wkvt, *wout0t, *win1t, *wout1t, *wlrut, *wgut, *wdt, *wrt;
  float* xc;
  bf16* h;
  bf16* cbuf;
  bf16* qkv;
  bf16* ycat;
  bf16* ut;
  float *ssqc, *ssqx, *ssq2;
  float* comp;
  float* gcomp;
  float* dtr;
  float *cst, *dtt, *wgp;
  int* cnt;
  int* cntt;
  int* tokinfo;
  float* tokw;
  int* list;
  unsigned* bar;
  int pad0;
  int pad1;
};
constexpr size_t QB_OFF = 0, KB_OFF = (size_t)NB * 8 * NPOS * 96, VT_OFF = 2 * KB_OFF;
constexpr size_t Q2_OFF = 0, K2_OFF = (size_t)NB * 8 * NPOS * 64, V2T_OFF = K2_OFF + (size_t)NB * 2 * NPOS * 64,
                 ST_OFF = V2T_OFF + (size_t)NB * 2 * 64 * NPOS;
constexpr size_t QKV_ELEMS = (size_t)NSLOT * 1024;
static_assert(VT_OFF + (size_t)NB * 8 * 64 * NPOS <= QKV_ELEMS, "qkv region");
static_assert(ST_OFF + (size_t)NB * 2 * 8 * NCH * 64 * 128 <= QKV_ELEMS, "qkv region L1");
#define LAS3 __attribute__((address_space(3)))
template <int WM, int WN, bool ZERO = true, class PRow, class QRow>
DI void gemm_core(bf16* smem, int K, int krot, PRow prow, QRow qrow, f32x16 (&acc)[WM][WN], int hook_kt, const float (&hs)[WN]) {
  constexpr int TP = 64 * WM, TQ = 128 * WN, NR = TP + TQ, NCHK = NR / 64, STAGE = NR * 64;
  const int tid = tidx(), lane = tid & 63, wid = tid >> 6, wr = wid >> 2, wc = wid & 3, r = lane & 31, h = lane >> 5;
  const bf16* ps[NCHK];
#pragma unroll
  for (int j = 0; j < NCHK; ++j) {
    const int R = j * 64 + (tid >> 3);
    const int cs = (tid & 7) ^ ((R >> 1) & 7);
    ps[j] = (j < WM ? prow(R) : qrow(R - TP)) + cs * 8;
  }
  const int nkt = K >> 6;
  if (ZERO) {
#pragma unroll
    for (int i = 0; i < WM; ++i)
#pragma unroll
      for (int j = 0; j < WN; ++j)
#pragma unroll
        for (int e = 0; e < 16; ++e) acc[i][j][e] = 0.f;
  }
  {
    const int ko = (krot % nkt) * 64;
#pragma unroll
    for (int j = 0; j < NCHK; ++j)
      __builtin_amdgcn_global_load_lds((const unsigned*)(ps[j] + ko), (LAS3 unsigned*)(smem + (j * 512 + wid * 64) * 8), 16, 0, 0);
  }
  asm volatile("s_waitcnt vmcnt(0)" ::: "memory");
  __syncthreads();
  const int sw = (r >> 1) & 7;
  for (int kt = 0; kt < nkt; ++kt) {
    const int buf = kt & 1;
    if (kt + 1 < nkt) {
      const int ko = ((kt + 1 + krot) % nkt) * 64;
#pragma unroll
      for (int j = 0; j < NCHK; ++j)
        __builtin_amdgcn_global_load_lds((const unsigned*)(ps[j] + ko), (LAS3 unsigned*)(smem + (buf ^ 1) * STAGE + (j * 512 + wid * 64) * 8), 16, 0, 0);
    }
    if (kt == hook_kt) {
#pragma unroll
      for (int i = 0; i < WM; ++i)
#pragma unroll
        for (int j = 0; j < WN; ++j)
#pragma unroll
          for (int e = 0; e < 16; ++e) acc[i][j][e] *= hs[j];
    }
    const bf16* sP = smem + buf * STAGE + (wr * WM * 32 + r) * 64;
    const bf16* sQ = smem + buf * STAGE + (TP + wc * WN * 32 + r) * 64;
    bf16x8 a[2][WM], b[2][WN];
    {
      const int co = (h ^ sw) * 8;
#pragma unroll
      for (int i = 0; i < WM; ++i) a[0][i] = *(const bf16x8*)(sP + i * 32 * 64 + co);
#pragma unroll
      for (int j = 0; j < WN; ++j) b[0][j] = *(const bf16x8*)(sQ + j * 32 * 64 + co);
    }
#pragma unroll
    for (int ks = 0; ks < 4; ++ks) {
      if (ks < 3) {
        const int co = (((ks + 1) * 2 + h) ^ sw) * 8;
#pragma unroll
        for (int i = 0; i < WM; ++i) a[(ks + 1) & 1][i] = *(const bf16x8*)(sP + i * 32 * 64 + co);
#pragma unroll
        for (int j = 0; j < WN; ++j) b[(ks + 1) & 1][j] = *(const bf16x8*)(sQ + j * 32 * 64 + co);
      }
#pragma unroll
      for (int i = 0; i < WM; ++i)
#pragma unroll
        for (int j = 0; j < WN; ++j) acc[i][j] = mfma32(a[ks & 1][i], b[ks & 1][j], acc[i][j]);
      if (ks < 3) {
#pragma unroll
        for (int n = 0; n < WM + WN; ++n) { __builtin_amdgcn_sched_group_barrier(0x008, 1, 0); __builtin_amdgcn_sched_group_barrier(0x100, 1, 0); }
        __builtin_amdgcn_sched_group_barrier(0x008, WM * WN - (WM + WN), 0);
      }
    }
    asm volatile("s_waitcnt vmcnt(0)" ::: "memory");
    __syncthreads();
  }
}

struct WaveId { int lane, wid, wr, wc, r, h; };
template <int WM, int WN>
DI void epi_to_lds(bf16* sT, int lane_r, int lane_h, int wr, int wc, int i, int j, int g, float a0, float a1, float a2, float a3) {
  constexpr int LDT = 64 * WM + 8;
  *(u32x2*)(sT + (wc * WN * 32 + j * 32 + lane_r) * LDT + wr * WM * 32 + i * 32 + 8 * g + 4 * lane_h) = pack4(a0, a1, a2, a3);
}
DI WaveId wave_id() { WaveId w; w.lane = tidx() & 63; w.wid = tidx() >> 6; w.wr = w.wid >> 2; w.wc = w.wid & 3; w.r = w.lane & 31; w.h = w.lane >> 5; return w; }

DI void gemm_c1_item(const Params& P, bf16* smem, int pt, int qt) {
  f32x16 acc[4][2];
  const float hs[2] = {1.f, 1.f};
  const int p0 = pt * 256, q0 = qt * 256;
  gemm_core<4, 2>(smem, 1024, 0,
      [&](int rp) { return P.win0t + (size_t)(p0 + rp) * 1024; },
      [&](int rq) { return P.h + (size_t)(q0 + rq) * 1024; }, acc, -1, hs);
  const WaveId w = wave_id();
#pragma unroll
  for (int j = 0; j < 2; ++j) {
    const int tok = q0 + w.wc * 64 + j * 32 + w.r;
#pragma unroll
    for (int i2 = 0; i2 < 2; ++i2) {
      const int grp = (p0 + w.wr * 128 + i2 * 64) >> 6;
      float ss = 0.f;
#pragma unroll
      for (int ii = 0; ii < 2; ++ii)
#pragma unroll
        for (int g = 0; g < 4; ++g) {
          const int i = i2 * 2 + ii;
          const float a0 = acc[i][j][4 * g], a1 = acc[i][j][4 * g + 1], a2 = acc[i][j][4 * g + 2], a3 = acc[i][j][4 * g + 3];
          ss += a0 * a0 + a1 * a1 + a2 * a2 + a3 * a3;
          epi_to_lds<4, 2>(smem, w.r, w.h, w.wr, w.wc, i, j, g, a0, a1, a2, a3);
        }
      ss = xor32(ss);
      if (w.h == 0 && grp < 10) P.ssqc[tok * 16 + grp] = ss;
    }
  }
  __syncthreads();
  {
    const int tid = tidx(), c = tid & 31, rr = tid >> 5;
    if (p0 + c * 8 < C1LD) {
#pragma unroll
      for (int ps_ = 0; ps_ < 16; ++ps_) {
        const int row = rr + 16 * ps_;
        *(u32x4*)(P.cbuf + (size_t)(q0 + row) * C1LD + p0 + c * 8) = *(const u32x4*)(smem + row * 264 + c * 8);
      }
    }
  }
  __syncthreads();
}

#define rope_pair(X1, X2, TAB) do { const float* tb_ = (TAB); const float cs_ = tb_[0], sn_ = tb_[1]; const float a_ = (X1) * cs_ - (X2) * sn_, b_ = (X1) * sn_ + (X2) * cs_; (X1) = a_; (X2) = b_; } while (0)

DI void gemm_q_item(const Params& P, bf16* smem, int pt, int qt) {
  f32x16 acc[3][1];
  const float hs[1] = {1.f};
  const int p0 = pt * 192, q0 = qt * 128;
  gemm_core<3, 1>(smem, 384, 0,
      [&](int rp) { return P.wqt + (size_t)(p0 + rp) * 384; },
      [&](int rq) { return P.cbuf + (size_t)(q0 + rq) * C1LD; }, acc, -1, hs);
  const WaveId w = wave_id();
  const int hd = pt * 2 + w.wr;
  const float qscale = 0.10206207261596575f * LOG2E;
#pragma unroll
  for (int j = 0; j < 1; ++j) {
    const int tok = q0 + w.wc * 32 + w.r;
    int bmod, b, pos; bool lat; tok_info(tok, bmod, b, pos, lat);
    float s6 = 0.f;
    for (int g = 0; g < 6; ++g) s6 += P.ssqc[tok * 16 + g];
    const float rstd = rsqrtf(s6 * (1.f / 384.f) + EPS);
    float ss = 0.f;
#pragma unroll
    for (int i = 0; i < 3; ++i)
#pragma unroll
      for (int e = 0; e < 16; ++e) { acc[i][j][e] *= rstd; ss += acc[i][j][e] * acc[i][j][e]; }
    ss = xor32(ss);
    const float r2 = rsqrtf(ss * (1.f / 96.f) + EPS);
#pragma unroll
    for (int i = 0; i < 3; ++i)
#pragma unroll
      for (int g = 0; g < 4; ++g) {
        const f32x4 gg = *(const f32x4*)(P.mla_q_head_g + i * 32 + 8 * g + 4 * w.h);
#pragma unroll
        for (int e = 0; e < 4; ++e) acc[i][j][4 * g + e] *= r2 * gg[e];
      }
    if (lat) {
      const int sq = tok & (SEQ - 1), rowp = sq >> 6, colp = sq & 63;
#pragma unroll
      for (int e = 0; e < 4; ++e) {
        rope_pair(acc[2][j][e], acc[2][j][4 + e], P.ropeM + (rowp * 8 + 4 * w.h + e) * 2);
        rope_pair(acc[2][j][8 + e], acc[2][j][12 + e], P.ropeM + (colp * 8 + 4 * w.h + e) * 2);
      }
    }
    bf16* dst = P.qkv + QB_OFF + ((size_t)(b * 8 + hd) * NPOS + pos) * 96;
#pragma unroll
    for (int i = 0; i < 3; ++i)
#pragma unroll
      for (int g = 0; g < 4; ++g)
        *(u32x2*)(dst + i * 32 + 8 * g + 4 * w.h) = pack4(acc[i][j][4 * g] * qscale, acc[i][j][4 * g + 1] * qscale, acc[i][j][4 * g + 2] * qscale, acc[i][j][4 * g + 3] * qscale);
  }
}

DI void gemm_kv_item(const Params& P, bf16* smem, int pt, int qt) {
  f32x16 acc[4][1];
  const float hs[1] = {1.f};
  const int p0 = pt * 256, q0 = qt * 128;
  gemm_core<4, 1>(smem, 256, 0,
      [&](int rp) { return P.wkvt + (size_t)(p0 + rp) * 256; },
      [&](int rq) { return P.cbuf + (size_t)(q0 + rq) * C1LD + 384; }, acc, -1, hs);
  const WaveId w = wave_id();
  const int hd = pt * 2 + w.wr;
#pragma unroll
  for (int j = 0; j < 1; ++j) {
    const int tok = q0 + w.wc * 32 + w.r;
    int bmod, b, pos; bool lat; tok_info(tok, bmod, b, pos, lat);
    float s4 = 0.f;
    for (int g = 6; g < 10; ++g) s4 += P.ssqc[tok * 16 + g];
    const float rstd = rsqrtf(s4 * (1.f / 256.f) + EPS);
    float kr[16];
    {
      const bf16* src = P.cbuf + (size_t)tok * C1LD + 640 + 16 * w.h;
      float t8[8];
      unpack8(*(const u32x4*)src, t8);
      for (int i = 0; i < 8; ++i) kr[i] = t8[i];
      unpack8(*(const u32x4*)(src + 8), t8);
      for (int i = 0; i < 8; ++i) kr[8 + i] = t8[i];
    }
    float ss = 0.f;
#pragma unroll
    for (int i = 0; i < 2; ++i)
#pragma unroll
      for (int e = 0; e < 16; ++e) { acc[i][j][e] *= rstd; ss += acc[i][j][e] * acc[i][j][e]; }
#pragma unroll
    for (int i = 0; i < 16; ++i) ss += kr[i] * kr[i];
    ss = xor32(ss);
    const float r2 = rsqrtf(ss * (1.f / 96.f) + EPS);
    bf16* dst = P.qkv + KB_OFF + ((size_t)(b * 8 + hd) * NPOS + pos) * 96;
#pragma unroll
    for (int i = 0; i < 2; ++i)
#pragma unroll
      for (int g = 0; g < 4; ++g) {
        const f32x4 gg = *(const f32x4*)(P.mla_k_head_g + i * 32 + 8 * g + 4 * w.h);
        *(u32x2*)(dst + i * 32 + 8 * g + 4 * w.h) = pack4(acc[i][j][4 * g] * r2 * gg[0], acc[i][j][4 * g + 1] * r2 * gg[1], acc[i][j][4 * g + 2] * r2 * gg[2], acc[i][j][4 * g + 3] * r2 * gg[3]);
      }
#pragma unroll
    for (int i = 0; i < 16; ++i) kr[i] *= r2 * P.mla_k_head_g[64 + 16 * w.h + i];
    if (lat) {
      const int sq = tok & (SEQ - 1);
      const int pp = w.h ? (sq & 63) : (sq >> 6);
#pragma unroll
      for (int i = 0; i < 8; ++i) rope_pair(kr[i], kr[8 + i], P.ropeM + (pp * 8 + i) * 2);
    }
    {
      u32x4 o0, o1;
      for (int i = 0; i < 4; ++i) { o0[i] = pack2(kr[2 * i], kr[2 * i + 1]); o1[i] = pack2(kr[8 + 2 * i], kr[8 + 2 * i + 1]); }
      *(u32x4*)(dst + 64 + 16 * w.h) = o0;
      *(u32x4*)(dst + 64 + 16 * w.h + 8) = o1;
    }
    const int posp = (pos & ~15) | swap23(pos & 15);
    bf16* vdst = P.qkv + VT_OFF + (size_t)(b * 8 + hd) * 64 * NPOS + posp;
#pragma unroll
    for (int i = 0; i < 2; ++i)
#pragma unroll
      for (int e = 0; e < 16; ++e) vdst[(size_t)(i * 32 + crow(e, w.h)) * NPOS] = f2bf(acc[2 + i][j][e] * rstd);
  }
}

template <int WM>
DI void gemm_out_item(const Params& P, bf16* smem, int layer, int pt, int qt) {
  f32x16 acc[WM][2];
  const int p0 = pt * 64 * WM, q0 = qt * 256;
  const WaveId w = wave_id();
  float hs[2] = {1.f, 1.f};
  if (layer == 1) {
#pragma unroll
    for (int j = 0; j < 2; ++j) {
      const int tok = q0 + w.wc * 64 + j * 32 + w.r;
      float s = 0.f;
      for (int g = 0; g < 8; ++g) s += P.ssq2[tok * 8 + g];
      hs[j] = rsqrtf(s * (1.f / 512.f) + EPS);
    }
  }
  const bf16* wt = layer ? P.wout1t : P.wout0t;
  gemm_core<WM, 2>(smem, 1024, layer ? 8 : 0,
      [&](int rp) { return wt + (size_t)(p0 + rp) * 1024; },
      [&](int rq) { return P.ycat + (size_t)(q0 + rq) * 1024; }, acc, layer ? 8 : -1, hs);
#pragma unroll
  for (int j = 0; j < 2; ++j) {
    const int tok = q0 + w.wc * 64 + j * 32 + w.r;
    int bmod, b, pos; bool lat; tok_info(tok, bmod, b, pos, lat);
    const float* src = layer ? (P.out + (size_t)tok * 1024) : (lat ? P.x + (size_t)tok * 1024 : P.ctx + (size_t)(tok - NL) * 1024);
    float* dst = lat ? P.out + (size_t)tok * 1024 : P.xc + (size_t)(tok - NL) * 1024;
    const float* m2 = P.mods + ((size_t)(layer * 5 + bmod) * 6 + 2) * 1024;
#pragma unroll
    for (int i = 0; i < WM; ++i)
#pragma unroll
      for (int g = 0; g < 4; ++g) {
        const int f0 = p0 + w.wr * 32 * WM + i * 32 + 8 * g + 4 * w.h;
        const f32x4 xv = *(const f32x4*)(src + f0);
        const f32x4 mv = *(const f32x4*)(m2 + f0);
        f32x4 o;
#pragma unroll
        for (int e = 0; e < 4; ++e) o[e] = xv[e] + mv[e] * acc[i][j][4 * g + e];
        *(f32x4*)(dst + f0) = o;
        if (g == 3) __builtin_amdgcn_sched_barrier(0);
      }
  }
}

DI void moe1_item(const Params& P, bf16* smem, int layer, int e, int m0, int pt, int cnt_e, int off_e) {
  f32x16 acc[4][2];
  const float hs[2] = {1.f, 1.f};
  const int* lst = P.list + (size_t)e * NT;
  gemm_core<4, 2>(smem, 1024, 0,
      [&](int rp) { return P.wgut + ((size_t)e * 1024 + pt * 256 + rp) * 1024; },
      [&](int rq) { int m = m0 + rq; if (m > cnt_e - 1) m = cnt_e - 1; return P.h + (size_t)lst[m] * 1024; }, acc, -1, hs);
  const WaveId w = wave_id();
  constexpr int LDT = 136;
#pragma unroll
  for (int j = 0; j < 2; ++j) {
    const int row = w.wc * 64 + j * 32 + w.r;
#pragma unroll
    for (int i2 = 0; i2 < 2; ++i2)
#pragma unroll
      for (int g = 0; g < 4; ++g) {
        float o[4];
#pragma unroll
        for (int k = 0; k < 4; ++k) o[k] = siluf_(acc[2 * i2][j][4 * g + k]) * acc[2 * i2 + 1][j][4 * g + k];
        *(u32x2*)(smem + row * LDT + w.wr * 64 + i2 * 32 + 8 * g + 4 * w.h) = pack4(o[0], o[1], o[2], o[3]);
      }
  }
  __syncthreads();
  {
    const int tid = tidx(), c = tid & 15, rr = tid >> 4;
#pragma unroll
    for (int ps_ = 0; ps_ < 8; ++ps_) {
      const int row = rr + 32 * ps_;
      if (m0 + row < cnt_e) *(u32x4*)(P.cbuf + (size_t)(off_e + m0 + row) * 512 + pt * 128 + c * 8) = *(const u32x4*)(smem + row * LDT + c * 8);
    }
  }
  __syncthreads();
}
DI void moe2_item(const Params& P, bf16* smem, int e, int m0, int pt, int cnt_e, int off_e, int total) {
  f32x16 acc[4][2];
  const float hs[2] = {1.f, 1.f};
  gemm_core<4, 2>(smem, 512, 0,
      [&](int rp) { return P.wdt + ((size_t)e * 1024 + pt * 256 + rp) * 512; },
      [&](int rq) { int s = off_e + m0 + rq; if (s > total - 1) s = total - 1; return P.cbuf + (size_t)s * 512; }, acc, -1, hs);
  const WaveId w = wave_id();
#pragma unroll
  for (int j = 0; j < 2; ++j)
#pragma unroll
    for (int i = 0; i < 4; ++i)
#pragma unroll
      for (int g = 0; g < 4; ++g) epi_to_lds<4, 2>(smem, w.r, w.h, w.wr, w.wc, i, j, g, acc[i][j][4 * g], acc[i][j][4 * g + 1], acc[i][j][4 * g + 2], acc[i][j][4 * g + 3]);
  __syncthreads();
  {
    const int tid = tidx(), c = tid & 31, rr = tid >> 5;
#pragma unroll
    for (int ps_ = 0; ps_ < 16; ++ps_) {
      const int row = rr + 16 * ps_;
      if (m0 + row < cnt_e) *(u32x4*)(P.qkv + (size_t)(off_e + m0 + row) * 1024 + pt * 256 + c * 8) = *(const u32x4*)(smem + row * 264 + c * 8);
    }
  }
  __syncthreads();
}

DI void c2_block_epilogue(const Params& P, const WaveId& w, int fb, int tok, f32x16& a0, f32x16& a1) {
  int bmod, b, pos; bool lat; tok_info(tok, bmod, b, pos, lat);
  const float qscale = 0.125f * LOG2E;
  if (fb < 10) {
    const bool isq = fb < 8;
    const float* gain = isq ? P.swa_q_head_g : P.swa_k_head_g;
    float ss = 0.f;
#pragma unroll
    for (int e = 0; e < 16; ++e) ss += a0[e] * a0[e] + a1[e] * a1[e];
    ss = xor32(ss);
    const float r2 = rsqrtf(ss * (1.f / 64.f) + EPS);
#pragma unroll
    for (int g = 0; g < 4; ++g) {
      const f32x4 g0 = *(const f32x4*)(gain + 8 * g + 4 * w.h), g1 = *(const f32x4*)(gain + 32 + 8 * g + 4 * w.h);
#pragma unroll
      for (int e = 0; e < 4; ++e) { a0[4 * g + e] *= r2 * g0[e]; a1[4 * g + e] *= r2 * g1[e]; }
    }
    if (lat) {
      const int sq = tok & (SEQ - 1), rowp = sq >> 6, colp = sq & 63;
#pragma unroll
      for (int e = 0; e < 4; ++e) {
        rope_pair(a0[e], a0[8 + e], P.ropeS + (rowp * 16 + 4 * w.h + e) * 2);
        rope_pair(a0[4 + e], a0[12 + e], P.ropeS + (rowp * 16 + 8 + 4 * w.h + e) * 2);
        rope_pair(a1[e], a1[8 + e], P.ropeS + (colp * 16 + 4 * w.h + e) * 2);
        rope_pair(a1[4 + e], a1[12 + e], P.ropeS + (colp * 16 + 8 + 4 * w.h + e) * 2);
      }
    }
    if (isq && !lat) return;
    const float sc = isq ? qscale : 1.f;
    bf16* dst = isq ? P.qkv + Q2_OFF + ((size_t)(b * 8 + fb) * NPOS + pos) * 64
                    : P.qkv + K2_OFF + ((size_t)(b * 2 + (fb - 8)) * NPOS + pos) * 64;
#pragma unroll
    for (int g = 0; g < 4; ++g) {
      *(u32x2*)(dst + 8 * g + 4 * w.h) = pack4(a0[4 * g] * sc, a0[4 * g + 1] * sc, a0[4 * g + 2] * sc, a0[4 * g + 3] * sc);
      *(u32x2*)(dst + 32 + 8 * g + 4 * w.h) = pack4(a1[4 * g] * sc, a1[4 * g + 1] * sc, a1[4 * g + 2] * sc, a1[4 * g + 3] * sc);
    }
  } else if (fb < 12) {
    const int posp = (pos & ~15) | swap23(pos & 15);
    bf16* vdst = P.qkv + V2T_OFF + (size_t)(b * 2 + (fb - 10)) * 64 * NPOS + posp;
#pragma unroll
    for (int e = 0; e < 16; ++e) {
      vdst[(size_t)(crow(e, w.h)) * NPOS] = f2bf(a0[e]);
      vdst[(size_t)(32 + crow(e, w.h)) * NPOS] = f2bf(a1[e]);
    }
  } else if (fb < 36) {
    bf16* dst = P.cbuf + (size_t)tok * C2LD + fb * 64;
#pragma unroll
    for (int g = 0; g < 4; ++g) {
      *(u32x2*)(dst + 8 * g + 4 * w.h) = pack4(a0[4 * g], a0[4 * g + 1], a0[4 * g + 2], a0[4 * g + 3]);
      *(u32x2*)(dst + 32 + 8 * g + 4 * w.h) = pack4(a1[4 * g], a1[4 * g + 1], a1[4 * g + 2], a1[4 * g + 3]);
    }
  }
}
DI void gemm_c2_item(const Params& P, bf16* smem, int pt, int qt) {
  f32x16 acc[4][2];
  const float hs[2] = {1.f, 1.f};
  const int p0 = pt * 256, q0 = qt * 256;
  gemm_core<4, 2>(smem, 1024, 0,
      [&](int rp) { return P.win1t + (size_t)(p0 + rp) * 1024; },
      [&](int rq) { return P.h + (size_t)(q0 + rq) * 1024; }, acc, -1, hs);
  const WaveId w = wave_id();
#pragma unroll
  for (int j = 0; j < 2; ++j) {
    const int tok = q0 + w.wc * 64 + j * 32 + w.r;
#pragma unroll
    for (int i2 = 0; i2 < 2; ++i2) c2_block_epilogue(P, w, (p0 + w.wr * 128 + i2 * 64) >> 6, tok, acc[2 * i2][j], acc[2 * i2 + 1][j]);
  }
}
DI void gemm_c2dt_item(const Params& P, bf16* smem, int qt) {
  f32x16 acc[1][2];
  const float hs[2] = {1.f, 1.f};
  const int q0 = qt * 256;
  gemm_core<1, 2>(smem, 1024, 0,
      [&](int rp) { return P.win1t + (size_t)(2304 + rp) * 1024; },
      [&](int rq) { return P.h + (size_t)(q0 + rq) * 1024; }, acc, -1, hs);
  const WaveId w = wave_id();
  if (w.wr == 0) {
#pragma unroll
    for (int j = 0; j < 2; ++j) {
      const int tok = q0 + w.wc * 64 + j * 32 + w.r;
#pragma unroll
      for (int g = 0; g < 2; ++g) {
        f32x4 o = {acc[0][j][4 * g], acc[0][j][4 * g + 1], acc[0][j][4 * g + 2], acc[0][j][4 * g + 3]};
        *(f32x4*)(P.dtr + (size_t)tok * 16 + 8 * g + 4 * w.h) = o;
      }
    }
  }
}
template <int DQK, bool WIN>
DI void attn_item(bf16* smem, const bf16* Qp, const bf16* Kp, const bf16* Vtp, int qrow0, int nq, int ntiles, int nctx, int band_k0, int q_lat0,
                  float negM, float sinkterm, bf16* outp) {
  constexpr int KS = DQK / 16, LDK = DQK + 8, LDV = 72, CPR = DQK / 8, NCK = 64 * CPR;
  const int tid = tidx(), lane = tid & 63, w = tid >> 6, r = lane & 31, h = lane >> 5;
  bf16* sK = smem;
  bf16* sV = smem + 2 * 64 * LDK;
  bf16x8 qf[2][KS];
#pragma unroll
  for (int qt = 0; qt < 2; ++qt) {
    int qi = w * 64 + qt * 32 + r;
    if (qi > nq - 1) qi = nq - 1;
#pragma unroll
    for (int s = 0; s < KS; ++s) qf[qt][s] = *(const bf16x8*)(Qp + (size_t)(qrow0 + qi) * DQK + s * 16 + h * 8);
  }
  f32x16 O[2][2];
#pragma unroll
  for (int a = 0; a < 2; ++a)
#pragma unroll
    for (int b = 0; b < 2; ++b)
#pragma unroll
      for (int e = 0; e < 16; ++e) O[a][b][e] = 0.f;
  float lsum[2] = {0.f, 0.f};
  const int kr0 = tid / CPR, kc0 = tid % CPR;
  const int id1 = tid + 512;
  const bool has1 = id1 < NCK;
  const int kr1 = has1 ? id1 / CPR : 0, kc1 = has1 ? id1 % CPR : 0;
  const int vr = tid >> 3, vc = tid & 7;
  u32x4 rK0, rK1, rV;
  rK1 = rK0 = rV = u32x4{0, 0, 0, 0};
  auto tilepos = [&](int t) { return t < nctx ? t * 64 : LC + band_k0 + (t - nctx) * 64; };
  auto gload = [&](int t) {
    const int pos = tilepos(t);
    rK0 = *(const u32x4*)(Kp + (size_t)(pos + kr0) * DQK + kc0 * 8);
    if (has1) rK1 = *(const u32x4*)(Kp + (size_t)(pos + kr1) * DQK + kc1 * 8);
    rV = *(const u32x4*)(Vtp + (size_t)vr * NPOS + pos + vc * 8);
  };
  auto swrite = [&](int buf) {
    *(u32x4*)(sK + buf * 64 * LDK + kr0 * LDK + kc0 * 8) = rK0;
    if (has1) *(u32x4*)(sK + buf * 64 * LDK + kr1 * LDK + kc1 * 8) = rK1;
    *(u32x4*)(sV + buf * 64 * LDV + vr * LDV + vc * 8) = rV;
  };
  gload(0); swrite(0);
  __syncthreads();
  const int qw = q_lat0 + w * 64;
  for (int t = 0; t < ntiles; ++t) {
    const int buf = t & 1;
    if (t + 1 < ntiles) gload(t + 1);
    bool act = (w * 64 < nq);
    int kk0 = 0;
    const bool band = WIN && t >= nctx;
    if (band) { kk0 = band_k0 + (t - nctx) * 64; act = act && (kk0 + 63 >= qw - 128) && (kk0 <= qw + 191); }
    if (act) {
      const bf16* sKb = sK + buf * 64 * LDK;
      const bf16* sVb = sV + buf * 64 * LDV;
#pragma unroll 1
      for (int ksub = 0; ksub < 2; ++ksub) {
        bf16x8 pb[2][2];
        {
          const bf16* kfp = sKb + (ksub * 32 + r) * LDK + h * 8;
#pragma unroll
          for (int qt = 0; qt < 2; ++qt) {
            f32x16 sc;
#pragma unroll
            for (int e = 0; e < 16; ++e) sc[e] = negM;
#pragma unroll
            for (int s = 0; s < KS; ++s) sc = mfma32(*(const bf16x8*)(kfp + s * 16), qf[qt][s], sc);
            float p[16];
#pragma unroll
            for (int e = 0; e < 16; ++e) p[e] = __builtin_amdgcn_exp2f(sc[e]);
            if (band) {
              const int qi = qw + qt * 32 + r;
#pragma unroll
              for (int e = 0; e < 16; ++e) {
                const int dd = qi - (kk0 + ksub * 32 + crow(e, h));
                if (dd > 128 || dd < -128) p[e] = 0.f;
              }
            }
            float ps = 0.f;
#pragma unroll
            for (int e = 0; e < 16; ++e) ps += p[e];
            lsum[qt] += ps;
            float p0[8], p1[8];
#pragma unroll
            for (int e = 0; e < 8; ++e) { p0[e] = p[e]; p1[e] = p[8 + e]; }
            pb[qt][0] = pack8(p0); pb[qt][1] = pack8(p1);
          }
        }
#pragma unroll
        for (int dt = 0; dt < 2; ++dt)
#pragma unroll
          for (int st = 0; st < 2; ++st) {
            const bf16x8 vf = *(const bf16x8*)(sVb + (dt * 32 + r) * LDV + ksub * 32 + st * 16 + h * 8);
            O[0][dt] = mfma32(vf, pb[0][st], O[0][dt]);
            O[1][dt] = mfma32(vf, pb[1][st], O[1][dt]);
          }
      }
    }
    if (t + 1 < ntiles) swrite(buf ^ 1);
    __syncthreads();
  }
#pragma unroll
  for (int qt = 0; qt < 2; ++qt) {
    const float l = xor32(lsum[qt]) + sinkterm;
    const float inv = 1.f / l;
    const int qi = w * 64 + qt * 32 + r;
    if (qi < nq) {
      bf16* dst = outp + (size_t)qi * 1024;
#pragma unroll
      for (int dt = 0; dt < 2; ++dt)
#pragma unroll
        for (int g = 0; g < 4; ++g)
          *(u32x2*)(dst + dt * 32 + 8 * g + 4 * h) = pack4(O[qt][dt][4 * g] * inv, O[qt][dt][4 * g + 1] * inv, O[qt][dt][4 * g + 2] * inv, O[qt][dt][4 * g + 3] * inv);
    }
  }
}

constexpr int LCH = 80, LGR = 9;
DI void lru_apply(float (&h)[4], const float* base, int col, bool valid) {
#pragma unroll
  for (int n = 0; n < 4; ++n) {
    const f32x2 cm = *(const f32x2*)(base + (16 * n + col) * 2);
    h[n] = valid ? cm[0] * h[n] + cm[1] : h[n];
  }
}
DI void lru_chunk(const Params& P, const float* sGateBase, const float* sTaps, bf16* hfw, int bi, int j, int c, int pass, float* sComp) {
  const int lane = tidx() & 63, col = lane & 15, g = lane >> 4;
  const bool isctx = c < 16;
  const int L = isctx ? LC : SEQ;
  const int sp0 = isctx ? c * 16 : (c - 16) * 128;
  const int tokbase = isctx ? (NL + bi * LC + sp0) : (bi * SEQ + sp0);
  const int nsteps = isctx ? 1 : 8;
  const bf16* C1 = P.cbuf;
  bf16* XCV = P.h;
  if (pass == 0) {
    for (int st = 0; st < nsteps; ++st) {
      const int t = st * 16 + col;
      u32x4 raw[2][4];
#pragma unroll
      for (int s = 0; s < 2; ++s)
#pragma unroll
        for (int k = 0; k < 4; ++k) {
          const int tt = sp0 + t + k - 2;
          const bool ok = tt >= 0 && tt < L;
          const int row = ok ? (tokbase + t + k - 2) : tokbase + t;
          raw[s][k] = *(const u32x4*)(C1 + (size_t)row * C1LD + 672 + 64 * j + 32 * s + 8 * g);
        }
#pragma unroll
      for (int s = 0; s < 2; ++s) {
        const int c0 = 64 * j + 32 * s + 8 * g;
        float a8[8];
        {
          const f32x4 b0 = *(const f32x4*)(sTaps + 2048 + c0), b1 = *(const f32x4*)(sTaps + 2048 + c0 + 4);
          for (int i = 0; i < 4; ++i) { a8[i] = b0[i]; a8[4 + i] = b1[i]; }
        }
#pragma unroll
        for (int k = 0; k < 4; ++k) {
          const int tt = sp0 + t + k - 2;
          const float m = (tt >= 0 && tt < L) ? 1.f : 0.f;
          float x8[8];
          unpack8(raw[s][k], x8);
          const f32x4 w0 = *(const f32x4*)(sTaps + k * 512 + c0), w1 = *(const f32x4*)(sTaps + k * 512 + c0 + 4);
          for (int i = 0; i < 4; ++i) { a8[i] += m * w0[i] * x8[i]; a8[4 + i] += m * w1[i] * x8[4 + i]; }
        }
        *(bf16x8*)(XCV + (size_t)(tokbase + t) * 512 + c0) = pack8(a8);
      }
    }
  }
#pragma unroll 1
  for (int dir = 0; dir < 2; ++dir) {
    bf16x8 wb[8][2];
#pragma unroll
    for (int n = 0; n < 8; ++n)
#pragma unroll
      for (int s = 0; s < 2; ++s)
        wb[n][s] = *(const bf16x8*)(P.wlrut + ((size_t)(((dir * 2 + (n >> 2)) * 8 + j) * 64 + 16 * (n & 3) + col)) * 64 + 32 * s + 8 * g);
    bf16x8 idf[2];
#pragma unroll
    for (int n = 0; n < 2; ++n)
#pragma unroll
      for (int jj = 0; jj < 8; ++jj) idf[n][jj] = ((8 * g + jj) == 16 * n + col) ? (short)0x3F80 : (short)0;
    float hst[4], arun[4];
#pragma unroll
    for (int n = 0; n < 4; ++n) { hst[n] = 0.f; arun[n] = 1.f; }
    const float* sGate = sGateBase + dir * 1536 + 64 * j + col;
    if (pass == 1) {
      const float* cbase = P.comp + ((size_t)(bi * 2 + dir) * LCH) * 1024 + 128 * j;
      const float* gbase = P.gcomp + ((size_t)(bi * 2 + dir) * LGR) * 1024 + 128 * j;
      if (isctx) {
#pragma unroll
        for (int i = 0; i < 15; ++i) {
          const int cc = dir == 0 ? i : 15 - i;
          const bool valid = dir == 0 ? (i < c) : (15 - i > c);
          lru_apply(hst, cbase + (size_t)(valid ? cc : 0) * 1024, col, valid);
        }
      } else {
        const int q = (c - 16) >> 3;
        lru_apply(hst, gbase, col, true);
#pragma unroll
        for (int i = 0; i < 7; ++i) {
          const int qq = dir == 0 ? i : 7 - i;
          const bool valid = dir == 0 ? (i < q) : (7 - i > q);
          lru_apply(hst, gbase + (size_t)(1 + (valid ? qq : 0)) * 1024, col, valid);
        }
#pragma unroll
        for (int i = 0; i < 7; ++i) {
          const int cc = dir == 0 ? 16 + 8 * q + i : 16 + 8 * q + 7 - i;
          const bool valid = dir == 0 ? (cc < c) : (cc > c);
          lru_apply(hst, cbase + (size_t)(valid ? cc : 16) * 1024, col, valid);
        }
      }
    }
    bf16x8 afc[2];
    auto issue = [&](int st, bf16x8 (&af)[2]) {
      const int t = st * 16 + col;
#pragma unroll
      for (int s = 0; s < 2; ++s) af[s] = *(const bf16x8*)(XCV + (size_t)(tokbase + t) * 512 + 64 * j + 32 * s + 8 * g);
    };
    issue(dir ? nsteps - 1 : 0, afc);
    for (int step = 0; step < nsteps; ++step) {
      const int st = dir ? nsteps - 1 - step : step;
      const int t0 = st * 16;
      bf16x8 af[2];
      af[0] = afc[0]; af[1] = afc[1];
      if (step + 1 < nsteps) issue(dir ? st - 1 : st + 1, afc);
      f32x4 ag[8], xcC[4];
      const f32x4 z4 = {0.f, 0.f, 0.f, 0.f};
#pragma unroll
      for (int n = 0; n < 8; ++n) { ag[n] = mfma16(af[0], wb[n][0], z4); ag[n] = mfma16(af[1], wb[n][1], ag[n]); }
#pragma unroll
      for (int n = 0; n < 4; ++n) xcC[n] = mfma16(af[n >> 1], idf[n & 1], z4);
#pragma unroll
      for (int n = 0; n < 4; ++n) {
        float av[4], bv[4];
#pragma unroll
        for (int e = 0; e < 4; ++e) {
          const float rg = sigmoidf_(ag[n][e] + sGate[16 * n]);
          const float ig = sigmoidf_(ag[4 + n][e] + sGate[512 + 16 * n]);
          const float a = __expf(-sGate[1024 + 16 * n] * rg);
          av[e] = a;
          bv[e] = __builtin_amdgcn_sqrtf(fmaxf(fmaf(-a, a, 1.f), 0.f)) * ig * xcC[n][e];
        }
        float A = 1.f, H = 0.f;
        if (dir == 0) { for (int e = 0; e < 4; ++e) { H = av[e] * H + bv[e]; A *= av[e]; } }
        else { for (int e = 3; e >= 0; --e) { H = av[e] * H + bv[e]; A *= av[e]; } }
        float A1, H1, Aex, Hex, At, Ht;
        if (dir == 0) {
          A1 = __shfl_up(A, 16); H1 = __shfl_up(H, 16);
          if (g >= 1) { H = A * H1 + H; A = A * A1; }
          A1 = __shfl_up(A, 32); H1 = __shfl_up(H, 32);
          if (g >= 2) { H = A * H1 + H; A = A * A1; }
          Aex = __shfl_up(A, 16); Hex = __shfl_up(H, 16);
          if (g == 0) { Aex = 1.f; Hex = 0.f; }
          At = __shfl(A, col + 48); Ht = __shfl(H, col + 48);
        } else {
          A1 = __shfl_down(A, 16); H1 = __shfl_down(H, 16);
          if (g <= 2) { H = A * H1 + H; A = A * A1; }
          A1 = __shfl_down(A, 32); H1 = __shfl_down(H, 32);
          if (g <= 1) { H = A * H1 + H; A = A * A1; }
          Aex = __shfl_down(A, 16); Hex = __shfl_down(H, 16);
          if (g == 3) { Aex = 1.f; Hex = 0.f; }
          At = __shfl(A, col); Ht = __shfl(H, col);
        }
        if (pass == 0) {
          hst[n] = At * hst[n] + Ht; arun[n] = At * arun[n];
        } else {
          float hc = Aex * hst[n] + Hex;
          hst[n] = At * hst[n] + Ht;
          float o[4];
          if (dir == 0) { for (int e = 0; e < 4; ++e) { hc = av[e] * hc + bv[e]; o[e] = hc; } }
          else { for (int e = 3; e >= 0; --e) { hc = av[e] * hc + bv[e]; o[e] = hc; } }
#pragma unroll
          for (int e = 0; e < 4; ++e) {
            bf16* yp = hfw + (t0 + 4 * g + e) * 64 + 16 * n + col;
            if (dir == 0) *yp = f2bf(o[e]); else *yp = f2bf(bf2f(*yp) + o[e]);
          }
        }
      }
    }
    if (pass == 0 && g == 0) {
#pragma unroll
      for (int n = 0; n < 4; ++n) {
        f32x2 cm = {arun[n], hst[n]};
        *(f32x2*)(P.comp + ((size_t)((bi * 2 + dir) * LCH + c) * 512 + 64 * j + 16 * n + col) * 2) = cm;
        *(f32x2*)(sComp + (dir * 64 + 16 * n + col) * 2) = cm;
      }
    }
  }
  if (pass == 1) {
    const int ntok = nsteps * 16;
    for (int i0 = 0; i0 < ntok * 8; i0 += 64 * 4) {
      u32x4 gr[4];
#pragma unroll
      for (int u = 0; u < 4; ++u) {
        const int id = i0 + u * 64 + lane;
        const int tk = id >> 3, cc = id & 7;
        gr[u] = u32x4{0, 0, 0, 0};
        if (tk < ntok) gr[u] = *(const u32x4*)(C1 + (size_t)(tokbase + tk) * C1LD + 1184 + 64 * j + cc * 8);
      }
#pragma unroll
      for (int u = 0; u < 4; ++u) {
        const int id = i0 + u * 64 + lane;
        const int tk = id >> 3, cc = id & 7;
        if (tk < ntok) {
          float hv[8], gv[8];
          unpack8(*(const u32x4*)(hfw + tk * 64 + cc * 8), hv);
          unpack8(gr[u], gv);
#pragma unroll
          for (int e = 0; e < 8; ++e) hv[e] *= geluf_(gv[e]);
          *(bf16x8*)(P.ycat + (size_t)(tokbase + tk) * 1024 + 512 + 64 * j + cc * 8) = pack8(hv);
        }
      }
    }
  }
}

DI void lru_block_item(const Params& P, float* fsm, int bi, int j, int grp, int pass) {
  const int tid = tidx(), wid = tid >> 6;
  const float* sGate = fsm;
  const float* sTaps = fsm + 3072;
  float* sComp = fsm + 5632;
  bf16* hfw = (bf16*)(fsm + 3072) + wid * 8192;
  if (grp == 0) {
    lru_chunk(P, sGate, sTaps, hfw, bi, j, 2 * wid, pass, sComp + (2 * wid) * 256);
    lru_chunk(P, sGate, sTaps, hfw, bi, j, 2 * wid + 1, pass, sComp + (2 * wid + 1) * 256);
  } else {
    lru_chunk(P, sGate, sTaps, hfw, bi, j, 16 + 8 * (grp - 1) + wid, pass, sComp + wid * 256);
  }
  if (pass == 0) {
    __syncthreads();
    if (tid < 128) {
      const int dir = tid >> 6, ch = tid & 63;
      const int n = grp == 0 ? 16 : 8;
      float A = 1.f, H = 0.f;
      for (int i = 0; i < n; ++i) {
        const int cc = dir == 0 ? i : n - 1 - i;
        const float a = sComp[cc * 256 + (dir * 64 + ch) * 2], hh = sComp[cc * 256 + (dir * 64 + ch) * 2 + 1];
        H = a * H + hh; A = a * A;
      }
      f32x2 cm = {A, H};
      *(f32x2*)(P.gcomp + ((size_t)((bi * 2 + dir) * LGR + grp) * 512 + 64 * j + ch) * 2) = cm;
    }
    __syncthreads();
  }
}
DI void chunk_geom(int bi, int ck, int& L, int& sp0, int& tokbase, int& pos0) {
  const bool isctx = ck < 2;
  L = isctx ? LC : SEQ;
  sp0 = isctx ? ck * 128 : (ck - 2) * 128;
  tokbase = isctx ? (NL + bi * LC + sp0) : (bi * SEQ + sp0);
  pos0 = isctx ? sp0 : LC + sp0;
}

DI void ssd_conv_item(const Params& P, bf16* smem, int gc, int cr) {
  const int bi = gc / NCH, ck = gc % NCH;
  int L, sp0, tokbase, pos0; chunk_geom(bi, ck, L, sp0, tokbase, pos0);
  const int tid = tidx();
  constexpr int LDT = 257;
  {
    const int cc = tid & 31, tg = tid >> 5;
    const int c0 = cr * 256 + cc * 8;
    f32x4 wv[4][2], bv[2];
#pragma unroll
    for (int k = 0; k < 4; ++k) { wv[k][0] = *(const f32x4*)(P.ssd_conv_w + k * 1024 + c0); wv[k][1] = *(const f32x4*)(P.ssd_conv_w + k * 1024 + c0 + 4); }
    bv[0] = *(const f32x4*)(P.ssd_conv_b + c0); bv[1] = *(const f32x4*)(P.ssd_conv_b + c0 + 4);
    u32x4 raw[11];
#pragma unroll
    for (int i = 0; i < 11; ++i) {
      const int t = tg * 8 + i - 2, tt = sp0 + t;
      const bool ok = tt >= 0 && tt < L;
      raw[i] = u32x4{0, 0, 0, 0};
      if (ok) raw[i] = *(const u32x4*)(P.cbuf + (size_t)(tokbase + t) * C2LD + 1280 + c0);
    }
#pragma unroll
    for (int i = 0; i < 8; ++i) {
      float a8[8];
#pragma unroll
      for (int e = 0; e < 4; ++e) { a8[e] = bv[0][e]; a8[4 + e] = bv[1][e]; }
#pragma unroll
      for (int k = 0; k < 4; ++k) {
        float x8[8];
        unpack8(raw[i + k], x8);
#pragma unroll
        for (int e = 0; e < 4; ++e) { a8[e] += wv[k][0][e] * x8[e]; a8[4 + e] += wv[k][1][e] * x8[4 + e]; }
      }
#pragma unroll
      for (int e = 0; e < 8; ++e) a8[e] = siluf_(a8[e]);
      const bf16x8 o = pack8(a8);
      const int t = tg * 8 + i;
      *(bf16x8*)(P.h + (size_t)(tokbase + t) * 1024 + c0) = o;
#pragma unroll
      for (int e = 0; e < 8; ++e) smem[t * LDT + cc * 8 + e] = (bf16)o[e];
    }
  }
  __syncthreads();
  {
    const int o = tid & 15, cb = tid >> 4;
#pragma unroll
    for (int i = 0; i < 8; ++i) {
      const int c = cb + 32 * i;
      float v8[8];
#pragma unroll
      for (int e = 0; e < 8; ++e) {
        const int pp = 8 * o + e;
        const int t = (pp & ~15) | swap23(pp & 15);
        v8[e] = bf2f(smem[t * LDT + c]);
      }
      *(bf16x8*)(P.ut + ((size_t)(bi * 1024 + cr * 256 + c)) * NPOS + pos0 + 8 * o) = pack8(v8);
    }
  }
  __syncthreads();
}

DI void ssd_cumsum_item(const Params& P, int gc) {
  const int bi = gc / NCH, ck = gc % NCH;
  int L, sp0, tokbase, pos0; chunk_geom(bi, ck, L, sp0, tokbase, pos0);
  const int lane = tidx() & 63;
  f32x4 raw[2][4];
#pragma unroll
  for (int u = 0; u < 2; ++u)
#pragma unroll
    for (int q = 0; q < 4; ++q) raw[u][q] = *(const f32x4*)(P.dtr + (size_t)(tokbase + 64 * u + lane) * 16 + 4 * q);
  const int perm = (lane & ~15) | swap23(lane & 15);
#pragma unroll
  for (int idx = 0; idx < 16; ++idx) {
    const float A = -__expf(P.ssd_a_log[idx]);
    const float bias = P.ssd_dt_bias[idx];
    const float dt0 = softplusf_(raw[0][idx >> 2][idx & 3] + bias), dt1 = softplusf_(raw[1][idx >> 2][idx & 3] + bias);
    const float a0 = dt0 * A, a1 = dt1 * A;
    float c0 = a0, c1 = a1;
#pragma unroll
    for (int d = 1; d < 64; d <<= 1) {
      const float v0 = __shfl_up(c0, d), v1 = __shfl_up(c1, d);
      if (lane >= d) { c0 += v0; c1 += v1; }
    }
    c1 += __shfl(c0, 63);
    const float total = __shfl(c1, 63);
    const size_t rowb = (size_t)(bi * 16 + idx) * NPOS + pos0;
    P.dtt[rowb + lane] = dt0; P.dtt[rowb + 64 + lane] = dt1;
    P.cst[rowb + lane] = c0; P.cst[rowb + 64 + lane] = c1;
    const float w0 = idx < 8 ? dt0 * __expf(total - c0) : dt0 * __expf(c0 - a0);
    const float w1 = idx < 8 ? dt1 * __expf(total - c1) : dt1 * __expf(c1 - a1);
    P.wgp[rowb + perm] = w0; P.wgp[rowb + 64 + perm] = w1;
  }
}

DI void ssd_passA_item(const Params& P, int gc, int hd, int dir, int pt) {
  const int bi = gc / NCH, ck = gc % NCH;
  int L, sp0, tokbase, pos0; chunk_geom(bi, ck, L, sp0, tokbase, pos0);
  const int lane = tidx() & 63, r = lane & 31, h = lane >> 5;
  const int idx = dir * 8 + hd, grp = hd >> 2;
  const bf16* xrow = P.ut + ((size_t)(bi * 1024 + hd * 64 + 32 * pt + r)) * NPOS + pos0 + 8 * h;
  const float* wrow = P.wgp + (size_t)(bi * 16 + idx) * NPOS + pos0 + 8 * h;
  const bf16* brow = P.ut + ((size_t)(bi * 1024 + 512 + grp * 128 + r)) * NPOS + pos0 + 8 * h;
  bf16x8 xs[8];
  {
    u32x4 xr[8]; f32x4 w0[8], w1[8];
#pragma unroll
    for (int ks = 0; ks < 8; ++ks) { xr[ks] = *(const u32x4*)(xrow + 16 * ks); w0[ks] = *(const f32x4*)(wrow + 16 * ks); w1[ks] = *(const f32x4*)(wrow + 16 * ks + 4); }
#pragma unroll
    for (int ks = 0; ks < 8; ++ks) {
      float x8[8];
      unpack8(xr[ks], x8);
#pragma unroll
      for (int e = 0; e < 4; ++e) { x8[e] *= w0[ks][e]; x8[4 + e] *= w1[ks][e]; }
      xs[ks] = pack8(x8);
    }
  }
  f32x16 acc[4];
#pragma unroll
  for (int nt = 0; nt < 4; ++nt)
#pragma unroll
    for (int e = 0; e < 16; ++e) acc[nt][e] = 0.f;
#pragma unroll
  for (int ks = 0; ks < 8; ++ks)
#pragma unroll
    for (int nt = 0; nt < 4; ++nt) acc[nt] = mfma32(*(const bf16x8*)(brow + (size_t)(32 * nt) * NPOS + 16 * ks), xs[ks], acc[nt]);
  bf16* dst = P.qkv + ST_OFF + ((size_t)(((bi * 2 + dir) * 8 + hd) * NCH + ck)) * 8192 + (32 * pt + r) * 128 + 4 * h;
#pragma unroll
  for (int nt = 0; nt < 4; ++nt)
#pragma unroll
    for (int g = 0; g < 4; ++g) *(u32x2*)(dst + 32 * nt + 8 * g) = pack4(acc[nt][4 * g], acc[nt][4 * g + 1], acc[nt][4 * g + 2], acc[nt][4 * g + 3]);
}

DI void ssd_passB(const Params& P, int bid, int nblk) {
  const int nthr = nblk * 512;
  for (int id = bid * 512 + tidx(); id < NB * 2 * 8 * 2048; id += nthr) {
    const int e4 = id & 2047, hd = (id >> 11) & 7, dir = (id >> 14) & 1, bi = id >> 15;
    bf16* base = P.qkv + ST_OFF + ((size_t)((bi * 2 + dir) * 8 + hd)) * NCH * 8192 + e4 * 4;
    const float* crow_ = P.cst + (size_t)(bi * 16 + dir * 8 + hd) * NPOS;
    float S0 = 0.f, S1 = 0.f, S2 = 0.f, S3 = 0.f;
    for (int i0 = 0; i0 < NCH; i0 += 6) {
      u32x2 raw[6]; float dec[6]; int cks[6];
#pragma unroll
      for (int u = 0; u < 6; ++u) {
        const int i = i0 + u;
        const int ck = dir == 0 ? i : (i == 0 ? 1 : (i == 1 ? 0 : 67 - i));
        cks[u] = ck;
        raw[u] = *(const u32x2*)(base + (size_t)ck * 8192);
        dec[u] = __expf(crow_[ck * 128 + 127]);
      }
#pragma unroll
      for (int u = 0; u < 6; ++u) {
        *(u32x2*)(base + (size_t)cks[u] * 8192) = pack4(S0, S1, S2, S3);
        S0 = dec[u] * S0 + lo16(raw[u][0]); S1 = dec[u] * S1 + hi16(raw[u][0]);
        S2 = dec[u] * S2 + lo16(raw[u][1]); S3 = dec[u] * S3 + hi16(raw[u][1]);
      }
    }
  }
}

DI void ssd_passC_item(const Params& P, bf16* smem, int bi, int ck, int grp) {
  int L, sp0, tokbase, pos0; chunk_geom(bi, ck, L, sp0, tokbase, pos0);
  const int tid = tidx(), lane = tid & 63, wid = tid >> 6, r = lane & 31, h = lane >> 5;
  constexpr int LDB = 136;
  bf16* sB = smem;
  bf16* sC = smem + 128 * LDB;
  bf16* sX = smem + 256 * LDB;
  float* sCS = (float*)(smem + 512 * LDB);
  float* sDT = sCS + 1024;
  const bf16* U = P.h;
  {
    u32x4 tb[4], tc[4], tx[8];
#pragma unroll
    for (int i = 0; i < 4; ++i) {
      const int id = tid + 512 * i, row = id >> 4, c = id & 15;
      tb[i] = *(const u32x4*)(U + (size_t)(tokbase + row) * 1024 + 512 + grp * 128 + c * 8);
      tc[i] = *(const u32x4*)(U + (size_t)(tokbase + row) * 1024 + 768 + grp * 128 + c * 8);
    }
#pragma unroll
    for (int i = 0; i < 8; ++i) {
      const int id = tid + 512 * i, row = id >> 4, c = id & 15;
      tx[i] = *(const u32x4*)(P.ut + ((size_t)(bi * 1024 + grp * 256 + row)) * NPOS + pos0 + c * 8);
    }
    float cv[2], dv[2];
#pragma unroll
    for (int i = 0; i < 2; ++i) {
      const int id = tid + 512 * i, dir = id >> 9, hl = (id >> 7) & 3, t = id & 127;
      const size_t o = (size_t)(bi * 16 + dir * 8 + grp * 4 + hl) * NPOS + pos0 + t;
      cv[i] = P.cst[o]; dv[i] = P.dtt[o];
    }
#pragma unroll
    for (int i = 0; i < 4; ++i) {
      const int id = tid + 512 * i, row = id >> 4, c = id & 15;
      *(u32x4*)(sB + row * LDB + c * 8) = tb[i];
      *(u32x4*)(sC + row * LDB + c * 8) = tc[i];
    }
#pragma unroll
    for (int i = 0; i < 8; ++i) {
      const int id = tid + 512 * i, row = id >> 4, c = id & 15;
      *(u32x4*)(sX + row * LDB + c * 8) = tx[i];
    }
#pragma unroll
    for (int i = 0; i < 2; ++i) { sCS[tid + 512 * i] = cv[i]; sDT[tid + 512 * i] = dv[i]; }
  }
  __syncthreads();
  const int hl = wid >> 1, hd = grp * 4 + hl;
  const float Ah0 = -__expf(P.ssd_a_log[hd]), Ah1 = -__expf(P.ssd_a_log[8 + hd]);
  const float dsk = P.ssd_d[hd] + P.ssd_d[8 + hd];
  const float* csF = sCS + hl * 128;
  const float* csR = sCS + 512 + hl * 128;
  const float* dtF = sDT + hl * 128;
  const float* dtR = sDT + 512 + hl * 128;
#pragma unroll 1
  for (int lq = 0; lq < 2; ++lq) {
    const int lt = 2 * (wid & 1) + lq;
    const int l = lt * 32 + r;
    const size_t tok = tokbase + l;
    bf16x8 cfr[8];
#pragma unroll
    for (int ks = 0; ks < 8; ++ks) cfr[ks] = *(const bf16x8*)(sC + l * LDB + 16 * ks + 8 * h);
    f32x16 acc[2];
#pragma unroll
    for (int pt = 0; pt < 2; ++pt)
#pragma unroll
      for (int e = 0; e < 16; ++e) acc[pt][e] = 0.f;
    const float cslF = csF[l], cslR = csR[l];
    const float exlR = cslR - dtR[l] * Ah1;
#pragma unroll
    for (int dir = 0; dir < 2; ++dir) {
      const float fac = dir == 0 ? __expf(cslF) : __expf(csR[127] - exlR);
#pragma unroll
      for (int pt = 0; pt < 2; ++pt) {
        f32x16 yo;
#pragma unroll
        for (int e = 0; e < 16; ++e) yo[e] = 0.f;
        const bf16* srow = P.qkv + ST_OFF + ((size_t)(((bi * 2 + dir) * 8 + hd) * NCH + ck)) * 8192 + (32 * pt + r) * 128 + 8 * h;
#pragma unroll
        for (int ks = 0; ks < 8; ++ks) yo = mfma32(*(const bf16x8*)(srow + 16 * ks), cfr[ks], yo);
#pragma unroll
        for (int e = 0; e < 16; ++e) acc[pt][e] += fac * yo[e];
      }
    }
#pragma unroll 1
    for (int st = 0; st < 4; ++st) {
      f32x16 G;
#pragma unroll
      for (int e = 0; e < 16; ++e) G[e] = 0.f;
#pragma unroll
      for (int ks = 0; ks < 8; ++ks) G = mfma32(*(const bf16x8*)(sB + (st * 32 + r) * LDB + 16 * ks + 8 * h), cfr[ks], G);
      const bf16* x0p = sX + (hl * 64 + r) * LDB + st * 32 + 8 * h;
      const bf16x8 x00 = *(const bf16x8*)(x0p), x01 = *(const bf16x8*)(x0p + 16);
      const bf16x8 x10 = *(const bf16x8*)(x0p + 32 * LDB), x11 = *(const bf16x8*)(x0p + 32 * LDB + 16);
      if (st <= lt) {
        float m[16];
#pragma unroll
        for (int g = 0; g < 4; ++g) {
          const int sb = st * 32 + 8 * g + 4 * h;
          const f32x4 cs4 = *(const f32x4*)(csF + sb), dt4 = *(const f32x4*)(dtF + sb);
#pragma unroll
          for (int e = 0; e < 4; ++e) m[4 * g + e] = (sb + e <= l) ? G[4 * g + e] * __expf(cslF - cs4[e]) * dt4[e] : 0.f;
        }
        float t0[8], t1[8];
#pragma unroll
        for (int e = 0; e < 8; ++e) { t0[e] = m[e]; t1[e] = m[8 + e]; }
        const bf16x8 p0 = pack8(t0), p1 = pack8(t1);
        acc[0] = mfma32(x00, p0, acc[0]); acc[0] = mfma32(x01, p1, acc[0]);
        acc[1] = mfma32(x10, p0, acc[1]); acc[1] = mfma32(x11, p1, acc[1]);
      }
      if (st >= lt) {
        float m[16];
#pragma unroll
        for (int g = 0; g < 4; ++g) {
          const int sb = st * 32 + 8 * g + 4 * h;
          const f32x4 cs4 = *(const f32x4*)(csR + sb), dt4 = *(const f32x4*)(dtR + sb);
#pragma unroll
          for (int e = 0; e < 4; ++e) m[4 * g + e] = (sb + e >= l) ? G[4 * g + e] * __expf((cs4[e] - dt4[e] * Ah1) - exlR) * dt4[e] : 0.f;
        }
        float t0[8], t1[8];
#pragma unroll
        for (int e = 0; e < 8; ++e) { t0[e] = m[e]; t1[e] = m[8 + e]; }
        const bf16x8 p0 = pack8(t0), p1 = pack8(t1);
        acc[0] = mfma32(x00, p0, acc[0]); acc[0] = mfma32(x01, p1, acc[0]);
        acc[1] = mfma32(x10, p0, acc[1]); acc[1] = mfma32(x11, p1, acc[1]);
      }
    }
    (void)Ah0;
    float ss = 0.f;
#pragma unroll
    for (int pt = 0; pt < 2; ++pt)
#pragma unroll
      for (int g = 0; g < 4; ++g) {
        const int p0 = 32 * pt + 8 * g + 4 * h;
        const u32x2 xr = *(const u32x2*)(U + tok * 1024 + hd * 64 + p0);
        const u32x2 zr = *(const u32x2*)(P.cbuf + tok * C2LD + 768 + hd * 64 + p0);
        const float xs[4] = {lo16(xr[0]), hi16(xr[0]), lo16(xr[1]), hi16(xr[1])};
        const float zz[4] = {lo16(zr[0]), hi16(zr[0]), lo16(zr[1]), hi16(zr[1])};
        float o[4];
#pragma unroll
        for (int e = 0; e < 4; ++e) { o[e] = (acc[pt][4 * g + e] + dsk * xs[e]) * siluf_(zz[e]); ss += o[e] * o[e]; }
        *(u32x2*)(P.ycat + tok * 1024 + 512 + hd * 64 + p0) = pack4(o[0], o[1], o[2], o[3]);
      }
    ss = xor32(ss);
    if (h == 0) P.ssq2[tok * 8 + hd] = ss;
  }
  __syncthreads();
}

DI void row_pass2(const Params& P, int mode, int layer, int tokA, int ntok, const int* sOff) {
  const int lane = tidx() & 63;
  const int tk[2] = {tokA, tokA + 1 < ntok ? tokA + 1 : tokA};
  const bool ok1 = tokA + 1 < ntok;
  f32x4 v[2][4];
  const float* src[2];
  int bm[2];
#pragma unroll
  for (int u = 0; u < 2; ++u) {
    int b, pos; bool lat; tok_info(tk[u], bm[u], b, pos, lat);
    src[u] = mode == 0 ? (lat ? P.x + (size_t)tk[u] * 1024 : P.ctx + (size_t)(tk[u] - NL) * 1024)
                       : (lat ? P.out + (size_t)tk[u] * 1024 : P.xc + (size_t)(tk[u] - NL) * 1024);
#pragma unroll
    for (int i = 0; i < 4; ++i) v[u][i] = *(const f32x4*)(src[u] + 4 * lane + 256 * i);
  }
  if (mode == 1 || mode == 2) {
    u32x2 y0[2][4], y1[2][4];
    float w0[2], w1[2];
#pragma unroll
    for (int u = 0; u < 2; ++u) {
      const int* ti = P.tokinfo + (size_t)tk[u] * 4;
      const int s0 = sOff[ti[0]] + ti[1], s1 = sOff[ti[2]] + ti[3];
      w0[u] = P.tokw[tk[u] * 2]; w1[u] = P.tokw[tk[u] * 2 + 1];
#pragma unroll
      for (int i = 0; i < 4; ++i) {
        const int k = 4 * lane + 256 * i;
        y0[u][i] = *(const u32x2*)(P.qkv + (size_t)s0 * 1024 + k); y1[u][i] = *(const u32x2*)(P.qkv + (size_t)s1 * 1024 + k);
      }
    }
#pragma unroll
    for (int u = 0; u < 2; ++u) {
      const float* m5 = P.mods + ((size_t)((mode - 1) * 5 + bm[u]) * 6 + 5) * 1024;
      float* dst = tk[u] < NL ? P.out + (size_t)tk[u] * 1024 : P.xc + (size_t)(tk[u] - NL) * 1024;
#pragma unroll
      for (int i = 0; i < 4; ++i) {
        const int k = 4 * lane + 256 * i;
        const f32x4 mv = *(const f32x4*)(m5 + k);
        v[u][i][0] += mv[0] * (w0[u] * lo16(y0[u][i][0]) + w1[u] * lo16(y1[u][i][0]));
        v[u][i][1] += mv[1] * (w0[u] * hi16(y0[u][i][0]) + w1[u] * hi16(y1[u][i][0]));
        v[u][i][2] += mv[2] * (w0[u] * lo16(y0[u][i][1]) + w1[u] * lo16(y1[u][i][1]));
        v[u][i][3] += mv[3] * (w0[u] * hi16(y0[u][i][1]) + w1[u] * hi16(y1[u][i][1]));
        if (u == 0 || ok1) *(f32x4*)(dst + k) = v[u][i];
      }
    }
    if (mode == 2) return;
  }
#pragma unroll
  for (int u = 0; u < 2; ++u) {
    float ss = 0.f;
#pragma unroll
    for (int i = 0; i < 4; ++i) ss += v[u][i][0] * v[u][i][0] + v[u][i][1] * v[u][i][1] + v[u][i][2] * v[u][i][2] + v[u][i][3] * v[u][i][3];
    ss = wave_sum(ss);
    const float rstd = rsqrtf(ss * (1.f / 1024.f) + EPS);
    const float* g1 = P.norm1_g + layer * 1024;
    const float* sh = P.mods + ((size_t)(layer * 5 + bm[u]) * 6 + 0) * 1024;
    const float* sc = P.mods + ((size_t)(layer * 5 + bm[u]) * 6 + 1) * 1024;
    if (u == 0 || ok1) {
#pragma unroll
      for (int i = 0; i < 4; ++i) {
        const int k = 4 * lane + 256 * i;
        const f32x4 gv = *(const f32x4*)(g1 + k), sv = *(const f32x4*)(sc + k), hv = *(const f32x4*)(sh + k);
        float o[4];
#pragma unroll
        for (int e = 0; e < 4; ++e) o[e] = v[u][i][e] * rstd * gv[e] * (1.f + sv[e]) + hv[e];
        *(u32x2*)(P.h + (size_t)tk[u] * 1024 + k) = pack4(o[0], o[1], o[2], o[3]);
      }
    }
  }
}

DI void route_tokens(const Params& P, int layer, float* sW, int item, int tok_lo, int tok_hi) {
  const int tid = tidx(), lane = tid & 63, wid = tid >> 6;
  int* sCnt = (int*)sW;
  if (tid < 32) sCnt[tid * 36 + 32] = 0;
  __syncthreads();
  const float* g2 = P.norm2_g + layer * 1024;
  const float rb = P.router_b[lane >> 1];
  float gm[16], sh[16], xn[16];
  int cur_b = -1;
  auto xsrc = [&](int tok) { return tok < NL ? P.out + (size_t)tok * 1024 : P.xc + (size_t)(tok - NL) * 1024; };
  int t0 = tok_lo + wid;
  if (t0 < tok_hi) {
    const float* src = xsrc(t0);
#pragma unroll
    for (int i = 0; i < 16; ++i) xn[i] = src[lane + 64 * i];
  }
  for (; t0 < tok_hi; t0 += 8) {
    const int tok = t0;
    float v[16];
    float ss = 0.f;
#pragma unroll
    for (int i = 0; i < 16; ++i) { v[i] = xn[i]; ss += v[i] * v[i]; }
    if (t0 + 8 < tok_hi) {
      const float* src = xsrc(t0 + 8);
#pragma unroll
      for (int i = 0; i < 16; ++i) xn[i] = src[lane + 64 * i];
    }
    const int bmod = tok < NL ? (tok >> 13) : 4;
    if (bmod != cur_b) {
      cur_b = bmod;
      const float* shp = P.mods + ((size_t)(layer * 5 + bmod) * 6 + 3) * 1024;
      const float* scp = P.mods + ((size_t)(layer * 5 + bmod) * 6 + 4) * 1024;
#pragma unroll
      for (int i = 0; i < 16; ++i) { const int k = lane + 64 * i; gm[i] = g2[k] * (1.f + scp[k]); sh[i] = shp[k]; }
    }
    ss = wave_sum(ss);
    const float rstd = rsqrtf(ss * (1.f / 1024.f) + EPS);
#pragma unroll
    for (int i = 0; i < 16; ++i) {
      v[i] = v[i] * rstd * gm[i] + sh[i];
      P.h[(size_t)tok * 1024 + lane + 64 * i] = f2bf(v[i]);
    }
    float acc[32];
#pragma unroll
    for (int e = 0; e < 32; ++e) acc[e] = 0.f;
#pragma unroll
    for (int i = 0; i < 16; ++i) {
      const float* wr = sW + (lane + 64 * i) * 36;
#pragma unroll
      for (int c = 0; c < 8; ++c) {
        const f32x4 w4 = *(const f32x4*)(wr + 4 * c);
#pragma unroll
        for (int e = 0; e < 4; ++e) acc[4 * c + e] += v[i] * w4[e];
      }
      if ((i & 3) == 3) asm volatile("" ::: "memory");
    }
    float a16[16], a8[8], a4[4], a2[2], a1;
    {
      const bool up = (lane & 32) != 0;
#pragma unroll
      for (int i = 0; i < 16; ++i) { const float keep = up ? acc[16 + i] : acc[i], send = up ? acc[i] : acc[16 + i]; a16[i] = keep + __shfl_xor(send, 32); }
    }
    {
      const bool up = (lane & 16) != 0;
#pragma unroll
      for (int i = 0; i < 8; ++i) { const float keep = up ? a16[8 + i] : a16[i], send = up ? a16[i] : a16[8 + i]; a8[i] = keep + __shfl_xor(send, 16); }
    }
    {
      const bool up = (lane & 8) != 0;
#pragma unroll
      for (int i = 0; i < 4; ++i) { const float keep = up ? a8[4 + i] : a8[i], send = up ? a8[i] : a8[4 + i]; a4[i] = keep + __shfl_xor(send, 8); }
    }
    {
      const bool up = (lane & 4) != 0;
#pragma unroll
      for (int i = 0; i < 2; ++i) { const float keep = up ? a4[2 + i] : a4[i], send = up ? a4[i] : a4[2 + i]; a2[i] = keep + __shfl_xor(send, 4); }
    }
    {
      const bool up = (lane & 2) != 0;
      const float keep = up ? a2[1] : a2[0], send = up ? a2[0] : a2[1];
      a1 = keep + __shfl_xor(send, 2);
    }
    a1 += __shfl_xor(a1, 1);
    const float us = 1.f / (1.f + expf(-a1));
    const float xbs = us + rb;
    float bestg = -3.0e38f, bu0 = 0.f, bu1 = 0.f;
    int be0 = 0, be1 = 0;
#pragma unroll
    for (int q = 0; q < 4; ++q) {
      float m1 = -3.0e38f, m2 = -3.0e38f, u1 = 0.f, u2 = 0.f;
      int i1 = 0, i2 = 0;
#pragma unroll
      for (int m = 0; m < 8; ++m) {
        const float uu = __shfl(us, 2 * (8 * q + m)), xb = __shfl(xbs, 2 * (8 * q + m));
        if (xb > m1) { m2 = m1; i2 = i1; u2 = u1; m1 = xb; i1 = m; u1 = uu; }
        else if (xb > m2) { m2 = xb; i2 = m; u2 = uu; }
      }
      const float gs = m1 + m2;
      if (gs > bestg) { bestg = gs; be0 = 8 * q + i1; be1 = 8 * q + i2; bu0 = u1; bu1 = u2; }
    }
    if (lane == 0) {
      const int r0 = atomicAdd(&sCnt[be0 * 36 + 32], 1), r1 = atomicAdd(&sCnt[be1 * 36 + 32], 1);
      const float inv = 1.f / (bu0 + bu1);
      int* ti = P.tokinfo + (size_t)tok * 4;
      ti[0] = be0; ti[1] = r0; ti[2] = be1; ti[3] = r1;
      P.tokw[tok * 2] = bu0 * inv; P.tokw[tok * 2 + 1] = bu1 * inv;
    }
  }
  __syncthreads();
  if (tid < 32) P.cntt[item * 32 + tid] = sCnt[tid * 36 + 32];
  __syncthreads();
}
DI void conv_tile(float* sT, const float* src, int K, int N, bf16* dst, int dld, int rmode, const float* scale, int koff, int tk, int tn) {
  const int tid = tidx();
  const int k0 = tk * 64, n0 = tn * 256;
  {
    const int n4 = (tid & 63) * 4, kk = tid >> 6;
    f32x4 v[8];
#pragma unroll
    for (int p = 0; p < 8; ++p) {
      v[p] = f32x4{0.f, 0.f, 0.f, 0.f};
      if (n0 + n4 < N) v[p] = *(const f32x4*)(src + (size_t)(k0 + kk + 8 * p) * N + n0 + n4);
    }
#pragma unroll
    for (int p = 0; p < 8; ++p) {
      const int k = k0 + kk + 8 * p;
      float s = 1.f;
      if (scale != nullptr && k >= koff) s = scale[k - koff];
#pragma unroll
      for (int e = 0; e < 4; ++e) sT[(kk + 8 * p) * 257 + n4 + e] = v[p][e] * s;
    }
  }
  __syncthreads();
  {
    const int kc = (tid & 7) * 8;
#pragma unroll
    for (int q = 0; q < 4; ++q) {
      const int n = (tid >> 3) + 64 * q;
      if (n0 + n < N) {
        float v8[8];
#pragma unroll
        for (int e = 0; e < 8; ++e) v8[e] = sT[(kc + e) * 257 + n];
        const int nn = n0 + n;
        const int row = rmode == 0 ? nn : (64 * (nn >> 5) + (nn & 31) + (rmode == 2 ? 32 : 0));
        *(bf16x8*)(dst + (size_t)row * dld + k0 + kc) = pack8(v8);
      }
    }
  }
  __syncthreads();
}

DI void conv_moe_tile(const Params& P, float* sT, int layer, int t) {
  const int e = t / 96, u = t % 96;
  if (u < 32) conv_tile(sT, P.moe_w_gate + ((size_t)(layer * 32 + e)) * 1024 * 512, 1024, 512, P.wgut + (size_t)e * 1024 * 1024, 1024, 1, nullptr, 0, u >> 1, u & 1);
  else if (u < 64) conv_tile(sT, P.moe_w_up + ((size_t)(layer * 32 + e)) * 1024 * 512, 1024, 512, P.wgut + (size_t)e * 1024 * 1024, 1024, 2, nullptr, 0, (u - 32) >> 1, (u - 32) & 1);
  else conv_tile(sT, P.moe_w_down + ((size_t)(layer * 32 + e)) * 512 * 1024, 512, 1024, P.wdt + (size_t)e * 1024 * 512, 512, 0, nullptr, 0, (u - 64) >> 2, (u - 64) & 3);
}
constexpr int NCONV_MOE = 32 * 96;

constexpr int NCONV_DENSE = 112 + 18 + 16 + 64 + 160 + 64 + 32;
DI void conv_dense_tile(const Params& P, float* sT, int t) {
  if (t < 112) { conv_tile(sT, P.ab_w_in, 1024, 1696, P.win0t, 1024, 0, nullptr, 0, t / 7, t % 7); return; }
  t -= 112;
  if (t < 18) { conv_tile(sT, P.mla_w_q_up, 384, 768, P.wqt, 384, 0, P.mla_q_norm_g, 0, t / 3, t % 3); return; }
  t -= 18;
  if (t < 16) { conv_tile(sT, P.mla_w_kv_up, 256, 1024, P.wkvt, 256, 0, P.mla_kv_norm_g, 0, t / 4, t % 4); return; }
  t -= 16;
  if (t < 64) { conv_tile(sT, P.ab_w_out, 1024, 1024, P.wout0t, 1024, 0, nullptr, 0, t / 4, t % 4); return; }
  t -= 64;
  if (t < 160) { conv_tile(sT, P.cd_w_in, 1024, 2320, P.win1t, 1024, 0, nullptr, 0, t / 10, t % 10); return; }
  t -= 160;
  if (t < 64) { conv_tile(sT, P.cd_w_out, 1024, 1024, P.wout1t, 1024, 0, P.ssd_norm_g, 512, t / 4, t % 4); return; }
  t -= 64;
  {
    const int blk = t & 7, gate = (t >> 3) & 1, dir = t >> 4;
    const float* src = (gate ? P.lru_w_x : P.lru_w_a) + ((size_t)(dir * 8 + blk)) * 4096;
    conv_tile(sT, src, 64, 64, P.wlrut + ((size_t)((dir * 2 + gate) * 8 + blk)) * 4096, 64, 0, nullptr, 0, 0, 0);
  }
}

DI void mods_item(const Params& P, float* sS, float* sR, int layer, int cb) {
  const int tid = tidx(), col = tid & 63, kq = tid >> 6;
  float a[5] = {0.f, 0.f, 0.f, 0.f, 0.f};
  const float* wp = P.ada_w + (size_t)layer * 1024 * 6144 + cb * 64 + col;
  for (int k = kq * 128; k < kq * 128 + 128; ++k) {
    const float wv = wp[(size_t)k * 6144];
#pragma unroll
    for (int v = 0; v < 5; ++v) a[v] += sS[v * 1024 + k] * wv;
  }
#pragma unroll
  for (int v = 0; v < 5; ++v) sR[(kq * 5 + v) * 64 + col] = a[v];
  __syncthreads();
  if (tid < 320) {
    const int v = tid >> 6;
    float s = P.ada_b[layer * 6144 + cb * 64 + col];
    for (int q = 0; q < 8; ++q) s += sR[(q * 5 + v) * 64 + col];
    P.mods[((size_t)(layer * 5 + v)) * 6144 + cb * 64 + col] = s;
  }
  __syncthreads();
}

enum { PH_PREP, PH_NORM1_0, PH_C1, PH_QKV, PH_ATTN0, PH_OUT0, PH_NORM2_0, PH_SCAT0, PH_MOE1_0, PH_MOE2_0, PH_COMB0, PH_C2, PH_SSDPREP, PH_SSDA, PH_SSDB, PH_SSDC, PH_OUT1, PH_NORM2_1, PH_SCAT1, PH_MOE1_1, PH_MOE2_1, PH_FINAL, NPHASE };
constexpr int GEMM_LDS = (256 + 256) * 2 * 72 * 2;

DI void run_phase(const Params& P, int ph, unsigned char* lds, int bid, int nblk) {
  bf16* smem = (bf16*)lds;
  float* fsm = (float*)lds;
  int* ism = (int*)lds;
  const int tid = tidx(), wid = tid >> 6;
  const int gw = bid * 8 + wid, ngw = nblk * 8;
  const int nrep = 1 + ((P.pad0 >> ph) & 1);
#define REP for (int rep_ = 0; rep_ < nrep; ++rep_)
#define REPB(bit) for (int rep_ = 0, nr_ = 1 + ((P.pad0 >> (bit)) & 1); rep_ < nr_; ++rep_)
  switch (ph) {
    case PH_PREP: {
      if (bid == 0) {
        for (int i = tid; i < 128 * 8; i += 512) {
          const int p = i >> 3, f = i & 7;
          float rev = (float)p * __builtin_amdgcn_exp2f(-(float)f * (13.287712379549449f / 8.f)) * 0.15915494309189535f;
          rev -= floorf(rev);
          P.ropeM[i * 2] = __builtin_amdgcn_cosf(rev); P.ropeM[i * 2 + 1] = __builtin_amdgcn_sinf(rev);
        }
        for (int i = tid; i < 128 * 16; i += 512) {
          const int p = i >> 4, f = i & 15;
          float rev = (float)p * __builtin_amdgcn_exp2f(-(float)f * (13.287712379549449f / 16.f)) * 0.15915494309189535f;
          rev -= floorf(rev);
          P.ropeS[i * 2] = __builtin_amdgcn_cosf(rev); P.ropeS[i * 2 + 1] = __builtin_amdgcn_sinf(rev);
        }
        if (tid == 0) {
          float gq = 0.f, gk = 0.f, sq = 0.f, sk = 0.f, sm = 0.f;
          for (int i = 0; i < 96; ++i) { gq = fmaxf(gq, fabsf(P.mla_q_head_g[i])); gk = fmaxf(gk, fabsf(P.mla_k_head_g[i])); }
          for (int i = 0; i < 64; ++i) { sq = fmaxf(sq, fabsf(P.swa_q_head_g[i])); sk = fmaxf(sk, fabsf(P.swa_k_head_g[i])); }
          for (int i = 0; i < 8; ++i) sm = fmaxf(sm, P.swa_sink[i]);
          P.msh[0] = 9.797958971132712f * gq * gk * LOG2E;
          P.msh[1] = fmaxf(8.f * sq * sk, sm) * LOG2E;
        }
      }
      for (int i = tid; i < 5 * 1024; i += 512) {
        const float v = i < 4096 ? P.c[i] : P.c_ctx[i - 4096];
        fsm[i] = siluf_(v);
      }
      __syncthreads();
      REPB(30) for (int it = bid; it < 2 * 96; it += nblk) mods_item(P, fsm, fsm + 5120, it / 96, it % 96);
      __syncthreads();
      REP for (int it = bid; it < NCONV_DENSE + NCONV_MOE; it += nblk) {
        if (it < NCONV_DENSE) conv_dense_tile(P, fsm, it); else conv_moe_tile(P, fsm, 0, it - NCONV_DENSE);
      }
    } break;
    case PH_NORM1_0: {
      REP for (int tok = 2 * gw; tok < NT; tok += 2 * ngw) row_pass2(P, 0, 0, tok, NT, nullptr);
    } break;
    case PH_C1: {
      REP for (int it = bid; it < 7 * 132; it += nblk) gemm_c1_item(P, smem, it % 7, it / 7);
    } break;
    case PH_QKV: {
      REP for (int it = bid; it < 264 * 8; it += nblk) {
        const int qt = it >> 3, u = it & 7;
        if (u < 4) gemm_q_item(P, smem, u, qt); else gemm_kv_item(P, smem, u - 4, qt);
      }
      __syncthreads();
      for (int i = tid; i < 2560; i += 512) fsm[3072 + i] = i < 2048 ? P.lru_conv_w[i] : P.lru_conv_b[i - 2048];
      for (int i = tid; i < 3072; i += 512) { const int d = i / 1536, u = i % 1536, k = u >> 9, ch = u & 511; fsm[i] = k == 0 ? P.lru_b_a[d * 512 + ch] : (k == 1 ? P.lru_b_x[d * 512 + ch] : 8.f * softplusf_(-P.lru_lambda[d * 512 + ch])); }
      __syncthreads();
      REPB(26) for (int it = bid; it < NB * 8 * LGR; it += nblk) { const int u = it < 256 ? it : it - 256; lru_block_item(P, fsm, it < 256 ? (u >> 6) : (u >> 3), it < 256 ? ((u >> 3) & 7) : (u & 7), it < 256 ? 1 + (u & 7) : 0, 0); }
    } break;
    case PH_ATTN0: {
      for (int i = tid; i < 2560; i += 512) fsm[3072 + i] = i < 2048 ? P.lru_conv_w[i] : P.lru_conv_b[i - 2048];
      for (int i = tid; i < 3072; i += 512) { const int d = i / 1536, u = i % 1536, k = u >> 9, ch = u & 511; fsm[i] = k == 0 ? P.lru_b_a[d * 512 + ch] : (k == 1 ? P.lru_b_x[d * 512 + ch] : 8.f * softplusf_(-P.lru_lambda[d * 512 + ch])); }
      __syncthreads();
      REPB(27) for (int it = bid; it < NB * 8 * LGR; it += nblk) { const int u = it < 256 ? it : it - 256; lru_block_item(P, fsm, it < 256 ? (u >> 6) : (u >> 3), it < 256 ? ((u >> 3) & 7) : (u & 7), it < 256 ? 1 + (u & 7) : 0, 1); }
      __syncthreads();
      const float negM = -P.msh[0];
      REP for (int it = bid; it < 32 + 512; it += nblk) {
        if (it < 32) {
          const int b = it >> 3, hd = it & 7;
          const size_t hb = (size_t)(b * 8 + hd) * NPOS;
          attn_item<96, false>(smem, P.qkv + QB_OFF + hb * 96, P.qkv + KB_OFF + hb * 96, P.qkv + VT_OFF + hb * 64, 0, 256, 4, 4, 0, 0, negM, 0.f,
                               P.ycat + (size_t)(NL + b * LC) * 1024 + hd * 64);
        } else {
          const int u = it - 32, qb = u & 15, hd = (u >> 4) & 7, b = u >> 7;
          const size_t hb = (size_t)(b * 8 + hd) * NPOS;
          attn_item<96, false>(smem, P.qkv + QB_OFF + hb * 96, P.qkv + KB_OFF + hb * 96, P.qkv + VT_OFF + hb * 64, LC + qb * 512, 512, 132, 132, 0, 0, negM, 0.f,
                               P.ycat + (size_t)(b * SEQ + qb * 512) * 1024 + hd * 64);
        }
      }
    } break;
    case PH_OUT0: {
      REP for (int it = bid; it < 512 + 32; it += nblk) { if (it < 512) gemm_out_item<4>(P, smem, 0, it & 3, it >> 2); else gemm_out_item<2>(P, smem, 0, (it - 512) & 7, 128 + ((it - 512) >> 3)); }
    } break;
    case PH_NORM2_0: case PH_NORM2_1: {
      const int layer = ph == PH_NORM2_0 ? 0 : 1;
      const int ntok = layer == 0 ? NT : NL;
      const int T = (ntok + nblk - 1) / nblk;
      __syncthreads();
      for (int i = tid; i < 32768; i += 512) fsm[(i >> 5) * 36 + (i & 31)] = P.router_w[i];
      __syncthreads();
      { const int lo_ = bid * T, hi_ = lo_ + T < ntok ? lo_ + T : ntok; route_tokens(P, layer, fsm, bid, lo_ < ntok ? lo_ : ntok, hi_ > lo_ ? hi_ : lo_); }
      if (layer == 1) {
        __syncthreads();
        for (int it = bid; it < NCONV_MOE; it += nblk) conv_moe_tile(P, fsm, 1, it);
      }
    } break;
    case PH_SCAT0: case PH_SCAT1: {
      const int layer = ph == PH_SCAT0 ? 0 : 1;
      const int ntok = layer == 0 ? NT : NL;
      const int T = (ntok + nblk - 1) / nblk;
      const int nit = nblk;
      __syncthreads();
      for (int i = tid; i < nit * 32; i += 512) ism[i] = P.cntt[i];
      __syncthreads();
      if (tid < 32) {
        int run = 0;
        for (int i = 0; i < nit; ++i) { const int c = ism[i * 32 + tid]; ism[i * 32 + tid] = run; run += c; }
        if (bid == 0) P.cnt[layer * 32 + tid] = run;
      }
      __syncthreads();
      {
        const int lo_ = bid * T, hi_ = lo_ + T < ntok ? lo_ + T : ntok;
        for (int tok = lo_ + tid; tok < hi_; tok += 512) {
          int* ti = P.tokinfo + (size_t)tok * 4;
          const int e0 = ti[0], e1 = ti[2];
          const int p0 = ism[bid * 32 + e0] + ti[1], p1 = ism[bid * 32 + e1] + ti[3];
          ti[1] = p0; ti[3] = p1;
          P.list[(size_t)e0 * NT + p0] = tok;
          P.list[(size_t)e1 * NT + p1] = tok;
        }
      }
    } break;
    case PH_MOE1_0: case PH_MOE2_0: case PH_MOE1_1: case PH_MOE2_1: {
      const int layer = ph >= PH_MOE1_1 ? 1 : 0;
      const bool second = (ph == PH_MOE2_0 || ph == PH_MOE2_1);
      __syncthreads();
      if (tid == 0) {
        int off = 0, toff = 0;
        for (int e = 0; e < 32; ++e) { const int c = P.cnt[layer * 32 + e]; ism[e] = c; ism[32 + e] = off; ism[65 + e] = toff; off += c; toff += (c + 255) >> 8; }
        ism[64] = off; ism[97] = toff;
      }
      __syncthreads();
      const int ntile = ism[97], total = ism[64];
      REP for (int it = bid; it < ntile * 4; it += nblk) {
        const int mtg = it >> 2, pt = it & 3;
        int e = 0;
        while (e < 31 && ism[65 + e + 1] <= mtg) ++e;
        const int m0 = (mtg - ism[65 + e]) * 256, cnt_e = ism[e], off_e = ism[32 + e];
        bf16* gsm = smem + 256;
        if (!second) moe1_item(P, gsm, layer, e, m0, pt, cnt_e, off_e); else moe2_item(P, gsm, e, m0, pt, cnt_e, off_e, total);
      }
    } break;
    case PH_COMB0: case PH_FINAL: {
      const int layer = ph == PH_COMB0 ? 0 : 1;
      __syncthreads();
      if (tid == 0) { int off = 0; for (int e = 0; e < 32; ++e) { ism[e] = off; off += P.cnt[layer * 32 + e]; } }
      __syncthreads();
      const int ntok = layer == 0 ? NT : NL;
      for (int tok = 2 * gw; tok < ntok; tok += 2 * ngw) row_pass2(P, layer == 0 ? 1 : 2, 1, tok, ntok, ism);
    } break;
    case PH_C2: {
      REP for (int it = bid; it < 10 * 132; it += nblk) { if (it < 9 * 132) gemm_c2_item(P, smem, it % 9, it / 9); else gemm_c2dt_item(P, smem, it - 9 * 132); }
    } break;
    case PH_SSDPREP: {
      REPB(28) for (int it = gw; it < NB * NCH; it += ngw) ssd_cumsum_item(P, it);
      REPB(29) for (int it = bid; it < NB * NCH * 4; it += nblk) ssd_conv_item(P, smem, it >> 2, it & 3);
      __syncthreads();
      const float negM = -P.msh[1];
      REP for (int it = bid; it < 512; it += nblk) {
        const int qb = it & 15, hq = (it >> 4) & 7, b = it >> 7;
        const size_t hb = (size_t)(b * 8 + hq) * NPOS, kb = (size_t)(b * 2 + (hq >> 2)) * NPOS;
        const int k0 = qb * 512 - 128 < 0 ? 0 : qb * 512 - 128;
        const int k1 = qb * 512 + 640 > SEQ ? SEQ : qb * 512 + 640;
        const float sinkterm = __builtin_amdgcn_exp2f(P.swa_sink[hq] * LOG2E + negM);
        attn_item<64, true>(smem, P.qkv + Q2_OFF + hb * 64, P.qkv + K2_OFF + kb * 64, P.qkv + V2T_OFF + kb * 64, LC + qb * 512, 512, 4 + (k1 - k0) / 64, 4, k0, qb * 512,
                            negM, sinkterm, P.ycat + (size_t)(b * SEQ + qb * 512) * 1024 + hq * 64);
      }
    } break;
    case PH_SSDA: {
      REP for (int it = gw; it < NB * NCH * 8 * 2 * 2; it += ngw) {
        const int pt = it & 1, dir = (it >> 1) & 1, hd = (it >> 2) & 7, gc = it >> 5;
        ssd_passA_item(P, gc, hd, dir, pt);
      }
    } break;
    case PH_SSDB: ssd_passB(P, bid, nblk); break;
    case PH_SSDC: {
      REP for (int it = bid; it < NB * 64 * 2; it += nblk) ssd_passC_item(P, smem, it >> 7, 2 + ((it >> 1) & 63), it & 1);
    } break;
    case PH_OUT1: {
      for (int it = bid; it < 512; it += nblk) gemm_out_item<4>(P, smem, 1, it & 3, it >> 2);
    } break;
    default: break;
  }
}
#define XB_TMO      128
#define XB_XCNT(j)  (256  + 64 * (j))
#define XB_XSUB(j)  (1280 + 64 * (j))
#define XB_XGEN(j)  (2304 + 64 * (j))
#define XB_TOP      3328
#define XB_TOPGEN   3392
#define XCD_BAR_WORDS 3456
#define XB_SPIN_CAP (1u << 22)
#define LAS __attribute__((address_space(3)))
DI unsigned xb_ld(unsigned* p) { return __hip_atomic_load(p, __ATOMIC_RELAXED, __HIP_MEMORY_SCOPE_AGENT); }
DI unsigned xb_add(unsigned* p, unsigned v) { return __hip_atomic_fetch_add(p, v, __ATOMIC_RELAXED, __HIP_MEMORY_SCOPE_AGENT); }
DI unsigned xb_xcc_id() { return (unsigned)__builtin_amdgcn_s_getreg((3 << 11) | 20) & 0xFu; }
#define XB_SPIN(cond, bar) do { unsigned _sp = 0; while (cond) { __builtin_amdgcn_s_sleep(1); \
    if ((++_sp & 255u) == 0u) { if (xb_ld(&(bar)[XB_TMO])) break; if (_sp > XB_SPIN_CAP) { atomicAdd(&(bar)[XB_TMO], 1u); break; } } } } while (0)
struct XcdBarrier { unsigned* bar; unsigned x; volatile LAS unsigned* st; };
DI XcdBarrier xcd_barrier_post(unsigned* bar, volatile LAS unsigned* st) {
  XcdBarrier b; b.bar = bar; b.x = xb_xcc_id(); b.st = st;
  if (tidx() == 0) (void)xb_add(&bar[XB_XCNT(b.x)], 1u);
  return b;
}
DI void xcd_barrier_complete(unsigned* bar, unsigned x, unsigned& nloc, unsigned& nx) {
  const unsigned G = gridDim.x * gridDim.y * gridDim.z;
  unsigned sum, cnt, mine, sp = 0u;
  for (;;) {
    sum = 0u; cnt = 0u; mine = 0u;
#pragma unroll
    for (unsigned j = 0; j < 16; ++j) { const unsigned c = xb_ld(&bar[XB_XCNT(j)]); sum += c; cnt += (c > 0u) ? 1u : 0u; mine = (j == x) ? c : mine; }
    if (sum == G) break;
    __builtin_amdgcn_s_sleep(1);
    if ((++sp & 255u) == 0u) { if (xb_ld(&bar[XB_TMO])) break; if (sp > XB_SPIN_CAP) { atomicAdd(&bar[XB_TMO], 1u); break; } }
  }
  nloc = mine > 0u ? mine : 1u; nx = cnt > 0u ? cnt : 1u;
}
DI void xcd_barrier(const XcdBarrier& b) {
  asm volatile("s_waitcnt vmcnt(0)" ::: "memory");
  __syncthreads();
  if (tidx() == 0) {
    unsigned* bar = b.bar;
    __builtin_amdgcn_s_waitcnt(0);
    unsigned nloc = b.st[0], nx = b.st[1];
    if (nloc == 0u) { xcd_barrier_complete(bar, b.x, nloc, nx); b.st[0] = nloc; b.st[1] = nx; }
    const unsigned old = xb_add(&bar[XB_XSUB(b.x)], 1u);
    const unsigned gen = old / nloc;
    if (old + 1u == (gen + 1u) * nloc) {
      __builtin_amdgcn_fence(__ATOMIC_RELEASE, "agent");
      asm volatile("s_waitcnt vmcnt(0)" ::: "memory");
      const unsigned og = xb_add(&bar[XB_TOP], 1u);
      const unsigned tg = og / nx;
      if (og + 1u == (tg + 1u) * nx) xb_add(&bar[XB_TOPGEN], 1u);
      else XB_SPIN(xb_ld(&bar[XB_TOPGEN]) == tg, bar);
      __builtin_amdgcn_fence(__ATOMIC_ACQUIRE, "agent");
      xb_add(&bar[XB_XGEN(b.x)], 1u);
      asm volatile("s_waitcnt vmcnt(0)" ::: "memory");
    } else {
      XB_SPIN(xb_ld(&bar[XB_XGEN(b.x)]) == gen, bar);
      __builtin_amdgcn_fence(__ATOMIC_ACQUIRE, "agent");
      asm volatile("s_waitcnt vmcnt(0)" ::: "memory");
    }
  }
  __syncthreads();
}

#ifndef PROBE_K
#define PROBE_K 8
#endif
#ifndef REPMASK
#define REPMASK 0
#endif
#ifndef ONE_LAUNCH
#define ONE_LAUNCH 1
#endif
constexpr int LDS_BYTES = GEMM_LDS + 1024;

#if ONE_LAUNCH
#define BAR_ARG , const XcdBarrier& xb
#define BAR_PASS , xb
#else
#define BAR_ARG
#define BAR_PASS
#endif
template <int PH>
DI void phase_step(unsigned char* lds, int ph_lo, int ph_hi BAR_ARG) {
  if (PH >= ph_lo && PH < ph_hi) {
    const __attribute__((address_space(4))) Params* kp = (const __attribute__((address_space(4))) Params*)__builtin_amdgcn_kernarg_segment_ptr();
    asm volatile("" : "+s"(kp));
    run_phase(*(const Params*)kp, PH, lds, blockIdx.x, gridDim.x);
#if ONE_LAUNCH
    if (PROBE_PH >= 0 && PH + 1 == ph_hi) { asm volatile("s_waitcnt vmcnt(0)" ::: "memory"); __syncthreads(); }
    if (PROBE_PH >= 0 && tidx() == 0 && blockIdx.x == 0 && PH + 1 == ph_hi) ((volatile unsigned long long*)(lds + GEMM_LDS + 528))[PH + 1] = __builtin_amdgcn_s_memrealtime();
    if (PH + 1 < ph_hi) {
      if (PH == 0) cg::this_grid().sync(); else xcd_barrier(xb);
      if ((REPMASK >> 25) & 1) xcd_barrier(xb);
      if (PROBE_PH >= 0 && tidx() == 0 && blockIdx.x == 0) ((volatile unsigned long long*)(lds + GEMM_LDS + 528))[PH + 1] = __builtin_amdgcn_s_memrealtime();
    }
#endif
  }
}

__global__ void __launch_bounds__(512, 2) mega(Params P, int ph_lo, int ph_hi) {
  extern __shared__ __attribute__((aligned(16))) unsigned char lds[];
#if ONE_LAUNCH
  volatile LAS unsigned* st = (volatile LAS unsigned*)(lds + GEMM_LDS + 512);
  if (tidx() < 2) st[tidx()] = 0u;
  __syncthreads();
  XcdBarrier xb = xcd_barrier_post(P.bar, st);
  if (PROBE_PH == -2 && tidx() == 0) *(volatile unsigned long long*)(lds + PROBE_LDS_OFF) = 0ull;
#endif
#if ONE_LAUNCH
  if (PROBE_PH >= 0 && tidx() == 0 && blockIdx.x == 0) ((volatile unsigned long long*)(lds + GEMM_LDS + 528))[0] = __builtin_amdgcn_s_memrealtime();
#endif
#define STEP(N) phase_step<N>(lds, ph_lo, ph_hi BAR_PASS);
  STEP(0) STEP(1) STEP(2) STEP(3) STEP(4) STEP(5) STEP(6) STEP(7) STEP(8) STEP(9)
  STEP(10) STEP(11) STEP(12) STEP(13) STEP(14) STEP(15) STEP(16) STEP(17) STEP(18) STEP(19) STEP(20) STEP(21)
#undef STEP
#if ONE_LAUNCH
  if (PROBE_PH == -2 && tidx() == 0 && blockIdx.x == 0) {
    const unsigned long long dur = *(volatile unsigned long long*)(lds + PROBE_LDS_OFF);
    const unsigned long long until = __builtin_amdgcn_s_memrealtime() + (unsigned long long)PROBE_K * dur;
    while (__builtin_amdgcn_s_memrealtime() < until) __builtin_amdgcn_s_sleep(32);
  }
  if (PROBE_PH >= 0 && tidx() == 0 && blockIdx.x == 0) {
    volatile unsigned long long* ts = (volatile unsigned long long*)(lds + GEMM_LDS + 528);
    const unsigned long long dur = ts[PROBE_PH + 1] - ts[PROBE_PH];
    const unsigned long long until = ts[NPHASE] + (unsigned long long)PROBE_K * dur;
    while (__builtin_amdgcn_s_memrealtime() < until) __builtin_amdgcn_s_sleep(32);
  }
#endif
}

static size_t carve(size_t& off, size_t bytes) { size_t o = off; off = (off + bytes + 255) & ~(size_t)255; return o; }

extern "C" void kernel_launch(void* const* d_in, const int* in_sizes, int n_in, void* d_out, int out_size, void* d_ws, size_t ws_size, hipStream_t stream) {
  static int grid = 0;
  if (grid == 0) {
    int dev = 0, cus = 0, per_cu = 0;
    hipGetDevice(&dev);
    hipDeviceGetAttribute(&cus, hipDeviceAttributeMultiprocessorCount, dev);
    if (hipFuncSetAttribute((const void*)mega, hipFuncAttributeMaxDynamicSharedMemorySize, LDS_BYTES) != hipSuccess) { fprintf(stderr, "kernel_launch: hipFuncSetAttribute failed\n"); }
    hipOccupancyMaxActiveBlocksPerMultiprocessor(&per_cu, (const void*)mega, 512, LDS_BYTES);
    if (per_cu < 1) { fprintf(stderr, "kernel_launch: occupancy query says %d blocks per CU\n", per_cu); per_cu = 1; }
    (void)hipGetLastError();
    grid = cus;
  }
  Params P;
  memset(&P, 0, sizeof(P));
  P.pad0 = REPMASK;
  const float** in = (const float**)&P;
  for (int i = 0; i < 39 && i < n_in; ++i) in[i] = (const float*)d_in[i];
  P.out = (float*)d_out;
  char* ws = (char*)d_ws;
  size_t off = 0;
  P.bar = (unsigned*)(ws + carve(off, XCD_BAR_WORDS * 4));
  P.mods = (float*)(ws + carve(off, 2 * 5 * 6144 * 4));
  P.ropeM = (float*)(ws + carve(off, 128 * 8 * 2 * 4));
  P.ropeS = (float*)(ws + carve(off, 128 * 16 * 2 * 4));
  P.msh = (float*)(ws + carve(off, 64));
  P.win0t = (bf16*)(ws + carve(off, (size_t)1792 * 1024 * 2));
  P.wqt = (bf16*)(ws + carve(off, (size_t)768 * 384 * 2));
  P.wkvt = (bf16*)(ws + carve(off, (size_t)1024 * 256 * 2));
  P.wout0t = (bf16*)(ws + carve(off, (size_t)1024 * 1024 * 2));
  P.win1t = (bf16*)(ws + carve(off, (size_t)2432 * 1024 * 2));
  P.wout1t = (bf16*)(ws + carve(off, (size_t)1024 * 1024 * 2));
  P.wlrut = (bf16*)(ws + carve(off, (size_t)32 * 4096 * 2));
  P.wgut = (bf16*)(ws + carve(off, (size_t)32 * 1024 * 1024 * 2));
  P.wdt = (bf16*)(ws + carve(off, (size_t)32 * 1024 * 512 * 2));
  P.wrt = (bf16*)(ws + carve(off, (size_t)64 * 3072 * 2));
  P.ut = P.wgut;
  P.xc = (float*)(ws + carve(off, (size_t)NC * 1024 * 4));
  P.h = (bf16*)(ws + carve(off, (size_t)NT * 1024 * 2));
  P.cbuf = (bf16*)(ws + carve(off, (size_t)NT * C2LD * 2));
  P.qkv = (bf16*)(ws + carve(off, QKV_ELEMS * 2));
  P.ycat = (bf16*)(ws + carve(off, (size_t)NT * 1024 * 2));
  P.ssqc = (float*)(ws + carve(off, (size_t)NT * 16 * 4));
  P.ssqx = (float*)(ws + carve(off, (size_t)NT * 16 * 4));
  P.ssq2 = (float*)(ws + carve(off, (size_t)NT * 8 * 4));
  P.comp = (float*)(ws + carve(off, (size_t)NB * 2 * LCH * 512 * 2 * 4));
  P.gcomp = (float*)(ws + carve(off, (size_t)NB * 2 * LGR * 512 * 2 * 4));
  P.dtr = (float*)(ws + carve(off, (size_t)NT * 16 * 4));
  P.cst = (float*)(ws + carve(off, (size_t)NB * 16 * NPOS * 4));
  P.dtt = (float*)(ws + carve(off, (size_t)NB * 16 * NPOS * 4));
  P.wgp = (float*)(ws + carve(off, (size_t)NB * 16 * NPOS * 4));
  P.cnt = (int*)(ws + carve(off, 64 * 4));
  P.cntt = (int*)(ws + carve(off, (size_t)2048 * 32 * 4));
  P.tokinfo = (int*)(ws + carve(off, (size_t)NT * 4 * 4));
  P.tokw = (float*)(ws + carve(off, (size_t)NT * 2 * 4));
  P.list = (int*)(ws + carve(off, (size_t)32 * NT * 4));
  if (off > ws_size || n_in != 39 || out_size != NL * 1024) {
    fprintf(stderr, "kernel_launch: needs %zu bytes of workspace (got %zu), 39 inputs (got %d), out %d (got %d); nothing launched\n", off, ws_size, n_in, NL * 1024, out_size);
    return;
  }
#if ONE_LAUNCH
  hipMemsetAsync(P.bar, 0, XCD_BAR_WORDS * 4, stream);
  int lo = 0, hi = NPHASE;
  void* args[] = {&P, &lo, &hi};
  hipError_t e = hipLaunchCooperativeKernel((const void*)mega, dim3(grid), dim3(512), args, LDS_BYTES, stream);
  if (e != hipSuccess) fprintf(stderr, "kernel_launch: cooperative launch failed: %s (grid %d)\n", hipGetErrorString(e), grid);
#else
  for (int ph = 0; ph < NPHASE; ++ph) hipLaunchKernelGGL(mega, dim3(grid), dim3(512), LDS_BYTES, stream, P, ph, ph + 1);
#endif
}
```

```cpp
#define REPMASK 0
#define PROBE_PH (-1)
#define PROBE_SEC 0
#include <hip/hip_runtime.h>
#include <hip/hip_cooperative_groups.h>
#include <cstdio>
#include <cstdint>
#include <cstring>
namespace cg = cooperative_groups;

#define DI __device__ __forceinline__
typedef unsigned short bf16;
typedef __attribute__((ext_vector_type(8))) short bf16x8;
typedef __attribute__((ext_vector_type(16))) float f32x16;
typedef __attribute__((ext_vector_type(8))) float f32x8;
typedef __attribute__((ext_vector_type(4))) float f32x4;
typedef __attribute__((ext_vector_type(2))) float f32x2;
typedef __attribute__((ext_vector_type(4))) unsigned u32x4;
typedef __attribute__((ext_vector_type(2))) unsigned u32x2;
typedef __attribute__((ext_vector_type(2))) __bf16 bfx2;
typedef __attribute__((ext_vector_type(8))) __bf16 bfx8;

constexpr int D = 1024, NB = 4, SEQ = 8192, LC = 256;
constexpr int NL = NB * SEQ;
constexpr int NC = NB * LC;
constexpr int NT = NL + NC;
constexpr int NPOS = SEQ + LC;
constexpr int C1LD = 1696, C2LD = 2320;
constexpr int NCH = 66;
constexpr float EPS = 1e-6f;
constexpr float LOG2E = 1.4426950408889634f;
constexpr int NSLOT = 2 * NT;

#ifndef PROBE_PH
#define PROBE_PH (-1)
#endif
#ifndef PROBE_SEC
#define PROBE_SEC 0
#endif
#define PROBE_LDS_OFF (147456 + 800)
#define PB_BEGIN(SEC, lds_) unsigned long long pb_t0_##SEC = 0; if (PROBE_PH == -2 && PROBE_SEC == SEC && blockIdx.x == 0) { __syncthreads(); pb_t0_##SEC = __builtin_amdgcn_s_memrealtime(); }
#define PB_END(SEC, lds_) if (PROBE_PH == -2 && PROBE_SEC == SEC && blockIdx.x == 0) { __syncthreads(); if (threadIdx.x == 0) *(volatile unsigned long long*)((unsigned char*)(lds_) + PROBE_LDS_OFF) += __builtin_amdgcn_s_memrealtime() - pb_t0_##SEC; }
#define PBW_BEGIN(SEC, lds_) unsigned long long pbw_t0_##SEC = 0; if (PROBE_PH == -2 && PROBE_SEC == SEC && blockIdx.x == 0 && threadIdx.x < 64) { pbw_t0_##SEC = __builtin_amdgcn_s_memrealtime(); }
#define PBW_END(SEC, lds_) if (PROBE_PH == -2 && PROBE_SEC == SEC && blockIdx.x == 0 && threadIdx.x == 0) { *(volatile unsigned long long*)((unsigned char*)(lds_) + PROBE_LDS_OFF) += __builtin_amdgcn_s_memrealtime() - pbw_t0_##SEC; }
DI int tidx() { int t = threadIdx.x; asm volatile("" : "+v"(t)); return t; }
DI float bf2f(bf16 u) { return __uint_as_float(((unsigned)u) << 16); }
DI float lo16(unsigned u) { return __uint_as_float(u << 16); }
DI float hi16(unsigned u) { return __uint_as_float(u & 0xffff0000u); }
DI unsigned pack2(float a, float b) { f32x2 v = {a, b}; bfx2 r = __builtin_convertvector(v, bfx2); return __builtin_bit_cast(unsigned, r); }
DI bf16 f2bf(float x) { return (bf16)(pack2(x, 0.f) & 0xffffu); }
DI bf16x8 pack8(const float (&v)[8]) { f32x8 t; for (int i = 0; i < 8; ++i) t[i] = v[i]; bfx8 r = __builtin_convertvector(t, bfx8); return __builtin_bit_cast(bf16x8, r); }
DI u32x2 pack4(float a, float b, float c, float d) { u32x2 r; r[0] = pack2(a, b); r[1] = pack2(c, d); return r; }
DI void unpack8(u32x4 raw, float (&v)[8]) { for (int i = 0; i < 4; ++i) { v[2 * i] = lo16(raw[i]); v[2 * i + 1] = hi16(raw[i]); } }
DI int crow(int i, int h) { return (i & 3) + 8 * (i >> 2) + 4 * h; }
DI int swap23(int p) { return (p & ~12) | ((p & 4) << 1) | ((p & 8) >> 1); }
DI f32x16 mfma32(bf16x8 a, bf16x8 b, f32x16 c) { return __builtin_amdgcn_mfma_f32_32x32x16_bf16(a, b, c, 0, 0, 0); }
DI f32x4 mfma16(bf16x8 a, bf16x8 b, f32x4 c) { return __builtin_amdgcn_mfma_f32_16x16x32_bf16(a, b, c, 0, 0, 0); }
DI float rcpf_(float x) { return __builtin_amdgcn_rcpf(x); }
DI float sigmoidf_(float x) { return rcpf_(1.f + __expf(-x)); }
DI float siluf_(float x) { return x * rcpf_(1.f + __expf(-x)); }
DI float softplusf_(float x) { return x > 20.f ? x : log1pf(__expf(x)); }
DI float geluf_(float x) { float u = 0.7978845608028654f * (x + 0.044715f * x * x * x); float t = 1.f - 2.f * rcpf_(1.f + __expf(2.f * u)); return 0.5f * x * (1.f + t); }
DI float xor32(float v) { return v + __shfl_xor(v, 32); }
DI float wave_sum(float v) { for (int o = 32; o >= 1; o >>= 1) v += __shfl_xor(v, o); return v; }

DI void tok_info(int tok, int& bmod, int& b, int& pos, bool& lat) {
  if (tok < NL) { b = tok >> 13; bmod = b; pos = LC + (tok & (SEQ - 1)); lat = true; }
  else { int t = tok - NL; b = t >> 8; bmod = 4; pos = t & (LC - 1); lat = false; }
}

struct Params {
  const float *x, *c, *ctx, *c_ctx, *ada_w, *ada_b, *norm1_g, *norm2_g;
  const float *ab_w_in, *ab_w_out, *mla_q_norm_g, *mla_w_q_up, *mla_kv_norm_g, *mla_w_kv_up, *mla_q_head_g, *mla_k_head_g;
  const float *lru_conv_w, *lru_conv_b, *lru_w_a, *lru_b_a, *lru_w_x, *lru_b_x, *lru_lambda;
  const float *cd_w_in, *cd_w_out, *swa_q_head_g, *swa_k_head_g, *swa_sink;
  const float *ssd_conv_w, *ssd_conv_b, *ssd_a_log, *ssd_dt_bias, *ssd_d, *ssd_norm_g;
  const float *router_w, *router_b, *moe_w_gate, *moe_w_up, *moe_w_down;
  float* out;
  float* mods;
  float* ropeM;
  float* ropeS;
  float* msh;
  bf16 *win0t, *wqt, *wkvt, *wout0t, *win1t, *wout1t, *wlrut, *wgut, *wdt, *wrt;
  float* xc;
  bf16* h;
  bf16* cbuf;
  bf16* qkv;
  bf16* ycat;
  bf16* ut;
  float *ssqc, *ssqx, *ssq2;
  float* comp;
  float* gcomp;
  float* dtr;
  float *cst, *dtt, *wgp;
  int* cnt;
  int* cntt;
  int* tokinfo;
  float* tokw;
  int* list;
  unsigned* bar;
  int pad0;
  int pad1;
};
constexpr size_t QB_OFF = 0, KB_OFF = (size_t)NB * 8 * NPOS * 96, VT_OFF = 2 * KB_OFF;
constexpr size_t Q2_OFF = 0, K2_OFF = (size_t)NB * 8 * NPOS * 64, V2T_OFF = K2_OFF + (size_t)NB * 2 * NPOS * 64,
                 ST_OFF = V2T_OFF + (size_t)NB * 2 * 64 * NPOS;
constexpr size_t QKV_ELEMS = (size_t)NSLOT * 1024;
static_assert(VT_OFF + (size_t)NB * 8 * 64 * NPOS <= QKV_ELEMS, "qkv region");
static_assert(ST_OFF + (size_t)NB * 2 * 8 * NCH * 64 * 128 <= QKV_ELEMS, "qkv region L1");
#define LAS3 __attribute__((address_space(3)))
template <int WM, int WN, bool ZERO = true, class PRow, class QRow>
DI void gemm_core(bf16* smem, int K, int krot, PRow prow, QRow qrow, f32x16 (&acc)[WM][WN], int hook_kt, const float (&hs)[WN]) {
  constexpr int TP = 64 * WM, TQ = 128 * WN, NR = TP + TQ, NCHK = NR / 64, STAGE = NR * 64;
  const int tid = tidx(), lane = tid & 63, wid = tid >> 6, wr = wid >> 2, wc = wid & 3, r = lane & 31, h = lane >> 5;
  const bf16* ps[NCHK];
#pragma unroll
  for (int j = 0; j < NCHK; ++j) {
    const int R = j * 64 + (tid >> 3);
    const int cs = (tid & 7) ^ ((R >> 1) & 7);
    ps[j] = (j < WM ? prow(R) : qrow(R - TP)) + cs * 8;
  }
  const int nkt = K >> 6;
  if (ZERO) {
#pragma unroll
    for (int i = 0; i < WM; ++i)
#pragma unroll
      for (int j = 0; j < WN; ++j)
#pragma unroll
        for (int e = 0; e < 16; ++e) acc[i][j][e] = 0.f;
  }
  {
    const int ko = (krot % nkt) * 64;
#pragma unroll
    for (int j = 0; j < NCHK; ++j)
      __builtin_amdgcn_global_load_lds((const unsigned*)(ps[j] + ko), (LAS3 unsigned*)(smem + (j * 512 + wid * 64) * 8), 16, 0, 0);
  }
  asm volatile("s_waitcnt vmcnt(0)" ::: "memory");
  __syncthreads();
  const int sw = (r >> 1) & 7;
  for (int kt = 0; kt < nkt; ++kt) {
    const int buf = kt & 1;
    if (kt + 1 < nkt) {
      const int ko = ((kt + 1 + krot) % nkt) * 64;
#pragma unroll
      for (int j = 0; j < NCHK; ++j)
        __builtin_amdgcn_global_load_lds((const unsigned*)(ps[j] + ko), (LAS3 unsigned*)(smem + (buf ^ 1) * STAGE + (j * 512 + wid * 64) * 8), 16, 0, 0);
    }
    if (kt == hook_kt) {
#pragma unroll
      for (int i = 0; i < WM; ++i)
#pragma unroll
        for (int j = 0; j < WN; ++j)
#pragma unroll
          for (int e = 0; e < 16; ++e) acc[i][j][e] *= hs[j];
    }
    const bf16* sP = smem + buf * STAGE + (wr * WM * 32 + r) * 64;
    const bf16* sQ = smem + buf * STAGE + (TP + wc * WN * 32 + r) * 64;
    bf16x8 a[2][WM], b[2][WN];
    {
      const int co = (h ^ sw) * 8;
#pragma unroll
      for (int i = 0; i < WM; ++i) a[0][i] = *(const bf16x8*)(sP + i * 32 * 64 + co);
#pragma unroll
      for (int j = 0; j < WN; ++j) b[0][j] = *(const bf16x8*)(sQ + j * 32 * 64 + co);
    }
#pragma unroll
    for (int ks = 0; ks < 4; ++ks) {
      if (ks < 3) {
        const int co = (((ks + 1) * 2 + h) ^ sw) * 8;
#pragma unroll
        for (int i = 0; i < WM; ++i) a[(ks + 1) & 1][i] = *(const bf16x8*)(sP + i * 32 * 64 + co);
#pragma unroll
        for (int j = 0; j < WN; ++j) b[(ks + 1) & 1][j] = *(const bf16x8*)(sQ + j * 32 * 64 + co);
      }
#pragma unroll
      for (int i = 0; i < WM; ++i)
#pragma unroll
        for (int j = 0; j < WN; ++j) acc[i][j] = mfma32(a[ks & 1][i], b[ks & 1][j], acc[i][j]);
      if (ks < 3) {
#pragma unroll
        for (int n = 0; n < WM + WN; ++n) { __builtin_amdgcn_sched_group_barrier(0x008, 1, 0); __builtin_amdgcn_sched_group_barrier(0x100, 1, 0); }
        __builtin_amdgcn_sched_group_barrier(0x008, WM * WN - (WM + WN), 0);
      }
    }
    asm volatile("s_waitcnt vmcnt(0)" ::: "memory");
    __syncthreads();
  }
}

struct WaveId { int lane, wid, wr, wc, r, h; };
template <int WM, int WN>
DI void epi_to_lds(bf16* sT, int lane_r, int lane_h, int wr, int wc, int i, int j, int g, float a0, float a1, float a2, float a3) {
  constexpr int LDT = 64 * WM + 8;
  *(u32x2*)(sT + (wc * WN * 32 + j * 32 + lane_r) * LDT + wr * WM * 32 + i * 32 + 8 * g + 4 * lane_h) = pack4(a0, a1, a2, a3);
}
DI WaveId wave_id() { WaveId w; w.lane = tidx() & 63; w.wid = tidx() >> 6; w.wr = w.wid >> 2; w.wc = w.wid & 3; w.r = w.lane & 31; w.h = w.lane >> 5; return w; }

DI void gemm_c1_item(const Params& P, bf16* smem, int pt, int qt) {
  f32x16 acc[4][2];
  const float hs[2] = {1.f, 1.f};
  const int p0 = pt * 256, q0 = qt * 256;
  gemm_core<4, 2>(smem, 1024, 0,
      [&](int rp) { return P.win0t + (size_t)(p0 + rp) * 1024; },
      [&](int rq) { return P.h + (size_t)(q0 + rq) * 1024; }, acc, -1, hs);
  const WaveId w = wave_id();
#pragma unroll
  for (int j = 0; j < 2; ++j) {
    const int tok = q0 + w.wc * 64 + j * 32 + w.r;
#pragma unroll
    for (int i2 = 0; i2 < 2; ++i2) {
      const int grp = (p0 + w.wr * 128 + i2 * 64) >> 6;
      float ss = 0.f;
#pragma unroll
      for (int ii = 0; ii < 2; ++ii)
#pragma unroll
        for (int g = 0; g < 4; ++g) {
          const int i = i2 * 2 + ii;
          const float a0 = acc[i][j][4 * g], a1 = acc[i][j][4 * g + 1], a2 = acc[i][j][4 * g + 2], a3 = acc[i][j][4 * g + 3];
          ss += a0 * a0 + a1 * a1 + a2 * a2 + a3 * a3;
          epi_to_lds<4, 2>(smem, w.r, w.h, w.wr, w.wc, i, j, g, a0, a1, a2, a3);
        }
      ss = xor32(ss);
      if (w.h == 0 && grp < 10) P.ssqc[tok * 16 + grp] = ss;
    }
  }
  __syncthreads();
  {
    const int tid = tidx(), c = tid & 31, rr = tid >> 5;
    if (p0 + c * 8 < C1LD) {
#pragma unroll
      for (int ps_ = 0; ps_ < 16; ++ps_) {
        const int row = rr + 16 * ps_;
        *(u32x4*)(P.cbuf + (size_t)(q0 + row) * C1LD + p0 + c * 8) = *(const u32x4*)(smem + row * 264 + c * 8);
      }
    }
  }
  __syncthreads();
}

#define rope_pair(X1, X2, TAB) do { const float* tb_ = (TAB); const float cs_ = tb_[0], sn_ = tb_[1]; const float a_ = (X1) * cs_ - (X2) * sn_, b_ = (X1) * sn_ + (X2) * cs_; (X1) = a_; (X2) = b_; } while (0)

DI void gemm_q_item(const Params& P, bf16* smem, int pt, int qt) {
  f32x16 acc[3][1];
  const float hs[1] = {1.f};
  const int p0 = pt * 192, q0 = qt * 128;
  gemm_core<3, 1>(smem, 384, 0,
      [&](int rp) { return P.wqt + (size_t)(p0 + rp) * 384; },
      [&](int rq) { return P.cbuf + (size_t)(q0 + rq) * C1LD; }, acc, -1, hs);
  const WaveId w = wave_id();
  const int hd = pt * 2 + w.wr;
  const float qscale = 0.10206207261596575f * LOG2E;
#pragma unroll
  for (int j = 0; j < 1; ++j) {
    const int tok = q0 + w.wc * 32 + w.r;
    int bmod, b, pos; bool lat; tok_info(tok, bmod, b, pos, lat);
    float s6 = 0.f;
    for (int g = 0; g < 6; ++g) s6 += P.ssqc[tok * 16 + g];
    const float rstd = rsqrtf(s6 * (1.f / 384.f) + EPS);
    float ss = 0.f;
#pragma unroll
    for (int i = 0; i < 3; ++i)
#pragma unroll
      for (int e = 0; e < 16; ++e) { acc[i][j][e] *= rstd; ss += acc[i][j][e] * acc[i][j][e]; }
    ss = xor32(ss);
    const float r2 = rsqrtf(ss * (1.f / 96.f) + EPS);
#pragma unroll
    for (int i = 0; i < 3; ++i)
#pragma unroll
      for (int g = 0; g < 4; ++g) {
        const f32x4 gg = *(const f32x4*)(P.mla_q_head_g + i * 32 + 8 * g + 4 * w.h);
#pragma unroll
        for (int e = 0; e < 4; ++e) acc[i][j][4 * g + e] *= r2 * gg[e];
      }
    if (lat) {
      const int sq = tok & (SEQ - 1), rowp = sq >> 6, colp = sq & 63;
#pragma unroll
      for (int e = 0; e < 4; ++e) {
        rope_pair(acc[2][j][e], acc[2][j][4 + e], P.ropeM + (rowp * 8 + 4 * w.h + e) * 2);
        rope_pair(acc[2][j][8 + e], acc[2][j][12 + e], P.ropeM + (colp * 8 + 4 * w.h + e) * 2);
      }
    }
    bf16* dst = P.qkv + QB_OFF + ((size_t)(b * 8 + hd) * NPOS + pos) * 96;
#pragma unroll
    for (int i = 0; i < 3; ++i)
#pragma unroll
      for (int g = 0; g < 4; ++g)
        *(u32x2*)(dst + i * 32 + 8 * g + 4 * w.h) = pack4(acc[i][j][4 * g] * qscale, acc[i][j][4 * g + 1] * qscale, acc[i][j][4 * g + 2] * qscale, acc[i][j][4 * g + 3] * qscale);
  }
}

DI void gemm_kv_item(const Params& P, bf16* smem, int pt, int qt) {
  f32x16 acc[4][1];
  const float hs[1] = {1.f};
  const int p0 = pt * 256, q0 = qt * 128;
  gemm_core<4, 1>(smem, 256, 0,
      [&](int rp) { return P.wkvt + (size_t)(p0 + rp) * 256; },
      [&](int rq) { return P.cbuf + (size_t)(q0 + rq) * C1LD + 384; }, acc, -1, hs);
  const WaveId w = wave_id();
  const int hd = pt * 2 + w.wr;
#pragma unroll
  for (int j = 0; j < 1; ++j) {
    const int tok = q0 + w.wc * 32 + w.r;
    int bmod, b, pos; bool lat; tok_info(tok, bmod, b, pos, lat);
    float s4 = 0.f;
    for (int g = 6; g < 10; ++g) s4 += P.ssqc[tok * 16 + g];
    const float rstd = rsqrtf(s4 * (1.f / 256.f) + EPS);
    float kr[16];
    {
      const bf16* src = P.cbuf + (size_t)tok * C1LD + 640 + 16 * w.h;
      float t8[8];
      unpack8(*(const u32x4*)src, t8);
      for (int i = 0; i < 8; ++i) kr[i] = t8[i];
      unpack8(*(const u32x4*)(src + 8), t8);
      for (int i = 0; i < 8; ++i) kr[8 + i] = t8[i];
    }
    float ss = 0.f;
#pragma unroll
    for (int i = 0; i < 2; ++i)
#pragma unroll
      for (int e = 0; e < 16; ++e) { acc[i][j][e] *= rstd; ss += acc[i][j][e] * acc[i][j][e]; }
#pragma unroll
    for (int i = 0; i < 16; ++i) ss += kr[i] * kr[i];
    ss = xor32(ss);
    const float r2 = rsqrtf(ss * (1.f / 96.f) + EPS);
    bf16* dst = P.qkv + KB_OFF + ((size_t)(b * 8 + hd) * NPOS + pos) * 96;
#pragma unroll
    for (int i = 0; i < 2; ++i)
#pragma unroll
      for (int g = 0; g < 4; ++g) {
        const f32x4 gg = *(const f32x4*)(P.mla_k_head_g + i * 32 + 8 * g + 4 * w.h);
        *(u32x2*)(dst + i * 32 + 8 * g + 4 * w.h) = pack4(acc[i][j][4 * g] * r2 * gg[0], acc[i][j][4 * g + 1] * r2 * gg[1], acc[i][j][4 * g + 2] * r2 * gg[2], acc[i][j][4 * g + 3] * r2 * gg[3]);
      }
#pragma unroll
    for (int i = 0; i < 16; ++i) kr[i] *= r2 * P.mla_k_head_g[64 + 16 * w.h + i];
    if (lat) {
      const int sq = tok & (SEQ - 1);
      const int pp = w.h ? (sq & 63) : (sq >> 6);
#pragma unroll
      for (int i = 0; i < 8; ++i) rope_pair(kr[i], kr[8 + i], P.ropeM + (pp * 8 + i) * 2);
    }
    {
      u32x4 o0, o1;
      for (int i = 0; i < 4; ++i) { o0[i] = pack2(kr[2 * i], kr[2 * i + 1]); o1[i] = pack2(kr[8 + 2 * i], kr[8 + 2 * i + 1]); }
      *(u32x4*)(dst + 64 + 16 * w.h) = o0;
      *(u32x4*)(dst + 64 + 16 * w.h + 8) = o1;
    }
    const int posp = (pos & ~15) | swap23(pos & 15);
    bf16* vdst = P.qkv + VT_OFF + (size_t)(b * 8 + hd) * 64 * NPOS + posp;
#pragma unroll
    for (int i = 0; i < 2; ++i)
#pragma unroll
      for (int e = 0; e < 16; ++e) vdst[(size_t)(i * 32 + crow(e, w.h)) * NPOS] = f2bf(acc[2 + i][j][e] * rstd);
  }
}

template <int WM>
DI void gemm_out_item(const Params& P, bf16* smem, int layer, int pt, int qt) {
  f32x16 acc[WM][2];
  const int p0 = pt * 64 * WM, q0 = qt * 256;
  const WaveId w = wave_id();
  float hs[2] = {1.f, 1.f};
  if (layer == 1) {
#pragma unroll
    for (int j = 0; j < 2; ++j) {
      const int tok = q0 + w.wc * 64 + j * 32 + w.r;
      float s = 0.f;
      for (int g = 0; g < 8; ++g) s += P.ssq2[tok * 8 + g];
      hs[j] = rsqrtf(s * (1.f / 512.f) + EPS);
    }
  }
  const bf16* wt = layer ? P.wout1t : P.wout0t;
  gemm_core<WM, 2>(smem, 1024, layer ? 8 : 0,
      [&](int rp) { return wt + (size_t)(p0 + rp) * 1024; },
      [&](int rq) { return P.ycat + (size_t)(q0 + rq) * 1024; }, acc, layer ? 8 : -1, hs);
#pragma unroll
  for (int j = 0; j < 2; ++j) {
    const int tok = q0 + w.wc * 64 + j * 32 + w.r;
    int bmod, b, pos; bool lat; tok_info(tok, bmod, b, pos, lat);
    const float* src = layer ? (P.out + (size_t)tok * 1024) : (lat ? P.x + (size_t)tok * 1024 : P.ctx + (size_t)(tok - NL) * 1024);
    float* dst = lat ? P.out + (size_t)tok * 1024 : P.xc + (size_t)(tok - NL) * 1024;
    const float* m2 = P.mods + ((size_t)(layer * 5 + bmod) * 6 + 2) * 1024;
#pragma unroll
    for (int i = 0; i < WM; ++i)
#pragma unroll
      for (int g = 0; g < 4; ++g) {
        const int f0 = p0 + w.wr * 32 * WM + i * 32 + 8 * g + 4 * w.h;
        const f32x4 xv = *(const f32x4*)(src + f0);
        const f32x4 mv = *(const f32x4*)(m2 + f0);
        f32x4 o;
#pragma unroll
        for (int e = 0; e < 4; ++e) o[e] = xv[e] + mv[e] * acc[i][j][4 * g + e];
        *(f32x4*)(dst + f0) = o;
        if (g == 3) __builtin_amdgcn_sched_barrier(0);
      }
  }
}

DI void moe1_item(const Params& P, bf16* smem, int layer, int e, int m0, int pt, int cnt_e, int off_e) {
  f32x16 acc[4][2];
  const float hs[2] = {1.f, 1.f};
  const int* lst = P.list + (size_t)e * NT;
  gemm_core<4, 2>(smem, 1024, 0,
      [&](int rp) { return P.wgut + ((size_t)e * 1024 + pt * 256 + rp) * 1024; },
      [&](int rq) { int m = m0 + rq; if (m > cnt_e - 1) m = cnt_e - 1; return P.h + (size_t)lst[m] * 1024; }, acc, -1, hs);
  const WaveId w = wave_id();
  constexpr int LDT = 136;
#pragma unroll
  for (int j = 0; j < 2; ++j) {
    const int row = w.wc * 64 + j * 32 + w.r;
#pragma unroll
    for (int i2 = 0; i2 < 2; ++i2)
#pragma unroll
      for (int g = 0; g < 4; ++g) {
        float o[4];
#pragma unroll
        for (int k = 0; k < 4; ++k) o[k] = siluf_(acc[2 * i2][j][4 * g + k]) * acc[2 * i2 + 1][j][4 * g + k];
        *(u32x2*)(smem + row * LDT + w.wr * 64 + i2 * 32 + 8 * g + 4 * w.h) = pack4(o[0], o[1], o[2], o[3]);
      }
  }
  __syncthreads();
  {
    const int tid = tidx(), c = tid & 15, rr = tid >> 4;
#pragma unroll
    for (int ps_ = 0; ps_ < 8; ++ps_) {
      const int row = rr + 32 * ps_;
      if (m0 + row < cnt_e) *(u32x4*)(P.cbuf + (size_t)(off_e + m0 + row) * 512 + pt * 128 + c * 8) = *(const u32x4*)(smem + row * LDT + c * 8);
    }
  }
  __syncthreads();
}
DI void moe2_item(const Params& P, bf16* smem, int e, int m0, int pt, int cnt_e, int off_e, int total) {
  f32x16 acc[4][2];
  const float hs[2] = {1.f, 1.f};
  gemm_core<4, 2>(smem, 512, 0,
      [&](int rp) { return P.wdt + ((size_t)e * 1024 + pt * 256 + rp) * 512; },
      [&](int rq) { int s = off_e + m0 + rq; if (s > total - 1) s = total - 1; return P.cbuf + (size_t)s * 512; }, acc, -1, hs);
  const WaveId w = wave_id();
#pragma unroll
  for (int j = 0; j < 2; ++j)
#pragma unroll
    for (int i = 0; i < 4; ++i)
#pragma unroll
      for (int g = 0; g < 4; ++g) epi_to_lds<4, 2>(smem, w.r, w.h, w.wr, w.wc, i, j, g, acc[i][j][4 * g], acc[i][j][4 * g + 1], acc[i][j][4 * g + 2], acc[i][j][4 * g + 3]);
  __syncthreads();
  {
    const int tid = tidx(), c = tid & 31, rr = tid >> 5;
#pragma unroll
    for (int ps_ = 0; ps_ < 16; ++ps_) {
      const int row = rr + 16 * ps_;
      if (m0 + row < cnt_e) *(u32x4*)(P.qkv + (size_t)(off_e + m0 + row) * 1024 + pt * 256 + c * 8) = *(const u32x4*)(smem + row * 264 + c * 8);
    }
  }
  __syncthreads();
}

DI void moe1_half(const Params& P, bf16* smem, int layer, int e, int m0, int pt2, int cnt_e, int off_e) {
  f32x16 acc[2][2];
  const float hs[2] = {1.f, 1.f};
  const int* lst = P.list + (size_t)e * NT;
  gemm_core<2, 2>(smem, 1024, 0,
      [&](int rp) { return P.wgut + ((size_t)e * 1024 + pt2 * 128 + rp) * 1024; },
      [&](int rq) { int m = m0 + rq; if (m > cnt_e - 1) m = cnt_e - 1; return P.h + (size_t)lst[m] * 1024; }, acc, -1, hs);
  const WaveId w = wave_id();
  constexpr int LDT = 72;
#pragma unroll
  for (int j = 0; j < 2; ++j) {
    const int row = w.wc * 64 + j * 32 + w.r;
#pragma unroll
    for (int g = 0; g < 4; ++g) {
      float o[4];
#pragma unroll
      for (int k = 0; k < 4; ++k) o[k] = siluf_(acc[0][j][4 * g + k]) * acc[1][j][4 * g + k];
      *(u32x2*)(smem + row * LDT + w.wr * 32 + 8 * g + 4 * w.h) = pack4(o[0], o[1], o[2], o[3]);
    }
  }
  __syncthreads();
  {
    const int tid = tidx(), c = tid & 7, rr = tid >> 3;
#pragma unroll
    for (int ps_ = 0; ps_ < 4; ++ps_) {
      const int row = rr + 64 * ps_;
      if (m0 + row < cnt_e) *(u32x4*)(P.cbuf + (size_t)(off_e + m0 + row) * 512 + pt2 * 64 + c * 8) = *(const u32x4*)(smem + row * LDT + c * 8);
    }
  }
  __syncthreads();
}
DI void moe2_half(const Params& P, bf16* smem, int e, int m0, int pt2, int cnt_e, int off_e, int total) {
  f32x16 acc[2][2];
  const float hs[2] = {1.f, 1.f};
  gemm_core<2, 2>(smem, 512, 0,
      [&](int rp) { return P.wdt + ((size_t)e * 1024 + pt2 * 128 + rp) * 512; },
      [&](int rq) { int s = off_e + m0 + rq; if (s > total - 1) s = total - 1; return P.cbuf + (size_t)s * 512; }, acc, -1, hs);
  const WaveId w = wave_id();
#pragma unroll
  for (int j = 0; j < 2; ++j)
#pragma unroll
    for (int i = 0; i < 2; ++i)
#pragma unroll
      for (int g = 0; g < 4; ++g) epi_to_lds<2, 2>(smem, w.r, w.h, w.wr, w.wc, i, j, g, acc[i][j][4 * g], acc[i][j][4 * g + 1], acc[i][j][4 * g + 2], acc[i][j][4 * g + 3]);
  __syncthreads();
  {
    const int tid = tidx(), c = tid & 15, rr = tid >> 4;
#pragma unroll
    for (int ps_ = 0; ps_ < 8; ++ps_) {
      const int row = rr + 32 * ps_;
      if (m0 + row < cnt_e) *(u32x4*)(P.qkv + (size_t)(off_e + m0 + row) * 1024 + pt2 * 128 + c * 8) = *(const u32x4*)(smem + row * 136 + c * 8);
    }
  }
  __syncthreads();
}

DI void c2_block_epilogue(const Params& P, const WaveId& w, int fb, int tok, f32x16& a0, f32x16& a1) {
  int bmod, b, pos; bool lat; tok_info(tok, bmod, b, pos, lat);
  const float qscale = 0.125f * LOG2E;
  if (fb < 10) {
    const bool isq = fb < 8;
    const float* gain = isq ? P.swa_q_head_g : P.swa_k_head_g;
    float ss = 0.f;
#pragma unroll
    for (int e = 0; e < 16; ++e) ss += a0[e] * a0[e] + a1[e] * a1[e];
    ss = xor32(ss);
    const float r2 = rsqrtf(ss * (1.f / 64.f) + EPS);
#pragma unroll
    for (int g = 0; g < 4; ++g) {
      const f32x4 g0 = *(const f32x4*)(gain + 8 * g + 4 * w.h), g1 = *(const f32x4*)(gain + 32 + 8 * g + 4 * w.h);
#pragma unroll
      for (int e = 0; e < 4; ++e) { a0[4 * g + e] *= r2 * g0[e]; a1[4 * g + e] *= r2 * g1[e]; }
    }
    if (lat) {
      const int sq = tok & (SEQ - 1), rowp = sq >> 6, colp = sq & 63;
#pragma unroll
      for (int e = 0; e < 4; ++e) {
        rope_pair(a0[e], a0[8 + e], P.ropeS + (rowp * 16 + 4 * w.h + e) * 2);
        rope_pair(a0[4 + e], a0[12 + e], P.ropeS + (rowp * 16 + 8 + 4 * w.h + e) * 2);
        rope_pair(a1[e], a1[8 + e], P.ropeS + (colp * 16 + 4 * w.h + e) * 2);
        rope_pair(a1[4 + e], a1[12 + e], P.ropeS + (colp * 16 + 8 + 4 * w.h + e) * 2);
      }
    }
    if (isq && !lat) return;
    const float sc = isq ? qscale : 1.f;
    bf16* dst = isq ? P.qkv + Q2_OFF + ((size_t)(b * 8 + fb) * NPOS + pos) * 64
                    : P.qkv + K2_OFF + ((size_t)(b * 2 + (fb - 8)) * NPOS + pos) * 64;
#pragma unroll
    for (int g = 0; g < 4; ++g) {
      *(u32x2*)(dst + 8 * g + 4 * w.h) = pack4(a0[4 * g] * sc, a0[4 * g + 1] * sc, a0[4 * g + 2] * sc, a0[4 * g + 3] * sc);
      *(u32x2*)(dst + 32 + 8 * g + 4 * w.h) = pack4(a1[4 * g] * sc, a1[4 * g + 1] * sc, a1[4 * g + 2] * sc, a1[4 * g + 3] * sc);
    }
  } else if (fb < 12) {
    const int posp = (pos & ~15) | swap23(pos & 15);
    bf16* vdst = P.qkv + V2T_OFF + (size_t)(b * 2 + (fb - 10)) * 64 * NPOS + posp;
#pragma unroll
    for (int e = 0; e < 16; ++e) {
      vdst[(size_t)(crow(e, w.h)) * NPOS] = f2bf(a0[e]);
      vdst[(size_t)(32 + crow(e, w.h)) * NPOS] = f2bf(a1[e]);
    }
  } else if (fb < 36) {
    bf16* dst = P.cbuf + (size_t)tok * C2LD + fb * 64;
#pragma unroll
    for (int g = 0; g < 4; ++g) {
      *(u32x2*)(dst + 8 * g + 4 * w.h) = pack4(a0[4 * g], a0[4 * g + 1], a0[4 * g + 2], a0[4 * g + 3]);
      *(u32x2*)(dst + 32 + 8 * g + 4 * w.h) = pack4(a1[4 * g], a1[4 * g + 1], a1[4 * g + 2], a1[4 * g + 3]);
    }
  }
}
DI void gemm_c2_item(const Params& P, bf16* smem, int pt, int qt) {
  f32x16 acc[4][2];
  const float hs[2] = {1.f, 1.f};
  const int p0 = pt * 256, q0 = qt * 256;
  gemm_core<4, 2>(smem, 1024, 0,
      [&](int rp) { return P.win1t + (size_t)(p0 + rp) * 1024; },
      [&](int rq) { return P.h + (size_t)(q0 + rq) * 1024; }, acc, -1, hs);
  const WaveId w = wave_id();
#pragma unroll
  for (int j = 0; j < 2; ++j) {
    const int tok = q0 + w.wc * 64 + j * 32 + w.r;
#pragma unroll
    for (int i2 = 0; i2 < 2; ++i2) c2_block_epilogue(P, w, (p0 + w.wr * 128 + i2 * 64) >> 6, tok, acc[2 * i2][j], acc[2 * i2 + 1][j]);
  }
}
DI void gemm_c2dt_item(const Params& P, bf16* smem, int qt) {
  f32x16 acc[1][2];
  const float hs[2] = {1.f, 1.f};
  const int q0 = qt * 256;
  gemm_core<1, 2>(smem, 1024, 0,
      [&](int rp) { return P.win1t + (size_t)(2304 + rp) * 1024; },
      [&](int rq) { return P.h + (size_t)(q0 + rq) * 1024; }, acc, -1, hs);
  const WaveId w = wave_id();
  if (w.wr == 0) {
#pragma unroll
    for (int j = 0; j < 2; ++j) {
      const int tok = q0 + w.wc * 64 + j * 32 + w.r;
#pragma unroll
      for (int g = 0; g < 2; ++g) {
        f32x4 o = {acc[0][j][4 * g], acc[0][j][4 * g + 1], acc[0][j][4 * g + 2], acc[0][j][4 * g + 3]};
        *(f32x4*)(P.dtr + (size_t)tok * 16 + 8 * g + 4 * w.h) = o;
      }
    }
  }
}
template <int DQK, bool WIN, bool GQA = false>
DI void attn_item(bf16* smem, const bf16* Qp, const bf16* Kp, const bf16* Vtp, int qrow0, int nq, int ntiles, int nctx, int band_k0, int q_lat0,
                  float negM, float sinkterm, bf16* outp, const float* sinks = nullptr) {
  constexpr int KS = DQK / 16, LDK = DQK + 8, LDV = 72, CPR = DQK / 8, NCK = 64 * CPR;
  const int tid = tidx(), lane = tid & 63, w = tid >> 6, r = lane & 31, h = lane >> 5;
  bf16* sK = smem;
  bf16* sV = smem + 2 * 64 * LDK;
  const int wq = GQA ? (w & 1) * 64 : w * 64;
  if (GQA) { Qp += (size_t)(w >> 1) * NPOS * DQK; outp += (w >> 1) * 64; sinkterm = __builtin_amdgcn_exp2f(sinks[w >> 1] * LOG2E + negM); }
  bf16x8 qf[2][KS];
#pragma unroll
  for (int qt = 0; qt < 2; ++qt) {
    int qi = wq + qt * 32 + r;
    if (qi > nq - 1) qi = nq - 1;
#pragma unroll
    for (int s = 0; s < KS; ++s) qf[qt][s] = *(const bf16x8*)(Qp + (size_t)(qrow0 + qi) * DQK + s * 16 + h * 8);
  }
  f32x16 O[2][2];
#pragma unroll
  for (int a = 0; a < 2; ++a)
#pragma unroll
    for (int b = 0; b < 2; ++b)
#pragma unroll
      for (int e = 0; e < 16; ++e) O[a][b][e] = 0.f;
  float lsum[2] = {0.f, 0.f};
  const int kr0 = tid / CPR, kc0 = tid % CPR;
  const int id1 = tid + 512;
  const bool has1 = id1 < NCK;
  const int kr1 = has1 ? id1 / CPR : 0, kc1 = has1 ? id1 % CPR : 0;
  const int vr = tid >> 3, vc = tid & 7;
  u32x4 rK0, rK1, rV;
  rK1 = rK0 = rV = u32x4{0, 0, 0, 0};
  auto tilepos = [&](int t) { return t < nctx ? t * 64 : LC + band_k0 + (t - nctx) * 64; };
  auto gload = [&](int t) {
    const int pos = tilepos(t);
    rK0 = *(const u32x4*)(Kp + (size_t)(pos + kr0) * DQK + kc0 * 8);
    if (has1) rK1 = *(const u32x4*)(Kp + (size_t)(pos + kr1) * DQK + kc1 * 8);
    rV = *(const u32x4*)(Vtp + (size_t)vr * NPOS + pos + vc * 8);
  };
  auto swrite = [&](int buf) {
    *(u32x4*)(sK + buf * 64 * LDK + kr0 * LDK + kc0 * 8) = rK0;
    if (has1) *(u32x4*)(sK + buf * 64 * LDK + kr1 * LDK + kc1 * 8) = rK1;
    *(u32x4*)(sV + buf * 64 * LDV + vr * LDV + vc * 8) = rV;
  };
  gload(0); swrite(0);
  __syncthreads();
  const int qw = q_lat0 + wq;
  for (int t = 0; t < ntiles; ++t) {
    const int buf = t & 1;
    if (t + 1 < ntiles) gload(t + 1);
    bool act = (wq < nq);
    int kk0 = 0;
    const bool band = WIN && t >= nctx;
    if (band) { kk0 = band_k0 + (t - nctx) * 64; act = act && (kk0 + 63 >= qw - 128) && (kk0 <= qw + 191); }
    if (act) {
      const bf16* sKb = sK + buf * 64 * LDK;
      const bf16* sVb = sV + buf * 64 * LDV;
#pragma unroll 1
      for (int ksub = 0; ksub < 2; ++ksub) {
        bf16x8 pb[2][2];
        {
          const bf16* kfp = sKb + (ksub * 32 + r) * LDK + h * 8;
#pragma unroll
          for (int qt = 0; qt < 2; ++qt) {
            f32x16 sc;
#pragma unroll
            for (int e = 0; e < 16; ++e) sc[e] = negM;
#pragma unroll
            for (int s = 0; s < KS; ++s) sc = mfma32(*(const bf16x8*)(kfp + s * 16), qf[qt][s], sc);
            float p[16];
#pragma unroll
            for (int e = 0; e < 16; ++e) p[e] = __builtin_amdgcn_exp2f(sc[e]);
            if (band) {
              const int qi = qw + qt * 32 + r;
#pragma unroll
              for (int e = 0; e < 16; ++e) {
                const int dd = qi - (kk0 + ksub * 32 + crow(e, h));
                if (dd > 128 || dd < -128) p[e] = 0.f;
              }
            }
            float ps = 0.f;
#pragma unroll
            for (int e = 0; e < 16; ++e) ps += p[e];
            lsum[qt] += ps;
            float p0[8], p1[8];
#pragma unroll
            for (int e = 0; e < 8; ++e) { p0[e] = p[e]; p1[e] = p[8 + e]; }
            pb[qt][0] = pack8(p0); pb[qt][1] = pack8(p1);
          }
        }
#pragma unroll
        for (int dt = 0; dt < 2; ++dt)
#pragma unroll
          for (int st = 0; st < 2; ++st) {
            const bf16x8 vf = *(const bf16x8*)(sVb + (dt * 32 + r) * LDV + ksub * 32 + st * 16 + h * 8);
            O[0][dt] = mfma32(vf, pb[0][st], O[0][dt]);
            O[1][dt] = mfma32(vf, pb[1][st], O[1][dt]);
          }
      }
    }
    if (t + 1 < ntiles) swrite(buf ^ 1);
    __syncthreads();
  }
#pragma unroll
  for (int qt = 0; qt < 2; ++qt) {
    const float l = xor32(lsum[qt]) + sinkterm;
    const float inv = 1.f / l;
    const int qi = wq + qt * 32 + r;
    if (qi < nq) {
      bf16* dst = outp + (size_t)qi * 1024;
#pragma unroll
      for (int dt = 0; dt < 2; ++dt)
#pragma unroll
        for (int g = 0; g < 4; ++g)
          *(u32x2*)(dst + dt * 32 + 8 * g + 4 * h) = pack4(O[qt][dt][4 * g] * inv, O[qt][dt][4 * g + 1] * inv, O[qt][dt][4 * g + 2] * inv, O[qt][dt][4 * g + 3] * inv);
    }
  }
}

constexpr int LCH = 80, LGR = 9;
DI void lru_apply(float (&h)[4], const float* base, int col, bool valid) {
#pragma unroll
  for (int n = 0; n < 4; ++n) {
    const f32x2 cm = *(const f32x2*)(base + (16 * n + col) * 2);
    h[n] = valid ? cm[0] * h[n] + cm[1] : h[n];
  }
}
DI void lru_chunk(const Params& P, const float* sGateBase, const float* sTaps, bf16* hfw, int bi, int j, int c, int pass, float* sComp) {
  const int lane = tidx() & 63, col = lane & 15, g = lane >> 4;
  const bool isctx = c < 16;
  const int L = isctx ? LC : SEQ;
  const int sp0 = isctx ? c * 16 : (c - 16) * 128;
  const int tokbase = isctx ? (NL + bi * LC + sp0) : (bi * SEQ + sp0);
  const int nsteps = isctx ? 1 : 8;
  const bf16* C1 = P.cbuf;
  bf16* XCV = P.h;
  if (pass == 0) {
    for (int st = 0; st < nsteps; ++st) {
      const int t = st * 16 + col;
      u32x4 raw[2][4];
#pragma unroll
      for (int s = 0; s < 2; ++s)
#pragma unroll
        for (int k = 0; k < 4; ++k) {
          const int tt = sp0 + t + k - 2;
          const bool ok = tt >= 0 && tt < L;
          const int row = ok ? (tokbase + t + k - 2) : tokbase + t;
          raw[s][k] = *(const u32x4*)(C1 + (size_t)row * C1LD + 672 + 64 * j + 32 * s + 8 * g);
        }
#pragma unroll
      for (int s = 0; s < 2; ++s) {
        const int c0 = 64 * j + 32 * s + 8 * g;
        float a8[8];
        {
          const f32x4 b0 = *(const f32x4*)(sTaps + 2048 + c0), b1 = *(const f32x4*)(sTaps + 2048 + c0 + 4);
          for (int i = 0; i < 4; ++i) { a8[i] = b0[i]; a8[4 + i] = b1[i]; }
        }
#pragma unroll
        for (int k = 0; k < 4; ++k) {
          const int tt = sp0 + t + k - 2;
          const float m = (tt >= 0 && tt < L) ? 1.f : 0.f;
          float x8[8];
          unpack8(raw[s][k], x8);
          const f32x4 w0 = *(const f32x4*)(sTaps + k * 512 + c0), w1 = *(const f32x4*)(sTaps + k * 512 + c0 + 4);
          for (int i = 0; i < 4; ++i) { a8[i] += m * w0[i] * x8[i]; a8[4 + i] += m * w1[i] * x8[4 + i]; }
        }
        *(bf16x8*)(XCV + (size_t)(tokbase + t) * 512 + c0) = pack8(a8);
      }
    }
  }
#pragma unroll 1
  for (int dir = 0; dir < 2; ++dir) {
    bf16x8 wb[8][2];
#pragma unroll
    for (int n = 0; n < 8; ++n)
#pragma unroll
      for (int s = 0; s < 2; ++s)
        wb[n][s] = *(const bf16x8*)(P.wlrut + ((size_t)(((dir * 2 + (n >> 2)) * 8 + j) * 64 + 16 * (n & 3) + col)) * 64 + 32 * s + 8 * g);
    bf16x8 idf[2];
#pragma unroll
    for (int n = 0; n < 2; ++n)
#pragma unroll
      for (int jj = 0; jj < 8; ++jj) idf[n][jj] = ((8 * g + jj) == 16 * n + col) ? (short)0x3F80 : (short)0;
    float hst[4], arun[4];
#pragma unroll
    for (int n = 0; n < 4; ++n) { hst[n] = 0.f; arun[n] = 1.f; }
    const float* sGate = sGateBase + dir * 1536 + 64 * j + col;
    if (pass == 1) {
      const float* cbase = P.comp + ((size_t)(bi * 2 + dir) * LCH) * 1024 + 128 * j;
      const float* gbase = P.gcomp + ((size_t)(bi * 2 + dir) * LGR) * 1024 + 128 * j;
      if (isctx) {
#pragma unroll
        for (int i = 0; i < 15; ++i) {
          const int cc = dir == 0 ? i : 15 - i;
          const bool valid = dir == 0 ? (i < c) : (15 - i > c);
          lru_apply(hst, cbase + (size_t)(valid ? cc : 0) * 1024, col, valid);
        }
      } else {
        const int q = (c - 16) >> 3;
        lru_apply(hst, gbase, col, true);
#pragma unroll
        for (int i = 0; i < 7; ++i) {
          const int qq = dir == 0 ? i : 7 - i;
          const bool valid = dir == 0 ? (i < q) : (7 - i > q);
          lru_apply(hst, gbase + (size_t)(1 + (valid ? qq : 0)) * 1024, col, valid);
        }
#pragma unroll
        for (int i = 0; i < 7; ++i) {
          const int cc = dir == 0 ? 16 + 8 * q + i : 16 + 8 * q + 7 - i;
          const bool valid = dir == 0 ? (cc < c) : (cc > c);
          lru_apply(hst, cbase + (size_t)(valid ? cc : 16) * 1024, col, valid);
        }
      }
    }
    bf16x8 afc[2];
    auto issue = [&](int st, bf16x8 (&af)[2]) {
      const int t = st * 16 + col;
#pragma unroll
      for (int s = 0; s < 2; ++s) af[s] = *(const bf16x8*)(XCV + (size_t)(tokbase + t) * 512 + 64 * j + 32 * s + 8 * g);
    };
    issue(dir ? nsteps - 1 : 0, afc);
    for (int step = 0; step < nsteps; ++step) {
      const int st = dir ? nsteps - 1 - step : step;
      const int t0 = st * 16;
      bf16x8 af[2];
      af[0] = afc[0]; af[1] = afc[1];
      if (step + 1 < nsteps) issue(dir ? st - 1 : st + 1, afc);
      f32x4 ag[8], xcC[4];
      const f32x4 z4 = {0.f, 0.f, 0.f, 0.f};
#pragma unroll
      for (int n = 0; n < 8; ++n) { ag[n] = mfma16(af[0], wb[n][0], z4); ag[n] = mfma16(af[1], wb[n][1], ag[n]); }
#pragma unroll
      for (int n = 0; n < 4; ++n) xcC[n] = mfma16(af[n >> 1], idf[n & 1], z4);
#pragma unroll
      for (int n = 0; n < 4; ++n) {
        float av[4], bv[4];
#pragma unroll
        for (int e = 0; e < 4; ++e) {
          const float rg = sigmoidf_(ag[n][e] + sGate[16 * n]);
          const float ig = sigmoidf_(ag[4 + n][e] + sGate[512 + 16 * n]);
          const float a = __expf(-sGate[1024 + 16 * n] * rg);
          av[e] = a;
          bv[e] = __builtin_amdgcn_sqrtf(fmaxf(fmaf(-a, a, 1.f), 0.f)) * ig * xcC[n][e];
        }
        float A = 1.f, H = 0.f;
        if (dir == 0) { for (int e = 0; e < 4; ++e) { H = av[e] * H + bv[e]; A *= av[e]; } }
        else { for (int e = 3; e >= 0; --e) { H = av[e] * H + bv[e]; A *= av[e]; } }
        float A1, H1, Aex, Hex, At, Ht;
        if (dir == 0) {
          A1 = __shfl_up(A, 16); H1 = __shfl_up(H, 16);
          if (g >= 1) { H = A * H1 + H; A = A * A1; }
          A1 = __shfl_up(A, 32); H1 = __shfl_up(H, 32);
          if (g >= 2) { H = A * H1 + H; A = A * A1; }
          Aex = __shfl_up(A, 16); Hex = __shfl_up(H, 16);
          if (g == 0) { Aex = 1.f; Hex = 0.f; }
          At = __shfl(A, col + 48); Ht = __shfl(H, col + 48);
        } else {
          A1 = __shfl_down(A, 16); H1 = __shfl_down(H, 16);
          if (g <= 2) { H = A * H1 + H; A = A * A1; }
          A1 = __shfl_down(A, 32); H1 = __shfl_down(H, 32);
          if (g <= 1) { H = A * H1 + H; A = A * A1; }
          Aex = __shfl_down(A, 16); Hex = __shfl_down(H, 16);
          if (g == 3) { Aex = 1.f; Hex = 0.f; }
          At = __shfl(A, col); Ht = __shfl(H, col);
        }
        if (pass == 0) {
          hst[n] = At * hst[n] + Ht; arun[n] = At * arun[n];
        } else {
          float hc = Aex * hst[n] + Hex;
          hst[n] = At * hst[n] + Ht;
          float o[4];
          if (dir == 0) { for (int e = 0; e < 4; ++e) { hc = av[e] * hc + bv[e]; o[e] = hc; } }
          else { for (int e = 3; e >= 0; --e) { hc = av[e] * hc + bv[e]; o[e] = hc; } }
#pragma unroll
          for (int e = 0; e < 4; ++e) {
            bf16* yp = hfw + (t0 + 4 * g + e) * 64 + 16 * n + col;
            if (dir == 0) *yp = f2bf(o[e]); else *yp = f2bf(bf2f(*yp) + o[e]);
          }
        }
      }
    }
    if (pass == 0 && g == 0) {
#pragma unroll
      for (int n = 0; n < 4; ++n) {
        f32x2 cm = {arun[n], hst[n]};
        *(f32x2*)(P.comp + ((size_t)((bi * 2 + dir) * LCH + c) * 512 + 64 * j + 16 * n + col) * 2) = cm;
        *(f32x2*)(sComp + (dir * 64 + 16 * n + col) * 2) = cm;
      }
    }
  }
  if (pass == 1) {
    const int ntok = nsteps * 16;
    for (int i0 = 0; i0 < ntok * 8; i0 += 64 * 4) {
      u32x4 gr[4];
#pragma unroll
      for (int u = 0; u < 4; ++u) {
        const int id = i0 + u * 64 + lane;
        const int tk = id >> 3, cc = id & 7;
        gr[u] = u32x4{0, 0, 0, 0};
        if (tk < ntok) gr[u] = *(const u32x4*)(C1 + (size_t)(tokbase + tk) * C1LD + 1184 + 64 * j + cc * 8);
      }
#pragma unroll
      for (int u = 0; u < 4; ++u) {
        const int id = i0 + u * 64 + lane;
        const int tk = id >> 3, cc = id & 7;
        if (tk < ntok) {
          float hv[8], gv[8];
          unpack8(*(const u32x4*)(hfw + tk * 64 + cc * 8), hv);
          unpack8(gr[u], gv);
#pragma unroll
          for (int e = 0; e < 8; ++e) hv[e] *= geluf_(gv[e]);
          *(bf16x8*)(P.ycat + (size_t)(tokbase + tk) * 1024 + 512 + 64 * j + cc * 8) = pack8(hv);
        }
      }
    }
  }
}

DI void lru_block_item(const Params& P, float* fsm, int bi, int j, int grp, int pass) {
  const int tid = tidx(), wid = tid >> 6;
  const float* sGate = fsm;
  const float* sTaps = fsm + 3072;
  float* sComp = fsm + 5632;
  bf16* hfw = (bf16*)(fsm + 3072) + wid * 8192;
  if (grp == 0) {
    lru_chunk(P, sGate, sTaps, hfw, bi, j, 2 * wid, pass, sComp + (2 * wid) * 256);
    lru_chunk(P, sGate, sTaps, hfw, bi, j, 2 * wid + 1, pass, sComp + (2 * wid + 1) * 256);
  } else {
    lru_chunk(P, sGate, sTaps, hfw, bi, j, 16 + 8 * (grp - 1) + wid, pass, sComp + wid * 256);
  }
  if (pass == 0) {
    __syncthreads();
    if (tid < 128) {
      const int dir = tid >> 6, ch = tid & 63;
      const int n = grp == 0 ? 16 : 8;
      float A = 1.f, H = 0.f;
      for (int i = 0; i < n; ++i) {
        const int cc = dir == 0 ? i : n - 1 - i;
        const float a = sComp[cc * 256 + (dir * 64 + ch) * 2], hh = sComp[cc * 256 + (dir * 64 + ch) * 2 + 1];
        H = a * H + hh; A = a * A;
      }
      f32x2 cm = {A, H};
      *(f32x2*)(P.gcomp + ((size_t)((bi * 2 + dir) * LGR + grp) * 512 + 64 * j + ch) * 2) = cm;
    }
    __syncthreads();
  }
}
DI void chunk_geom(int bi, int ck, int& L, int& sp0, int& tokbase, int& pos0) {
  const bool isctx = ck < 2;
  L = isctx ? LC : SEQ;
  sp0 = isctx ? ck * 128 : (ck - 2) * 128;
  tokbase = isctx ? (NL + bi * LC + sp0) : (bi * SEQ + sp0);
  pos0 = isctx ? sp0 : LC + sp0;
}

DI void ssd_conv_item(const Params& P, bf16* smem, int gc, int cr) {
  (void)smem;
  const int bi = gc / NCH, ck = gc % NCH;
  int L, sp0, tokbase, pos0; chunk_geom(bi, ck, L, sp0, tokbase, pos0);
  const int tid = tidx();
  const int cc = tid & 31, o = tid >> 5;
  const int c0 = cr * 256 + cc * 8;
  f32x4 wv[4][2], bv[2];
#pragma unroll
  for (int k = 0; k < 4; ++k) { wv[k][0] = *(const f32x4*)(P.ssd_conv_w + k * 1024 + c0); wv[k][1] = *(const f32x4*)(P.ssd_conv_w + k * 1024 + c0 + 4); }
  bv[0] = *(const f32x4*)(P.ssd_conv_b + c0); bv[1] = *(const f32x4*)(P.ssd_conv_b + c0 + 4);
  const int tA = 16 * (o >> 1) + 4 * (o & 1);
  u32x4 raw[2][7];
#pragma unroll
  for (int rn = 0; rn < 2; ++rn)
#pragma unroll
    for (int i = 0; i < 7; ++i) {
      const int t = tA + 8 * rn + i - 2, tt = sp0 + t;
      raw[rn][i] = u32x4{0, 0, 0, 0};
      if (tt >= 0 && tt < L) raw[rn][i] = *(const u32x4*)(P.cbuf + (size_t)(tokbase + t) * C2LD + 1280 + c0);
    }
  float ut[8][8];
#pragma unroll
  for (int rn = 0; rn < 2; ++rn)
#pragma unroll
    for (int i = 0; i < 4; ++i) {
      float a8[8];
#pragma unroll
      for (int e = 0; e < 4; ++e) { a8[e] = bv[0][e]; a8[4 + e] = bv[1][e]; }
#pragma unroll
      for (int k = 0; k < 4; ++k) {
        float x8[8];
        unpack8(raw[rn][i + k], x8);
#pragma unroll
        for (int e = 0; e < 4; ++e) { a8[e] += wv[k][0][e] * x8[e]; a8[4 + e] += wv[k][1][e] * x8[4 + e]; }
      }
#pragma unroll
      for (int e = 0; e < 8; ++e) { a8[e] = siluf_(a8[e]); ut[e][4 * rn + i] = a8[e]; }
      *(bf16x8*)(P.h + (size_t)(tokbase + tA + 8 * rn + i) * 1024 + c0) = pack8(a8);
    }
#pragma unroll
  for (int e = 0; e < 8; ++e) *(bf16x8*)(P.ut + ((size_t)(bi * 1024 + c0 + e)) * NPOS + pos0 + 8 * o) = pack8(ut[e]);
}

DI void ssd_cumsum_item(const Params& P, int gc) {
  const int bi = gc / NCH, ck = gc % NCH;
  int L, sp0, tokbase, pos0; chunk_geom(bi, ck, L, sp0, tokbase, pos0);
  const int lane = tidx() & 63;
  f32x4 raw[2][4];
#pragma unroll
  for (int u = 0; u < 2; ++u)
#pragma unroll
    for (int q = 0; q < 4; ++q) raw[u][q] = *(const f32x4*)(P.dtr + (size_t)(tokbase + 64 * u + lane) * 16 + 4 * q);
  const int perm = (lane & ~15) | swap23(lane & 15);
#pragma unroll
  for (int idx = 0; idx < 16; ++idx) {
    const float A = -__expf(P.ssd_a_log[idx]);
    const float bias = P.ssd_dt_bias[idx];
    const float dt0 = softplusf_(raw[0][idx >> 2][idx & 3] + bias), dt1 = softplusf_(raw[1][idx >> 2][idx & 3] + bias);
    const float a0 = dt0 * A, a1 = dt1 * A;
    float c0 = a0, c1 = a1;
#pragma unroll
    for (int d = 1; d < 64; d <<= 1) {
      const float v0 = __shfl_up(c0, d), v1 = __shfl_up(c1, d);
      if (lane >= d) { c0 += v0; c1 += v1; }
    }
    c1 += __shfl(c0, 63);
    const float total = __shfl(c1, 63);
    const size_t rowb = (size_t)(bi * 16 + idx) * NPOS + pos0;
    P.dtt[rowb + lane] = dt0; P.dtt[rowb + 64 + lane] = dt1;
    P.cst[rowb + lane] = c0; P.cst[rowb + 64 + lane] = c1;
    const float w0 = idx < 8 ? dt0 * __expf(total - c0) : dt0 * __expf(c0 - a0);
    const float w1 = idx < 8 ? dt1 * __expf(total - c1) : dt1 * __expf(c1 - a1);
    P.wgp[rowb + perm] = w0; P.wgp[rowb + 64 + perm] = w1;
  }
}

DI void ssd_passA_item(const Params& P, int gc, int hd, int dir, int pt) {
  const int bi = gc / NCH, ck = gc % NCH;
  int L, sp0, tokbase, pos0; chunk_geom(bi, ck, L, sp0, tokbase, pos0);
  const int lane = tidx() & 63, r = lane & 31, h = lane >> 5;
  const int idx = dir * 8 + hd, grp = hd >> 2;
  const bf16* xrow = P.ut + ((size_t)(bi * 1024 + hd * 64 + 32 * pt + r)) * NPOS + pos0 + 8 * h;
  const float* wrow = P.wgp + (size_t)(bi * 16 + idx) * NPOS + pos0 + 8 * h;
  const bf16* brow = P.ut + ((size_t)(bi * 1024 + 512 + grp * 128 + r)) * NPOS + pos0 + 8 * h;
  bf16x8 xs[8];
  {
    u32x4 xr[8]; f32x4 w0[8], w1[8];
#pragma unroll
    for (int ks = 0; ks < 8; ++ks) { xr[ks] = *(const u32x4*)(xrow + 16 * ks); w0[ks] = *(const f32x4*)(wrow + 16 * ks); w1[ks] = *(const f32x4*)(wrow + 16 * ks + 4); }
#pragma unroll
    for (int ks = 0; ks < 8; ++ks) {
      float x8[8];
      unpack8(xr[ks], x8);
#pragma unroll
      for (int e = 0; e < 4; ++e) { x8[e] *= w0[ks][e]; x8[4 + e] *= w1[ks][e]; }
      xs[ks] = pack8(x8);
    }
  }
  f32x16 acc[4];
#pragma unroll
  for (int nt = 0; nt < 4; ++nt)
#pragma unroll
    for (int e = 0; e < 16; ++e) acc[nt][e] = 0.f;
#pragma unroll
  for (int ks = 0; ks < 8; ++ks)
#pragma unroll
    for (int nt = 0; nt < 4; ++nt) acc[nt] = mfma32(*(const bf16x8*)(brow + (size_t)(32 * nt) * NPOS + 16 * ks), xs[ks], acc[nt]);
  bf16* dst = P.qkv + ST_OFF + ((size_t)(((bi * 2 + dir) * 8 + hd) * NCH + ck)) * 8192 + (32 * pt + r) * 128 + 4 * h;
#pragma unroll
  for (int nt = 0; nt < 4; ++nt)
#pragma unroll
    for (int g = 0; g < 4; ++g) *(u32x2*)(dst + 32 * nt + 8 * g) = pack4(acc[nt][4 * g], acc[nt][4 * g + 1], acc[nt][4 * g + 2], acc[nt][4 * g + 3]);
}

DI void ssd_passB(const Params& P, int bid, int nblk) {
  const int nthr = nblk * 512;
  for (int id = bid * 512 + tidx(); id < NB * 2 * 8 * 2048; id += nthr) {
    const int e4 = id & 2047, hd = (id >> 11) & 7, dir = (id >> 14) & 1, bi = id >> 15;
    bf16* base = P.qkv + ST_OFF + ((size_t)((bi * 2 + dir) * 8 + hd)) * NCH * 8192 + e4 * 4;
    const float* crow_ = P.cst + (size_t)(bi * 16 + dir * 8 + hd) * NPOS;
    float S0 = 0.f, S1 = 0.f, S2 = 0.f, S3 = 0.f;
    for (int i0 = 0; i0 < NCH; i0 += 6) {
      u32x2 raw[6]; float dec[6]; int cks[6];
#pragma unroll
      for (int u = 0; u < 6; ++u) {
        const int i = i0 + u;
        const int ck = dir == 0 ? i : (i == 0 ? 1 : (i == 1 ? 0 : 67 - i));
        cks[u] = ck;
        raw[u] = *(const u32x2*)(base + (size_t)ck * 8192);
        dec[u] = __expf(crow_[ck * 128 + 127]);
      }
#pragma unroll
      for (int u = 0; u < 6; ++u) {
        *(u32x2*)(base + (size_t)cks[u] * 8192) = pack4(S0, S1, S2, S3);
        S0 = dec[u] * S0 + lo16(raw[u][0]); S1 = dec[u] * S1 + hi16(raw[u][0]);
        S2 = dec[u] * S2 + lo16(raw[u][1]); S3 = dec[u] * S3 + hi16(raw[u][1]);
      }
    }
  }
}

DI void ssd_passC_item(const Params& P, bf16* smem, int bi, int ck, int grp) {
  int L, sp0, tokbase, pos0; chunk_geom(bi, ck, L, sp0, tokbase, pos0);
  const int tid = tidx(), lane = tid & 63, wid = tid >> 6, r = lane & 31, h = lane >> 5;
  constexpr int LDB = 136;
  bf16* sB = smem;
  bf16* sC = smem + 128 * LDB;
  bf16* sX = smem + 256 * LDB;
  float* sCS = (float*)(smem + 512 * LDB);
  float* sDT = sCS + 1024;
  const bf16* U = P.h;
  {
    u32x4 tb[4], tc[4], tx[8];
#pragma unroll
    for (int i = 0; i < 4; ++i) {
      const int id = tid + 512 * i, row = id >> 4, c = id & 15;
      tb[i] = *(const u32x4*)(U + (size_t)(tokbase + row) * 1024 + 512 + grp * 128 + c * 8);
      tc[i] = *(const u32x4*)(U + (size_t)(tokbase + row) * 1024 + 768 + grp * 128 + c * 8);
    }
#pragma unroll
    for (int i = 0; i < 8; ++i) {
      const int id = tid + 512 * i, row = id >> 4, c = id & 15;
      tx[i] = *(const u32x4*)(P.ut + ((size_t)(bi * 1024 + grp * 256 + row)) * NPOS + pos0 + c * 8);
    }
    float cv[2], dv[2];
#pragma unroll
    for (int i = 0; i < 2; ++i) {
      const int id = tid + 512 * i, dir = id >> 9, hl = (id >> 7) & 3, t = id & 127;
      const size_t o = (size_t)(bi * 16 + dir * 8 + grp * 4 + hl) * NPOS + pos0 + t;
      cv[i] = P.cst[o]; dv[i] = P.dtt[o];
    }
#pragma unroll
    for (int i = 0; i < 4; ++i) {
      const int id = tid + 512 * i, row = id >> 4, c = id & 15;
      *(u32x4*)(sB + row * LDB + c * 8) = tb[i];
      *(u32x4*)(sC + row * LDB + c * 8) = tc[i];
    }
#pragma unroll
    for (int i = 0; i < 8; ++i) {
      const int id = tid + 512 * i, row = id >> 4, c = id & 15;
      *(u32x4*)(sX + row * LDB + c * 8) = tx[i];
    }
#pragma unroll
    for (int i = 0; i < 2; ++i) { sCS[tid + 512 * i] = cv[i]; sDT[tid + 512 * i] = dv[i]; }
  }
  __syncthreads();
  const int hl = wid >> 1, hd = grp * 4 + hl;
  const float Ah0 = -__expf(P.ssd_a_log[hd]), Ah1 = -__expf(P.ssd_a_log[8 + hd]);
  const float dsk = P.ssd_d[hd] + P.ssd_d[8 + hd];
  const float* csF = sCS + hl * 128;
  const float* csR = sCS + 512 + hl * 128;
  const float* dtF = sDT + hl * 128;
  const float* dtR = sDT + 512 + hl * 128;
#pragma unroll 1
  for (int lq = 0; lq < 2; ++lq) {
    const int lt = 2 * (wid & 1) + lq;
    const int l = lt * 32 + r;
    const size_t tok = tokbase + l;
    bf16x8 cfr[8];
#pragma unroll
    for (int ks = 0; ks < 8; ++ks) cfr[ks] = *(const bf16x8*)(sC + l * LDB + 16 * ks + 8 * h);
    f32x16 acc[2];
#pragma unroll
    for (int pt = 0; pt < 2; ++pt)
#pragma unroll
      for (int e = 0; e < 16; ++e) acc[pt][e] = 0.f;
    const float cslF = csF[l], cslR = csR[l];
    const float exlR = cslR - dtR[l] * Ah1;
#pragma unroll
    for (int dir = 0; dir < 2; ++dir) {
      const float fac = dir == 0 ? __expf(cslF) : __expf(csR[127] - exlR);
#pragma unroll
      for (int pt = 0; pt < 2; ++pt) {
        f32x16 yo;
#pragma unroll
        for (int e = 0; e < 16; ++e) yo[e] = 0.f;
        const bf16* srow = P.qkv + ST_OFF + ((size_t)(((bi * 2 + dir) * 8 + hd) * NCH + ck)) * 8192 + (32 * pt + r) * 128 + 8 * h;
#pragma unroll
        for (int ks = 0; ks < 8; ++ks) yo = mfma32(*(const bf16x8*)(srow + 16 * ks), cfr[ks], yo);
#pragma unroll
        for (int e = 0; e < 16; ++e) acc[pt][e] += fac * yo[e];
      }
    }
#pragma unroll 1
    for (int st = 0; st < 4; ++st) {
      f32x16 G;
#pragma unroll
      for (int e = 0; e < 16; ++e) G[e] = 0.f;
#pragma unroll
      for (int ks = 0; ks < 8; ++ks) G = mfma32(*(const bf16x8*)(sB + (st * 32 + r) * LDB + 16 * ks + 8 * h), cfr[ks], G);
      const bf16* x0p = sX + (hl * 64 + r) * LDB + st * 32 + 8 * h;
      const bf16x8 x00 = *(const bf16x8*)(x0p), x01 = *(const bf16x8*)(x0p + 16);
      const bf16x8 x10 = *(const bf16x8*)(x0p + 32 * LDB), x11 = *(const bf16x8*)(x0p + 32 * LDB + 16);
      if (st <= lt) {
        float m[16];
#pragma unroll
        for (int g = 0; g < 4; ++g) {
          const int sb = st * 32 + 8 * g + 4 * h;
          const f32x4 cs4 = *(const f32x4*)(csF + sb), dt4 = *(const f32x4*)(dtF + sb);
#pragma unroll
          for (int e = 0; e < 4; ++e) m[4 * g + e] = (sb + e <= l) ? G[4 * g + e] * __expf(cslF - cs4[e]) * dt4[e] : 0.f;
        }
        float t0[8], t1[8];
#pragma unroll
        for (int e = 0; e < 8; ++e) { t0[e] = m[e]; t1[e] = m[8 + e]; }
        const bf16x8 p0 = pack8(t0), p1 = pack8(t1);
        acc[0] = mfma32(x00, p0, acc[0]); acc[0] = mfma32(x01, p1, acc[0]);
        acc[1] = mfma32(x10, p0, acc[1]); acc[1] = mfma32(x11, p1, acc[1]);
      }
      if (st >= lt) {
        float m[16];
#pragma unroll
        for (int g = 0; g < 4; ++g) {
          const int sb = st * 32 + 8 * g + 4 * h;
          const f32x4 cs4 = *(const f32x4*)(csR + sb), dt4 = *(const f32x4*)(dtR + sb);
#pragma unroll
          for (int e = 0; e < 4; ++e) m[4 * g + e] = (sb + e >= l) ? G[4 * g + e] * __expf((cs4[e] - dt4[e] * Ah1) - exlR) * dt4[e] : 0.f;
        }
        float t0[8], t1[8];
#pragma unroll
        for (int e = 0; e < 8; ++e) { t0[e] = m[e]; t1[e] = m[8 + e]; }
        const bf16x8 p0 = pack8(t0), p1 = pack8(t1);
        acc[0] = mfma32(x00, p0, acc[0]); acc[0] = mfma32(x01, p1, acc[0]);
        acc[1] = mfma32(x10, p0, acc[1]); acc[1] = mfma32(x11, p1, acc[1]);
      }
    }
    (void)Ah0;
    float ss = 0.f;
#pragma unroll
    for (int pt = 0; pt < 2; ++pt)
#pragma unroll
      for (int g = 0; g < 4; ++g) {
        const int p0 = 32 * pt + 8 * g + 4 * h;
        const u32x2 xr = *(const u32x2*)(U + tok * 1024 + hd * 64 + p0);
        const u32x2 zr = *(const u32x2*)(P.cbuf + tok * C2LD + 768 + hd * 64 + p0);
        const float xs[4] = {lo16(xr[0]), hi16(xr[0]), lo16(xr[1]), hi16(xr[1])};
        const float zz[4] = {lo16(zr[0]), hi16(zr[0]), lo16(zr[1]), hi16(zr[1])};
        float o[4];
#pragma unroll
        for (int e = 0; e < 4; ++e) { o[e] = (acc[pt][4 * g + e] + dsk * xs[e]) * siluf_(zz[e]); ss += o[e] * o[e]; }
        *(u32x2*)(P.ycat + tok * 1024 + 512 + hd * 64 + p0) = pack4(o[0], o[1], o[2], o[3]);
      }
    ss = xor32(ss);
    if (h == 0) P.ssq2[tok * 8 + hd] = ss;
  }
  __syncthreads();
}

DI void row_pass2(const Params& P, int mode, int layer, int tokA, int ntok, const int* sOff) {
  const int lane = tidx() & 63;
  const int tk[2] = {tokA, tokA + 1 < ntok ? tokA + 1 : tokA};
  const bool ok1 = tokA + 1 < ntok;
  f32x4 v[2][4];
  const float* src[2];
  int bm[2];
#pragma unroll
  for (int u = 0; u < 2; ++u) {
    int b, pos; bool lat; tok_info(tk[u], bm[u], b, pos, lat);
    src[u] = mode == 0 ? (lat ? P.x + (size_t)tk[u] * 1024 : P.ctx + (size_t)(tk[u] - NL) * 1024)
                       : (lat ? P.out + (size_t)tk[u] * 1024 : P.xc + (size_t)(tk[u] - NL) * 1024);
#pragma unroll
    for (int i = 0; i < 4; ++i) v[u][i] = *(const f32x4*)(src[u] + 4 * lane + 256 * i);
  }
  if (mode == 1 || mode == 2) {
    u32x2 y0[2][4], y1[2][4];
    float w0[2], w1[2];
#pragma unroll
    for (int u = 0; u < 2; ++u) {
      const int* ti = P.tokinfo + (size_t)tk[u] * 4;
      const int s0 = sOff[ti[0]] + ti[1], s1 = sOff[ti[2]] + ti[3];
      w0[u] = P.tokw[tk[u] * 2]; w1[u] = P.tokw[tk[u] * 2 + 1];
#pragma unroll
      for (int i = 0; i < 4; ++i) {
        const int k = 4 * lane + 256 * i;
        y0[u][i] = *(const u32x2*)(P.qkv + (size_t)s0 * 1024 + k); y1[u][i] = *(const u32x2*)(P.qkv + (size_t)s1 * 1024 + k);
      }
    }
#pragma unroll
    for (int u = 0; u < 2; ++u) {
      const float* m5 = P.mods + ((size_t)((mode - 1) * 5 + bm[u]) * 6 + 5) * 1024;
      float* dst = tk[u] < NL ? P.out + (size_t)tk[u] * 1024 : P.xc + (size_t)(tk[u] - NL) * 1024;
#pragma unroll
      for (int i = 0; i < 4; ++i) {
        const int k = 4 * lane + 256 * i;
        const f32x4 mv = *(const f32x4*)(m5 + k);
        v[u][i][0] += mv[0] * (w0[u] * lo16(y0[u][i][0]) + w1[u] * lo16(y1[u][i][0]));
        v[u][i][1] += mv[1] * (w0[u] * hi16(y0[u][i][0]) + w1[u] * hi16(y1[u][i][0]));
        v[u][i][2] += mv[2] * (w0[u] * lo16(y0[u][i][1]) + w1[u] * lo16(y1[u][i][1]));
        v[u][i][3] += mv[3] * (w0[u] * hi16(y0[u][i][1]) + w1[u] * hi16(y1[u][i][1]));
        if (u == 0 || ok1) *(f32x4*)(dst + k) = v[u][i];
      }
    }
    if (mode == 2) return;
  }
#pragma unroll
  for (int u = 0; u < 2; ++u) {
    float ss = 0.f;
#pragma unroll
    for (int i = 0; i < 4; ++i) ss += v[u][i][0] * v[u][i][0] + v[u][i][1] * v[u][i][1] + v[u][i][2] * v[u][i][2] + v[u][i][3] * v[u][i][3];
    ss = wave_sum(ss);
    const float rstd = rsqrtf(ss * (1.f / 1024.f) + EPS);
    const float* g1 = P.norm1_g + layer * 1024;
    const float* sh = P.mods + ((size_t)(layer * 5 + bm[u]) * 6 + 0) * 1024;
    const float* sc = P.mods + ((size_t)(layer * 5 + bm[u]) * 6 + 1) * 1024;
    if (u == 0 || ok1) {
#pragma unroll
      for (int i = 0; i < 4; ++i) {
        const int k = 4 * lane + 256 * i;
        const f32x4 gv = *(const f32x4*)(g1 + k), sv = *(const f32x4*)(sc + k), hv = *(const f32x4*)(sh + k);
        float o[4];
#pragma unroll
        for (int e = 0; e < 4; ++e) o[e] = v[u][i][e] * rstd * gv[e] * (1.f + sv[e]) + hv[e];
        *(u32x2*)(P.h + (size_t)tk[u] * 1024 + k) = pack4(o[0], o[1], o[2], o[3]);
      }
    }
  }
}

DI void route_tokens(const Params& P, int layer, float* sW, int item, int tok_lo, int tok_hi) {
  const int tid = tidx(), lane = tid & 63, wid = tid >> 6;
  int* sCnt = (int*)sW;
  if (tid < 32) sCnt[tid * 36 + 32] = 0;
  __syncthreads();
  const float* g2 = P.norm2_g + layer * 1024;
  const float rb = P.router_b[lane >> 1];
  float gm[16], sh[16], xn[16];
  int cur_b = -1;
  auto xsrc = [&](int tok) { return tok < NL ? P.out + (size_t)tok * 1024 : P.xc + (size_t)(tok - NL) * 1024; };
  int t0 = tok_lo + wid;
  if (t0 < tok_hi) {
    const float* src = xsrc(t0);
#pragma unroll
    for (int i = 0; i < 16; ++i) xn[i] = src[lane + 64 * i];
  }
  for (; t0 < tok_hi; t0 += 8) {
    const int tok = t0;
    float v[16];
    float ss = 0.f;
#pragma unroll
    for (int i = 0; i < 16; ++i) { v[i] = xn[i]; ss += v[i] * v[i]; }
    if (t0 + 8 < tok_hi) {
      const float* src = xsrc(t0 + 8);
#pragma unroll
      for (int i = 0; i < 16; ++i) xn[i] = src[lane + 64 * i];
    }
    const int bmod = tok < NL ? (tok >> 13) : 4;
    if (bmod != cur_b) {
      cur_b = bmod;
      const float* shp = P.mods + ((size_t)(layer * 5 + bmod) * 6 + 3) * 1024;
      const float* scp = P.mods + ((size_t)(layer * 5 + bmod) * 6 + 4) * 1024;
#pragma unroll
      for (int i = 0; i < 16; ++i) { const int k = lane + 64 * i; gm[i] = g2[k] * (1.f + scp[k]); sh[i] = shp[k]; }
    }
    ss = wave_sum(ss);
    const float rstd = rsqrtf(ss * (1.f / 1024.f) + EPS);
#pragma unroll
    for (int i = 0; i < 16; ++i) {
      v[i] = v[i] * rstd * gm[i] + sh[i];
      P.h[(size_t)tok * 1024 + lane + 64 * i] = f2bf(v[i]);
    }
    float acc[32];
#pragma unroll
    for (int e = 0; e < 32; ++e) acc[e] = 0.f;
#pragma unroll
    for (int i = 0; i < 16; ++i) {
      const float* wr = sW + (lane + 64 * i) * 36;
#pragma unroll
      for (int c = 0; c < 8; ++c) {
        const f32x4 w4 = *(const f32x4*)(wr + 4 * c);
#pragma unroll
        for (int e = 0; e < 4; ++e) acc[4 * c + e] += v[i] * w4[e];
      }
      if ((i & 3) == 3) asm volatile("" ::: "memory");
    }
    float a16[16], a8[8], a4[4], a2[2], a1;
    {
      const bool up = (lane & 32) != 0;
#pragma unroll
      for (int i = 0; i < 16; ++i) { const float keep = up ? acc[16 + i] : acc[i], send = up ? acc[i] : acc[16 + i]; a16[i] = keep + __shfl_xor(send, 32); }
    }
    {
      const bool up = (lane & 16) != 0;
#pragma unroll
      for (int i = 0; i < 8; ++i) { const float keep = up ? a16[8 + i] : a16[i], send = up ? a16[i] : a16[8 + i]; a8[i] = keep + __shfl_xor(send, 16); }
    }
    {
      const bool up = (lane & 8) != 0;
#pragma unroll
      for (int i = 0; i < 4; ++i) { const float keep = up ? a8[4 + i] : a8[i], send = up ? a8[i] : a8[4 + i]; a4[i] = keep + __shfl_xor(send, 8); }
    }
    {
      const bool up = (lane & 4) != 0;
#pragma unroll
      for (int i = 0; i < 2; ++i) { const float keep = up ? a4[2 + i] : a4[i], send = up ? a4[i] : a4[2 + i]; a2[i] = keep + __shfl_xor(send, 4); }
    }
    {
      const bool up = (lane & 2) != 0;
      const float keep = up ? a2[1] : a2[0], send = up ? a2[0] : a2[1];
      a1 = keep + __shfl_xor(send, 2);
    }
    a1 += __shfl_xor(a1, 1);
    const float us = 1.f / (1.f + expf(-a1));
    const float xbs = us + rb;
    float bestg = -3.0e38f, bu0 = 0.f, bu1 = 0.f;
    int be0 = 0, be1 = 0;
#pragma unroll
    for (int q = 0; q < 4; ++q) {
      float m1 = -3.0e38f, m2 = -3.0e38f, u1 = 0.f, u2 = 0.f;
      int i1 = 0, i2 = 0;
#pragma unroll
      for (int m = 0; m < 8; ++m) {
        const float uu = __shfl(us, 2 * (8 * q + m)), xb = __shfl(xbs, 2 * (8 * q + m));
        if (xb > m1) { m2 = m1; i2 = i1; u2 = u1; m1 = xb; i1 = m; u1 = uu; }
        else if (xb > m2) { m2 = xb; i2 = m; u2 = uu; }
      }
      const float gs = m1 + m2;
      if (gs > bestg) { bestg = gs; be0 = 8 * q + i1; be1 = 8 * q + i2; bu0 = u1; bu1 = u2; }
    }
    if (lane == 0) {
      const int r0 = atomicAdd(&sCnt[be0 * 36 + 32], 1), r1 = atomicAdd(&sCnt[be1 * 36 + 32], 1);
      const float inv = 1.f / (bu0 + bu1);
      int* ti = P.tokinfo + (size_t)tok * 4;
      ti[0] = be0; ti[1] = r0; ti[2] = be1; ti[3] = r1;
      P.tokw[tok * 2] = bu0 * inv; P.tokw[tok * 2 + 1] = bu1 * inv;
    }
  }
  __syncthreads();
  if (tid < 32) P.cntt[item * 32 + tid] = sCnt[tid * 36 + 32];
  __syncthreads();
}
DI void conv_tile(float* sT, const float* src, int K, int N, bf16* dst, int dld, int rmode, const float* scale, int koff, int tk, int tn) {
  const int tid = tidx();
  const int k0 = tk * 64, n0 = tn * 256;
  {
    const int n4 = (tid & 63) * 4, kk = tid >> 6;
    f32x4 v[8];
#pragma unroll
    for (int p = 0; p < 8; ++p) {
      v[p] = f32x4{0.f, 0.f, 0.f, 0.f};
      if (n0 + n4 < N) v[p] = *(const f32x4*)(src + (size_t)(k0 + kk + 8 * p) * N + n0 + n4);
    }
#pragma unroll
    for (int p = 0; p < 8; ++p) {
      const int k = k0 + kk + 8 * p;
      float s = 1.f;
      if (scale != nullptr && k >= koff) s = scale[k - koff];
#pragma unroll
      for (int e = 0; e < 4; ++e) sT[(kk + 8 * p) * 257 + n4 + e] = v[p][e] * s;
    }
  }
  __syncthreads();
  {
    const int kc = (tid & 7) * 8;
#pragma unroll
    for (int q = 0; q < 4; ++q) {
      const int n = (tid >> 3) + 64 * q;
      if (n0 + n < N) {
        float v8[8];
#pragma unroll
        for (int e = 0; e < 8; ++e) v8[e] = sT[(kc + e) * 257 + n];
        const int nn = n0 + n;
        const int row = rmode == 0 ? nn : (64 * (nn >> 5) + (nn & 31) + (rmode == 2 ? 32 : 0));
        *(bf16x8*)(dst + (size_t)row * dld + k0 + kc) = pack8(v8);
      }
    }
  }
  __syncthreads();
}

DI void conv_moe_tile(const Params& P, float* sT, int layer, int t) {
  const int e = t / 96, u = t % 96;
  if (u < 32) conv_tile(sT, P.moe_w_gate + ((size_t)(layer * 32 + e)) * 1024 * 512, 1024, 512, P.wgut + (size_t)e * 1024 * 1024, 1024, 1, nullptr, 0, u >> 1, u & 1);
  else if (u < 64) conv_tile(sT, P.moe_w_up + ((size_t)(layer * 32 + e)) * 1024 * 512, 1024, 512, P.wgut + (size_t)e * 1024 * 1024, 1024, 2, nullptr, 0, (u - 32) >> 1, (u - 32) & 1);
  else conv_tile(sT, P.moe_w_down + ((size_t)(layer * 32 + e)) * 512 * 1024, 512, 1024, P.wdt + (size_t)e * 1024 * 512, 512, 0, nullptr, 0, (u - 64) >> 2, (u - 64) & 3);
}
constexpr int NCONV_MOE = 32 * 96;

constexpr int NCONV_DENSE = 112 + 18 + 16 + 64 + 160 + 64 + 32;
DI void conv_dense_tile(const Params& P, float* sT, int t) {
  if (t < 112) { conv_tile(sT, P.ab_w_in, 1024, 1696, P.win0t, 1024, 0, nullptr, 0, t / 7, t % 7); return; }
  t -= 112;
  if (t < 18) { conv_tile(sT, P.mla_w_q_up, 384, 768, P.wqt, 384, 0, P.mla_q_norm_g, 0, t / 3, t % 3); return; }
  t -= 18;
  if (t < 16) { conv_tile(sT, P.mla_w_kv_up, 256, 1024, P.wkvt, 256, 0, P.mla_kv_norm_g, 0, t / 4, t % 4); return; }
  t -= 16;
  if (t < 64) { conv_tile(sT, P.ab_w_out, 1024, 1024, P.wout0t, 1024, 0, nullptr, 0, t / 4, t % 4); return; }
  t -= 64;
  if (t < 160) { conv_tile(sT, P.cd_w_in, 1024, 2320, P.win1t, 1024, 0, nullptr, 0, t / 10, t % 10); return; }
  t -= 160;
  if (t < 64) { conv_tile(sT, P.cd_w_out, 1024, 1024, P.wout1t, 1024, 0, P.ssd_norm_g, 512, t / 4, t % 4); return; }
  t -= 64;
  {
    const int blk = t & 7, gate = (t >> 3) & 1, dir = t >> 4;
    const float* src = (gate ? P.lru_w_x : P.lru_w_a) + ((size_t)(dir * 8 + blk)) * 4096;
    conv_tile(sT, src, 64, 64, P.wlrut + ((size_t)((dir * 2 + gate) * 8 + blk)) * 4096, 64, 0, nullptr, 0, 0, 0);
  }
}

DI void mods_item(const Params& P, float* sS, float* sR, int layer, int cb) {
  const int tid = tidx(), col = tid & 63, kq = tid >> 6;
  float a[5] = {0.f, 0.f, 0.f, 0.f, 0.f};
  const float* wp = P.ada_w + (size_t)layer * 1024 * 6144 + cb * 64 + col;
  for (int k = kq * 128; k < kq * 128 + 128; ++k) {
    const float wv = wp[(size_t)k * 6144];
#pragma unroll
    for (int v = 0; v < 5; ++v) a[v] += sS[v * 1024 + k] * wv;
  }
#pragma unroll
  for (int v = 0; v < 5; ++v) sR[(kq * 5 + v) * 64 + col] = a[v];
  __syncthreads();
  if (tid < 320) {
    const int v = tid >> 6;
    float s = P.ada_b[layer * 6144 + cb * 64 + col];
    for (int q = 0; q < 8; ++q) s += sR[(q * 5 + v) * 64 + col];
    P.mods[((size_t)(layer * 5 + v)) * 6144 + cb * 64 + col] = s;
  }
  __syncthreads();
}

enum { PH_PREP, PH_NORM1_0, PH_C1, PH_QKV, PH_ATTN0, PH_OUT0, PH_NORM2_0, PH_SCAT0, PH_MOE1_0, PH_MOE2_0, PH_COMB0, PH_C2, PH_SSDPREP, PH_SSDA, PH_SSDB, PH_SSDC, PH_OUT1, PH_NORM2_1, PH_SCAT1, PH_MOE1_1, PH_MOE2_1, PH_FINAL, NPHASE };
constexpr int GEMM_LDS = (256 + 256) * 2 * 72 * 2;

DI void run_phase(const Params& P, int ph, unsigned char* lds, int bid, int nblk) {
  bf16* smem = (bf16*)lds;
  float* fsm = (float*)lds;
  int* ism = (int*)lds;
  const int tid = tidx(), wid = tid >> 6;
  const int gw = bid * 8 + wid, ngw = nblk * 8;
  const int nrep = 1 + ((P.pad0 >> ph) & 1);
#define REP for (int rep_ = 0; rep_ < nrep; ++rep_)
#define REPB(bit) for (int rep_ = 0, nr_ = 1 + ((P.pad0 >> (bit)) & 1); rep_ < nr_; ++rep_)
  switch (ph) {
    case PH_PREP: {
      if (bid == 0) {
        for (int i = tid; i < 128 * 8; i += 512) {
          const int p = i >> 3, f = i & 7;
          float rev = (float)p * __builtin_amdgcn_exp2f(-(float)f * (13.287712379549449f / 8.f)) * 0.15915494309189535f;
          rev -= floorf(rev);
          P.ropeM[i * 2] = __builtin_amdgcn_cosf(rev); P.ropeM[i * 2 + 1] = __builtin_amdgcn_sinf(rev);
        }
        for (int i = tid; i < 128 * 16; i += 512) {
          const int p = i >> 4, f = i & 15;
          float rev = (float)p * __builtin_amdgcn_exp2f(-(float)f * (13.287712379549449f / 16.f)) * 0.15915494309189535f;
          rev -= floorf(rev);
          P.ropeS[i * 2] = __builtin_amdgcn_cosf(rev); P.ropeS[i * 2 + 1] = __builtin_amdgcn_sinf(rev);
        }
        if (tid == 0) {
          float gq = 0.f, gk = 0.f, sq = 0.f, sk = 0.f, sm = 0.f;
          for (int i = 0; i < 96; ++i) { gq = fmaxf(gq, fabsf(P.mla_q_head_g[i])); gk = fmaxf(gk, fabsf(P.mla_k_head_g[i])); }
          for (int i = 0; i < 64; ++i) { sq = fmaxf(sq, fabsf(P.swa_q_head_g[i])); sk = fmaxf(sk, fabsf(P.swa_k_head_g[i])); }
          for (int i = 0; i < 8; ++i) sm = fmaxf(sm, P.swa_sink[i]);
          P.msh[0] = 9.797958971132712f * gq * gk * LOG2E;
          P.msh[1] = fmaxf(8.f * sq * sk, sm) * LOG2E;
        }
      }
      for (int i = tid; i < 5 * 1024; i += 512) {
        const float v = i < 4096 ? P.c[i] : P.c_ctx[i - 4096];
        fsm[i] = siluf_(v);
      }
      __syncthreads();
      REPB(30) for (int it = bid; it < 2 * 96; it += nblk) mods_item(P, fsm, fsm + 5120, it / 96, it % 96);
      __syncthreads();
      REP for (int it = bid; it < NCONV_DENSE + NCONV_MOE; it += nblk) {
        if (it < NCONV_DENSE) conv_dense_tile(P, fsm, it); else conv_moe_tile(P, fsm, 0, it - NCONV_DENSE);
      }
    } break;
    case PH_NORM1_0: {
      REP for (int tok = 2 * gw; tok < NT; tok += 2 * ngw) row_pass2(P, 0, 0, tok, NT, nullptr);
    } break;
    case PH_C1: {
      REP for (int it = bid; it < 7 * 132; it += nblk) gemm_c1_item(P, smem, it % 7, it / 7);
    } break;
    case PH_QKV: {
      REP for (int it = bid; it < 264 * 8; it += nblk) {
        const int qt = it >> 3, u = it & 7;
        if (u < 4) gemm_q_item(P, smem, u, qt); else gemm_kv_item(P, smem, u - 4, qt);
      }
      __syncthreads();
      for (int i = tid; i < 2560; i += 512) fsm[3072 + i] = i < 2048 ? P.lru_conv_w[i] : P.lru_conv_b[i - 2048];
      for (int i = tid; i < 3072; i += 512) { const int d = i / 1536, u = i % 1536, k = u >> 9, ch = u & 511; fsm[i] = k == 0 ? P.lru_b_a[d * 512 + ch] : (k == 1 ? P.lru_b_x[d * 512 + ch] : 8.f * softplusf_(-P.lru_lambda[d * 512 + ch])); }
      __syncthreads();
      REPB(26) for (int it = bid; it < NB * 8 * LGR; it += nblk) { const int u = it < 256 ? it : it - 256; lru_block_item(P, fsm, it < 256 ? (u >> 6) : (u >> 3), it < 256 ? ((u >> 3) & 7) : (u & 7), it < 256 ? 1 + (u & 7) : 0, 0); }
    } break;
    case PH_ATTN0: {
      for (int i = tid; i < 2560; i += 512) fsm[3072 + i] = i < 2048 ? P.lru_conv_w[i] : P.lru_conv_b[i - 2048];
      for (int i = tid; i < 3072; i += 512) { const int d = i / 1536, u = i % 1536, k = u >> 9, ch = u & 511; fsm[i] = k == 0 ? P.lru_b_a[d * 512 + ch] : (k == 1 ? P.lru_b_x[d * 512 + ch] : 8.f * softplusf_(-P.lru_lambda[d * 512 + ch])); }
      __syncthreads();
      REPB(27) for (int it = bid; it < NB * 8 * LGR; it += nblk) { const int u = it < 256 ? it : it - 256; lru_block_item(P, fsm, it < 256 ? (u >> 6) : (u >> 3), it < 256 ? ((u >> 3) & 7) : (u & 7), it < 256 ? 1 + (u & 7) : 0, 1); }
      __syncthreads();
      const float negM = -P.msh[0];
      REP {
        for (int u = bid; u < 512; u += nblk) {
          const int qb = u & 15, hd = (u >> 4) & 7, b = u >> 7;
          const size_t hb = (size_t)(b * 8 + hd) * NPOS;
          attn_item<96, false>(smem, P.qkv + QB_OFF + hb * 96, P.qkv + KB_OFF + hb * 96, P.qkv + VT_OFF + hb * 64, LC + qb * 512, 512, 132, 132, 0, 0, negM, 0.f,
                               P.ycat + (size_t)(b * SEQ + qb * 512) * 1024 + hd * 64);
        }
        for (int it = nblk - 1 - bid; it < 32; it += nblk) {
          const int b = it >> 3, hd = it & 7;
          const size_t hb = (size_t)(b * 8 + hd) * NPOS;
          attn_item<96, false>(smem, P.qkv + QB_OFF + hb * 96, P.qkv + KB_OFF + hb * 96, P.qkv + VT_OFF + hb * 64, 0, 256, 4, 4, 0, 0, negM, 0.f,
                               P.ycat + (size_t)(NL + b * LC) * 1024 + hd * 64);
        }
      }
    } break;
    case PH_OUT0: {
      REP for (int it = bid; it < 512 + 32; it += nblk) { if (it < 512) gemm_out_item<4>(P, smem, 0, it & 3, it >> 2); else gemm_out_item<2>(P, smem, 0, (it - 512) & 7, 128 + ((it - 512) >> 3)); }
    } break;
    case PH_NORM2_0: case PH_NORM2_1: {
      const int layer = ph == PH_NORM2_0 ? 0 : 1;
      const int ntok = layer == 0 ? NT : NL;
      const int T = (ntok + nblk - 1) / nblk;
      __syncthreads();
      for (int i = tid; i < 32768; i += 512) fsm[(i >> 5) * 36 + (i & 31)] = P.router_w[i];
      __syncthreads();
      { const int lo_ = bid * T, hi_ = lo_ + T < ntok ? lo_ + T : ntok; route_tokens(P, layer, fsm, bid, lo_ < ntok ? lo_ : ntok, hi_ > lo_ ? hi_ : lo_); }
      if (layer == 1) {
        __syncthreads();
        for (int it = bid; it < NCONV_MOE; it += nblk) conv_moe_tile(P, fsm, 1, it);
      }
    } break;
    case PH_SCAT0: case PH_SCAT1: {
      const int layer = ph == PH_SCAT0 ? 0 : 1;
      const int ntok = layer == 0 ? NT : NL;
      const int T = (ntok + nblk - 1) / nblk;
      const int nit = nblk;
      __syncthreads();
      for (int i = tid; i < nit * 32; i += 512) ism[i] = P.cntt[i];
      __syncthreads();
      if (tid < 32) {
        int run = 0;
        for (int i = 0; i < nit; ++i) { const int c = ism[i * 32 + tid]; ism[i * 32 + tid] = run; run += c; }
        if (bid == 0) P.cnt[layer * 32 + tid] = run;
      }
      __syncthreads();
      {
        const int lo_ = bid * T, hi_ = lo_ + T < ntok ? lo_ + T : ntok;
        for (int tok = lo_ + tid; tok < hi_; tok += 512) {
          int* ti = P.tokinfo + (size_t)tok * 4;
          const int e0 = ti[0], e1 = ti[2];
          const int p0 = ism[bid * 32 + e0] + ti[1], p1 = ism[bid * 32 + e1] + ti[3];
          ti[1] = p0; ti[3] = p1;
          P.list[(size_t)e0 * NT + p0] = tok;
          P.list[(size_t)e1 * NT + p1] = tok;
        }
      }
    } break;
    case PH_MOE1_0: case PH_MOE2_0: case PH_MOE1_1: case PH_MOE2_1: {
      const int layer = ph >= PH_MOE1_1 ? 1 : 0;
      const bool second = (ph == PH_MOE2_0 || ph == PH_MOE2_1);
      __syncthreads();
      if (tid == 0) {
        int off = 0, toff = 0;
        for (int e = 0; e < 32; ++e) { const int c = P.cnt[layer * 32 + e]; ism[e] = c; ism[32 + e] = off; ism[65 + e] = toff; off += c; toff += (c + 255) >> 8; }
        ism[64] = off; ism[97] = toff;
      }
      __syncthreads();
      const int ntile = ism[97], total = ism[64];
      const int nitems = ntile * 4, nfull = (nitems / nblk) * nblk, rem = nitems - nfull;
      bf16* gsm = smem + 256;
      REP {
        for (int it = bid; it < nfull; it += nblk) {
          const int mtg = it >> 2, pt = it & 3;
          int e = 0;
          while (e < 31 && ism[65 + e + 1] <= mtg) ++e;
          const int m0 = (mtg - ism[65 + e]) * 256, cnt_e = ism[e], off_e = ism[32 + e];
          if (!second) moe1_item(P, gsm, layer, e, m0, pt, cnt_e, off_e); else moe2_item(P, gsm, e, m0, pt, cnt_e, off_e, total);
        }
        for (int ht = bid; ht < 2 * rem; ht += nblk) {
          const int it = nfull + (ht >> 1), mtg = it >> 2, pt2 = (it & 3) * 2 + (ht & 1);
          int e = 0;
          while (e < 31 && ism[65 + e + 1] <= mtg) ++e;
          const int m0 = (mtg - ism[65 + e]) * 256, cnt_e = ism[e], off_e = ism[32 + e];
          if (!second) moe1_half(P, gsm, layer, e, m0, pt2, cnt_e, off_e); else moe2_half(P, gsm, e, m0, pt2, cnt_e, off_e, total);
        }
      }
    } break;
    case PH_COMB0: case PH_FINAL: {
      const int layer = ph == PH_COMB0 ? 0 : 1;
      __syncthreads();
      if (tid == 0) { int off = 0; for (int e = 0; e < 32; ++e) { ism[e] = off; off += P.cnt[layer * 32 + e]; } }
      __syncthreads();
      const int ntok = layer == 0 ? NT : NL;
      for (int tok = 2 * gw; tok < ntok; tok += 2 * ngw) row_pass2(P, layer == 0 ? 1 : 2, 1, tok, ntok, ism);
    } break;
    case PH_C2: {
      REP for (int it = bid; it < 10 * 132; it += nblk) { if (it < 9 * 132) gemm_c2_item(P, smem, it % 9, it / 9); else gemm_c2dt_item(P, smem, it - 9 * 132); }
    } break;
    case PH_SSDPREP: {
      REPB(28) for (int it = gw; it < NB * NCH; it += ngw) ssd_cumsum_item(P, it);
      REPB(29) for (int it = bid; it < NB * NCH * 4; it += nblk) ssd_conv_item(P, smem, it >> 2, it & 3);
      __syncthreads();
      const float negM = -P.msh[1];
      REP for (int it = bid; it < 512; it += nblk) {
        const int qb = it & 63, kvh = (it >> 6) & 1, b = it >> 7;
        const size_t hb = (size_t)(b * 8 + kvh * 4) * NPOS, kb = (size_t)(b * 2 + kvh) * NPOS;
        const int q0 = qb * 128;
        const int k0 = q0 - 128 < 0 ? 0 : q0 - 128;
        const int k1 = q0 + 256 > SEQ ? SEQ : q0 + 256;
        attn_item<64, true, true>(smem, P.qkv + Q2_OFF + hb * 64, P.qkv + K2_OFF + kb * 64, P.qkv + V2T_OFF + kb * 64, LC + q0, 128, 4 + (k1 - k0) / 64, 4, k0, q0,
                                  negM, 0.f, P.ycat + (size_t)(b * SEQ + q0) * 1024 + kvh * 256, P.swa_sink + kvh * 4);
      }
    } break;
    case PH_SSDA: {
      REP for (int it = gw; it < NB * NCH * 8 * 2 * 2; it += ngw) {
        const int pt = it & 1, dir = (it >> 1) & 1, hd = (it >> 2) & 7, gc = it >> 5;
        ssd_passA_item(P, gc, hd, dir, pt);
      }
    } break;
    case PH_SSDB: ssd_passB(P, bid, nblk); break;
    case PH_SSDC: {
      REP for (int it = bid; it < NB * 64 * 2; it += nblk) ssd_passC_item(P, smem, it >> 7, 2 + ((it >> 1) & 63), it & 1);
    } break;
    case PH_OUT1: {
      for (int it = bid; it < 512; it += nblk) gemm_out_item<4>(P, smem, 1, it & 3, it >> 2);
    } break;
    default: break;
  }
}
#define XB_TMO      128
#define XB_XCNT(j)  (256  + 64 * (j))
#define XB_XSUB(j)  (1280 + 64 * (j))
#define XB_XGEN(j)  (2304 + 64 * (j))
#define XB_TOP      3328
#define XB_TOPGEN   3392
#define XCD_BAR_WORDS 3456
#define XB_SPIN_CAP (1u << 22)
#define LAS __attribute__((address_space(3)))
DI unsigned xb_ld(unsigned* p) { return __hip_atomic_load(p, __ATOMIC_RELAXED, __HIP_MEMORY_SCOPE_AGENT); }
DI unsigned xb_add(unsigned* p, unsigned v) { return __hip_atomic_fetch_add(p, v, __ATOMIC_RELAXED, __HIP_MEMORY_SCOPE_AGENT); }
DI unsigned xb_xcc_id() { return (unsigned)__builtin_amdgcn_s_getreg((3 << 11) | 20) & 0xFu; }
#define XB_SPIN(cond, bar) do { unsigned _sp = 0; while (cond) { __builtin_amdgcn_s_sleep(1); \
    if ((++_sp & 255u) == 0u) { if (xb_ld(&(bar)[XB_TMO])) break; if (_sp > XB_SPIN_CAP) { atomicAdd(&(bar)[XB_TMO], 1u); break; } } } } while (0)
struct XcdBarrier { unsigned* bar; unsigned x; volatile LAS unsigned* st; };
DI XcdBarrier xcd_barrier_post(unsigned* bar, volatile LAS unsigned* st) {
  XcdBarrier b; b.bar = bar; b.x = xb_xcc_id(); b.st = st;
  if (tidx() == 0) (void)xb_add(&bar[XB_XCNT(b.x)], 1u);
  return b;
}
DI void xcd_barrier_complete(unsigned* bar, unsigned x, unsigned& nloc, unsigned& nx) {
  const unsigned G = gridDim.x * gridDim.y * gridDim.z;
  unsigned sum, cnt, mine, sp = 0u;
  for (;;) {
    sum = 0u; cnt = 0u; mine = 0u;
#pragma unroll
    for (unsigned j = 0; j < 16; ++j) { const unsigned c = xb_ld(&bar[XB_XCNT(j)]); sum += c; cnt += (c > 0u) ? 1u : 0u; mine = (j == x) ? c : mine; }
    if (sum == G) break;
    __builtin_amdgcn_s_sleep(1);
    if ((++sp & 255u) == 0u) { if (xb_ld(&bar[XB_TMO])) break; if (sp > XB_SPIN_CAP) { atomicAdd(&bar[XB_TMO], 1u); break; } }
  }
  nloc = mine > 0u ? mine : 1u; nx = cnt > 0u ? cnt : 1u;
}
DI void xcd_barrier(const XcdBarrier& b) {
  asm volatile("s_waitcnt vmcnt(0)" ::: "memory");
  __syncthreads();
  if (tidx() == 0) {
    unsigned* bar = b.bar;
    __builtin_amdgcn_s_waitcnt(0);
    unsigned nloc = b.st[0], nx = b.st[1];
    if (nloc == 0u) { xcd_barrier_complete(bar, b.x, nloc, nx); b.st[0] = nloc; b.st[1] = nx; }
    const unsigned old = xb_add(&bar[XB_XSUB(b.x)], 1u);
    const unsigned gen = old / nloc;
    if (old + 1u == (gen + 1u) * nloc) {
      __builtin_amdgcn_fence(__ATOMIC_RELEASE, "agent");
      asm volatile("s_waitcnt vmcnt(0)" ::: "memory");
      const unsigned og = xb_add(&bar[XB_TOP], 1u);
      const unsigned tg = og / nx;
      if (og + 1u == (tg + 1u) * nx) xb_add(&bar[XB_TOPGEN], 1u);
      else XB_SPIN(xb_ld(&bar[XB_TOPGEN]) == tg, bar);
      __builtin_amdgcn_fence(__ATOMIC_ACQUIRE, "agent");
      xb_add(&bar[XB_XGEN(b.x)], 1u);
      asm volatile("s_waitcnt vmcnt(0)" ::: "memory");
    } else {
      XB_SPIN(xb_ld(&bar[XB_XGEN(b.x)]) == gen, bar);
      __builtin_amdgcn_fence(__ATOMIC_ACQUIRE, "agent");
      asm volatile("s_waitcnt vmcnt(0)" ::: "memory");
    }
  }
  __syncthreads();
}

#ifndef PROBE_K
#define PROBE_K 8
#endif
#ifndef REPMASK
#define REPMASK 0
#endif
#ifndef ONE_LAUNCH
#define ONE_LAUNCH 1
#endif
constexpr int LDS_BYTES = GEMM_LDS + 1024;

#if ONE_LAUNCH
#define BAR_ARG , const XcdBarrier& xb
#define BAR_PASS , xb
#else
#define BAR_ARG
#define BAR_PASS
#endif
template <int PH>
DI void phase_step(unsigned char* lds, int ph_lo, int ph_hi BAR_ARG) {
  if (PH >= ph_lo && PH < ph_hi) {
    const __attribute__((address_space(4))) Params* kp = (const __attribute__((address_space(4))) Params*)__builtin_amdgcn_kernarg_segment_ptr();
    asm volatile("" : "+s"(kp));
    run_phase(*(const Params*)kp, PH, lds, blockIdx.x, gridDim.x);
#if ONE_LAUNCH
    if (PROBE_PH >= 0 && PH + 1 == ph_hi) { asm volatile("s_waitcnt vmcnt(0)" ::: "memory"); __syncthreads(); }
    if (PROBE_PH >= 0 && tidx() == 0 && blockIdx.x == 0 && PH + 1 == ph_hi) ((volatile unsigned long long*)(lds + GEMM_LDS + 528))[PH + 1] = __builtin_amdgcn_s_memrealtime();
    if (PH + 1 < ph_hi) {
      if (PH == 0) cg::this_grid().sync(); else xcd_barrier(xb);
      if ((REPMASK >> 25) & 1) xcd_barrier(xb);
      if (PROBE_PH >= 0 && tidx() == 0 && blockIdx.x == 0) ((volatile unsigned long long*)(lds + GEMM_LDS + 528))[PH + 1] = __builtin_amdgcn_s_memrealtime();
    }
#endif
  }
}

__global__ void __launch_bounds__(512, 2) mega(Params P, int ph_lo, int ph_hi) {
  extern __shared__ __attribute__((aligned(16))) unsigned char lds[];
#if ONE_LAUNCH
  volatile LAS unsigned* st = (volatile LAS unsigned*)(lds + GEMM_LDS + 512);
  if (tidx() < 2) st[tidx()] = 0u;
  __syncthreads();
  XcdBarrier xb = xcd_barrier_post(P.bar, st);
  if (PROBE_PH == -2 && tidx() == 0) *(volatile unsigned long long*)(lds + PROBE_LDS_OFF) = 0ull;
#endif
#if ONE_LAUNCH
  if (PROBE_PH >= 0 && tidx() == 0 && blockIdx.x == 0) ((volatile unsigned long long*)(lds + GEMM_LDS + 528))[0] = __builtin_amdgcn_s_memrealtime();
#endif
#define STEP(N) phase_step<N>(lds, ph_lo, ph_hi BAR_PASS);
  STEP(0) STEP(1) STEP(2) STEP(3) STEP(4) STEP(5) STEP(6) STEP(7) STEP(8) STEP(9)
  STEP(10) STEP(11) STEP(12) STEP(13) STEP(14) STEP(15) STEP(16) STEP(17) STEP(18) STEP(19) STEP(20) STEP(21)
#undef STEP
#if ONE_LAUNCH
  if (PROBE_PH == -2 && tidx() == 0 && blockIdx.x == 0) {
    const unsigned long long dur = *(volatile unsigned long long*)(lds + PROBE_LDS_OFF);
    const unsigned long long until = __builtin_amdgcn_s_memrealtime() + (unsigned long long)PROBE_K * dur;
    while (__builtin_amdgcn_s_memrealtime() < until) __builtin_amdgcn_s_sleep(32);
  }
  if (PROBE_PH >= 0 && tidx() == 0 && blockIdx.x == 0) {
    volatile unsigned long long* ts = (volatile unsigned long long*)(lds + GEMM_LDS + 528);
    const unsigned long long dur = ts[PROBE_PH + 1] - ts[PROBE_PH];
    const unsigned long long until = ts[NPHASE] + (unsigned long long)PROBE_K * dur;
    while (__builtin_amdgcn_s_memrealtime() < until) __builtin_amdgcn_s_sleep(32);
  }
#endif
}

static size_t carve(size_t& off, size_t bytes) { size_t o = off; off = (off + bytes + 255) & ~(size_t)255; return o; }

extern "C" void kernel_launch(void* const* d_in, const int* in_sizes, int n_in, void* d_out, int out_size, void* d_ws, size_t ws_size, hipStream_t stream) {
  static int grid = 0;
  if (grid == 0) {
    int dev = 0, cus = 0, per_cu = 0;
    hipGetDevice(&dev);
    hipDeviceGetAttribute(&cus, hipDeviceAttributeMultiprocessorCount, dev);
    if (hipFuncSetAttribute((const void*)mega, hipFuncAttributeMaxDynamicSharedMemorySize, LDS_BYTES) != hipSuccess) { fprintf(stderr, "kernel_launch: hipFuncSetAttribute failed\n"); }
    hipOccupancyMaxActiveBlocksPerMultiprocessor(&per_cu, (const void*)mega, 512, LDS_BYTES);
    if (per_cu < 1) { fprintf(stderr, "kernel_launch: occupancy query says %d blocks per CU\n", per_cu); per_cu = 1; }
    (void)hipGetLastError();
    grid = cus;
  }
  Params P;
  memset(&P, 0, sizeof(P));
  P.pad0 = REPMASK;
  const float** in = (const float**)&P;
  for (int i = 0; i < 39 && i < n_in; ++i) in[i] = (const float*)d_in[i];
  P.out = (float*)d_out;
  char* ws = (char*)d_ws;
  size_t off = 0;
  P.bar = (unsigned*)(ws + carve(off, XCD_BAR_WORDS * 4));
  P.mods = (float*)(ws + carve(off, 2 * 5 * 6144 * 4));
  P.ropeM = (float*)(ws + carve(off, 128 * 8 * 2 * 4));
  P.ropeS = (float*)(ws + carve(off, 128 * 16 * 2 * 4));
  P.msh = (float*)(ws + carve(off, 64));
  P.win0t = (bf16*)(ws + carve(off, (size_t)1792 * 1024 * 2));
  P.wqt = (bf16*)(ws + carve(off, (size_t)768 * 384 * 2));
  P.wkvt = (bf16*)(ws + carve(off, (size_t)1024 * 256 * 2));
  P.wout0t = (bf16*)(ws + carve(off, (size_t)1024 * 1024 * 2));
  P.win1t = (bf16*)(ws + carve(off, (size_t)2432 * 1024 * 2));
  P.wout1t = (bf16*)(ws + carve(off, (size_t)1024 * 1024 * 2));
  P.wlrut = (bf16*)(ws + carve(off, (size_t)32 * 4096 * 2));
  P.wgut = (bf16*)(ws + carve(off, (size_t)32 * 1024 * 1024 * 2));
  P.wdt = (bf16*)(ws + carve(off, (size_t)32 * 1024 * 512 * 2));
  P.wrt = (bf16*)(ws + carve(off, (size_t)64 * 3072 * 2));
  P.ut = P.wgut;
  P.xc = (float*)(ws + carve(off, (size_t)NC * 1024 * 4));
  P.h = (bf16*)(ws + carve(off, (size_t)NT * 1024 * 2));
  P.cbuf = (bf16*)(ws + carve(off, (size_t)NT * C2LD * 2));
  P.qkv = (bf16*)(ws + carve(off, QKV_ELEMS * 2));
  P.ycat = (bf16*)(ws + carve(off, (size_t)NT * 1024 * 2));
  P.ssqc = (float*)(ws + carve(off, (size_t)NT * 16 * 4));
  P.ssqx = (float*)(ws + carve(off, (size_t)NT * 16 * 4));
  P.ssq2 = (float*)(ws + carve(off, (size_t)NT * 8 * 4));
  P.comp = (float*)(ws + carve(off, (size_t)NB * 2 * LCH * 512 * 2 * 4));
  P.gcomp = (float*)(ws + carve(off, (size_t)NB * 2 * LGR * 512 * 2 * 4));
  P.dtr = (float*)(ws + carve(off, (size_t)NT * 16 * 4));
  P.cst = (float*)(ws + carve(off, (size_t)NB * 16 * NPOS * 4));
  P.dtt = (float*)(ws + carve(off, (size_t)NB * 16 * NPOS * 4));
  P.wgp = (float*)(ws + carve(off, (size_t)NB * 16 * NPOS * 4));
  P.cnt = (int*)(ws + carve(off, 64 * 4));
  P.cntt = (int*)(ws + carve(off, (size_t)2048 * 32 * 4));
  P.tokinfo = (int*)(ws + carve(off, (size_t)NT * 4 * 4));
  P.tokw = (float*)(ws + carve(off, (size_t)NT * 2 * 4));
  P.list = (int*)(ws + carve(off, (size_t)32 * NT * 4));
  if (off > ws_size || n_in != 39 || out_size != NL * 1024) {
    fprintf(stderr, "kernel_launch: needs %zu bytes of workspace (got %zu), 39 inputs (got %d), out %d (got %d); nothing launched\n", off, ws_size, n_in, NL * 1024, out_size);
    return;
  }
#if ONE_LAUNCH
  hipMemsetAsync(P.bar, 0, XCD_BAR_WORDS * 4, stream);
  int lo = 0, hi = NPHASE;
  void* args[] = {&P, &lo, &hi};
  hipError_t e = hipLaunchCooperativeKernel((const void*)mega, dim3(grid), dim3(512), args, LDS_BYTES, stream);
  if (e != hipSuccess) fprintf(stderr, "kernel_launch: cooperative launch failed: %s (grid %d)\n", hipGetErrorString(e), grid);
#else
  for (int ph = 0; ph < NPHASE; ++ph) hipLaunchKernelGGL(mega, dim3(grid), dim3(512), LDS_BYTES, stream, P, ph, ph + 1);
#endif
}
```

```cpp
#define REPMASK 0
#define PROBE_PH (-1)
#define PROBE_SEC 0
#include <hip/hip_runtime.h>
#include <hip/hip_cooperative_groups.h>
#include <cstdio>
#include <cstdint>
#include <cstring>
namespace cg = cooperative_groups;

#define DI __device__ __forceinline__
typedef unsigned short bf16;
typedef __attribute__((ext_vector_type(8))) short bf16x8;
typedef __attribute__((ext_vector_type(16))) float f32x16;
typedef __attribute__((ext_vector_type(8))) float f32x8;
typedef __attribute__((ext_vector_type(4))) float f32x4;
typedef __attribute__((ext_vector_type(2))) float f32x2;
typedef __attribute__((ext_vector_type(4))) unsigned u32x4;
typedef __attribute__((ext_vector_type(2))) unsigned u32x2;
typedef __attribute__((ext_vector_type(2))) __bf16 bfx2;
typedef __attribute__((ext_vector_type(8))) __bf16 bfx8;

constexpr int D = 1024, NB = 4, SEQ = 8192, LC = 256;
constexpr int NL = NB * SEQ;
constexpr int NC = NB * LC;
constexpr int NT = NL + NC;
constexpr int NPOS = SEQ + LC;
constexpr int C1LD = 1696, C2LD = 2320;
constexpr int NCH = 66;
constexpr float EPS = 1e-6f;
constexpr float LOG2E = 1.4426950408889634f;
constexpr int NSLOT = 2 * NT;

#ifndef PROBE_PH
#define PROBE_PH (-1)
#endif
#ifndef PROBE_SEC
#define PROBE_SEC 0
#endif
#define PROBE_LDS_OFF (147456 + 800)
#define PB_BEGIN(SEC, lds_) unsigned long long pb_t0_##SEC = 0; if (PROBE_PH == -2 && PROBE_SEC == SEC && blockIdx.x == 0) { __syncthreads(); pb_t0_##SEC = __builtin_amdgcn_s_memrealtime(); }
#define PB_END(SEC, lds_) if (PROBE_PH == -2 && PROBE_SEC == SEC && blockIdx.x == 0) { __syncthreads(); if (threadIdx.x == 0) *(volatile unsigned long long*)((unsigned char*)(lds_) + PROBE_LDS_OFF) += __builtin_amdgcn_s_memrealtime() - pb_t0_##SEC; }
#define PBW_BEGIN(SEC, lds_) unsigned long long pbw_t0_##SEC = 0; if (PROBE_PH == -2 && PROBE_SEC == SEC && blockIdx.x == 0 && threadIdx.x < 64) { pbw_t0_##SEC = __builtin_amdgcn_s_memrealtime(); }
#define PBW_END(SEC, lds_) if (PROBE_PH == -2 && PROBE_SEC == SEC && blockIdx.x == 0 && threadIdx.x == 0) { *(volatile unsigned long long*)((unsigned char*)(lds_) + PROBE_LDS_OFF) += __builtin_amdgcn_s_memrealtime() - pbw_t0_##SEC; }
DI int tidx() { int t = threadIdx.x; asm volatile("" : "+v"(t)); return t; }
DI float bf2f(bf16 u) { return __uint_as_float(((unsigned)u) << 16); }
DI float lo16(unsigned u) { return __uint_as_float(u << 16); }
DI float hi16(unsigned u) { return __uint_as_float(u & 0xffff0000u); }
DI unsigned pack2(float a, float b) { f32x2 v = {a, b}; bfx2 r = __builtin_convertvector(v, bfx2); return __builtin_bit_cast(unsigned, r); }
DI bf16 f2bf(float x) { return (bf16)(pack2(x, 0.f) & 0xffffu); }
DI bf16x8 pack8(const float (&v)[8]) { f32x8 t; for (int i = 0; i < 8; ++i) t[i] = v[i]; bfx8 r = __builtin_convertvector(t, bfx8); return __builtin_bit_cast(bf16x8, r); }
DI u32x2 pack4(float a, float b, float c, float d) { u32x2 r; r[0] = pack2(a, b); r[1] = pack2(c, d); return r; }
DI void unpack8(u32x4 raw, float (&v)[8]) { for (int i = 0; i < 4; ++i) { v[2 * i] = lo16(raw[i]); v[2 * i + 1] = hi16(raw[i]); } }
DI int crow(int i, int h) { return (i & 3) + 8 * (i >> 2) + 4 * h; }
DI int swap23(int p) { return (p & ~12) | ((p & 4) << 1) | ((p & 8) >> 1); }
DI f32x16 mfma32(bf16x8 a, bf16x8 b, f32x16 c) { return __builtin_amdgcn_mfma_f32_32x32x16_bf16(a, b, c, 0, 0, 0); }
DI f32x4 mfma16(bf16x8 a, bf16x8 b, f32x4 c) { return __builtin_amdgcn_mfma_f32_16x16x32_bf16(a, b, c, 0, 0, 0); }
DI float rcpf_(float x) { return __builtin_amdgcn_rcpf(x); }
DI float sigmoidf_(float x) { return rcpf_(1.f + __expf(-x)); }
DI float siluf_(float x) { return x * rcpf_(1.f + __expf(-x)); }
DI float softplusf_(float x) { return x > 20.f ? x : log1pf(__expf(x)); }
DI float geluf_(float x) { float u = 0.7978845608028654f * (x + 0.044715f * x * x * x); float t = 1.f - 2.f * rcpf_(1.f + __expf(2.f * u)); return 0.5f * x * (1.f + t); }
DI float xor32(float v) { return v + __shfl_xor(v, 32); }
DI float wave_sum(float v) { for (int o = 32; o >= 1; o >>= 1) v += __shfl_xor(v, o); return v; }

DI void tok_info(int tok, int& bmod, int& b, int& pos, bool& lat) {
  if (tok < NL) { b = tok >> 13; bmod = b; pos = LC + (tok & (SEQ - 1)); lat = true; }
  else { int t = tok - NL; b = t >> 8; bmod = 4; pos = t & (LC - 1); lat = false; }
}

struct Params {
  const float *x, *c, *ctx, *c_ctx, *ada_w, *ada_b, *norm1_g, *norm2_g;
  const float *ab_w_in, *ab_w_out, *mla_q_norm_g, *mla_w_q_up, *mla_kv_norm_g, *mla_w_kv_up, *mla_q_head_g, *mla_k_head_g;
  const float *lru_conv_w, *lru_conv_b, *lru_w_a, *lru_b_a, *lru_w_x, *lru_b_x, *lru_lambda;
  const float *cd_w_in, *cd_w_out, *swa_q_head_g, *swa_k_head_g, *swa_sink;
  const float *ssd_conv_w, *ssd_conv_b, *ssd_a_log, *ssd_dt_bias, *ssd_d, *ssd_norm_g;
  const float *router_w, *router_b, *moe_w_gate, *moe_w_up, *moe_w_down;
  float* out;
  float* mods;
  float* ropeM;
  float* ropeS;
  float* msh;
  bf16 *win0t, *wqt, *wkvt, *wout0t, *win1t, *wout1t, *wlrut, *wgut, *wdt, *wrt;
  float* xc;
  bf16* h;
  bf16* cbuf;
  bf16* qkv;
  bf16* ycat;
  bf16* ut;
  float *ssqc, *ssqx, *ssq2;
  float* comp;
  float* gcomp;
  float* dtr;
  float *cst, *dtt, *wgp;
  int* cnt;
  int* cntt;
  int* tokinfo;
  float* tokw;
  int* list;
  unsigned* bar;
  int pad0;
  int pad1;
};
constexpr size_t QB_OFF = 0, KB_OFF = (size_t)NB * 8 * NPOS * 96, VT_OFF = 2 * KB_OFF;
constexpr size_t Q2_OFF = 0, K2_OFF = (size_t)NB * 8 * NPOS * 64, V2T_OFF = K2_OFF + (size_t)NB * 2 * NPOS * 64,
                 ST_OFF = V2T_OFF + (size_t)NB * 2 * 64 * NPOS;
constexpr size_t QKV_ELEMS = (size_t)NSLOT * 1024;
static_assert(VT_OFF + (size_t)NB * 8 * 64 * NPOS <= QKV_ELEMS, "qkv region");
static_assert(ST_OFF + (size_t)NB * 2 * 8 * NCH * 64 * 128 <= QKV_ELEMS, "qkv region L1");
#define LAS3 __attribute__((address_space(3)))
template <int WM, int WN, bool ZERO = true, class PRow, class QRow>
DI void gemm_core(bf16* smem, int K, int krot, PRow prow, QRow qrow, f32x16 (&acc)[WM][WN], int hook_kt, const float (&hs)[WN]) {
  constexpr int TP = 64 * WM, TQ = 128 * WN, NR = TP + TQ, NCHK = NR / 64, STAGE = NR * 64;
  const int tid = tidx(), lane = tid & 63, wid = tid >> 6, wr = wid >> 2, wc = wid & 3, r = lane & 31, h = lane >> 5;
  const bf16* ps[NCHK];
#pragma unroll
  for (int j = 0; j < NCHK; ++j) {
    const int R = j * 64 + (tid >> 3);
    const int cs = (tid & 7) ^ ((R >> 1) & 7);
    ps[j] = (j < WM ? prow(R) : qrow(R - TP)) + cs * 8;
  }
  const int nkt = K >> 6;
  if (ZERO) {
#pragma unroll
    for (int i = 0; i < WM; ++i)
#pragma unroll
      for (int j = 0; j < WN; ++j)
#pragma unroll
        for (int e = 0; e < 16; ++e) acc[i][j][e] = 0.f;
  }
  {
    const int ko = (krot % nkt) * 64;
#pragma unroll
    for (int j = 0; j < NCHK; ++j)
      __builtin_amdgcn_global_load_lds((const unsigned*)(ps[j] + ko), (LAS3 unsigned*)(smem + (j * 512 + wid * 64) * 8), 16, 0, 0);
  }
  asm volatile("s_waitcnt vmcnt(0)" ::: "memory");
  __syncthreads();
  const int sw = (r >> 1) & 7;
  for (int kt = 0; kt < nkt; ++kt) {
    const int buf = kt & 1;
    if (kt + 1 < nkt) {
      const int ko = ((kt + 1 + krot) % nkt) * 64;
#pragma unroll
      for (int j = 0; j < NCHK; ++j)
        __builtin_amdgcn_global_load_lds((const unsigned*)(ps[j] + ko), (LAS3 unsigned*)(smem + (buf ^ 1) * STAGE + (j * 512 + wid * 64) * 8), 16, 0, 0);
    }
    if (kt == hook_kt) {
#pragma unroll
      for (int i = 0; i < WM; ++i)
#pragma unroll
        for (int j = 0; j < WN; ++j)
#pragma unroll
          for (int e = 0; e < 16; ++e) acc[i][j][e] *= hs[j];
    }
    const bf16* sP = smem + buf * STAGE + (wr * WM * 32 + r) * 64;
    const bf16* sQ = smem + buf * STAGE + (TP + wc * WN * 32 + r) * 64;
    bf16x8 a[2][WM], b[2][WN];
    {
      const int co = (h ^ sw) * 8;
#pragma unroll
      for (int i = 0; i < WM; ++i) a[0][i] = *(const bf16x8*)(sP + i * 32 * 64 + co);
#pragma unroll
      for (int j = 0; j < WN; ++j) b[0][j] = *(const bf16x8*)(sQ + j * 32 * 64 + co);
    }
#pragma unroll
    for (int ks = 0; ks < 4; ++ks) {
      if (ks < 3) {
        const int co = (((ks + 1) * 2 + h) ^ sw) * 8;
#pragma unroll
        for (int i = 0; i < WM; ++i) a[(ks + 1) & 1][i] = *(const bf16x8*)(sP + i * 32 * 64 + co);
#pragma unroll
        for (int j = 0; j < WN; ++j) b[(ks + 1) & 1][j] = *(const bf16x8*)(sQ + j * 32 * 64 + co);
      }
#pragma unroll
      for (int i = 0; i < WM; ++i)
#pragma unroll
        for (int j = 0; j < WN; ++j) acc[i][j] = mfma32(a[ks & 1][i], b[ks & 1][j], acc[i][j]);
      if (ks < 3) {
#pragma unroll
        for (int n = 0; n < WM + WN; ++n) { __builtin_amdgcn_sched_group_barrier(0x008, 1, 0); __builtin_amdgcn_sched_group_barrier(0x100, 1, 0); }
        __builtin_amdgcn_sched_group_barrier(0x008, WM * WN - (WM + WN), 0);
      }
    }
    asm volatile("s_waitcnt vmcnt(0)" ::: "memory");
    __syncthreads();
  }
}

struct WaveId { int lane, wid, wr, wc, r, h; };
template <int WM, int WN>
DI void epi_to_lds(bf16* sT, int lane_r, int lane_h, int wr, int wc, int i, int j, int g, float a0, float a1, float a2, float a3) {
  constexpr int LDT = 64 * WM + 8;
  *(u32x2*)(sT + (wc * WN * 32 + j * 32 + lane_r) * LDT + wr * WM * 32 + i * 32 + 8 * g + 4 * lane_h) = pack4(a0, a1, a2, a3);
}
DI WaveId wave_id() { WaveId w; w.lane = tidx() & 63; w.wid = tidx() >> 6; w.wr = w.wid >> 2; w.wc = w.wid & 3; w.r = w.lane & 31; w.h = w.lane >> 5; return w; }

DI void gemm_c1_item(const Params& P, bf16* smem, int pt, int qt) {
  f32x16 acc[4][2];
  const float hs[2] = {1.f, 1.f};
  const int p0 = pt * 256, q0 = qt * 256;
  gemm_core<4, 2>(smem, 1024, 0,
      [&](int rp) { return P.win0t + (size_t)(p0 + rp) * 1024; },
      [&](int rq) { return P.h + (size_t)(q0 + rq) * 1024; }, acc, -1, hs);
  const WaveId w = wave_id();
#pragma unroll
  for (int j = 0; j < 2; ++j) {
    const int tok = q0 + w.wc * 64 + j * 32 + w.r;
#pragma unroll
    for (int i2 = 0; i2 < 2; ++i2) {
      const int grp = (p0 + w.wr * 128 + i2 * 64) >> 6;
      float ss = 0.f;
#pragma unroll
      for (int ii = 0; ii < 2; ++ii)
#pragma unroll
        for (int g = 0; g < 4; ++g) {
          const int i = i2 * 2 + ii;
          const float a0 = acc[i][j][4 * g], a1 = acc[i][j][4 * g + 1], a2 = acc[i][j][4 * g + 2], a3 = acc[i][j][4 * g + 3];
          ss += a0 * a0 + a1 * a1 + a2 * a2 + a3 * a3;
          epi_to_lds<4, 2>(smem, w.r, w.h, w.wr, w.wc, i, j, g, a0, a1, a2, a3);
        }
      ss = xor32(ss);
      if (w.h == 0 && grp < 10) P.ssqc[tok * 16 + grp] = ss;
    }
  }
  __syncthreads();
  {
    const int tid = tidx(), c = tid & 31, rr = tid >> 5;
    if (p0 + c * 8 < C1LD) {
#pragma unroll
      for (int ps_ = 0; ps_ < 16; ++ps_) {
        const int row = rr + 16 * ps_;
        *(u32x4*)(P.cbuf + (size_t)(q0 + row) * C1LD + p0 + c * 8) = *(const u32x4*)(smem + row * 264 + c * 8);
      }
    }
  }
  __syncthreads();
}

#define rope_pair(X1, X2, TAB) do { const float* tb_ = (TAB); const float cs_ = tb_[0], sn_ = tb_[1]; const float a_ = (X1) * cs_ - (X2) * sn_, b_ = (X1) * sn_ + (X2) * cs_; (X1) = a_; (X2) = b_; } while (0)

DI void gemm_q_item(const Params& P, bf16* smem, int pt, int qt) {
  f32x16 acc[3][1];
  const float hs[1] = {1.f};
  const int p0 = pt * 192, q0 = qt * 128;
  gemm_core<3, 1>(smem, 384, 0,
      [&](int rp) { return P.wqt + (size_t)(p0 + rp) * 384; },
      [&](int rq) { return P.cbuf + (size_t)(q0 + rq) * C1LD; }, acc, -1, hs);
  const WaveId w = wave_id();
  const int hd = pt * 2 + w.wr;
  const float qscale = 0.10206207261596575f * LOG2E;
#pragma unroll
  for (int j = 0; j < 1; ++j) {
    const int tok = q0 + w.wc * 32 + w.r;
    int bmod, b, pos; bool lat; tok_info(tok, bmod, b, pos, lat);
    float s6 = 0.f;
    for (int g = 0; g < 6; ++g) s6 += P.ssqc[tok * 16 + g];
    const float rstd = rsqrtf(s6 * (1.f / 384.f) + EPS);
    float ss = 0.f;
#pragma unroll
    for (int i = 0; i < 3; ++i)
#pragma unroll
      for (int e = 0; e < 16; ++e) { acc[i][j][e] *= rstd; ss += acc[i][j][e] * acc[i][j][e]; }
    ss = xor32(ss);
    const float r2 = rsqrtf(ss * (1.f / 96.f) + EPS);
#pragma unroll
    for (int i = 0; i < 3; ++i)
#pragma unroll
      for (int g = 0; g < 4; ++g) {
        const f32x4 gg = *(const f32x4*)(P.mla_q_head_g + i * 32 + 8 * g + 4 * w.h);
#pragma unroll
        for (int e = 0; e < 4; ++e) acc[i][j][4 * g + e] *= r2 * gg[e];
      }
    if (lat) {
      const int sq = tok & (SEQ - 1), rowp = sq >> 6, colp = sq & 63;
#pragma unroll
      for (int e = 0; e < 4; ++e) {
        rope_pair(acc[2][j][e], acc[2][j][4 + e], P.ropeM + (rowp * 8 + 4 * w.h + e) * 2);
        rope_pair(acc[2][j][8 + e], acc[2][j][12 + e], P.ropeM + (colp * 8 + 4 * w.h + e) * 2);
      }
    }
    bf16* dst = P.qkv + QB_OFF + ((size_t)(b * 8 + hd) * NPOS + pos) * 96;
#pragma unroll
    for (int i = 0; i < 3; ++i)
#pragma unroll
      for (int g = 0; g < 4; ++g)
        *(u32x2*)(dst + i * 32 + 8 * g + 4 * w.h) = pack4(acc[i][j][4 * g] * qscale, acc[i][j][4 * g + 1] * qscale, acc[i][j][4 * g + 2] * qscale, acc[i][j][4 * g + 3] * qscale);
  }
}

DI void gemm_kv_item(const Params& P, bf16* smem, int pt, int qt) {
  f32x16 acc[4][1];
  const float hs[1] = {1.f};
  const int p0 = pt * 256, q0 = qt * 128;
  gemm_core<4, 1>(smem, 256, 0,
      [&](int rp) { return P.wkvt + (size_t)(p0 + rp) * 256; },
      [&](int rq) { return P.cbuf + (size_t)(q0 + rq) * C1LD + 384; }, acc, -1, hs);
  const WaveId w = wave_id();
  const int hd = pt * 2 + w.wr;
#pragma unroll
  for (int j = 0; j < 1; ++j) {
    const int tok = q0 + w.wc * 32 + w.r;
    int bmod, b, pos; bool lat; tok_info(tok, bmod, b, pos, lat);
    float s4 = 0.f;
    for (int g = 6; g < 10; ++g) s4 += P.ssqc[tok * 16 + g];
    const float rstd = rsqrtf(s4 * (1.f / 256.f) + EPS);
    float kr[16];
    {
      const bf16* src = P.cbuf + (size_t)tok * C1LD + 640 + 16 * w.h;
      float t8[8];
      unpack8(*(const u32x4*)src, t8);
      for (int i = 0; i < 8; ++i) kr[i] = t8[i];
      unpack8(*(const u32x4*)(src + 8), t8);
      for (int i = 0; i < 8; ++i) kr[8 + i] = t8[i];
    }
    float ss = 0.f;
#pragma unroll
    for (int i = 0; i < 2; ++i)
#pragma unroll
      for (int e = 0; e < 16; ++e) { acc[i][j][e] *= rstd; ss += acc[i][j][e] * acc[i][j][e]; }
#pragma unroll
    for (int i = 0; i < 16; ++i) ss += kr[i] * kr[i];
    ss = xor32(ss);
    const float r2 = rsqrtf(ss * (1.f / 96.f) + EPS);
    bf16* dst = P.qkv + KB_OFF + ((size_t)(b * 8 + hd) * NPOS + pos) * 96;
#pragma unroll
    for (int i = 0; i < 2; ++i)
#pragma unroll
      for (int g = 0; g < 4; ++g) {
        const f32x4 gg = *(const f32x4*)(P.mla_k_head_g + i * 32 + 8 * g + 4 * w.h);
        *(u32x2*)(dst + i * 32 + 8 * g + 4 * w.h) = pack4(acc[i][j][4 * g] * r2 * gg[0], acc[i][j][4 * g + 1] * r2 * gg[1], acc[i][j][4 * g + 2] * r2 * gg[2], acc[i][j][4 * g + 3] * r2 * gg[3]);
      }
#pragma unroll
    for (int i = 0; i < 16; ++i) kr[i] *= r2 * P.mla_k_head_g[64 + 16 * w.h + i];
    if (lat) {
      const int sq = tok & (SEQ - 1);
      const int pp = w.h ? (sq & 63) : (sq >> 6);
#pragma unroll
      for (int i = 0; i < 8; ++i) rope_pair(kr[i], kr[8 + i], P.ropeM + (pp * 8 + i) * 2);
    }
    {
      u32x4 o0, o1;
      for (int i = 0; i < 4; ++i) { o0[i] = pack2(kr[2 * i], kr[2 * i + 1]); o1[i] = pack2(kr[8 + 2 * i], kr[8 + 2 * i + 1]); }
      *(u32x4*)(dst + 64 + 16 * w.h) = o0;
      *(u32x4*)(dst + 64 + 16 * w.h + 8) = o1;
    }
    const int posp = (pos & ~15) | swap23(pos & 15);
    bf16* vdst = P.qkv + VT_OFF + (size_t)(b * 8 + hd) * 64 * NPOS + posp;
#pragma unroll
    for (int i = 0; i < 2; ++i)
#pragma unroll
      for (int e = 0; e < 16; ++e) vdst[(size_t)(i * 32 + crow(e, w.h)) * NPOS] = f2bf(acc[2 + i][j][e] * rstd);
  }
}

template <int WM>
DI void gemm_out_item(const Params& P, bf16* smem, int layer, int pt, int qt) {
  f32x16 acc[WM][2];
  const int p0 = pt * 64 * WM, q0 = qt * 256;
  const WaveId w = wave_id();
  float hs[2] = {1.f, 1.f};
  if (layer == 1) {
#pragma unroll
    for (int j = 0; j < 2; ++j) {
      const int tok = q0 + w.wc * 64 + j * 32 + w.r;
      float s = 0.f;
      for (int g = 0; g < 8; ++g) s += P.ssq2[tok * 8 + g];
      hs[j] = rsqrtf(s * (1.f / 512.f) + EPS);
    }
  }
  const bf16* wt = layer ? P.wout1t : P.wout0t;
  gemm_core<WM, 2>(smem, 1024, layer ? 8 : 0,
      [&](int rp) { return wt + (size_t)(p0 + rp) * 1024; },
      [&](int rq) { return P.ycat + (size_t)(q0 + rq) * 1024; }, acc, layer ? 8 : -1, hs);
#pragma unroll
  for (int j = 0; j < 2; ++j) {
    const int tok = q0 + w.wc * 64 + j * 32 + w.r;
    int bmod, b, pos; bool lat; tok_info(tok, bmod, b, pos, lat);
    const float* src = layer ? (P.out + (size_t)tok * 1024) : (lat ? P.x + (size_t)tok * 1024 : P.ctx + (size_t)(tok - NL) * 1024);
    float* dst = lat ? P.out + (size_t)tok * 1024 : P.xc + (size_t)(tok - NL) * 1024;
    const float* m2 = P.mods + ((size_t)(layer * 5 + bmod) * 6 + 2) * 1024;
#pragma unroll
    for (int i = 0; i < WM; ++i)
#pragma unroll
      for (int g = 0; g < 4; ++g) {
        const int f0 = p0 + w.wr * 32 * WM + i * 32 + 8 * g + 4 * w.h;
        const f32x4 xv = *(const f32x4*)(src + f0);
        const f32x4 mv = *(const f32x4*)(m2 + f0);
        f32x4 o;
#pragma unroll
        for (int e = 0; e < 4; ++e) o[e] = xv[e] + mv[e] * acc[i][j][4 * g + e];
        *(f32x4*)(dst + f0) = o;
        if (g == 3) __builtin_amdgcn_sched_barrier(0);
      }
  }
}

DI void moe1_item(const Params& P, bf16* smem, int layer, int e, int m0, int pt, int cnt_e, int off_e) {
  f32x16 acc[4][2];
  const float hs[2] = {1.f, 1.f};
  const int* lst = P.list + (size_t)e * NT;
  gemm_core<4, 2>(smem, 1024, 0,
      [&](int rp) { return P.wgut + ((size_t)e * 1024 + pt * 256 + rp) * 1024; },
      [&](int rq) { int m = m0 + rq; if (m > cnt_e - 1) m = cnt_e - 1; return P.h + (size_t)lst[m] * 1024; }, acc, -1, hs);
  const WaveId w = wave_id();
  constexpr int LDT = 136;
#pragma unroll
  for (int j = 0; j < 2; ++j) {
    const int row = w.wc * 64 + j * 32 + w.r;
#pragma unroll
    for (int i2 = 0; i2 < 2; ++i2)
#pragma unroll
      for (int g = 0; g < 4; ++g) {
        float o[4];
#pragma unroll
        for (int k = 0; k < 4; ++k) o[k] = siluf_(acc[2 * i2][j][4 * g + k]) * acc[2 * i2 + 1][j][4 * g + k];
        *(u32x2*)(smem + row * LDT + w.wr * 64 + i2 * 32 + 8 * g + 4 * w.h) = pack4(o[0], o[1], o[2], o[3]);
      }
  }
  __syncthreads();
  {
    const int tid = tidx(), c = tid & 15, rr = tid >> 4;
#pragma unroll
    for (int ps_ = 0; ps_ < 8; ++ps_) {
      const int row = rr + 32 * ps_;
      if (m0 + row < cnt_e) *(u32x4*)(P.cbuf + (size_t)(off_e + m0 + row) * 512 + pt * 128 + c * 8) = *(const u32x4*)(smem + row * LDT + c * 8);
    }
  }
  __syncthreads();
}
DI void moe2_item(const Params& P, bf16* smem, int e, int m0, int pt, int cnt_e, int off_e, int total) {
  f32x16 acc[4][2];
  const float hs[2] = {1.f, 1.f};
  gemm_core<4, 2>(smem, 512, 0,
      [&](int rp) { return P.wdt + ((size_t)e * 1024 + pt * 256 + rp) * 512; },
      [&](int rq) { int s = off_e + m0 + rq; if (s > total - 1) s = total - 1; return P.cbuf + (size_t)s * 512; }, acc, -1, hs);
  const WaveId w = wave_id();
#pragma unroll
  for (int j = 0; j < 2; ++j)
#pragma unroll
    for (int i = 0; i < 4; ++i)
#pragma unroll
      for (int g = 0; g < 4; ++g) epi_to_lds<4, 2>(smem, w.r, w.h, w.wr, w.wc, i, j, g, acc[i][j][4 * g], acc[i][j][4 * g + 1], acc[i][j][4 * g + 2], acc[i][j][4 * g + 3]);
  __syncthreads();
  {
    const int tid = tidx(), c = tid & 31, rr = tid >> 5;
#pragma unroll
    for (int ps_ = 0; ps_ < 16; ++ps_) {
      const int row = rr + 16 * ps_;
      if (m0 + row < cnt_e) *(u32x4*)(P.qkv + (size_t)(off_e + m0 + row) * 1024 + pt * 256 + c * 8) = *(const u32x4*)(smem + row * 264 + c * 8);
    }
  }
  __syncthreads();
}

DI void moe1_half(const Params& P, bf16* smem, int layer, int e, int m0, int pt2, int cnt_e, int off_e) {
  f32x16 acc[2][2];
  const float hs[2] = {1.f, 1.f};
  const int* lst = P.list + (size_t)e * NT;
  gemm_core<2, 2>(smem, 1024, 0,
      [&](int rp) { return P.wgut + ((size_t)e * 1024 + pt2 * 128 + rp) * 1024; },
      [&](int rq) { int m = m0 + rq; if (m > cnt_e - 1) m = cnt_e - 1; return P.h + (size_t)lst[m] * 1024; }, acc, -1, hs);
  const WaveId w = wave_id();
  constexpr int LDT = 72;
#pragma unroll
  for (int j = 0; j < 2; ++j) {
    const int row = w.wc * 64 + j * 32 + w.r;
#pragma unroll
    for (int g = 0; g < 4; ++g) {
      float o[4];
#pragma unroll
      for (int k = 0; k < 4; ++k) o[k] = siluf_(acc[0][j][4 * g + k]) * acc[1][j][4 * g + k];
      *(u32x2*)(smem + row * LDT + w.wr * 32 + 8 * g + 4 * w.h) = pack4(o[0], o[1], o[2], o[3]);
    }
  }
  __syncthreads();
  {
    const int tid = tidx(), c = tid & 7, rr = tid >> 3;
#pragma unroll
    for (int ps_ = 0; ps_ < 4; ++ps_) {
      const int row = rr + 64 * ps_;
      if (m0 + row < cnt_e) *(u32x4*)(P.cbuf + (size_t)(off_e + m0 + row) * 512 + pt2 * 64 + c * 8) = *(const u32x4*)(smem + row * LDT + c * 8);
    }
  }
  __syncthreads();
}
DI void moe2_half(const Params& P, bf16* smem, int e, int m0, int pt2, int cnt_e, int off_e, int total) {
  f32x16 acc[2][2];
  const float hs[2] = {1.f, 1.f};
  gemm_core<2, 2>(smem, 512, 0,
      [&](int rp) { return P.wdt + ((size_t)e * 1024 + pt2 * 128 + rp) * 512; },
      [&](int rq) { int s = off_e + m0 + rq; if (s > total - 1) s = total - 1; return P.cbuf + (size_t)s * 512; }, acc, -1, hs);
  const WaveId w = wave_id();
#pragma unroll
  for (int j = 0; j < 2; ++j)
#pragma unroll
    for (int i = 0; i < 2; ++i)
#pragma unroll
      for (int g = 0; g < 4; ++g) epi_to_lds<2, 2>(smem, w.r, w.h, w.wr, w.wc, i, j, g, acc[i][j][4 * g], acc[i][j][4 * g + 1], acc[i][j][4 * g + 2], acc[i][j][4 * g + 3]);
  __syncthreads();
  {
    const int tid = tidx(), c = tid & 15, rr = tid >> 4;
#pragma unroll
    for (int ps_ = 0; ps_ < 8; ++ps_) {
      const int row = rr + 32 * ps_;
      if (m0 + row < cnt_e) *(u32x4*)(P.qkv + (size_t)(off_e + m0 + row) * 1024 + pt2 * 128 + c * 8) = *(const u32x4*)(smem + row * 136 + c * 8);
    }
  }
  __syncthreads();
}

DI void c2_block_epilogue(const Params& P, const WaveId& w, int fb, int tok, f32x16& a0, f32x16& a1) {
  int bmod, b, pos; bool lat; tok_info(tok, bmod, b, pos, lat);
  const float qscale = 0.125f * LOG2E;
  if (fb < 10) {
    const bool isq = fb < 8;
    const float* gain = isq ? P.swa_q_head_g : P.swa_k_head_g;
    float ss = 0.f;
#pragma unroll
    for (int e = 0; e < 16; ++e) ss += a0[e] * a0[e] + a1[e] * a1[e];
    ss = xor32(ss);
    const float r2 = rsqrtf(ss * (1.f / 64.f) + EPS);
#pragma unroll
    for (int g = 0; g < 4; ++g) {
      const f32x4 g0 = *(const f32x4*)(gain + 8 * g + 4 * w.h), g1 = *(const f32x4*)(gain + 32 + 8 * g + 4 * w.h);
#pragma unroll
      for (int e = 0; e < 4; ++e) { a0[4 * g + e] *= r2 * g0[e]; a1[4 * g + e] *= r2 * g1[e]; }
    }
    if (lat) {
      const int sq = tok & (SEQ - 1), rowp = sq >> 6, colp = sq & 63;
#pragma unroll
      for (int e = 0; e < 4; ++e) {
        rope_pair(a0[e], a0[8 + e], P.ropeS + (rowp * 16 + 4 * w.h + e) * 2);
        rope_pair(a0[4 + e], a0[12 + e], P.ropeS + (rowp * 16 + 8 + 4 * w.h + e) * 2);
        rope_pair(a1[e], a1[8 + e], P.ropeS + (colp * 16 + 4 * w.h + e) * 2);
        rope_pair(a1[4 + e], a1[12 + e], P.ropeS + (colp * 16 + 8 + 4 * w.h + e) * 2);
      }
    }
    if (isq && !lat) return;
    const float sc = isq ? qscale : 1.f;
    bf16* dst = isq ? P.qkv + Q2_OFF + ((size_t)(b * 8 + fb) * NPOS + pos) * 64
                    : P.qkv + K2_OFF + ((size_t)(b * 2 + (fb - 8)) * NPOS + pos) * 64;
#pragma unroll
    for (int g = 0; g < 4; ++g) {
      *(u32x2*)(dst + 8 * g + 4 * w.h) = pack4(a0[4 * g] * sc, a0[4 * g + 1] * sc, a0[4 * g + 2] * sc, a0[4 * g + 3] * sc);
      *(u32x2*)(dst + 32 + 8 * g + 4 * w.h) = pack4(a1[4 * g] * sc, a1[4 * g + 1] * sc, a1[4 * g + 2] * sc, a1[4 * g + 3] * sc);
    }
  } else if (fb < 12) {
    const int posp = (pos & ~15) | swap23(pos & 15);
    bf16* vdst = P.qkv + V2T_OFF + (size_t)(b * 2 + (fb - 10)) * 64 * NPOS + posp;
#pragma unroll
    for (int e = 0; e < 16; ++e) {
      vdst[(size_t)(crow(e, w.h)) * NPOS] = f2bf(a0[e]);
      vdst[(size_t)(32 + crow(e, w.h)) * NPOS] = f2bf(a1[e]);
    }
  } else if (fb < 36) {
    bf16* dst = P.cbuf + (size_t)tok * C2LD + fb * 64;
#pragma unroll
    for (int g = 0; g < 4; ++g) {
      *(u32x2*)(dst + 8 * g + 4 * w.h) = pack4(a0[4 * g], a0[4 * g + 1], a0[4 * g + 2], a0[4 * g + 3]);
      *(u32x2*)(dst + 32 + 8 * g + 4 * w.h) = pack4(a1[4 * g], a1[4 * g + 1], a1[4 * g + 2], a1[4 * g + 3]);
    }
  }
}
DI void gemm_c2_item(const Params& P, bf16* smem, int pt, int qt) {
  f32x16 acc[4][2];
  const float hs[2] = {1.f, 1.f};
  const int p0 = pt * 256, q0 = qt * 256;
  gemm_core<4, 2>(smem, 1024, 0,
      [&](int rp) { return P.win1t + (size_t)(p0 + rp) * 1024; },
      [&](int rq) { return P.h + (size_t)(q0 + rq) * 1024; }, acc, -1, hs);
  const WaveId w = wave_id();
#pragma unroll
  for (int j = 0; j < 2; ++j) {
    const int tok = q0 + w.wc * 64 + j * 32 + w.r;
#pragma unroll
    for (int i2 = 0; i2 < 2; ++i2) c2_block_epilogue(P, w, (p0 + w.wr * 128 + i2 * 64) >> 6, tok, acc[2 * i2][j], acc[2 * i2 + 1][j]);
  }
}
DI void gemm_c2dt_item(const Params& P, bf16* smem, int qt) {
  f32x16 acc[1][2];
  const float hs[2] = {1.f, 1.f};
  const int q0 = qt * 256;
  gemm_core<1, 2>(smem, 1024, 0,
      [&](int rp) { return P.win1t + (size_t)(2304 + rp) * 1024; },
      [&](int rq) { return P.h + (size_t)(q0 + rq) * 1024; }, acc, -1, hs);
  const WaveId w = wave_id();
  if (w.wr == 0) {
#pragma unroll
    for (int j = 0; j < 2; ++j) {
      const int tok = q0 + w.wc * 64 + j * 32 + w.r;
#pragma unroll
      for (int g = 0; g < 2; ++g) {
        f32x4 o = {acc[0][j][4 * g], acc[0][j][4 * g + 1], acc[0][j][4 * g + 2], acc[0][j][4 * g + 3]};
        *(f32x4*)(P.dtr + (size_t)tok * 16 + 8 * g + 4 * w.h) = o;
      }
    }
  }
}
template <int DQK, bool WIN, bool GQA = false>
DI void attn_item(bf16* smem, const bf16* Qp, const bf16* Kp, const bf16* Vtp, int qrow0, int nq, int ntiles, int nctx, int band_k0, int q_lat0,
                  float negM, float sinkterm, bf16* outp, const float* sinks = nullptr) {
  constexpr int KS = DQK / 16, LDK = DQK + 8, LDV = 72, CPR = DQK / 8, NCK = 64 * CPR;
  const int tid = tidx(), lane = tid & 63, w = tid >> 6, r = lane & 31, h = lane >> 5;
  bf16* sK = smem;
  bf16* sV = smem + 2 * 64 * LDK;
  const int wq = GQA ? (w & 1) * 64 : w * 64;
  if (GQA) { Qp += (size_t)(w >> 1) * NPOS * DQK; outp += (w >> 1) * 64; sinkterm = __builtin_amdgcn_exp2f(sinks[w >> 1] * LOG2E + negM); }
  bf16x8 qf[2][KS];
#pragma unroll
  for (int qt = 0; qt < 2; ++qt) {
    int qi = wq + qt * 32 + r;
    if (qi > nq - 1) qi = nq - 1;
#pragma unroll
    for (int s = 0; s < KS; ++s) qf[qt][s] = *(const bf16x8*)(Qp + (size_t)(qrow0 + qi) * DQK + s * 16 + h * 8);
  }
  f32x16 O[2][2];
#pragma unroll
  for (int a = 0; a < 2; ++a)
#pragma unroll
    for (int b = 0; b < 2; ++b)
#pragma unroll
      for (int e = 0; e < 16; ++e) O[a][b][e] = 0.f;
  float lsum[2] = {0.f, 0.f};
  const int kr0 = tid / CPR, kc0 = tid % CPR;
  const int id1 = tid + 512;
  const bool has1 = id1 < NCK;
  const int kr1 = has1 ? id1 / CPR : 0, kc1 = has1 ? id1 % CPR : 0;
  const int vr = tid >> 3, vc = tid & 7;
  u32x4 rK0, rK1, rV;
  rK1 = rK0 = rV = u32x4{0, 0, 0, 0};
  auto tilepos = [&](int t) { return t < nctx ? t * 64 : LC + band_k0 + (t - nctx) * 64; };
  auto gload = [&](int t) {
    const int pos = tilepos(t);
    rK0 = *(const u32x4*)(Kp + (size_t)(pos + kr0) * DQK + kc0 * 8);
    if (has1) rK1 = *(const u32x4*)(Kp + (size_t)(pos + kr1) * DQK + kc1 * 8);
    rV = *(const u32x4*)(Vtp + (size_t)vr * NPOS + pos + vc * 8);
  };
  auto swrite = [&](int buf) {
    *(u32x4*)(sK + buf * 64 * LDK + kr0 * LDK + kc0 * 8) = rK0;
    if (has1) *(u32x4*)(sK + buf * 64 * LDK + kr1 * LDK + kc1 * 8) = rK1;
    *(u32x4*)(sV + buf * 64 * LDV + vr * LDV + vc * 8) = rV;
  };
  gload(0); swrite(0);
  __syncthreads();
  const int qw = q_lat0 + wq;
  for (int t = 0; t < ntiles; ++t) {
    const int buf = t & 1;
    if (t + 1 < ntiles) gload(t + 1);
    bool act = (wq < nq);
    int kk0 = 0;
    const bool band = WIN && t >= nctx;
    if (band) { kk0 = band_k0 + (t - nctx) * 64; act = act && (kk0 + 63 >= qw - 128) && (kk0 <= qw + 191); }
    if (act) {
      const bf16* sKb = sK + buf * 64 * LDK;
      const bf16* sVb = sV + buf * 64 * LDV;
#pragma unroll 1
      for (int ksub = 0; ksub < 2; ++ksub) {
        bf16x8 pb[2][2];
        {
          const bf16* kfp = sKb + (ksub * 32 + r) * LDK + h * 8;
#pragma unroll
          for (int qt = 0; qt < 2; ++qt) {
            f32x16 sc;
#pragma unroll
            for (int e = 0; e < 16; ++e) sc[e] = negM;
#pragma unroll
            for (int s = 0; s < KS; ++s) sc = mfma32(*(const bf16x8*)(kfp + s * 16), qf[qt][s], sc);
            float p[16];
#pragma unroll
            for (int e = 0; e < 16; ++e) p[e] = __builtin_amdgcn_exp2f(sc[e]);
            if (band) {
              const int qi = qw + qt * 32 + r;
#pragma unroll
              for (int e = 0; e < 16; ++e) {
                const int dd = qi - (kk0 + ksub * 32 + crow(e, h));
                if (dd > 128 || dd < -128) p[e] = 0.f;
              }
            }
            float ps = 0.f;
#pragma unroll
            for (int e = 0; e < 16; ++e) ps += p[e];
            lsum[qt] += ps;
            float p0[8], p1[8];
#pragma unroll
            for (int e = 0; e < 8; ++e) { p0[e] = p[e]; p1[e] = p[8 + e]; }
            pb[qt][0] = pack8(p0); pb[qt][1] = pack8(p1);
          }
        }
#pragma unroll
        for (int dt = 0; dt < 2; ++dt)
#pragma unroll
          for (int st = 0; st < 2; ++st) {
            const bf16x8 vf = *(const bf16x8*)(sVb + (dt * 32 + r) * LDV + ksub * 32 + st * 16 + h * 8);
            O[0][dt] = mfma32(vf, pb[0][st], O[0][dt]);
            O[1][dt] = mfma32(vf, pb[1][st], O[1][dt]);
          }
      }
    }
    if (t + 1 < ntiles) swrite(buf ^ 1);
    __syncthreads();
  }
#pragma unroll
  for (int qt = 0; qt < 2; ++qt) {
    const float l = xor32(lsum[qt]) + sinkterm;
    const float inv = 1.f / l;
    const int qi = wq + qt * 32 + r;
    if (qi < nq) {
      bf16* dst = outp + (size_t)qi * 1024;
#pragma unroll
      for (int dt = 0; dt < 2; ++dt)
#pragma unroll
        for (int g = 0; g < 4; ++g)
          *(u32x2*)(dst + dt * 32 + 8 * g + 4 * h) = pack4(O[qt][dt][4 * g] * inv, O[qt][dt][4 * g + 1] * inv, O[qt][dt][4 * g + 2] * inv, O[qt][dt][4 * g + 3] * inv);
    }
  }
}

constexpr int LCH = 80, LGR = 9;
DI void lru_apply(float (&h)[4], const float* base, int col, bool valid) {
#pragma unroll
  for (int n = 0; n < 4; ++n) {
    const f32x2 cm = *(const f32x2*)(base + (16 * n + col) * 2);
    h[n] = valid ? cm[0] * h[n] + cm[1] : h[n];
  }
}
DI void lru_chunk(const Params& P, const float* sGateBase, const float* sTaps, bf16* hfw, int bi, int j, int c, int pass, float* sComp) {
  const int lane = tidx() & 63, col = lane & 15, g = lane >> 4;
  const bool isctx = c < 16;
  const int L = isctx ? LC : SEQ;
  const int sp0 = isctx ? c * 16 : (c - 16) * 128;
  const int tokbase = isctx ? (NL + bi * LC + sp0) : (bi * SEQ + sp0);
  const int nsteps = isctx ? 1 : 8;
  const bf16* C1 = P.cbuf;
  bf16* XCV = P.h;
  if (pass == 0) {
    for (int st = 0; st < nsteps; ++st) {
      const int t = st * 16 + col;
      u32x4 raw[2][4];
#pragma unroll
      for (int s = 0; s < 2; ++s)
#pragma unroll
        for (int k = 0; k < 4; ++k) {
          const int tt = sp0 + t + k - 2;
          const bool ok = tt >= 0 && tt < L;
          const int row = ok ? (tokbase + t + k - 2) : tokbase + t;
          raw[s][k] = *(const u32x4*)(C1 + (size_t)row * C1LD + 672 + 64 * j + 32 * s + 8 * g);
        }
#pragma unroll
      for (int s = 0; s < 2; ++s) {
        const int c0 = 64 * j + 32 * s + 8 * g;
        float a8[8];
        {
          const f32x4 b0 = *(const f32x4*)(sTaps + 2048 + c0), b1 = *(const f32x4*)(sTaps + 2048 + c0 + 4);
          for (int i = 0; i < 4; ++i) { a8[i] = b0[i]; a8[4 + i] = b1[i]; }
        }
#pragma unroll
        for (int k = 0; k < 4; ++k) {
          const int tt = sp0 + t + k - 2;
          const float m = (tt >= 0 && tt < L) ? 1.f : 0.f;
          float x8[8];
          unpack8(raw[s][k], x8);
          const f32x4 w0 = *(const f32x4*)(sTaps + k * 512 + c0), w1 = *(const f32x4*)(sTaps + k * 512 + c0 + 4);
          for (int i = 0; i < 4; ++i) { a8[i] += m * w0[i] * x8[i]; a8[4 + i] += m * w1[i] * x8[4 + i]; }
        }
        *(bf16x8*)(XCV + (size_t)(tokbase + t) * 512 + c0) = pack8(a8);
      }
    }
  }
#pragma unroll 1
  for (int dir = 0; dir < 2; ++dir) {
    bf16x8 wb[8][2];
#pragma unroll
    for (int n = 0; n < 8; ++n)
#pragma unroll
      for (int s = 0; s < 2; ++s)
        wb[n][s] = *(const bf16x8*)(P.wlrut + ((size_t)(((dir * 2 + (n >> 2)) * 8 + j) * 64 + 16 * (n & 3) + col)) * 64 + 32 * s + 8 * g);
    bf16x8 idf[2];
#pragma unroll
    for (int n = 0; n < 2; ++n)
#pragma unroll
      for (int jj = 0; jj < 8; ++jj) idf[n][jj] = ((8 * g + jj) == 16 * n + col) ? (short)0x3F80 : (short)0;
    float hst[4], arun[4];
#pragma unroll
    for (int n = 0; n < 4; ++n) { hst[n] = 0.f; arun[n] = 1.f; }
    const float* sGate = sGateBase + dir * 1536 + 64 * j + col;
    if (pass == 1) {
      const float* cbase = P.comp + ((size_t)(bi * 2 + dir) * LCH) * 1024 + 128 * j;
      const float* gbase = P.gcomp + ((size_t)(bi * 2 + dir) * LGR) * 1024 + 128 * j;
      if (isctx) {
#pragma unroll
        for (int i = 0; i < 15; ++i) {
          const int cc = dir == 0 ? i : 15 - i;
          const bool valid = dir == 0 ? (i < c) : (15 - i > c);
          lru_apply(hst, cbase + (size_t)(valid ? cc : 0) * 1024, col, valid);
        }
      } else {
        const int q = (c - 16) >> 3;
        lru_apply(hst, gbase, col, true);
#pragma unroll
        for (int i = 0; i < 7; ++i) {
          const int qq = dir == 0 ? i : 7 - i;
          const bool valid = dir == 0 ? (i < q) : (7 - i > q);
          lru_apply(hst, gbase + (size_t)(1 + (valid ? qq : 0)) * 1024, col, valid);
        }
#pragma unroll
        for (int i = 0; i < 7; ++i) {
          const int cc = dir == 0 ? 16 + 8 * q + i : 16 + 8 * q + 7 - i;
          const bool valid = dir == 0 ? (cc < c) : (cc > c);
          lru_apply(hst, cbase + (size_t)(valid ? cc : 16) * 1024, col, valid);
        }
      }
    }
    bf16x8 afc[2];
    auto issue = [&](int st, bf16x8 (&af)[2]) {
      const int t = st * 16 + col;
#pragma unroll
      for (int s = 0; s < 2; ++s) af[s] = *(const bf16x8*)(XCV + (size_t)(tokbase + t) * 512 + 64 * j + 32 * s + 8 * g);
    };
    issue(dir ? nsteps - 1 : 0, afc);
    for (int step = 0; step < nsteps; ++step) {
      const int st = dir ? nsteps - 1 - step : step;
      const int t0 = st * 16;
      bf16x8 af[2];
      af[0] = afc[0]; af[1] = afc[1];
      if (step + 1 < nsteps) issue(dir ? st - 1 : st + 1, afc);
      f32x4 ag[8], xcC[4];
      const f32x4 z4 = {0.f, 0.f, 0.f, 0.f};
#pragma unroll
      for (int n = 0; n < 8; ++n) { ag[n] = mfma16(af[0], wb[n][0], z4); ag[n] = mfma16(af[1], wb[n][1], ag[n]); }
#pragma unroll
      for (int n = 0; n < 4; ++n) xcC[n] = mfma16(af[n >> 1], idf[n & 1], z4);
#pragma unroll
      for (int n = 0; n < 4; ++n) {
        float av[4], bv[4];
#pragma unroll
        for (int e = 0; e < 4; ++e) {
          const float rg = sigmoidf_(ag[n][e] + sGate[16 * n]);
          const float ig = sigmoidf_(ag[4 + n][e] + sGate[512 + 16 * n]);
          const float a = __expf(-sGate[1024 + 16 * n] * rg);
          av[e] = a;
          bv[e] = __builtin_amdgcn_sqrtf(fmaxf(fmaf(-a, a, 1.f), 0.f)) * ig * xcC[n][e];
        }
        float A = 1.f, H = 0.f;
        if (dir == 0) { for (int e = 0; e < 4; ++e) { H = av[e] * H + bv[e]; A *= av[e]; } }
        else { for (int e = 3; e >= 0; --e) { H = av[e] * H + bv[e]; A *= av[e]; } }
        float A1, H1, Aex, Hex, At, Ht;
        if (dir == 0) {
          A1 = __shfl_up(A, 16); H1 = __shfl_up(H, 16);
          if (g >= 1) { H = A * H1 + H; A = A * A1; }
          A1 = __shfl_up(A, 32); H1 = __shfl_up(H, 32);
          if (g >= 2) { H = A * H1 + H; A = A * A1; }
          Aex = __shfl_up(A, 16); Hex = __shfl_up(H, 16);
          if (g == 0) { Aex = 1.f; Hex = 0.f; }
          At = __shfl(A, col + 48); Ht = __shfl(H, col + 48);
        } else {
          A1 = __shfl_down(A, 16); H1 = __shfl_down(H, 16);
          if (g <= 2) { H = A * H1 + H; A = A * A1; }
          A1 = __shfl_down(A, 32); H1 = __shfl_down(H, 32);
          if (g <= 1) { H = A * H1 + H; A = A * A1; }
          Aex = __shfl_down(A, 16); Hex = __shfl_down(H, 16);
          if (g == 3) { Aex = 1.f; Hex = 0.f; }
          At = __shfl(A, col); Ht = __shfl(H, col);
        }
        if (pass == 0) {
          hst[n] = At * hst[n] + Ht; arun[n] = At * arun[n];
        } else {
          float hc = Aex * hst[n] + Hex;
          hst[n] = At * hst[n] + Ht;
          float o[4];
          if (dir == 0) { for (int e = 0; e < 4; ++e) { hc = av[e] * hc + bv[e]; o[e] = hc; } }
          else { for (int e = 3; e >= 0; --e) { hc = av[e] * hc + bv[e]; o[e] = hc; } }
#pragma unroll
          for (int e = 0; e < 4; ++e) {
            bf16* yp = hfw + (t0 + 4 * g + e) * 64 + 16 * n + col;
            if (dir == 0) *yp = f2bf(o[e]); else *yp = f2bf(bf2f(*yp) + o[e]);
          }
        }
      }
    }
    if (pass == 0 && g == 0) {
#pragma unroll
      for (int n = 0; n < 4; ++n) {
        f32x2 cm = {arun[n], hst[n]};
        *(f32x2*)(P.comp + ((size_t)((bi * 2 + dir) * LCH + c) * 512 + 64 * j + 16 * n + col) * 2) = cm;
        *(f32x2*)(sComp + (dir * 64 + 16 * n + col) * 2) = cm;
      }
    }
  }
  if (pass == 1) {
    const int ntok = nsteps * 16;
    for (int i0 = 0; i0 < ntok * 8; i0 += 64 * 4) {
      u32x4 gr[4];
#pragma unroll
      for (int u = 0; u < 4; ++u) {
        const int id = i0 + u * 64 + lane;
        const int tk = id >> 3, cc = id & 7;
        gr[u] = u32x4{0, 0, 0, 0};
        if (tk < ntok) gr[u] = *(const u32x4*)(C1 + (size_t)(tokbase + tk) * C1LD + 1184 + 64 * j + cc * 8);
      }
#pragma unroll
      for (int u = 0; u < 4; ++u) {
        const int id = i0 + u * 64 + lane;
        const int tk = id >> 3, cc = id & 7;
        if (tk < ntok) {
          float hv[8], gv[8];
          unpack8(*(const u32x4*)(hfw + tk * 64 + cc * 8), hv);
          unpack8(gr[u], gv);
#pragma unroll
          for (int e = 0; e < 8; ++e) hv[e] *= geluf_(gv[e]);
          *(bf16x8*)(P.ycat + (size_t)(tokbase + tk) * 1024 + 512 + 64 * j + cc * 8) = pack8(hv);
        }
      }
    }
  }
}

DI void lru_block_item(const Params& P, float* fsm, int bi, int j, int grp, int pass) {
  const int tid = tidx(), wid = tid >> 6;
  const float* sGate = fsm;
  const float* sTaps = fsm + 3072;
  float* sComp = fsm + 5632;
  bf16* hfw = (bf16*)(fsm + 3072) + wid * 8192;
  if (grp == 0) {
    lru_chunk(P, sGate, sTaps, hfw, bi, j, 2 * wid, pass, sComp + (2 * wid) * 256);
    lru_chunk(P, sGate, sTaps, hfw, bi, j, 2 * wid + 1, pass, sComp + (2 * wid + 1) * 256);
  } else {
    lru_chunk(P, sGate, sTaps, hfw, bi, j, 16 + 8 * (grp - 1) + wid, pass, sComp + wid * 256);
  }
  if (pass == 0) {
    __syncthreads();
    if (tid < 128) {
      const int dir = tid >> 6, ch = tid & 63;
      const int n = grp == 0 ? 16 : 8;
      float A = 1.f, H = 0.f;
      for (int i = 0; i < n; ++i) {
        const int cc = dir == 0 ? i : n - 1 - i;
        const float a = sComp[cc * 256 + (dir * 64 + ch) * 2], hh = sComp[cc * 256 + (dir * 64 + ch) * 2 + 1];
        H = a * H + hh; A = a * A;
      }
      f32x2 cm = {A, H};
      *(f32x2*)(P.gcomp + ((size_t)((bi * 2 + dir) * LGR + grp) * 512 + 64 * j + ch) * 2) = cm;
    }
    __syncthreads();
  }
}
DI void chunk_geom(int bi, int ck, int& L, int& sp0, int& tokbase, int& pos0) {
  const bool isctx = ck < 2;
  L = isctx ? LC : SEQ;
  sp0 = isctx ? ck * 128 : (ck - 2) * 128;
  tokbase = isctx ? (NL + bi * LC + sp0) : (bi * SEQ + sp0);
  pos0 = isctx ? sp0 : LC + sp0;
}

DI void ssd_conv_item(const Params& P, bf16* smem, int gc, int cr) {
  (void)smem;
  const int bi = gc / NCH, ck = gc % NCH;
  int L, sp0, tokbase, pos0; chunk_geom(bi, ck, L, sp0, tokbase, pos0);
  const int tid = tidx();
  const int cc = tid & 31, o = tid >> 5;
  const int c0 = cr * 256 + cc * 8;
  f32x4 wv[4][2], bv[2];
#pragma unroll
  for (int k = 0; k < 4; ++k) { wv[k][0] = *(const f32x4*)(P.ssd_conv_w + k * 1024 + c0); wv[k][1] = *(const f32x4*)(P.ssd_conv_w + k * 1024 + c0 + 4); }
  bv[0] = *(const f32x4*)(P.ssd_conv_b + c0); bv[1] = *(const f32x4*)(P.ssd_conv_b + c0 + 4);
  const int tA = 16 * (o >> 1) + 4 * (o & 1);
  u32x4 raw[2][7];
#pragma unroll
  for (int rn = 0; rn < 2; ++rn)
#pragma unroll
    for (int i = 0; i < 7; ++i) {
      const int t = tA + 8 * rn + i - 2, tt = sp0 + t;
      raw[rn][i] = u32x4{0, 0, 0, 0};
      if (tt >= 0 && tt < L) raw[rn][i] = *(const u32x4*)(P.cbuf + (size_t)(tokbase + t) * C2LD + 1280 + c0);
    }
  float ut[8][8];
#pragma unroll
  for (int rn = 0; rn < 2; ++rn)
#pragma unroll
    for (int i = 0; i < 4; ++i) {
      float a8[8];
#pragma unroll
      for (int e = 0; e < 4; ++e) { a8[e] = bv[0][e]; a8[4 + e] = bv[1][e]; }
#pragma unroll
      for (int k = 0; k < 4; ++k) {
        float x8[8];
        unpack8(raw[rn][i + k], x8);
#pragma unroll
        for (int e = 0; e < 4; ++e) { a8[e] += wv[k][0][e] * x8[e]; a8[4 + e] += wv[k][1][e] * x8[4 + e]; }
      }
#pragma unroll
      for (int e = 0; e < 8; ++e) { a8[e] = siluf_(a8[e]); ut[e][4 * rn + i] = a8[e]; }
      *(bf16x8*)(P.h + (size_t)(tokbase + tA + 8 * rn + i) * 1024 + c0) = pack8(a8);
    }
#pragma unroll
  for (int e = 0; e < 8; ++e) *(bf16x8*)(P.ut + ((size_t)(bi * 1024 + c0 + e)) * NPOS + pos0 + 8 * o) = pack8(ut[e]);
}

DI void ssd_cumsum_item(const Params& P, int gc) {
  const int bi = gc / NCH, ck = gc % NCH;
  int L, sp0, tokbase, pos0; chunk_geom(bi, ck, L, sp0, tokbase, pos0);
  const int lane = tidx() & 63;
  f32x4 raw[2][4];
#pragma unroll
  for (int u = 0; u < 2; ++u)
#pragma unroll
    for (int q = 0; q < 4; ++q) raw[u][q] = *(const f32x4*)(P.dtr + (size_t)(tokbase + 64 * u + lane) * 16 + 4 * q);
  const int perm = (lane & ~15) | swap23(lane & 15);
#pragma unroll
  for (int idx = 0; idx < 16; ++idx) {
    const float A = -__expf(P.ssd_a_log[idx]);
    const float bias = P.ssd_dt_bias[idx];
    const float dt0 = softplusf_(raw[0][idx >> 2][idx & 3] + bias), dt1 = softplusf_(raw[1][idx >> 2][idx & 3] + bias);
    const float a0 = dt0 * A, a1 = dt1 * A;
    float c0 = a0, c1 = a1;
#pragma unroll
    for (int d = 1; d < 64; d <<= 1) {
      const float v0 = __shfl_up(c0, d), v1 = __shfl_up(c1, d);
      if (lane >= d) { c0 += v0; c1 += v1; }
    }
    c1 += __shfl(c0, 63);
    const float total = __shfl(c1, 63);
    const size_t rowb = (size_t)(bi * 16 + idx) * NPOS + pos0;
    P.dtt[rowb + lane] = dt0; P.dtt[rowb + 64 + lane] = dt1;
    P.cst[rowb + lane] = c0; P.cst[rowb + 64 + lane] = c1;
    const float w0 = idx < 8 ? dt0 * __expf(total - c0) : dt0 * __expf(c0 - a0);
    const float w1 = idx < 8 ? dt1 * __expf(total - c1) : dt1 * __expf(c1 - a1);
    P.wgp[rowb + perm] = w0; P.wgp[rowb + 64 + perm] = w1;
  }
}

DI void ssd_passA_item(const Params& P, int gc, int hd, int dir, int pt) {
  const int bi = gc / NCH, ck = gc % NCH;
  int L, sp0, tokbase, pos0; chunk_geom(bi, ck, L, sp0, tokbase, pos0);
  const int lane = tidx() & 63, r = lane & 31, h = lane >> 5;
  const int idx = dir * 8 + hd, grp = hd >> 2;
  const bf16* xrow = P.ut + ((size_t)(bi * 1024 + hd * 64 + 32 * pt + r)) * NPOS + pos0 + 8 * h;
  const float* wrow = P.wgp + (size_t)(bi * 16 + idx) * NPOS + pos0 + 8 * h;
  const bf16* brow = P.ut + ((size_t)(bi * 1024 + 512 + grp * 128 + r)) * NPOS + pos0 + 8 * h;
  bf16x8 xs[8];
  {
    u32x4 xr[8]; f32x4 w0[8], w1[8];
#pragma unroll
    for (int ks = 0; ks < 8; ++ks) { xr[ks] = *(const u32x4*)(xrow + 16 * ks); w0[ks] = *(const f32x4*)(wrow + 16 * ks); w1[ks] = *(const f32x4*)(wrow + 16 * ks + 4); }
#pragma unroll
    for (int ks = 0; ks < 8; ++ks) {
      float x8[8];
      unpack8(xr[ks], x8);
#pragma unroll
      for (int e = 0; e < 4; ++e) { x8[e] *= w0[ks][e]; x8[4 + e] *= w1[ks][e]; }
      xs[ks] = pack8(x8);
    }
  }
  f32x16 acc[4];
#pragma unroll
  for (int nt = 0; nt < 4; ++nt)
#pragma unroll
    for (int e = 0; e < 16; ++e) acc[nt][e] = 0.f;
#pragma unroll
  for (int ks = 0; ks < 8; ++ks)
#pragma unroll
    for (int nt = 0; nt < 4; ++nt) acc[nt] = mfma32(*(const bf16x8*)(brow + (size_t)(32 * nt) * NPOS + 16 * ks), xs[ks], acc[nt]);
  bf16* dst = P.qkv + ST_OFF + ((size_t)(((bi * 2 + dir) * 8 + hd) * NCH + ck)) * 8192 + (32 * pt + r) * 128 + 4 * h;
#pragma unroll
  for (int nt = 0; nt < 4; ++nt)
#pragma unroll
    for (int g = 0; g < 4; ++g) *(u32x2*)(dst + 32 * nt + 8 * g) = pack4(acc[nt][4 * g], acc[nt][4 * g + 1], acc[nt][4 * g + 2], acc[nt][4 * g + 3]);
}

DI void ssd_passB(const Params& P, int bid, int nblk) {
  const int nthr = nblk * 512;
  for (int id = bid * 512 + tidx(); id < NB * 2 * 8 * 2048; id += nthr) {
    const int e4 = id & 2047, hd = (id >> 11) & 7, dir = (id >> 14) & 1, bi = id >> 15;
    bf16* base = P.qkv + ST_OFF + ((size_t)((bi * 2 + dir) * 8 + hd)) * NCH * 8192 + e4 * 4;
    const float* crow_ = P.cst + (size_t)(bi * 16 + dir * 8 + hd) * NPOS;
    float S0 = 0.f, S1 = 0.f, S2 = 0.f, S3 = 0.f;
    for (int i0 = 0; i0 < NCH; i0 += 6) {
      u32x2 raw[6]; float dec[6]; int cks[6];
#pragma unroll
      for (int u = 0; u < 6; ++u) {
        const int i = i0 + u;
        const int ck = dir == 0 ? i : (i == 0 ? 1 : (i == 1 ? 0 : 67 - i));
        cks[u] = ck;
        raw[u] = *(const u32x2*)(base + (size_t)ck * 8192);
        dec[u] = __expf(crow_[ck * 128 + 127]);
      }
#pragma unroll
      for (int u = 0; u < 6; ++u) {
        *(u32x2*)(base + (size_t)cks[u] * 8192) = pack4(S0, S1, S2, S3);
        S0 = dec[u] * S0 + lo16(raw[u][0]); S1 = dec[u] * S1 + hi16(raw[u][0]);
        S2 = dec[u] * S2 + lo16(raw[u][1]); S3 = dec[u] * S3 + hi16(raw[u][1]);
      }
    }
  }
}

DI void ssd_passC_item(const Params& P, bf16* smem, int bi, int ck, int grp) {
  int L, sp0, tokbase, pos0; chunk_geom(bi, ck, L, sp0, tokbase, pos0);
  const int tid = tidx(), lane = tid & 63, wid = tid >> 6, r = lane & 31, h = lane >> 5;
  constexpr int LDB = 136;
  bf16* sB = smem;
  bf16* sC = smem + 128 * LDB;
  bf16* sX = smem + 256 * LDB;
  float* sCS = (float*)(smem + 512 * LDB);
  float* sDT = sCS + 1024;
  const bf16* U = P.h;
  {
    u32x4 tb[4], tc[4], tx[8];
#pragma unroll
    for (int i = 0; i < 4; ++i) {
      const int id = tid + 512 * i, row = id >> 4, c = id & 15;
      tb[i] = *(const u32x4*)(U + (size_t)(tokbase + row) * 1024 + 512 + grp * 128 + c * 8);
      tc[i] = *(const u32x4*)(U + (size_t)(tokbase + row) * 1024 + 768 + grp * 128 + c * 8);
    }
#pragma unroll
    for (int i = 0; i < 8; ++i) {
      const int id = tid + 512 * i, row = id >> 4, c = id & 15;
      tx[i] = *(const u32x4*)(P.ut + ((size_t)(bi * 1024 + grp * 256 + row)) * NPOS + pos0 + c * 8);
    }
    float cv[2], dv[2];
#pragma unroll
    for (int i = 0; i < 2; ++i) {
      const int id = tid + 512 * i, dir = id >> 9, hl = (id >> 7) & 3, t = id & 127;
      const size_t o = (size_t)(bi * 16 + dir * 8 + grp * 4 + hl) * NPOS + pos0 + t;
      cv[i] = P.cst[o]; dv[i] = P.dtt[o];
    }
#pragma unroll
    for (int i = 0; i < 4; ++i) {
      const int id = tid + 512 * i, row = id >> 4, c = id & 15;
      *(u32x4*)(sB + row * LDB + c * 8) = tb[i];
      *(u32x4*)(sC + row * LDB + c * 8) = tc[i];
    }
#pragma unroll
    for (int i = 0; i < 8; ++i) {
      const int id = tid + 512 * i, row = id >> 4, c = id & 15;
      *(u32x4*)(sX + row * LDB + c * 8) = tx[i];
    }
#pragma unroll
    for (int i = 0; i < 2; ++i) { sCS[tid + 512 * i] = cv[i]; sDT[tid + 512 * i] = dv[i]; }
  }
  __syncthreads();
  const int hl = wid >> 1, hd = grp * 4 + hl;
  const float Ah0 = -__expf(P.ssd_a_log[hd]), Ah1 = -__expf(P.ssd_a_log[8 + hd]);
  const float dsk = P.ssd_d[hd] + P.ssd_d[8 + hd];
  const float* csF = sCS + hl * 128;
  const float* csR = sCS + 512 + hl * 128;
  const float* dtF = sDT + hl * 128;
  const float* dtR = sDT + 512 + hl * 128;
#pragma unroll 1
  for (int lq = 0; lq < 2; ++lq) {
    const int lt = 2 * (wid & 1) + lq;
    const int l = lt * 32 + r;
    const size_t tok = tokbase + l;
    bf16x8 cfr[8];
#pragma unroll
    for (int ks = 0; ks < 8; ++ks) cfr[ks] = *(const bf16x8*)(sC + l * LDB + 16 * ks + 8 * h);
    f32x16 acc[2];
#pragma unroll
    for (int pt = 0; pt < 2; ++pt)
#pragma unroll
      for (int e = 0; e < 16; ++e) acc[pt][e] = 0.f;
    const float cslF = csF[l], cslR = csR[l];
    const float exlR = cslR - dtR[l] * Ah1;
#pragma unroll
    for (int dir = 0; dir < 2; ++dir) {
      const float fac = dir == 0 ? __expf(cslF) : __expf(csR[127] - exlR);
#pragma unroll
      for (int pt = 0; pt < 2; ++pt) {
        f32x16 yo;
#pragma unroll
        for (int e = 0; e < 16; ++e) yo[e] = 0.f;
        const bf16* srow = P.qkv + ST_OFF + ((size_t)(((bi * 2 + dir) * 8 + hd) * NCH + ck)) * 8192 + (32 * pt + r) * 128 + 8 * h;
#pragma unroll
        for (int ks = 0; ks < 8; ++ks) yo = mfma32(*(const bf16x8*)(srow + 16 * ks), cfr[ks], yo);
#pragma unroll
        for (int e = 0; e < 16; ++e) acc[pt][e] += fac * yo[e];
      }
    }
#pragma unroll 1
    for (int st = 0; st < 4; ++st) {
      f32x16 G;
#pragma unroll
      for (int e = 0; e < 16; ++e) G[e] = 0.f;
#pragma unroll
      for (int ks = 0; ks < 8; ++ks) G = mfma32(*(const bf16x8*)(sB + (st * 32 + r) * LDB + 16 * ks + 8 * h), cfr[ks], G);
      const bf16* x0p = sX + (hl * 64 + r) * LDB + st * 32 + 8 * h;
      const bf16x8 x00 = *(const bf16x8*)(x0p), x01 = *(const bf16x8*)(x0p + 16);
      const bf16x8 x10 = *(const bf16x8*)(x0p + 32 * LDB), x11 = *(const bf16x8*)(x0p + 32 * LDB + 16);
      if (st <= lt) {
        float m[16];
#pragma unroll
        for (int g = 0; g < 4; ++g) {
          const int sb = st * 32 + 8 * g + 4 * h;
          const f32x4 cs4 = *(const f32x4*)(csF + sb), dt4 = *(const f32x4*)(dtF + sb);
#pragma unroll
          for (int e = 0; e < 4; ++e) m[4 * g + e] = (sb + e <= l) ? G[4 * g + e] * __expf(cslF - cs4[e]) * dt4[e] : 0.f;
        }
        float t0[8], t1[8];
#pragma unroll
        for (int e = 0; e < 8; ++e) { t0[e] = m[e]; t1[e] = m[8 + e]; }
        const bf16x8 p0 = pack8(t0), p1 = pack8(t1);
        acc[0] = mfma32(x00, p0, acc[0]); acc[0] = mfma32(x01, p1, acc[0]);
        acc[1] = mfma32(x10, p0, acc[1]); acc[1] = mfma32(x11, p1, acc[1]);
      }
      if (st >= lt) {
        float m[16];
#pragma unroll
        for (int g = 0; g < 4; ++g) {
          const int sb = st * 32 + 8 * g + 4 * h;
          const f32x4 cs4 = *(const f32x4*)(csR + sb), dt4 = *(const f32x4*)(dtR + sb);
#pragma unroll
          for (int e = 0; e < 4; ++e) m[4 * g + e] = (sb + e >= l) ? G[4 * g + e] * __expf((cs4[e] - dt4[e] * Ah1) - exlR) * dt4[e] : 0.f;
        }
        float t0[8], t1[8];
#pragma unroll
        for (int e = 0; e < 8; ++e) { t0[e] = m[e]; t1[e] = m[8 + e]; }
        const bf16x8 p0 = pack8(t0), p1 = pack8(t1);
        acc[0] = mfma32(x00, p0, acc[0]); acc[0] = mfma32(x01, p1, acc[0]);
        acc[1] = mfma32(x10, p0, acc[1]); acc[1] = mfma32(x11, p1, acc[1]);
      }
    }
    (void)Ah0;
    float ss = 0.f;
#pragma unroll
    for (int pt = 0; pt < 2; ++pt)
#pragma unroll
      for (int g = 0; g < 4; ++g) {
        const int p0 = 32 * pt + 8 * g + 4 * h;
        const u32x2 xr = *(const u32x2*)(U + tok * 1024 + hd * 64 + p0);
        const u32x2 zr = *(const u32x2*)(P.cbuf + tok * C2LD + 768 + hd * 64 + p0);
        const float xs[4] = {lo16(xr[0]), hi16(xr[0]), lo16(xr[1]), hi16(xr[1])};
        const float zz[4] = {lo16(zr[0]), hi16(zr[0]), lo16(zr[1]), hi16(zr[1])};
        float o[4];
#pragma unroll
        for (int e = 0; e < 4; ++e) { o[e] = (acc[pt][4 * g + e] + dsk * xs[e]) * siluf_(zz[e]); ss += o[e] * o[e]; }
        *(u32x2*)(P.ycat + tok * 1024 + 512 + hd * 64 + p0) = pack4(o[0], o[1], o[2], o[3]);
      }
    ss = xor32(ss);
    if (h == 0) P.ssq2[tok * 8 + hd] = ss;
  }
  __syncthreads();
}

DI void row_pass2(const Params& P, int mode, int layer, int tokA, int ntok, const int* sOff) {
  const int lane = tidx() & 63;
  const int tk[2] = {tokA, tokA + 1 < ntok ? tokA + 1 : tokA};
  const bool ok1 = tokA + 1 < ntok;
  f32x4 v[2][4];
  const float* src[2];
  int bm[2];
#pragma unroll
  for (int u = 0; u < 2; ++u) {
    int b, pos; bool lat; tok_info(tk[u], bm[u], b, pos, lat);
    src[u] = mode == 0 ? (lat ? P.x + (size_t)tk[u] * 1024 : P.ctx + (size_t)(tk[u] - NL) * 1024)
                       : (lat ? P.out + (size_t)tk[u] * 1024 : P.xc + (size_t)(tk[u] - NL) * 1024);
#pragma unroll
    for (int i = 0; i < 4; ++i) v[u][i] = *(const f32x4*)(src[u] + 4 * lane + 256 * i);
  }
  if (mode == 1 || mode == 2) {
    u32x2 y0[2][4], y1[2][4];
    float w0[2], w1[2];
#pragma unroll
    for (int u = 0; u < 2; ++u) {
      const int* ti = P.tokinfo + (size_t)tk[u] * 4;
      const int s0 = sOff[ti[0]] + ti[1], s1 = sOff[ti[2]] + ti[3];
      w0[u] = P.tokw[tk[u] * 2]; w1[u] = P.tokw[tk[u] * 2 + 1];
#pragma unroll
      for (int i = 0; i < 4; ++i) {
        const int k = 4 * lane + 256 * i;
        y0[u][i] = *(const u32x2*)(P.qkv + (size_t)s0 * 1024 + k); y1[u][i] = *(const u32x2*)(P.qkv + (size_t)s1 * 1024 + k);
      }
    }
#pragma unroll
    for (int u = 0; u < 2; ++u) {
      const float* m5 = P.mods + ((size_t)((mode - 1) * 5 + bm[u]) * 6 + 5) * 1024;
      float* dst = tk[u] < NL ? P.out + (size_t)tk[u] * 1024 : P.xc + (size_t)(tk[u] - NL) * 1024;
#pragma unroll
      for (int i = 0; i < 4; ++i) {
        const int k = 4 * lane + 256 * i;
        const f32x4 mv = *(const f32x4*)(m5 + k);
        v[u][i][0] += mv[0] * (w0[u] * lo16(y0[u][i][0]) + w1[u] * lo16(y1[u][i][0]));
        v[u][i][1] += mv[1] * (w0[u] * hi16(y0[u][i][0]) + w1[u] * hi16(y1[u][i][0]));
        v[u][i][2] += mv[2] * (w0[u] * lo16(y0[u][i][1]) + w1[u] * lo16(y1[u][i][1]));
        v[u][i][3] += mv[3] * (w0[u] * hi16(y0[u][i][1]) + w1[u] * hi16(y1[u][i][1]));
        if (u == 0 || ok1) *(f32x4*)(dst + k) = v[u][i];
      }
    }
    if (mode == 2) return;
  }
#pragma unroll
  for (int u = 0; u < 2; ++u) {
    float ss = 0.f;
#pragma unroll
    for (int i = 0; i < 4; ++i) ss += v[u][i][0] * v[u][i][0] + v[u][i][1] * v[u][i][1] + v[u][i][2] * v[u][i][2] + v[u][i][3] * v[u][i][3];
    ss = wave_sum(ss);
    const float rstd = rsqrtf(ss * (1.f / 1024.f) + EPS);
    const float* g1 = P.norm1_g + layer * 1024;
    const float* sh = P.mods + ((size_t)(layer * 5 + bm[u]) * 6 + 0) * 1024;
    const float* sc = P.mods + ((size_t)(layer * 5 + bm[u]) * 6 + 1) * 1024;
    if (u == 0 || ok1) {
#pragma unroll
      for (int i = 0; i < 4; ++i) {
        const int k = 4 * lane + 256 * i;
        const f32x4 gv = *(const f32x4*)(g1 + k), sv = *(const f32x4*)(sc + k), hv = *(const f32x4*)(sh + k);
        float o[4];
#pragma unroll
        for (int e = 0; e < 4; ++e) o[e] = v[u][i][e] * rstd * gv[e] * (1.f + sv[e]) + hv[e];
        *(u32x2*)(P.h + (size_t)tk[u] * 1024 + k) = pack4(o[0], o[1], o[2], o[3]);
      }
    }
  }
}

DI void route_tokens(const Params& P, int layer, float* sW, int item, int tok_lo, int tok_hi) {
  const int tid = tidx(), lane = tid & 63, wid = tid >> 6, r = lane & 31, h = lane >> 5;
  float* sSS = sW;
  float* sAcc = sW + 256;
  int* sCnt = (int*)(sW + 256 + 8192);
  if (tid < 32) sCnt[tid] = 0;
  const int ks0 = 128 * wid;
  bf16x8 whi[8], wlo[8];
#pragma unroll
  for (int s = 0; s < 8; ++s) {
    float hi8[8], lo8[8];
#pragma unroll
    for (int j = 0; j < 8; ++j) {
      const float wv = P.router_w[(size_t)(ks0 + 16 * s + 8 * h + j) * 32 + r];
      const float hv = bf2f(f2bf(wv));
      hi8[j] = hv; lo8[j] = wv - hv;
    }
    whi[s] = pack8(hi8); wlo[s] = pack8(lo8);
  }
  const float* g2 = P.norm2_g + layer * 1024 + ks0 + 8 * h;
  __syncthreads();
  f32x4 xv[8][2];
  auto xload = [&](int t0) {
    const int tk = t0 + r < tok_hi ? t0 + r : tok_hi - 1;
    const float* src = (tk < NL ? P.out + (size_t)tk * 1024 : P.xc + (size_t)(tk - NL) * 1024) + ks0 + 8 * h;
#pragma unroll
    for (int s = 0; s < 8; ++s) { xv[s][0] = *(const f32x4*)(src + 16 * s); xv[s][1] = *(const f32x4*)(src + 16 * s + 4); }
  };
  if (tok_lo < tok_hi) xload(tok_lo);
  for (int t0 = tok_lo; t0 < tok_hi; t0 += 32) {
    const bool ok = t0 + r < tok_hi;
    const int tok = ok ? t0 + r : tok_hi - 1;
    const int bmod = tok < NL ? (tok >> 13) : 4;
    const float* shp = P.mods + ((size_t)(layer * 5 + bmod) * 6 + 3) * 1024 + ks0 + 8 * h;
    const float* scp = P.mods + ((size_t)(layer * 5 + bmod) * 6 + 4) * 1024 + ks0 + 8 * h;
    float ss = 0.f;
#pragma unroll
    for (int s = 0; s < 8; ++s)
#pragma unroll
      for (int e = 0; e < 4; ++e) ss += xv[s][0][e] * xv[s][0][e] + xv[s][1][e] * xv[s][1][e];
    ss = xor32(ss);
    if (h == 0) sSS[wid * 32 + r] = ss;
    __syncthreads();
    float tot = 0.f;
#pragma unroll
    for (int w8 = 0; w8 < 8; ++w8) tot += sSS[w8 * 32 + r];
    const float rstd = rsqrtf(tot * (1.f / 1024.f) + EPS);
    f32x16 acc;
#pragma unroll
    for (int e = 0; e < 16; ++e) acc[e] = 0.f;
#pragma unroll
    for (int s = 0; s < 8; ++s) {
      const f32x4 g0 = *(const f32x4*)(g2 + 16 * s), g1 = *(const f32x4*)(g2 + 16 * s + 4);
      const f32x4 c0 = *(const f32x4*)(scp + 16 * s), c1 = *(const f32x4*)(scp + 16 * s + 4);
      const f32x4 s0 = *(const f32x4*)(shp + 16 * s), s1 = *(const f32x4*)(shp + 16 * s + 4);
      float hv[8], hi8[8], lo8[8];
#pragma unroll
      for (int e = 0; e < 4; ++e) {
        hv[e] = xv[s][0][e] * rstd * g0[e] * (1.f + c0[e]) + s0[e];
        hv[4 + e] = xv[s][1][e] * rstd * g1[e] * (1.f + c1[e]) + s1[e];
      }
      const bf16x8 hb = pack8(hv);
#pragma unroll
      for (int e = 0; e < 8; ++e) { hi8[e] = bf2f((bf16)hb[e]); lo8[e] = hv[e] - hi8[e]; }
      const bf16x8 lb = pack8(lo8);
      if (ok) *(bf16x8*)(P.h + (size_t)tok * 1024 + ks0 + 16 * s + 8 * h) = hb;
      acc = mfma32(whi[s], hb, acc);
      acc = mfma32(whi[s], lb, acc);
      acc = mfma32(wlo[s], hb, acc);
    }
#pragma unroll
    for (int e = 0; e < 16; ++e) sAcc[(wid * 16 + e) * 64 + lane] = acc[e];
    if (t0 + 32 < tok_hi) xload(t0 + 32);
    __syncthreads();
    if (wid == 0) {
      float lo[16], hi[16];
#pragma unroll
      for (int e = 0; e < 16; ++e) {
        float v = 0.f;
#pragma unroll
        for (int w8 = 0; w8 < 8; ++w8) v += sAcc[(w8 * 16 + e) * 64 + lane];
        const float oth = __shfl_xor(v, 32);
        lo[e] = h == 0 ? v : oth; hi[e] = h == 0 ? oth : v;
      }
      float bestg = -3.0e38f, bu0 = 0.f, bu1 = 0.f;
      int be0 = 0, be1 = 0;
#pragma unroll
      for (int q = 0; q < 4; ++q) {
        float m1 = -3.0e38f, m2 = -3.0e38f, u1 = 0.f, u2 = 0.f;
        int i1 = 0, i2 = 0;
#pragma unroll
        for (int m = 0; m < 8; ++m) {
          const float lg = m < 4 ? lo[4 * q + (m & 3)] : hi[4 * q + (m & 3)];
          const float uu = 1.f / (1.f + expf(-lg));
          const float xb = uu + P.router_b[8 * q + m];
          if (xb > m1) { m2 = m1; i2 = i1; u2 = u1; m1 = xb; i1 = m; u1 = uu; }
          else if (xb > m2) { m2 = xb; i2 = m; u2 = uu; }
        }
        const float gs = m1 + m2;
        if (gs > bestg) { bestg = gs; be0 = 8 * q + i1; be1 = 8 * q + i2; bu0 = u1; bu1 = u2; }
      }
      if (ok && h == 0) {
        const int r0 = atomicAdd(&sCnt[be0], 1), r1 = atomicAdd(&sCnt[be1], 1);
        const float inv = 1.f / (bu0 + bu1);
        int* ti = P.tokinfo + (size_t)tok * 4;
        ti[0] = be0; ti[1] = r0; ti[2] = be1; ti[3] = r1;
        P.tokw[tok * 2] = bu0 * inv; P.tokw[tok * 2 + 1] = bu1 * inv;
      }
    }
    __syncthreads();
  }
  if (tid < 32) P.cntt[item * 32 + tid] = sCnt[tid];
  __syncthreads();
}
DI void conv_tile(float* sT, const float* src, int K, int N, bf16* dst, int dld, int rmode, const float* scale, int koff, int tk, int tn) {
  const int tid = tidx();
  const int k0 = tk * 64, n0 = tn * 256;
  {
    const int n4 = (tid & 63) * 4, kk = tid >> 6;
    f32x4 v[8];
#pragma unroll
    for (int p = 0; p < 8; ++p) {
      v[p] = f32x4{0.f, 0.f, 0.f, 0.f};
      if (n0 + n4 < N) v[p] = *(const f32x4*)(src + (size_t)(k0 + kk + 8 * p) * N + n0 + n4);
    }
#pragma unroll
    for (int p = 0; p < 8; ++p) {
      const int k = k0 + kk + 8 * p;
      float s = 1.f;
      if (scale != nullptr && k >= koff) s = scale[k - koff];
#pragma unroll
      for (int e = 0; e < 4; ++e) sT[(kk + 8 * p) * 257 + n4 + e] = v[p][e] * s;
    }
  }
  __syncthreads();
  {
    const int kc = (tid & 7) * 8;
#pragma unroll
    for (int q = 0; q < 4; ++q) {
      const int n = (tid >> 3) + 64 * q;
      if (n0 + n < N) {
        float v8[8];
#pragma unroll
        for (int e = 0; e < 8; ++e) v8[e] = sT[(kc + e) * 257 + n];
        const int nn = n0 + n;
        const int row = rmode == 0 ? nn : (64 * (nn >> 5) + (nn & 31) + (rmode == 2 ? 32 : 0));
        *(bf16x8*)(dst + (size_t)row * dld + k0 + kc) = pack8(v8);
      }
    }
  }
  __syncthreads();
}

DI void conv_moe_tile(const Params& P, float* sT, int layer, int t) {
  const int e = t / 96, u = t % 96;
  if (u < 32) conv_tile(sT, P.moe_w_gate + ((size_t)(layer * 32 + e)) * 1024 * 512, 1024, 512, P.wgut + (size_t)e * 1024 * 1024, 1024, 1, nullptr, 0, u >> 1, u & 1);
  else if (u < 64) conv_tile(sT, P.moe_w_up + ((size_t)(layer * 32 + e)) * 1024 * 512, 1024, 512, P.wgut + (size_t)e * 1024 * 1024, 1024, 2, nullptr, 0, (u - 32) >> 1, (u - 32) & 1);
  else conv_tile(sT, P.moe_w_down + ((size_t)(layer * 32 + e)) * 512 * 1024, 512, 1024, P.wdt + (size_t)e * 1024 * 512, 512, 0, nullptr, 0, (u - 64) >> 2, (u - 64) & 3);
}
constexpr int NCONV_MOE = 32 * 96;

constexpr int NCONV_DENSE = 112 + 18 + 16 + 64 + 160 + 64 + 32;
DI void conv_dense_tile(const Params& P, float* sT, int t) {
  if (t < 112) { conv_tile(sT, P.ab_w_in, 1024, 1696, P.win0t, 1024, 0, nullptr, 0, t / 7, t % 7); return; }
  t -= 112;
  if (t < 18) { conv_tile(sT, P.mla_w_q_up, 384, 768, P.wqt, 384, 0, P.mla_q_norm_g, 0, t / 3, t % 3); return; }
  t -= 18;
  if (t < 16) { conv_tile(sT, P.mla_w_kv_up, 256, 1024, P.wkvt, 256, 0, P.mla_kv_norm_g, 0, t / 4, t % 4); return; }
  t -= 16;
  if (t < 64) { conv_tile(sT, P.ab_w_out, 1024, 1024, P.wout0t, 1024, 0, nullptr, 0, t / 4, t % 4); return; }
  t -= 64;
  if (t < 160) { conv_tile(sT, P.cd_w_in, 1024, 2320, P.win1t, 1024, 0, nullptr, 0, t / 10, t % 10); return; }
  t -= 160;
  if (t < 64) { conv_tile(sT, P.cd_w_out, 1024, 1024, P.wout1t, 1024, 0, P.ssd_norm_g, 512, t / 4, t % 4); return; }
  t -= 64;
  {
    const int blk = t & 7, gate = (t >> 3) & 1, dir = t >> 4;
    const float* src = (gate ? P.lru_w_x : P.lru_w_a) + ((size_t)(dir * 8 + blk)) * 4096;
    conv_tile(sT, src, 64, 64, P.wlrut + ((size_t)((dir * 2 + gate) * 8 + blk)) * 4096, 64, 0, nullptr, 0, 0, 0);
  }
}

DI void mods_item(const Params& P, float* sS, float* sR, int layer, int cb) {
  const int tid = tidx(), col = tid & 63, kq = tid >> 6;
  float a[5] = {0.f, 0.f, 0.f, 0.f, 0.f};
  const float* wp = P.ada_w + (size_t)layer * 1024 * 6144 + cb * 64 + col;
  for (int k = kq * 128; k < kq * 128 + 128; ++k) {
    const float wv = wp[(size_t)k * 6144];
#pragma unroll
    for (int v = 0; v < 5; ++v) a[v] += sS[v * 1024 + k] * wv;
  }
#pragma unroll
  for (int v = 0; v < 5; ++v) sR[(kq * 5 + v) * 64 + col] = a[v];
  __syncthreads();
  if (tid < 320) {
    const int v = tid >> 6;
    float s = P.ada_b[layer * 6144 + cb * 64 + col];
    for (int q = 0; q < 8; ++q) s += sR[(q * 5 + v) * 64 + col];
    P.mods[((size_t)(layer * 5 + v)) * 6144 + cb * 64 + col] = s;
  }
  __syncthreads();
}

enum { PH_PREP, PH_NORM1_0, PH_C1, PH_QKV, PH_ATTN0, PH_OUT0, PH_NORM2_0, PH_SCAT0, PH_MOE1_0, PH_MOE2_0, PH_COMB0, PH_C2, PH_SSDPREP, PH_SSDA, PH_SSDB, PH_SSDC, PH_OUT1, PH_NORM2_1, PH_SCAT1, PH_MOE1_1, PH_MOE2_1, PH_FINAL, NPHASE };
constexpr int GEMM_LDS = (256 + 256) * 2 * 72 * 2;

DI void run_phase(const Params& P, int ph, unsigned char* lds, int bid, int nblk) {
  bf16* smem = (bf16*)lds;
  float* fsm = (float*)lds;
  int* ism = (int*)lds;
  const int tid = tidx(), wid = tid >> 6;
  const int gw = bid * 8 + wid, ngw = nblk * 8;
  const int nrep = 1 + ((P.pad0 >> ph) & 1);
#define REP for (int rep_ = 0; rep_ < nrep; ++rep_)
#define REPB(bit) for (int rep_ = 0, nr_ = 1 + ((P.pad0 >> (bit)) & 1); rep_ < nr_; ++rep_)
  switch (ph) {
    case PH_PREP: {
      if (bid == 0) {
        for (int i = tid; i < 128 * 8; i += 512) {
          const int p = i >> 3, f = i & 7;
          float rev = (float)p * __builtin_amdgcn_exp2f(-(float)f * (13.287712379549449f / 8.f)) * 0.15915494309189535f;
          rev -= floorf(rev);
          P.ropeM[i * 2] = __builtin_amdgcn_cosf(rev); P.ropeM[i * 2 + 1] = __builtin_amdgcn_sinf(rev);
        }
        for (int i = tid; i < 128 * 16; i += 512) {
          const int p = i >> 4, f = i & 15;
          float rev = (float)p * __builtin_amdgcn_exp2f(-(float)f * (13.287712379549449f / 16.f)) * 0.15915494309189535f;
          rev -= floorf(rev);
          P.ropeS[i * 2] = __builtin_amdgcn_cosf(rev); P.ropeS[i * 2 + 1] = __builtin_amdgcn_sinf(rev);
        }
        if (tid == 0) {
          float gq = 0.f, gk = 0.f, sq = 0.f, sk = 0.f, sm = 0.f;
          for (int i = 0; i < 96; ++i) { gq = fmaxf(gq, fabsf(P.mla_q_head_g[i])); gk = fmaxf(gk, fabsf(P.mla_k_head_g[i])); }
          for (int i = 0; i < 64; ++i) { sq = fmaxf(sq, fabsf(P.swa_q_head_g[i])); sk = fmaxf(sk, fabsf(P.swa_k_head_g[i])); }
          for (int i = 0; i < 8; ++i) sm = fmaxf(sm, P.swa_sink[i]);
          P.msh[0] = 9.797958971132712f * gq * gk * LOG2E;
          P.msh[1] = fmaxf(8.f * sq * sk, sm) * LOG2E;
        }
      }
      for (int i = tid; i < 5 * 1024; i += 512) {
        const float v = i < 4096 ? P.c[i] : P.c_ctx[i - 4096];
        fsm[i] = siluf_(v);
      }
      __syncthreads();
      REPB(30) for (int it = bid; it < 2 * 96; it += nblk) mods_item(P, fsm, fsm + 5120, it / 96, it % 96);
      __syncthreads();
      REP for (int it = bid; it < NCONV_DENSE + NCONV_MOE; it += nblk) {
        if (it < NCONV_DENSE) conv_dense_tile(P, fsm, it); else conv_moe_tile(P, fsm, 0, it - NCONV_DENSE);
      }
    } break;
    case PH_NORM1_0: {
      REP for (int tok = 2 * gw; tok < NT; tok += 2 * ngw) row_pass2(P, 0, 0, tok, NT, nullptr);
    } break;
    case PH_C1: {
      REP for (int it = bid; it < 7 * 132; it += nblk) gemm_c1_item(P, smem, it % 7, it / 7);
    } break;
    case PH_QKV: {
      REP for (int it = bid; it < 264 * 8; it += nblk) {
        const int qt = it >> 3, u = it & 7;
        if (u < 4) gemm_q_item(P, smem, u, qt); else gemm_kv_item(P, smem, u - 4, qt);
      }
      __syncthreads();
      for (int i = tid; i < 2560; i += 512) fsm[3072 + i] = i < 2048 ? P.lru_conv_w[i] : P.lru_conv_b[i - 2048];
      for (int i = tid; i < 3072; i += 512) { const int d = i / 1536, u = i % 1536, k = u >> 9, ch = u & 511; fsm[i] = k == 0 ? P.lru_b_a[d * 512 + ch] : (k == 1 ? P.lru_b_x[d * 512 + ch] : 8.f * softplusf_(-P.lru_lambda[d * 512 + ch])); }
      __syncthreads();
      REPB(26) for (int it = bid; it < NB * 8 * LGR; it += nblk) { const int u = it < 256 ? it : it - 256; lru_block_item(P, fsm, it < 256 ? (u >> 6) : (u >> 3), it < 256 ? ((u >> 3) & 7) : (u & 7), it < 256 ? 1 + (u & 7) : 0, 0); }
    } break;
    case PH_ATTN0: {
      for (int i = tid; i < 2560; i += 512) fsm[3072 + i] = i < 2048 ? P.lru_conv_w[i] : P.lru_conv_b[i - 2048];
      for (int i = tid; i < 3072; i += 512) { const int d = i / 1536, u = i % 1536, k = u >> 9, ch = u & 511; fsm[i] = k == 0 ? P.lru_b_a[d * 512 + ch] : (k == 1 ? P.lru_b_x[d * 512 + ch] : 8.f * softplusf_(-P.lru_lambda[d * 512 + ch])); }
      __syncthreads();
      REPB(27) for (int it = bid; it < NB * 8 * LGR; it += nblk) { const int u = it < 256 ? it : it - 256; lru_block_item(P, fsm, it < 256 ? (u >> 6) : (u >> 3), it < 256 ? ((u >> 3) & 7) : (u & 7), it < 256 ? 1 + (u & 7) : 0, 1); }
      __syncthreads();
      const float negM = -P.msh[0];
      REP {
        for (int u = bid; u < 512; u += nblk) {
          const int qb = u & 15, hd = (u >> 4) & 7, b = u >> 7;
          const size_t hb = (size_t)(b * 8 + hd) * NPOS;
          attn_item<96, false>(smem, P.qkv + QB_OFF + hb * 96, P.qkv + KB_OFF + hb * 96, P.qkv + VT_OFF + hb * 64, LC + qb * 512, 512, 132, 132, 0, 0, negM, 0.f,
                               P.ycat + (size_t)(b * SEQ + qb * 512) * 1024 + hd * 64);
        }
        for (int it = nblk - 1 - bid; it < 32; it += nblk) {
          const int b = it >> 3, hd = it & 7;
          const size_t hb = (size_t)(b * 8 + hd) * NPOS;
          attn_item<96, false>(smem, P.qkv + QB_OFF + hb * 96, P.qkv + KB_OFF + hb * 96, P.qkv + VT_OFF + hb * 64, 0, 256, 4, 4, 0, 0, negM, 0.f,
                               P.ycat + (size_t)(NL + b * LC) * 1024 + hd * 64);
        }
      }
    } break;
    case PH_OUT0: {
      REP for (int it = bid; it < 512 + 32; it += nblk) { if (it < 512) gemm_out_item<4>(P, smem, 0, it & 3, it >> 2); else gemm_out_item<2>(P, smem, 0, (it - 512) & 7, 128 + ((it - 512) >> 3)); }
    } break;
    case PH_NORM2_0: case PH_NORM2_1: {
      const int layer = ph == PH_NORM2_0 ? 0 : 1;
      const int ntok = layer == 0 ? NT : NL;
      const int T = (ntok + nblk - 1) / nblk;
      __syncthreads();
      { const int lo_ = bid * T, hi_ = lo_ + T < ntok ? lo_ + T : ntok; route_tokens(P, layer, fsm, bid, lo_ < ntok ? lo_ : ntok, hi_ > lo_ ? hi_ : lo_); }
      if (layer == 1) {
        __syncthreads();
        for (int it = bid; it < NCONV_MOE; it += nblk) conv_moe_tile(P, fsm, 1, it);
      }
    } break;
    case PH_SCAT0: case PH_SCAT1: {
      const int layer = ph == PH_SCAT0 ? 0 : 1;
      const int ntok = layer == 0 ? NT : NL;
      const int T = (ntok + nblk - 1) / nblk;
      const int nit = nblk;
      __syncthreads();
      for (int i = tid; i < nit * 32; i += 512) ism[i] = P.cntt[i];
      __syncthreads();
      if (tid < 32) {
        int run = 0;
        for (int i = 0; i < nit; ++i) { const int c = ism[i * 32 + tid]; ism[i * 32 + tid] = run; run += c; }
        if (bid == 0) P.cnt[layer * 32 + tid] = run;
      }
      __syncthreads();
      {
        const int lo_ = bid * T, hi_ = lo_ + T < ntok ? lo_ + T : ntok;
        for (int tok = lo_ + tid; tok < hi_; tok += 512) {
          int* ti = P.tokinfo + (size_t)tok * 4;
          const int e0 = ti[0], e1 = ti[2];
          const int p0 = ism[bid * 32 + e0] + ti[1], p1 = ism[bid * 32 + e1] + ti[3];
          ti[1] = p0; ti[3] = p1;
          P.list[(size_t)e0 * NT + p0] = tok;
          P.list[(size_t)e1 * NT + p1] = tok;
        }
      }
    } break;
    case PH_MOE1_0: case PH_MOE2_0: case PH_MOE1_1: case PH_MOE2_1: {
      const int layer = ph >= PH_MOE1_1 ? 1 : 0;
      const bool second = (ph == PH_MOE2_0 || ph == PH_MOE2_1);
      __syncthreads();
      if (tid == 0) {
        int off = 0, toff = 0;
        for (int e = 0; e < 32; ++e) { const int c = P.cnt[layer * 32 + e]; ism[e] = c; ism[32 + e] = off; ism[65 + e] = toff; off += c; toff += (c + 255) >> 8; }
        ism[64] = off; ism[97] = toff;
      }
      __syncthreads();
      const int ntile = ism[97], total = ism[64];
      const int nitems = ntile * 4, nfull = (nitems / nblk) * nblk, rem = nitems - nfull;
      bf16* gsm = smem + 256;
      REP {
        for (int it = bid; it < nfull; it += nblk) {
          const int mtg = it >> 2, pt = it & 3;
          int e = 0;
          while (e < 31 && ism[65 + e + 1] <= mtg) ++e;
          const int m0 = (mtg - ism[65 + e]) * 256, cnt_e = ism[e], off_e = ism[32 + e];
          if (!second) moe1_item(P, gsm, layer, e, m0, pt, cnt_e, off_e); else moe2_item(P, gsm, e, m0, pt, cnt_e, off_e, total);
        }
        for (int ht = bid; ht < 2 * rem; ht += nblk) {
          const int it = nfull + (ht >> 1), mtg = it >> 2, pt2 = (it & 3) * 2 + (ht & 1);
          int e = 0;
          while (e < 31 && ism[65 + e + 1] <= mtg) ++e;
          const int m0 = (mtg - ism[65 + e]) * 256, cnt_e = ism[e], off_e = ism[32 + e];
          if (!second) moe1_half(P, gsm, layer, e, m0, pt2, cnt_e, off_e); else moe2_half(P, gsm, e, m0, pt2, cnt_e, off_e, total);
        }
      }
    } break;
    case PH_COMB0: case PH_FINAL: {
      const int layer = ph == PH_COMB0 ? 0 : 1;
      __syncthreads();
      if (tid == 0) { int off = 0; for (int e = 0; e < 32; ++e) { ism[e] = off; off += P.cnt[layer * 32 + e]; } }
      __syncthreads();
      const int ntok = layer == 0 ? NT : NL;
      for (int tok = 2 * gw; tok < ntok; tok += 2 * ngw) row_pass2(P, layer == 0 ? 1 : 2, 1, tok, ntok, ism);
    } break;
    case PH_C2: {
      REP for (int it = bid; it < 10 * 132; it += nblk) { if (it < 9 * 132) gemm_c2_item(P, smem, it % 9, it / 9); else gemm_c2dt_item(P, smem, it - 9 * 132); }
    } break;
    case PH_SSDPREP: {
      REPB(28) for (int it = gw; it < NB * NCH; it += ngw) ssd_cumsum_item(P, it);
      REPB(29) for (int it = bid; it < NB * NCH * 4; it += nblk) ssd_conv_item(P, smem, it >> 2, it & 3);
      __syncthreads();
      const float negM = -P.msh[1];
      REP for (int it = bid; it < 512; it += nblk) {
        const int qb = it & 63, kvh = (it >> 6) & 1, b = it >> 7;
        const size_t hb = (size_t)(b * 8 + kvh * 4) * NPOS, kb = (size_t)(b * 2 + kvh) * NPOS;
        const int q0 = qb * 128;
        const int k0 = q0 - 128 < 0 ? 0 : q0 - 128;
        const int k1 = q0 + 256 > SEQ ? SEQ : q0 + 256;
        attn_item<64, true, true>(smem, P.qkv + Q2_OFF + hb * 64, P.qkv + K2_OFF + kb * 64, P.qkv + V2T_OFF + kb * 64, LC + q0, 128, 4 + (k1 - k0) / 64, 4, k0, q0,
                                  negM, 0.f, P.ycat + (size_t)(b * SEQ + q0) * 1024 + kvh * 256, P.swa_sink + kvh * 4);
      }
    } break;
    case PH_SSDA: {
      REP for (int it = gw; it < NB * NCH * 8 * 2 * 2; it += ngw) {
        const int pt = it & 1, dir = (it >> 1) & 1, hd = (it >> 2) & 7, gc = it >> 5;
        ssd_passA_item(P, gc, hd, dir, pt);
      }
    } break;
    case PH_SSDB: ssd_passB(P, bid, nblk); break;
    case PH_SSDC: {
      REP for (int it = bid; it < NB * 64 * 2; it += nblk) ssd_passC_item(P, smem, it >> 7, 2 + ((it >> 1) & 63), it & 1);
    } break;
    case PH_OUT1: {
      for (int it = bid; it < 512; it += nblk) gemm_out_item<4>(P, smem, 1, it & 3, it >> 2);
    } break;
    default: break;
  }
}
#define XB_TMO      128
#define XB_XCNT(j)  (256  + 64 * (j))
#define XB_XSUB(j)  (1280 + 64 * (j))
#define XB_XGEN(j)  (2304 + 64 * (j))
#define XB_TOP      3328
#define XB_TOPGEN   3392
#define XCD_BAR_WORDS 3456
#define XB_SPIN_CAP (1u << 22)
#define LAS __attribute__((address_space(3)))
DI unsigned xb_ld(unsigned* p) { return __hip_atomic_load(p, __ATOMIC_RELAXED, __HIP_MEMORY_SCOPE_AGENT); }
DI unsigned xb_add(unsigned* p, unsigned v) { return __hip_atomic_fetch_add(p, v, __ATOMIC_RELAXED, __HIP_MEMORY_SCOPE_AGENT); }
DI unsigned xb_xcc_id() { return (unsigned)__builtin_amdgcn_s_getreg((3 << 11) | 20) & 0xFu; }
#define XB_SPIN(cond, bar) do { unsigned _sp = 0; while (cond) { __builtin_amdgcn_s_sleep(1); \
    if ((++_sp & 255u) == 0u) { if (xb_ld(&(bar)[XB_TMO])) break; if (_sp > XB_SPIN_CAP) { atomicAdd(&(bar)[XB_TMO], 1u); break; } } } } while (0)
struct XcdBarrier { unsigned* bar; unsigned x; volatile LAS unsigned* st; };
DI XcdBarrier xcd_barrier_post(unsigned* bar, volatile LAS unsigned* st) {
  XcdBarrier b; b.bar = bar; b.x = xb_xcc_id(); b.st = st;
  if (tidx() == 0) (void)xb_add(&bar[XB_XCNT(b.x)], 1u);
  return b;
}
DI void xcd_barrier_complete(unsigned* bar, unsigned x, unsigned& nloc, unsigned& nx) {
  const unsigned G = gridDim.x * gridDim.y * gridDim.z;
  unsigned sum, cnt, mine, sp = 0u;
  for (;;) {
    sum = 0u; cnt = 0u; mine = 0u;
#pragma unroll
    for (unsigned j = 0; j < 16; ++j) { const unsigned c = xb_ld(&bar[XB_XCNT(j)]); sum += c; cnt += (c > 0u) ? 1u : 0u; mine = (j == x) ? c : mine; }
    if (sum == G) break;
    __builtin_amdgcn_s_sleep(1);
    if ((++sp & 255u) == 0u) { if (xb_ld(&bar[XB_TMO])) break; if (sp > XB_SPIN_CAP) { atomicAdd(&bar[XB_TMO], 1u); break; } }
  }
  nloc = mine > 0u ? mine : 1u; nx = cnt > 0u ? cnt : 1u;
}
DI void xcd_barrier(const XcdBarrier& b) {
  asm volatile("s_waitcnt vmcnt(0)" ::: "memory");
  __syncthreads();
  if (tidx() == 0) {
    unsigned* bar = b.bar;
    __builtin_amdgcn_s_waitcnt(0);
    unsigned nloc = b.st[0], nx = b.st[1];
    if (nloc == 0u) { xcd_barrier_complete(bar, b.x, nloc, nx); b.st[0] = nloc; b.st[1] = nx; }
    const unsigned old = xb_add(&bar[XB_XSUB(b.x)], 1u);
    const unsigned gen = old / nloc;
    if (old + 1u == (gen + 1u) * nloc) {
      __builtin_amdgcn_fence(__ATOMIC_RELEASE, "agent");
      asm volatile("s_waitcnt vmcnt(0)" ::: "memory");
      const unsigned og = xb_add(&bar[XB_TOP], 1u);
      const unsigned tg = og / nx;
      if (og + 1u == (tg + 1u) * nx) xb_add(&bar[XB_TOPGEN], 1u);
      else XB_SPIN(xb_ld(&bar[XB_TOPGEN]) == tg, bar);
      __builtin_amdgcn_fence(__ATOMIC_ACQUIRE, "agent");
      xb_add(&bar[XB_XGEN(b.x)], 1u);
      asm volatile("s_waitcnt vmcnt(0)" ::: "memory");
    } else {
      XB_SPIN(xb_ld(&bar[XB_XGEN(b.x)]) == gen, bar);
      __builtin_amdgcn_fence(__ATOMIC_ACQUIRE, "agent");
      asm volatile("s_waitcnt vmcnt(0)" ::: "memory");
    }
  }
  __syncthreads();
}

#ifndef PROBE_K
#define PROBE_K 8
#endif
#ifndef REPMASK
#define REPMASK 0
#endif
#ifndef ONE_LAUNCH
#define ONE_LAUNCH 1
#endif
constexpr int LDS_BYTES = GEMM_LDS + 1024;

#if ONE_LAUNCH
#define BAR_ARG , const XcdBarrier& xb
#define BAR_PASS , xb
#else
#define BAR_ARG
#define BAR_PASS
#endif
template <int PH>
DI void phase_step(unsigned char* lds, int ph_lo, int ph_hi BAR_ARG) {
  if (PH >= ph_lo && PH < ph_hi) {
    const __attribute__((address_space(4))) Params* kp = (const __attribute__((address_space(4))) Params*)__builtin_amdgcn_kernarg_segment_ptr();
    asm volatile("" : "+s"(kp));
    run_phase(*(const Params*)kp, PH, lds, blockIdx.x, gridDim.x);
#if ONE_LAUNCH
    if (PROBE_PH >= 0 && PH + 1 == ph_hi) { asm volatile("s_waitcnt vmcnt(0)" ::: "memory"); __syncthreads(); }
    if (PROBE_PH >= 0 && tidx() == 0 && blockIdx.x == 0 && PH + 1 == ph_hi) ((volatile unsigned long long*)(lds + GEMM_LDS + 528))[PH + 1] = __builtin_amdgcn_s_memrealtime();
    if (PH + 1 < ph_hi) {
      if (PH == 0) cg::this_grid().sync(); else xcd_barrier(xb);
      if ((REPMASK >> 25) & 1) xcd_barrier(xb);
      if (PROBE_PH >= 0 && tidx() == 0 && blockIdx.x == 0) ((volatile unsigned long long*)(lds + GEMM_LDS + 528))[PH + 1] = __builtin_amdgcn_s_memrealtime();
    }
#endif
  }
}

__global__ void __launch_bounds__(512, 2) mega(Params P, int ph_lo, int ph_hi) {
  extern __shared__ __attribute__((aligned(16))) unsigned char lds[];
#if ONE_LAUNCH
  volatile LAS unsigned* st = (volatile LAS unsigned*)(lds + GEMM_LDS + 512);
  if (tidx() < 2) st[tidx()] = 0u;
  __syncthreads();
  XcdBarrier xb = xcd_barrier_post(P.bar, st);
  if (PROBE_PH == -2 && tidx() == 0) *(volatile unsigned long long*)(lds + PROBE_LDS_OFF) = 0ull;
#endif
#if ONE_LAUNCH
  if (PROBE_PH >= 0 && tidx() == 0 && blockIdx.x == 0) ((volatile unsigned long long*)(lds + GEMM_LDS + 528))[0] = __builtin_amdgcn_s_memrealtime();
#endif
#define STEP(N) phase_step<N>(lds, ph_lo, ph_hi BAR_PASS);
  STEP(0) STEP(1) STEP(2) STEP(3) STEP(4) STEP(5) STEP(6) STEP(7) STEP(8) STEP(9)
  STEP(10) STEP(11) STEP(12) STEP(13) STEP(14) STEP(15) STEP(16) STEP(17) STEP(18) STEP(19) STEP(20) STEP(21)
#undef STEP
#if ONE_LAUNCH
  if (PROBE_PH == -2 && tidx() == 0 && blockIdx.x == 0) {
    const unsigned long long dur = *(volatile unsigned long long*)(lds + PROBE_LDS_OFF);
    const unsigned long long until = __builtin_amdgcn_s_memrealtime() + (unsigned long long)PROBE_K * dur;
    while (__builtin_amdgcn_s_memrealtime() < until) __builtin_amdgcn_s_sleep(32);
  }
  if (PROBE_PH >= 0 && tidx() == 0 && blockIdx.x == 0) {
    volatile unsigned long long* ts = (volatile unsigned long long*)(lds + GEMM_LDS + 528);
    const unsigned long long dur = ts[PROBE_PH + 1] - ts[PROBE_PH];
    const unsigned long long until = ts[NPHASE] + (unsigned long long)PROBE_K * dur;
    while (__builtin_amdgcn_s_memrealtime() < until) __builtin_amdgcn_s_sleep(32);
  }
#endif
}

static size_t carve(size_t& off, size_t bytes) { size_t o = off; off = (off + bytes + 255) & ~(size_t)255; return o; }

extern "C" void kernel_launch(void* const* d_in, const int* in_sizes, int n_in, void* d_out, int out_size, void* d_ws, size_t ws_size, hipStream_t stream) {
  static int grid = 0;
  if (grid == 0) {
    int dev = 0, cus = 0, per_cu = 0;
    hipGetDevice(&dev);
    hipDeviceGetAttribute(&cus, hipDeviceAttributeMultiprocessorCount, dev);
    if (hipFuncSetAttribute((const void*)mega, hipFuncAttributeMaxDynamicSharedMemorySize, LDS_BYTES) != hipSuccess) { fprintf(stderr, "kernel_launch: hipFuncSetAttribute failed\n"); }
    hipOccupancyMaxActiveBlocksPerMultiprocessor(&per_cu, (const void*)mega, 512, LDS_BYTES);
    if (per_cu < 1) { fprintf(stderr, "kernel_launch: occupancy query says %d blocks per CU\n", per_cu); per_cu = 1; }
    (void)hipGetLastError();
    grid = cus;
  }
  Params P;
  memset(&P, 0, sizeof(P));
  P.pad0 = REPMASK;
  const float** in = (const float**)&P;
  for (int i = 0; i < 39 && i < n_in; ++i) in[i] = (const float*)d_in[i];
  P.out = (float*)d_out;
  char* ws = (char*)d_ws;
  size_t off = 0;
  P.bar = (unsigned*)(ws + carve(off, XCD_BAR_WORDS * 4));
  P.mods = (float*)(ws + carve(off, 2 * 5 * 6144 * 4));
  P.ropeM = (float*)(ws + carve(off, 128 * 8 * 2 * 4));
  P.ropeS = (float*)(ws + carve(off, 128 * 16 * 2 * 4));
  P.msh = (float*)(ws + carve(off, 64));
  P.win0t = (bf16*)(ws + carve(off, (size_t)1792 * 1024 * 2));
  P.wqt = (bf16*)(ws + carve(off, (size_t)768 * 384 * 2));
  P.wkvt = (bf16*)(ws + carve(off, (size_t)1024 * 256 * 2));
  P.wout0t = (bf16*)(ws + carve(off, (size_t)1024 * 1024 * 2));
  P.win1t = (bf16*)(ws + carve(off, (size_t)2432 * 1024 * 2));
  P.wout1t = (bf16*)(ws + carve(off, (size_t)1024 * 1024 * 2));
  P.wlrut = (bf16*)(ws + carve(off, (size_t)32 * 4096 * 2));
  P.wgut = (bf16*)(ws + carve(off, (size_t)32 * 1024 * 1024 * 2));
  P.wdt = (bf16*)(ws + carve(off, (size_t)32 * 1024 * 512 * 2));
  P.wrt = (bf16*)(ws + carve(off, (size_t)64 * 3072 * 2));
  P.ut = P.wgut;
  P.xc = (float*)(ws + carve(off, (size_t)NC * 1024 * 4));
  P.h = (bf16*)(ws + carve(off, (size_t)NT * 1024 * 2));
  P.cbuf = (bf16*)(ws + carve(off, (size_t)NT * C2LD * 2));
  P.qkv = (bf16*)(ws + carve(off, QKV_ELEMS * 2));
  P.ycat = (bf16*)(ws + carve(off, (size_t)NT * 1024 * 2));
  P.ssqc = (float*)(ws + carve(off, (size_t)NT * 16 * 4));
  P.ssqx = (float*)(ws + carve(off, (size_t)NT * 16 * 4));
  P.ssq2 = (float*)(ws + carve(off, (size_t)NT * 8 * 4));
  P.comp = (float*)(ws + carve(off, (size_t)NB * 2 * LCH * 512 * 2 * 4));
  P.gcomp = (float*)(ws + carve(off, (size_t)NB * 2 * LGR * 512 * 2 * 4));
  P.dtr = (float*)(ws + carve(off, (size_t)NT * 16 * 4));
  P.cst = (float*)(ws + carve(off, (size_t)NB * 16 * NPOS * 4));
  P.dtt = (float*)(ws + carve(off, (size_t)NB * 16 * NPOS * 4));
  P.wgp = (float*)(ws + carve(off, (size_t)NB * 16 * NPOS * 4));
  P.cnt = (int*)(ws + carve(off, 64 * 4));
  P.cntt = (int*)(ws + carve(off, (size_t)2048 * 32 * 4));
  P.tokinfo = (int*)(ws + carve(off, (size_t)NT * 4 * 4));
  P.tokw = (float*)(ws + carve(off, (size_t)NT * 2 * 4));
  P.list = (int*)(ws + carve(off, (size_t)32 * NT * 4));
  if (off > ws_size || n_in != 39 || out_size != NL * 1024) {
    fprintf(stderr, "kernel_launch: needs %zu bytes of workspace (got %zu), 39 inputs (got %d), out %d (got %d); nothing launched\n", off, ws_size, n_in, NL * 1024, out_size);
    return;
  }
#if ONE_LAUNCH
  hipMemsetAsync(P.bar, 0, XCD_BAR_WORDS * 4, stream);
  int lo = 0, hi = NPHASE;
  void* args[] = {&P, &lo, &hi};
  hipError_t e = hipLaunchCooperativeKernel((const void*)mega, dim3(grid), dim3(512), args, LDS_BYTES, stream);
  if (e != hipSuccess) fprintf(stderr, "kernel_launch: cooperative launch failed: %s (grid %d)\n", hipGetErrorString(e), grid);
#else
  for (int ph = 0; ph < NPHASE; ++ph) hipLaunchKernelGGL(mega, dim3(grid), dim3(512), LDS_BYTES, stream, P, ph, ph + 1);
#endif
}
```

```cpp
#define REPMASK 0
#define PROBE_PH (-1)
#define PROBE_SEC 0
#include <hip/hip_runtime.h>
#include <hip/hip_cooperative_groups.h>
#include <cstdio>
#include <cstdint>
#include <cstring>
namespace cg = cooperative_groups;

#define DI __device__ __forceinline__
typedef unsigned short bf16;
typedef __attribute__((ext_vector_type(8))) short bf16x8;
typedef __attribute__((ext_vector_type(16))) float f32x16;
typedef __attribute__((ext_vector_type(8))) float f32x8;
typedef __attribute__((ext_vector_type(4))) float f32x4;
typedef __attribute__((ext_vector_type(2))) float f32x2;
typedef __attribute__((ext_vector_type(4))) unsigned u32x4;
typedef __attribute__((ext_vector_type(2))) unsigned u32x2;
typedef __attribute__((ext_vector_type(2))) __bf16 bfx2;
typedef __attribute__((ext_vector_type(8))) __bf16 bfx8;

constexpr int D = 1024, NB = 4, SEQ = 8192, LC = 256;
constexpr int NL = NB * SEQ;
constexpr int NC = NB * LC;
constexpr int NT = NL + NC;
constexpr int NPOS = SEQ + LC;
constexpr int C1LD = 1696, C2LD = 2320;
constexpr int NCH = 66;
constexpr float EPS = 1e-6f;
constexpr float LOG2E = 1.4426950408889634f;
constexpr int NSLOT = 2 * NT;

#ifndef PROBE_PH
#define PROBE_PH (-1)
#endif
#ifndef PROBE_SEC
#define PROBE_SEC 0
#endif
#define PROBE_LDS_OFF (147456 + 800)
#define PB_BEGIN(SEC, lds_) unsigned long long pb_t0_##SEC = 0; if (PROBE_PH == -2 && PROBE_SEC == SEC && blockIdx.x == 0) { __syncthreads(); pb_t0_##SEC = __builtin_amdgcn_s_memrealtime(); }
#define PB_END(SEC, lds_) if (PROBE_PH == -2 && PROBE_SEC == SEC && blockIdx.x == 0) { __syncthreads(); if (threadIdx.x == 0) *(volatile unsigned long long*)((unsigned char*)(lds_) + PROBE_LDS_OFF) += __builtin_amdgcn_s_memrealtime() - pb_t0_##SEC; }
#define PBW_BEGIN(SEC, lds_) unsigned long long pbw_t0_##SEC = 0; if (PROBE_PH == -2 && PROBE_SEC == SEC && blockIdx.x == 0 && threadIdx.x < 64) { pbw_t0_##SEC = __builtin_amdgcn_s_memrealtime(); }
#define PBW_END(SEC, lds_) if (PROBE_PH == -2 && PROBE_SEC == SEC && blockIdx.x == 0 && threadIdx.x == 0) { *(volatile unsigned long long*)((unsigned char*)(lds_) + PROBE_LDS_OFF) += __builtin_amdgcn_s_memrealtime() - pbw_t0_##SEC; }
DI int tidx() { int t = threadIdx.x; asm volatile("" : "+v"(t)); return t; }
DI float bf2f(bf16 u) { return __uint_as_float(((unsigned)u) << 16); }
DI float lo16(unsigned u) { return __uint_as_float(u << 16); }
DI float hi16(unsigned u) { return __uint_as_float(u & 0xffff0000u); }
DI unsigned pack2(float a, float b) { f32x2 v = {a, b}; bfx2 r = __builtin_convertvector(v, bfx2); return __builtin_bit_cast(unsigned, r); }
DI bf16 f2bf(float x) { return (bf16)(pack2(x, 0.f) & 0xffffu); }
DI bf16x8 pack8(const float (&v)[8]) { f32x8 t; for (int i = 0; i < 8; ++i) t[i] = v[i]; bfx8 r = __builtin_convertvector(t, bfx8); return __builtin_bit_cast(bf16x8, r); }
DI u32x2 pack4(float a, float b, float c, float d) { u32x2 r; r[0] = pack2(a, b); r[1] = pack2(c, d); return r; }
DI void unpack8(u32x4 raw, float (&v)[8]) { for (int i = 0; i < 4; ++i) { v[2 * i] = lo16(raw[i]); v[2 * i + 1] = hi16(raw[i]); } }
DI int crow(int i, int h) { return (i & 3) + 8 * (i >> 2) + 4 * h; }
DI int swap23(int p) { return (p & ~12) | ((p & 4) << 1) | ((p & 8) >> 1); }
DI int perm32(int k) { return ((k & 12) << 1) | ((k >> 2) & 4) | (k & 3); }
DI f32x16 mfma32(bf16x8 a, bf16x8 b, f32x16 c) { return __builtin_amdgcn_mfma_f32_32x32x16_bf16(a, b, c, 0, 0, 0); }
DI f32x4 mfma16(bf16x8 a, bf16x8 b, f32x4 c) { return __builtin_amdgcn_mfma_f32_16x16x32_bf16(a, b, c, 0, 0, 0); }
DI float rcpf_(float x) { return __builtin_amdgcn_rcpf(x); }
DI float sigmoidf_(float x) { return rcpf_(1.f + __expf(-x)); }
DI float siluf_(float x) { return x * rcpf_(1.f + __expf(-x)); }
DI float softplusf_(float x) { return x > 20.f ? x : log1pf(__expf(x)); }
DI float geluf_(float x) { float u = 0.7978845608028654f * (x + 0.044715f * x * x * x); float t = 1.f - 2.f * rcpf_(1.f + __expf(2.f * u)); return 0.5f * x * (1.f + t); }
DI float xor32(float v) { return v + __shfl_xor(v, 32); }
DI float wave_sum(float v) { for (int o = 32; o >= 1; o >>= 1) v += __shfl_xor(v, o); return v; }

DI void tok_info(int tok, int& bmod, int& b, int& pos, bool& lat) {
  if (tok < NL) { b = tok >> 13; bmod = b; pos = LC + (tok & (SEQ - 1)); lat = true; }
  else { int t = tok - NL; b = t >> 8; bmod = 4; pos = t & (LC - 1); lat = false; }
}

struct Params {
  const float *x, *c, *ctx, *c_ctx, *ada_w, *ada_b, *norm1_g, *norm2_g;
  const float *ab_w_in, *ab_w_out, *mla_q_norm_g, *mla_w_q_up, *mla_kv_norm_g, *mla_w_kv_up, *mla_q_head_g, *mla_k_head_g;
  const float *lru_conv_w, *lru_conv_b, *lru_w_a, *lru_b_a, *lru_w_x, *lru_b_x, *lru_lambda;
  const float *cd_w_in, *cd_w_out, *swa_q_head_g, *swa_k_head_g, *swa_sink;
  const float *ssd_conv_w, *ssd_conv_b, *ssd_a_log, *ssd_dt_bias, *ssd_d, *ssd_norm_g;
  const float *router_w, *router_b, *moe_w_gate, *moe_w_up, *moe_w_down;
  float* out;
  float* mods;
  float* ropeM;
  float* ropeS;
  float* msh;
  bf16 *win0t, *wqt, *wkvt, *wout0t, *win1t, *wout1t, *wlrut, *wgut, *wdt, *wrt;
  float* xc;
  bf16* h;
  bf16* cbuf;
  bf16* qkv;
  bf16* ycat;
  bf16* ut;
  float *ssqc, *ssqx, *ssq2;
  float* comp;
  float* gcomp;
  float* dtr;
  float *cst, *dtt, *wgp;
  int* cnt;
  int* cntt;
  int* tokinfo;
  float* tokw;
  int* list;
  unsigned* bar;
  int pad0;
  int pad1;
};
DI bf16* dbuf(const Params& P) { return P.cbuf + (size_t)40 * 1024 * 1024; }
static_assert((size_t)40 * 1024 * 1024 >= (size_t)NSLOT * 512 && (size_t)40 * 1024 * 1024 + (size_t)NT * 1024 <= (size_t)NT * C2LD, "delta buffer placement");
constexpr size_t QB_OFF = 0, KB_OFF = (size_t)NB * 8 * NPOS * 96, VT_OFF = 2 * KB_OFF;
constexpr size_t Q2_OFF = 0, K2_OFF = (size_t)NB * 8 * NPOS * 64, V2T_OFF = K2_OFF + (size_t)NB * 2 * NPOS * 64,
                 ST_OFF = V2T_OFF + (size_t)NB * 2 * 64 * NPOS;
constexpr size_t QKV_ELEMS = (size_t)NSLOT * 1024;
static_assert(VT_OFF + (size_t)NB * 8 * 64 * NPOS <= QKV_ELEMS, "qkv region");
static_assert(ST_OFF + (size_t)NB * 2 * 8 * NCH * 64 * 128 <= QKV_ELEMS, "qkv region L1");
#define LAS3 __attribute__((address_space(3)))
template <int WM, int WN, bool ZERO = true, class PRow, class QRow>
DI void gemm_core(bf16* smem, int K, int krot, PRow prow, QRow qrow, f32x16 (&acc)[WM][WN], int hook_kt, const float (&hs)[WN]) {
  constexpr int TP = 64 * WM, TQ = 128 * WN, NR = TP + TQ, NCHK = NR / 64, STAGE = NR * 64;
  const int tid = tidx(), lane = tid & 63, wid = tid >> 6, wr = wid >> 2, wc = wid & 3, r = lane & 31, h = lane >> 5;
  const bf16* ps[NCHK];
#pragma unroll
  for (int j = 0; j < NCHK; ++j) {
    const int R = j * 64 + (tid >> 3);
    const int cs = (tid & 7) ^ ((R >> 1) & 7);
    ps[j] = (j < WM ? prow(R) : qrow(R - TP)) + cs * 8;
  }
  const int nkt = K >> 6;
  if (ZERO) {
#pragma unroll
    for (int i = 0; i < WM; ++i)
#pragma unroll
      for (int j = 0; j < WN; ++j)
#pragma unroll
        for (int e = 0; e < 16; ++e) acc[i][j][e] = 0.f;
  }
  {
    const int ko = (krot % nkt) * 64;
#pragma unroll
    for (int j = 0; j < NCHK; ++j)
      __builtin_amdgcn_global_load_lds((const unsigned*)(ps[j] + ko), (LAS3 unsigned*)(smem + (j * 512 + wid * 64) * 8), 16, 0, 0);
  }
  asm volatile("s_waitcnt vmcnt(0)" ::: "memory");
  __syncthreads();
  const int sw = (r >> 1) & 7;
  for (int kt = 0; kt < nkt; ++kt) {
    const int buf = kt & 1;
    if (kt + 1 < nkt) {
      const int ko = ((kt + 1 + krot) % nkt) * 64;
#pragma unroll
      for (int j = 0; j < NCHK; ++j)
        __builtin_amdgcn_global_load_lds((const unsigned*)(ps[j] + ko), (LAS3 unsigned*)(smem + (buf ^ 1) * STAGE + (j * 512 + wid * 64) * 8), 16, 0, 0);
    }
    if (kt == hook_kt) {
#pragma unroll
      for (int i = 0; i < WM; ++i)
#pragma unroll
        for (int j = 0; j < WN; ++j)
#pragma unroll
          for (int e = 0; e < 16; ++e) acc[i][j][e] *= hs[j];
    }
    const bf16* sP = smem + buf * STAGE + (wr * WM * 32 + r) * 64;
    const bf16* sQ = smem + buf * STAGE + (TP + wc * WN * 32 + r) * 64;
    bf16x8 a[2][WM], b[2][WN];
    {
      const int co = (h ^ sw) * 8;
#pragma unroll
      for (int i = 0; i < WM; ++i) a[0][i] = *(const bf16x8*)(sP + i * 32 * 64 + co);
#pragma unroll
      for (int j = 0; j < WN; ++j) b[0][j] = *(const bf16x8*)(sQ + j * 32 * 64 + co);
    }
#pragma unroll
    for (int ks = 0; ks < 4; ++ks) {
      if (ks < 3) {
        const int co = (((ks + 1) * 2 + h) ^ sw) * 8;
#pragma unroll
        for (int i = 0; i < WM; ++i) a[(ks + 1) & 1][i] = *(const bf16x8*)(sP + i * 32 * 64 + co);
#pragma unroll
        for (int j = 0; j < WN; ++j) b[(ks + 1) & 1][j] = *(const bf16x8*)(sQ + j * 32 * 64 + co);
      }
#pragma unroll
      for (int i = 0; i < WM; ++i)
#pragma unroll
        for (int j = 0; j < WN; ++j) acc[i][j] = mfma32(a[ks & 1][i], b[ks & 1][j], acc[i][j]);
      if (ks < 3) {
#pragma unroll
        for (int n = 0; n < WM + WN; ++n) { __builtin_amdgcn_sched_group_barrier(0x008, 1, 0); __builtin_amdgcn_sched_group_barrier(0x100, 1, 0); }
        __builtin_amdgcn_sched_group_barrier(0x008, WM * WN - (WM + WN), 0);
      }
    }
    asm volatile("s_waitcnt vmcnt(0)" ::: "memory");
    __syncthreads();
  }
}

struct WaveId { int lane, wid, wr, wc, r, h; };
template <int WM, int WN>
DI void epi_to_lds(bf16* sT, int lane_r, int lane_h, int wr, int wc, int i, int j, int g, float a0, float a1, float a2, float a3) {
  constexpr int LDT = 64 * WM + 8;
  *(u32x2*)(sT + (wc * WN * 32 + j * 32 + lane_r) * LDT + wr * WM * 32 + i * 32 + 8 * g + 4 * lane_h) = pack4(a0, a1, a2, a3);
}
DI WaveId wave_id() { WaveId w; w.lane = tidx() & 63; w.wid = tidx() >> 6; w.wr = w.wid >> 2; w.wc = w.wid & 3; w.r = w.lane & 31; w.h = w.lane >> 5; return w; }

DI void gemm_c1_item(const Params& P, bf16* smem, int pt, int qt) {
  f32x16 acc[4][2];
  const float hs[2] = {1.f, 1.f};
  const int p0 = pt * 256, q0 = qt * 256;
  gemm_core<4, 2>(smem, 1024, 0,
      [&](int rp) { return P.win0t + (size_t)(p0 + rp) * 1024; },
      [&](int rq) { return P.h + (size_t)(q0 + rq) * 1024; }, acc, -1, hs);
  const WaveId w = wave_id();
#pragma unroll
  for (int j = 0; j < 2; ++j) {
    const int tok = q0 + w.wc * 64 + j * 32 + w.r;
#pragma unroll
    for (int i2 = 0; i2 < 2; ++i2) {
      const int grp = (p0 + w.wr * 128 + i2 * 64) >> 6;
      float ss = 0.f;
#pragma unroll
      for (int ii = 0; ii < 2; ++ii)
#pragma unroll
        for (int g = 0; g < 4; ++g) {
          const int i = i2 * 2 + ii;
          const float a0 = acc[i][j][4 * g], a1 = acc[i][j][4 * g + 1], a2 = acc[i][j][4 * g + 2], a3 = acc[i][j][4 * g + 3];
          ss += a0 * a0 + a1 * a1 + a2 * a2 + a3 * a3;
          epi_to_lds<4, 2>(smem, w.r, w.h, w.wr, w.wc, i, j, g, a0, a1, a2, a3);
        }
      ss = xor32(ss);
      if (w.h == 0 && grp < 10) P.ssqc[tok * 16 + grp] = ss;
    }
  }
  __syncthreads();
  {
    const int tid = tidx(), c = tid & 31, rr = tid >> 5;
    if (p0 + c * 8 < C1LD) {
#pragma unroll
      for (int ps_ = 0; ps_ < 16; ++ps_) {
        const int row = rr + 16 * ps_;
        *(u32x4*)(P.cbuf + (size_t)(q0 + row) * C1LD + p0 + c * 8) = *(const u32x4*)(smem + row * 264 + c * 8);
      }
    }
  }
  __syncthreads();
}

#define rope_pair(X1, X2, TAB) do { const float* tb_ = (TAB); const float cs_ = tb_[0], sn_ = tb_[1]; const float a_ = (X1) * cs_ - (X2) * sn_, b_ = (X1) * sn_ + (X2) * cs_; (X1) = a_; (X2) = b_; } while (0)

DI void gemm_q_item(const Params& P, bf16* smem, int pt, int qt) {
  f32x16 acc[3][1];
  const float hs[1] = {1.f};
  const int p0 = pt * 192, q0 = qt * 128;
  float q6[6];
  {
    const int tok_ = q0 + ((tidx() >> 6) & 3) * 32 + (tidx() & 31);
#pragma unroll
    for (int g = 0; g < 6; ++g) q6[g] = P.ssqc[tok_ * 16 + g];
  }
  gemm_core<3, 1>(smem, 384, 0,
      [&](int rp) { return P.wqt + (size_t)(p0 + rp) * 384; },
      [&](int rq) { return P.cbuf + (size_t)(q0 + rq) * C1LD; }, acc, -1, hs);
  const WaveId w = wave_id();
  const int hd = pt * 2 + w.wr;
  const float qscale = 0.10206207261596575f * LOG2E;
#pragma unroll
  for (int j = 0; j < 1; ++j) {
    const int tok = q0 + w.wc * 32 + w.r;
    int bmod, b, pos; bool lat; tok_info(tok, bmod, b, pos, lat);
    float s6 = 0.f;
#pragma unroll
    for (int g = 0; g < 6; ++g) s6 += q6[g];
    const float rstd = rsqrtf(s6 * (1.f / 384.f) + EPS);
    float ss = 0.f;
#pragma unroll
    for (int i = 0; i < 3; ++i)
#pragma unroll
      for (int e = 0; e < 16; ++e) { acc[i][j][e] *= rstd; ss += acc[i][j][e] * acc[i][j][e]; }
    ss = xor32(ss);
    const float r2 = rsqrtf(ss * (1.f / 96.f) + EPS);
#pragma unroll
    for (int i = 0; i < 3; ++i)
#pragma unroll
      for (int g = 0; g < 4; ++g) {
        const f32x4 gg = *(const f32x4*)(P.mla_q_head_g + i * 32 + 8 * g + 4 * w.h);
#pragma unroll
        for (int e = 0; e < 4; ++e) acc[i][j][4 * g + e] *= r2 * gg[e];
      }
    if (lat) {
      const int sq = tok & (SEQ - 1), rowp = sq >> 6, colp = sq & 63;
#pragma unroll
      for (int e = 0; e < 4; ++e) {
        rope_pair(acc[2][j][e], acc[2][j][4 + e], P.ropeM + (rowp * 8 + 4 * w.h + e) * 2);
        rope_pair(acc[2][j][8 + e], acc[2][j][12 + e], P.ropeM + (colp * 8 + 4 * w.h + e) * 2);
      }
    }
    bf16* dst = P.qkv + QB_OFF + ((size_t)(b * 8 + hd) * NPOS + pos) * 96;
#pragma unroll
    for (int i = 0; i < 3; ++i)
#pragma unroll
      for (int g = 0; g < 4; ++g)
        *(u32x2*)(dst + i * 32 + 8 * g + 4 * w.h) = pack4(acc[i][j][4 * g] * qscale, acc[i][j][4 * g + 1] * qscale, acc[i][j][4 * g + 2] * qscale, acc[i][j][4 * g + 3] * qscale);
  }
}

DI void gemm_kv_item(const Params& P, bf16* smem, int pt, int qt) {
  f32x16 acc[4][1];
  const float hs[1] = {1.f};
  const int p0 = pt * 256, q0 = qt * 128;
  float q4[4];
  u32x4 krr0, krr1;
  {
    const int tok_ = q0 + ((tidx() >> 6) & 3) * 32 + (tidx() & 31);
#pragma unroll
    for (int g = 0; g < 4; ++g) q4[g] = P.ssqc[tok_ * 16 + 6 + g];
    const bf16* src = P.cbuf + (size_t)tok_ * C1LD + 640 + 16 * ((tidx() & 63) >> 5);
    krr0 = *(const u32x4*)src; krr1 = *(const u32x4*)(src + 8);
  }
  gemm_core<4, 1>(smem, 256, 0,
      [&](int rp) { return P.wkvt + (size_t)(p0 + rp) * 256; },
      [&](int rq) { return P.cbuf + (size_t)(q0 + rq) * C1LD + 384; }, acc, -1, hs);
  const WaveId w = wave_id();
  const int hd = pt * 2 + w.wr;
#pragma unroll
  for (int j = 0; j < 1; ++j) {
    const int tok = q0 + w.wc * 32 + w.r;
    int bmod, b, pos; bool lat; tok_info(tok, bmod, b, pos, lat);
    float s4 = 0.f;
#pragma unroll
    for (int g = 0; g < 4; ++g) s4 += q4[g];
    const float rstd = rsqrtf(s4 * (1.f / 256.f) + EPS);
    float kr[16];
    {
      float t8[8];
      unpack8(krr0, t8);
      for (int i = 0; i < 8; ++i) kr[i] = t8[i];
      unpack8(krr1, t8);
      for (int i = 0; i < 8; ++i) kr[8 + i] = t8[i];
    }
    float ss = 0.f;
#pragma unroll
    for (int i = 0; i < 2; ++i)
#pragma unroll
      for (int e = 0; e < 16; ++e) { acc[i][j][e] *= rstd; ss += acc[i][j][e] * acc[i][j][e]; }
#pragma unroll
    for (int i = 0; i < 16; ++i) ss += kr[i] * kr[i];
    ss = xor32(ss);
    const float r2 = rsqrtf(ss * (1.f / 96.f) + EPS);
    bf16* dst = P.qkv + KB_OFF + ((size_t)(b * 8 + hd) * NPOS + pos) * 96;
#pragma unroll
    for (int i = 0; i < 2; ++i)
#pragma unroll
      for (int g = 0; g < 4; ++g) {
        const f32x4 gg = *(const f32x4*)(P.mla_k_head_g + i * 32 + 8 * g + 4 * w.h);
        *(u32x2*)(dst + i * 32 + 8 * g + 4 * w.h) = pack4(acc[i][j][4 * g] * r2 * gg[0], acc[i][j][4 * g + 1] * r2 * gg[1], acc[i][j][4 * g + 2] * r2 * gg[2], acc[i][j][4 * g + 3] * r2 * gg[3]);
      }
#pragma unroll
    for (int i = 0; i < 16; ++i) kr[i] *= r2 * P.mla_k_head_g[64 + 16 * w.h + i];
    if (lat) {
      const int sq = tok & (SEQ - 1);
      const int pp = w.h ? (sq & 63) : (sq >> 6);
#pragma unroll
      for (int i = 0; i < 8; ++i) rope_pair(kr[i], kr[8 + i], P.ropeM + (pp * 8 + i) * 2);
    }
    {
      u32x4 o0, o1;
      for (int i = 0; i < 4; ++i) { o0[i] = pack2(kr[2 * i], kr[2 * i + 1]); o1[i] = pack2(kr[8 + 2 * i], kr[8 + 2 * i + 1]); }
      *(u32x4*)(dst + 64 + 16 * w.h) = o0;
      *(u32x4*)(dst + 64 + 16 * w.h + 8) = o1;
    }
    const int posp = (pos & ~31) | perm32(pos & 31);
    bf16* vdst = P.qkv + VT_OFF + (size_t)(b * 8 + hd) * 64 * NPOS + posp;
#pragma unroll
    for (int i = 0; i < 2; ++i)
#pragma unroll
      for (int e = 0; e < 16; ++e) vdst[(size_t)(i * 32 + crow(e, w.h)) * NPOS] = f2bf(acc[2 + i][j][e] * rstd);
  }
}

template <int WM>
DI void gemm_out_item(const Params& P, bf16* smem, int layer, int pt, int qt) {
  f32x16 acc[WM][2];
  const int p0 = pt * 64 * WM, q0 = qt * 256;
  const WaveId w = wave_id();
  float hs[2] = {1.f, 1.f};
  if (layer == 1) {
#pragma unroll
    for (int j = 0; j < 2; ++j) {
      const int tok = q0 + w.wc * 64 + j * 32 + w.r;
      float s = 0.f;
      for (int g = 0; g < 8; ++g) s += P.ssq2[tok * 8 + g];
      hs[j] = rsqrtf(s * (1.f / 512.f) + EPS);
    }
  }
  const bf16* wt = layer ? P.wout1t : P.wout0t;
  gemm_core<WM, 2>(smem, 1024, layer ? 8 : 0,
      [&](int rp) { return wt + (size_t)(p0 + rp) * 1024; },
      [&](int rq) { return P.ycat + (size_t)(q0 + rq) * 1024; }, acc, layer ? 8 : -1, hs);
  {
    int bmod, b, pos; bool lat; tok_info(q0, bmod, b, pos, lat);
    const float* m2 = P.mods + ((size_t)(layer * 5 + bmod) * 6 + 2) * 1024;
#pragma unroll
    for (int i = 0; i < WM; ++i)
#pragma unroll
      for (int g = 0; g < 4; ++g) {
        const f32x4 mv = *(const f32x4*)(m2 + p0 + w.wr * 32 * WM + i * 32 + 8 * g + 4 * w.h);
#pragma unroll
        for (int j = 0; j < 2; ++j)
          epi_to_lds<WM, 2>(smem, w.r, w.h, w.wr, w.wc, i, j, g, mv[0] * acc[i][j][4 * g], mv[1] * acc[i][j][4 * g + 1], mv[2] * acc[i][j][4 * g + 2], mv[3] * acc[i][j][4 * g + 3]);
      }
  }
  __syncthreads();
  {
    constexpr int LDT = 64 * WM + 8, CPRW = 8 * WM, RPP = 512 / CPRW;
    const int tid = tidx(), c = tid % CPRW, rr = tid / CPRW;
#pragma unroll
    for (int ps_ = 0; ps_ < 256 / RPP; ++ps_) {
      const int row = rr + RPP * ps_;
      *(u32x4*)(dbuf(P) + (size_t)(q0 + row) * 1024 + p0 + c * 8) = *(const u32x4*)(smem + row * LDT + c * 8);
    }
  }
  __syncthreads();
}

DI void moe1_item(const Params& P, bf16* smem, int layer, int e, int m0, int pt, int cnt_e, int off_e) {
  f32x16 acc[4][2];
  const float hs[2] = {1.f, 1.f};
  const int* lst = P.list + (size_t)e * NT;
  gemm_core<4, 2>(smem, 1024, 0,
      [&](int rp) { return P.wgut + ((size_t)e * 1024 + pt * 256 + rp) * 1024; },
      [&](int rq) { int m = m0 + rq; if (m > cnt_e - 1) m = cnt_e - 1; return P.h + (size_t)lst[m] * 1024; }, acc, -1, hs);
  const WaveId w = wave_id();
  constexpr int LDT = 136;
#pragma unroll
  for (int j = 0; j < 2; ++j) {
    const int row = w.wc * 64 + j * 32 + w.r;
#pragma unroll
    for (int i2 = 0; i2 < 2; ++i2)
#pragma unroll
      for (int g = 0; g < 4; ++g) {
        float o[4];
#pragma unroll
        for (int k = 0; k < 4; ++k) o[k] = siluf_(acc[2 * i2][j][4 * g + k]) * acc[2 * i2 + 1][j][4 * g + k];
        *(u32x2*)(smem + row * LDT + w.wr * 64 + i2 * 32 + 8 * g + 4 * w.h) = pack4(o[0], o[1], o[2], o[3]);
      }
  }
  __syncthreads();
  {
    const int tid = tidx(), c = tid & 15, rr = tid >> 4;
#pragma unroll
    for (int ps_ = 0; ps_ < 8; ++ps_) {
      const int row = rr + 32 * ps_;
      if (m0 + row < cnt_e) *(u32x4*)(P.cbuf + (size_t)(off_e + m0 + row) * 512 + pt * 128 + c * 8) = *(const u32x4*)(smem + row * LDT + c * 8);
    }
  }
  __syncthreads();
}
DI void moe2_item(const Params& P, bf16* smem, int e, int m0, int pt, int cnt_e, int off_e, int total) {
  f32x16 acc[4][2];
  const float hs[2] = {1.f, 1.f};
  gemm_core<4, 2>(smem, 512, 0,
      [&](int rp) { return P.wdt + ((size_t)e * 1024 + pt * 256 + rp) * 512; },
      [&](int rq) { int s = off_e + m0 + rq; if (s > total - 1) s = total - 1; return P.cbuf + (size_t)s * 512; }, acc, -1, hs);
  const WaveId w = wave_id();
#pragma unroll
  for (int j = 0; j < 2; ++j)
#pragma unroll
    for (int i = 0; i < 4; ++i)
#pragma unroll
      for (int g = 0; g < 4; ++g) epi_to_lds<4, 2>(smem, w.r, w.h, w.wr, w.wc, i, j, g, acc[i][j][4 * g], acc[i][j][4 * g + 1], acc[i][j][4 * g + 2], acc[i][j][4 * g + 3]);
  __syncthreads();
  {
    const int tid = tidx(), c = tid & 31, rr = tid >> 5;
#pragma unroll
    for (int ps_ = 0; ps_ < 16; ++ps_) {
      const int row = rr + 16 * ps_;
      if (m0 + row < cnt_e) *(u32x4*)(P.qkv + (size_t)(off_e + m0 + row) * 1024 + pt * 256 + c * 8) = *(const u32x4*)(smem + row * 264 + c * 8);
    }
  }
  __syncthreads();
}

DI void moe1_half(const Params& P, bf16* smem, int layer, int e, int m0, int pt2, int cnt_e, int off_e) {
  f32x16 acc[2][2];
  const float hs[2] = {1.f, 1.f};
  const int* lst = P.list + (size_t)e * NT;
  gemm_core<2, 2>(smem, 1024, 0,
      [&](int rp) { return P.wgut + ((size_t)e * 1024 + pt2 * 128 + rp) * 1024; },
      [&](int rq) { int m = m0 + rq; if (m > cnt_e - 1) m = cnt_e - 1; return P.h + (size_t)lst[m] * 1024; }, acc, -1, hs);
  const WaveId w = wave_id();
  constexpr int LDT = 72;
#pragma unroll
  for (int j = 0; j < 2; ++j) {
    const int row = w.wc * 64 + j * 32 + w.r;
#pragma unroll
    for (int g = 0; g < 4; ++g) {
      float o[4];
#pragma unroll
      for (int k = 0; k < 4; ++k) o[k] = siluf_(acc[0][j][4 * g + k]) * acc[1][j][4 * g + k];
      *(u32x2*)(smem + row * LDT + w.wr * 32 + 8 * g + 4 * w.h) = pack4(o[0], o[1], o[2], o[3]);
    }
  }
  __syncthreads();
  {
    const int tid = tidx(), c = tid & 7, rr = tid >> 3;
#pragma unroll
    for (int ps_ = 0; ps_ < 4; ++ps_) {
      const int row = rr + 64 * ps_;
      if (m0 + row < cnt_e) *(u32x4*)(P.cbuf + (size_t)(off_e + m0 + row) * 512 + pt2 * 64 + c * 8) = *(const u32x4*)(smem + row * LDT + c * 8);
    }
  }
  __syncthreads();
}
DI void moe2_half(const Params& P, bf16* smem, int e, int m0, int pt2, int cnt_e, int off_e, int total) {
  f32x16 acc[2][2];
  const float hs[2] = {1.f, 1.f};
  gemm_core<2, 2>(smem, 512, 0,
      [&](int rp) { return P.wdt + ((size_t)e * 1024 + pt2 * 128 + rp) * 512; },
      [&](int rq) { int s = off_e + m0 + rq; if (s > total - 1) s = total - 1; return P.cbuf + (size_t)s * 512; }, acc, -1, hs);
  const WaveId w = wave_id();
#pragma unroll
  for (int j = 0; j < 2; ++j)
#pragma unroll
    for (int i = 0; i < 2; ++i)
#pragma unroll
      for (int g = 0; g < 4; ++g) epi_to_lds<2, 2>(smem, w.r, w.h, w.wr, w.wc, i, j, g, acc[i][j][4 * g], acc[i][j][4 * g + 1], acc[i][j][4 * g + 2], acc[i][j][4 * g + 3]);
  __syncthreads();
  {
    const int tid = tidx(), c = tid & 15, rr = tid >> 4;
#pragma unroll
    for (int ps_ = 0; ps_ < 8; ++ps_) {
      const int row = rr + 32 * ps_;
      if (m0 + row < cnt_e) *(u32x4*)(P.qkv + (size_t)(off_e + m0 + row) * 1024 + pt2 * 128 + c * 8) = *(const u32x4*)(smem + row * 136 + c * 8);
    }
  }
  __syncthreads();
}

DI void c2_block_epilogue(const Params& P, const WaveId& w, int fb, int tok, f32x16& a0, f32x16& a1) {
  int bmod, b, pos; bool lat; tok_info(tok, bmod, b, pos, lat);
  const float qscale = 0.125f * LOG2E;
  if (fb < 10) {
    const bool isq = fb < 8;
    const float* gain = isq ? P.swa_q_head_g : P.swa_k_head_g;
    float ss = 0.f;
#pragma unroll
    for (int e = 0; e < 16; ++e) ss += a0[e] * a0[e] + a1[e] * a1[e];
    ss = xor32(ss);
    const float r2 = rsqrtf(ss * (1.f / 64.f) + EPS);
#pragma unroll
    for (int g = 0; g < 4; ++g) {
      const f32x4 g0 = *(const f32x4*)(gain + 8 * g + 4 * w.h), g1 = *(const f32x4*)(gain + 32 + 8 * g + 4 * w.h);
#pragma unroll
      for (int e = 0; e < 4; ++e) { a0[4 * g + e] *= r2 * g0[e]; a1[4 * g + e] *= r2 * g1[e]; }
    }
    if (lat) {
      const int sq = tok & (SEQ - 1), rowp = sq >> 6, colp = sq & 63;
#pragma unroll
      for (int e = 0; e < 4; ++e) {
        rope_pair(a0[e], a0[8 + e], P.ropeS + (rowp * 16 + 4 * w.h + e) * 2);
        rope_pair(a0[4 + e], a0[12 + e], P.ropeS + (rowp * 16 + 8 + 4 * w.h + e) * 2);
        rope_pair(a1[e], a1[8 + e], P.ropeS + (colp * 16 + 4 * w.h + e) * 2);
        rope_pair(a1[4 + e], a1[12 + e], P.ropeS + (colp * 16 + 8 + 4 * w.h + e) * 2);
      }
    }
    if (isq && !lat) return;
    const float sc = isq ? qscale : 1.f;
    bf16* dst = isq ? P.qkv + Q2_OFF + ((size_t)(b * 8 + fb) * NPOS + pos) * 64
                    : P.qkv + K2_OFF + ((size_t)(b * 2 + (fb - 8)) * NPOS + pos) * 64;
#pragma unroll
    for (int g = 0; g < 4; ++g) {
      *(u32x2*)(dst + 8 * g + 4 * w.h) = pack4(a0[4 * g] * sc, a0[4 * g + 1] * sc, a0[4 * g + 2] * sc, a0[4 * g + 3] * sc);
      *(u32x2*)(dst + 32 + 8 * g + 4 * w.h) = pack4(a1[4 * g] * sc, a1[4 * g + 1] * sc, a1[4 * g + 2] * sc, a1[4 * g + 3] * sc);
    }
  } else if (fb < 12) {
    const int posp = (pos & ~31) | perm32(pos & 31);
    bf16* vdst = P.qkv + V2T_OFF + (size_t)(b * 2 + (fb - 10)) * 64 * NPOS + posp;
#pragma unroll
    for (int e = 0; e < 16; ++e) {
      vdst[(size_t)(crow(e, w.h)) * NPOS] = f2bf(a0[e]);
      vdst[(size_t)(32 + crow(e, w.h)) * NPOS] = f2bf(a1[e]);
    }
  } else if (fb < 36) {
    bf16* dst = P.cbuf + (size_t)tok * C2LD + fb * 64;
#pragma unroll
    for (int g = 0; g < 4; ++g) {
      *(u32x2*)(dst + 8 * g + 4 * w.h) = pack4(a0[4 * g], a0[4 * g + 1], a0[4 * g + 2], a0[4 * g + 3]);
      *(u32x2*)(dst + 32 + 8 * g + 4 * w.h) = pack4(a1[4 * g], a1[4 * g + 1], a1[4 * g + 2], a1[4 * g + 3]);
    }
  }
}
DI void gemm_c2_item(const Params& P, bf16* smem, int pt, int qt) {
  f32x16 acc[4][2];
  const float hs[2] = {1.f, 1.f};
  const int p0 = pt * 256, q0 = qt * 256;
  gemm_core<4, 2>(smem, 1024, 0,
      [&](int rp) { return P.win1t + (size_t)(p0 + rp) * 1024; },
      [&](int rq) { return P.h + (size_t)(q0 + rq) * 1024; }, acc, -1, hs);
  const WaveId w = wave_id();
#pragma unroll
  for (int j = 0; j < 2; ++j) {
    const int tok = q0 + w.wc * 64 + j * 32 + w.r;
#pragma unroll
    for (int i2 = 0; i2 < 2; ++i2) c2_block_epilogue(P, w, (p0 + w.wr * 128 + i2 * 64) >> 6, tok, acc[2 * i2][j], acc[2 * i2 + 1][j]);
  }
}
DI void gemm_c2dt_item(const Params& P, bf16* smem, int qt) {
  f32x16 acc[1][2];
  const float hs[2] = {1.f, 1.f};
  const int q0 = qt * 256;
  gemm_core<1, 2>(smem, 1024, 0,
      [&](int rp) { return P.win1t + (size_t)(2304 + rp) * 1024; },
      [&](int rq) { return P.h + (size_t)(q0 + rq) * 1024; }, acc, -1, hs);
  const WaveId w = wave_id();
  if (w.wr == 0) {
#pragma unroll
    for (int j = 0; j < 2; ++j) {
      const int tok = q0 + w.wc * 64 + j * 32 + w.r;
#pragma unroll
      for (int g = 0; g < 2; ++g) {
        f32x4 o = {acc[0][j][4 * g], acc[0][j][4 * g + 1], acc[0][j][4 * g + 2], acc[0][j][4 * g + 3]};
        *(f32x4*)(P.dtr + (size_t)tok * 16 + 8 * g + 4 * w.h) = o;
      }
    }
  }
}
template <int DQK, bool WIN, bool GQA = false, int VAR = 0>
DI void attn_item(bf16* smem, const bf16* Qp, const bf16* Kp, const bf16* Vtp, int qrow0, int nq, int ntiles, int nctx, int band_k0, int q_lat0,
                  float negM, float sinkterm, bf16* outp, const float* sinks = nullptr) {
  constexpr int KS = DQK / 32, LDK = DQK + 8, LDV = 72, CPR = DQK / 8, NCK = 64 * CPR;
  const int tid = tidx(), lane = tid & 63, w = tid >> 6, c = lane & 15, g = lane >> 4;
  bf16* sK = smem;
  bf16* sV = smem + 6 * 64 * LDK;
  const int wq = GQA ? (w & 1) * 64 : w * 64;
  if (GQA) { Qp += (size_t)(w >> 1) * NPOS * DQK; outp += (w >> 1) * 64; sinkterm = __builtin_amdgcn_exp2f(sinks[w >> 1] * LOG2E + negM); }
  bf16x8 qf[4][KS];
#pragma unroll
  for (int b = 0; b < 4; ++b) {
    int qi = wq + b * 16 + c;
    if (qi > nq - 1) qi = nq - 1;
#pragma unroll
    for (int s = 0; s < KS; ++s) qf[b][s] = *(const bf16x8*)(Qp + (size_t)(qrow0 + qi) * DQK + s * 32 + g * 8);
  }
  f32x4 O[4][4];
#pragma unroll
  for (int a = 0; a < 4; ++a)
#pragma unroll
    for (int b = 0; b < 4; ++b) O[a][b] = f32x4{0.f, 0.f, 0.f, 0.f};
  float lsum[4] = {0.f, 0.f, 0.f, 0.f};
  const int kr0 = tid / CPR, kc0 = tid % CPR;
  const int id1 = tid + 512;
  const bool has1 = id1 < NCK;
  const int kr1 = has1 ? id1 / CPR : 0, kc1 = has1 ? id1 % CPR : 0;
  const int vr = tid >> 3, vc = tid & 7;
  u32x4 rK0, rK1, rV;
  rK1 = rK0 = rV = u32x4{0, 0, 0, 0};
  auto tilepos = [&](int t) { return t < nctx ? t * 64 : LC + band_k0 + (t - nctx) * 64; };
  auto gload = [&](int t) {
    const int pos = tilepos(t);
    rK0 = *(const u32x4*)(Kp + (size_t)(pos + kr0) * DQK + kc0 * 8);
    if (has1) rK1 = *(const u32x4*)(Kp + (size_t)(pos + kr1) * DQK + kc1 * 8);
    rV = *(const u32x4*)(Vtp + (size_t)vr * NPOS + pos + vc * 8);
  };
  auto swrite = [&](int buf) {
    *(u32x4*)(sK + buf * 64 * LDK + kr0 * LDK + kc0 * 8) = rK0;
    if (has1) *(u32x4*)(sK + buf * 64 * LDK + kr1 * LDK + kc1 * 8) = rK1;
    *(u32x4*)(sV + buf * 64 * LDV + vr * LDV + vc * 8) = rV;
  };
  {
    u32x4 aK0, aK1, aV, bK0, bK1, bV;
    aK1 = bK1 = u32x4{0, 0, 0, 0};
    const int p1 = tilepos(1), p2 = tilepos(2);
    gload(0);
    aK0 = *(const u32x4*)(Kp + (size_t)(p1 + kr0) * DQK + kc0 * 8);
    if (has1) aK1 = *(const u32x4*)(Kp + (size_t)(p1 + kr1) * DQK + kc1 * 8);
    aV = *(const u32x4*)(Vtp + (size_t)vr * NPOS + p1 + vc * 8);
    bK0 = *(const u32x4*)(Kp + (size_t)(p2 + kr0) * DQK + kc0 * 8);
    if (has1) bK1 = *(const u32x4*)(Kp + (size_t)(p2 + kr1) * DQK + kc1 * 8);
    bV = *(const u32x4*)(Vtp + (size_t)vr * NPOS + p2 + vc * 8);
    swrite(0);
    *(u32x4*)(sK + 1 * 64 * LDK + kr0 * LDK + kc0 * 8) = aK0;
    if (has1) *(u32x4*)(sK + 1 * 64 * LDK + kr1 * LDK + kc1 * 8) = aK1;
    *(u32x4*)(sV + 1 * 64 * LDV + vr * LDV + vc * 8) = aV;
    *(u32x4*)(sK + 2 * 64 * LDK + kr0 * LDK + kc0 * 8) = bK0;
    if (has1) *(u32x4*)(sK + 2 * 64 * LDK + kr1 * LDK + kc1 * 8) = bK1;
    *(u32x4*)(sV + 2 * 64 * LDV + vr * LDV + vc * 8) = bV;
  }
  __syncthreads();
  const int qw = q_lat0 + wq;
  int buf = 0, ph3 = 0;
  for (int t = 0; t < ntiles; ++t) {
    if (VAR < 2 && t + 3 < ntiles) gload(t + 3);
    bool act = (wq < nq);
    int kk0 = 0;
    const bool band = WIN && t >= nctx;
    if (band) { kk0 = band_k0 + (t - nctx) * 64; act = act && (kk0 + 63 >= qw - 128) && (kk0 <= qw + 191); }
    if (act) {
      const bf16* sKb = sK + buf * 64 * LDK;
      const bf16* sVb = sV + buf * 64 * LDV;
#pragma unroll 1
      for (int ksub = 0; ksub < 2; ++ksub) {
        bf16x8 pb[4];
        {
          const bf16* kfp = sKb + (ksub * 32 + c) * LDK + g * 8;
          bf16x8 kf[2][KS];
#pragma unroll
          for (int a = 0; a < 2; ++a)
#pragma unroll
            for (int s = 0; s < KS; ++s) kf[a][s] = *(const bf16x8*)(kfp + a * 16 * LDK + s * 32);
#pragma unroll
          for (int b = 0; b < 4; ++b) {
            f32x4 sc0 = f32x4{negM, negM, negM, negM}, sc1 = sc0;
#pragma unroll
            for (int s = 0; s < KS; ++s) { sc0 = mfma16(kf[0][s], qf[b][s], sc0); sc1 = mfma16(kf[1][s], qf[b][s], sc1); }
            float p[8];
#pragma unroll
            for (int i = 0; i < 4; ++i) { p[i] = VAR == 1 ? sc0[i] : __builtin_amdgcn_exp2f(sc0[i]); p[4 + i] = VAR == 1 ? sc1[i] : __builtin_amdgcn_exp2f(sc1[i]); }
            if (band) {
              const int qi = qw + b * 16 + c;
#pragma unroll
              for (int i = 0; i < 8; ++i) {
                const int dd = qi - (kk0 + ksub * 32 + 16 * (i >> 2) + 4 * g + (i & 3));
                if (dd > 128 || dd < -128) p[i] = 0.f;
              }
            }
            float ps = 0.f;
#pragma unroll
            for (int i = 0; i < 8; ++i) ps += p[i];
            lsum[b] += ps;
            pb[b] = pack8(p);
          }
        }
#pragma unroll
        for (int dt = 0; dt < 4; ++dt) {
          const bf16x8 vf = *(const bf16x8*)(sVb + (dt * 16 + c) * LDV + ksub * 32 + g * 8);
#pragma unroll
          for (int b = 0; b < 4; ++b) O[b][dt] = mfma16(vf, pb[b], O[b][dt]);
        }
      }
    }
    if (VAR < 2 && t + 3 < ntiles) swrite(buf >= 3 ? buf - 3 : buf + 3);
    if (VAR < 3 && ph3 == 2) __syncthreads();
    buf = buf == 5 ? 0 : buf + 1;
    ph3 = ph3 == 2 ? 0 : ph3 + 1;
  }
  if (ph3 != 0) __syncthreads();
#pragma unroll
  for (int b = 0; b < 4; ++b) {
    float l = lsum[b];
    l += __shfl_xor(l, 16);
    l += __shfl_xor(l, 32);
    l += sinkterm;
    const float inv = 1.f / l;
    const int qi = wq + b * 16 + c;
    if (qi < nq) {
      bf16* dst = outp + (size_t)qi * 1024;
#pragma unroll
      for (int dt = 0; dt < 4; ++dt)
        *(u32x2*)(dst + dt * 16 + 4 * g) = pack4(O[b][dt][0] * inv, O[b][dt][1] * inv, O[b][dt][2] * inv, O[b][dt][3] * inv);
    }
  }
}

constexpr int LCH = 80, LGR = 9;
DI void lru_apply(float (&h)[4], const float* base, int col, bool valid) {
#pragma unroll
  for (int n = 0; n < 4; ++n) {
    const f32x2 cm = *(const f32x2*)(base + (16 * n + col) * 2);
    h[n] = valid ? cm[0] * h[n] + cm[1] : h[n];
  }
}
DI void lru_chunk(const Params& P, const float* sGateBase, const float* sTaps, bf16* hfw, int bi, int j, int c, int pass, float* sComp) {
  const int lane = tidx() & 63, col = lane & 15, g = lane >> 4;
  const bool isctx = c < 16;
  const int L = isctx ? LC : SEQ;
  const int sp0 = isctx ? c * 16 : (c - 16) * 128;
  const int tokbase = isctx ? (NL + bi * LC + sp0) : (bi * SEQ + sp0);
  const int nsteps = isctx ? 1 : 8;
  const bf16* C1 = P.cbuf;
  bf16* XCV = P.h;
  if (pass == 0) {
    for (int st = 0; st < nsteps; ++st) {
      const int t = st * 16 + col;
      u32x4 raw[2][4];
#pragma unroll
      for (int s = 0; s < 2; ++s)
#pragma unroll
        for (int k = 0; k < 4; ++k) {
          const int tt = sp0 + t + k - 2;
          const bool ok = tt >= 0 && tt < L;
          const int row = ok ? (tokbase + t + k - 2) : tokbase + t;
          raw[s][k] = *(const u32x4*)(C1 + (size_t)row * C1LD + 672 + 64 * j + 32 * s + 8 * g);
        }
#pragma unroll
      for (int s = 0; s < 2; ++s) {
        const int c0 = 64 * j + 32 * s + 8 * g;
        float a8[8];
        {
          const f32x4 b0 = *(const f32x4*)(sTaps + 2048 + c0), b1 = *(const f32x4*)(sTaps + 2048 + c0 + 4);
          for (int i = 0; i < 4; ++i) { a8[i] = b0[i]; a8[4 + i] = b1[i]; }
        }
#pragma unroll
        for (int k = 0; k < 4; ++k) {
          const int tt = sp0 + t + k - 2;
          const float m = (tt >= 0 && tt < L) ? 1.f : 0.f;
          float x8[8];
          unpack8(raw[s][k], x8);
          const f32x4 w0 = *(const f32x4*)(sTaps + k * 512 + c0), w1 = *(const f32x4*)(sTaps + k * 512 + c0 + 4);
          for (int i = 0; i < 4; ++i) { a8[i] += m * w0[i] * x8[i]; a8[4 + i] += m * w1[i] * x8[4 + i]; }
        }
        *(bf16x8*)(XCV + (size_t)(tokbase + t) * 512 + c0) = pack8(a8);
      }
    }
  }
#pragma unroll 1
  for (int dir = 0; dir < 2; ++dir) {
    bf16x8 wb[8][2];
#pragma unroll
    for (int n = 0; n < 8; ++n)
#pragma unroll
      for (int s = 0; s < 2; ++s)
        wb[n][s] = *(const bf16x8*)(P.wlrut + ((size_t)(((dir * 2 + (n >> 2)) * 8 + j) * 64 + 16 * (n & 3) + col)) * 64 + 32 * s + 8 * g);
    bf16x8 idf[2];
#pragma unroll
    for (int n = 0; n < 2; ++n)
#pragma unroll
      for (int jj = 0; jj < 8; ++jj) idf[n][jj] = ((8 * g + jj) == 16 * n + col) ? (short)0x3F80 : (short)0;
    float hst[4], arun[4];
#pragma unroll
    for (int n = 0; n < 4; ++n) { hst[n] = 0.f; arun[n] = 1.f; }
    const float* sGate = sGateBase + dir * 1536 + 64 * j + col;
    if (pass == 1) {
      const float* cbase = P.comp + ((size_t)(bi * 2 + dir) * LCH) * 1024 + 128 * j;
      const float* gbase = P.gcomp + ((size_t)(bi * 2 + dir) * LGR) * 1024 + 128 * j;
      if (isctx) {
#pragma unroll
        for (int i = 0; i < 15; ++i) {
          const int cc = dir == 0 ? i : 15 - i;
          const bool valid = dir == 0 ? (i < c) : (15 - i > c);
          lru_apply(hst, cbase + (size_t)(valid ? cc : 0) * 1024, col, valid);
        }
      } else {
        const int q = (c - 16) >> 3;
#pragma unroll
        for (int i = 0; i < 16; ++i) lru_apply(hst, cbase + (size_t)(dir == 0 ? i : 15 - i) * 1024, col, true);
#pragma unroll
        for (int i = 0; i < 7; ++i) {
          const int qq = dir == 0 ? i : 7 - i;
          const bool valid = dir == 0 ? (i < q) : (7 - i > q);
          lru_apply(hst, gbase + (size_t)(1 + (valid ? qq : 0)) * 1024, col, valid);
        }
#pragma unroll
        for (int i = 0; i < 7; ++i) {
          const int cc = dir == 0 ? 16 + 8 * q + i : 16 + 8 * q + 7 - i;
          const bool valid = dir == 0 ? (cc < c) : (cc > c);
          lru_apply(hst, cbase + (size_t)(valid ? cc : 16) * 1024, col, valid);
        }
      }
    }
    bf16x8 afc[2];
    auto issue = [&](int st, bf16x8 (&af)[2]) {
      const int t = st * 16 + col;
#pragma unroll
      for (int s = 0; s < 2; ++s) af[s] = *(const bf16x8*)(XCV + (size_t)(tokbase + t) * 512 + 64 * j + 32 * s + 8 * g);
    };
    issue(dir ? nsteps - 1 : 0, afc);
    for (int step = 0; step < nsteps; ++step) {
      const int st = dir ? nsteps - 1 - step : step;
      const int t0 = st * 16;
      bf16x8 af[2];
      af[0] = afc[0]; af[1] = afc[1];
      if (step + 1 < nsteps) issue(dir ? st - 1 : st + 1, afc);
      f32x4 ag[8], xcC[4];
      const f32x4 z4 = {0.f, 0.f, 0.f, 0.f};
#pragma unroll
      for (int n = 0; n < 8; ++n) { ag[n] = mfma16(af[0], wb[n][0], z4); ag[n] = mfma16(af[1], wb[n][1], ag[n]); }
#pragma unroll
      for (int n = 0; n < 4; ++n) xcC[n] = mfma16(af[n >> 1], idf[n & 1], z4);
#pragma unroll
      for (int n = 0; n < 4; ++n) {
        float av[4], bv[4];
#pragma unroll
        for (int e = 0; e < 4; ++e) {
          const float rg = sigmoidf_(ag[n][e] + sGate[16 * n]);
          const float ig = sigmoidf_(ag[4 + n][e] + sGate[512 + 16 * n]);
          const float a = __expf(-sGate[1024 + 16 * n] * rg);
          av[e] = a;
          bv[e] = __builtin_amdgcn_sqrtf(fmaxf(fmaf(-a, a, 1.f), 0.f)) * ig * xcC[n][e];
        }
        float A = 1.f, H = 0.f;
        if (dir == 0) { for (int e = 0; e < 4; ++e) { H = av[e] * H + bv[e]; A *= av[e]; } }
        else { for (int e = 3; e >= 0; --e) { H = av[e] * H + bv[e]; A *= av[e]; } }
        float A1, H1, Aex, Hex, At, Ht;
        if (dir == 0) {
          A1 = __shfl_up(A, 16); H1 = __shfl_up(H, 16);
          if (g >= 1) { H = A * H1 + H; A = A * A1; }
          A1 = __shfl_up(A, 32); H1 = __shfl_up(H, 32);
          if (g >= 2) { H = A * H1 + H; A = A * A1; }
          Aex = __shfl_up(A, 16); Hex = __shfl_up(H, 16);
          if (g == 0) { Aex = 1.f; Hex = 0.f; }
          At = __shfl(A, col + 48); Ht = __shfl(H, col + 48);
        } else {
          A1 = __shfl_down(A, 16); H1 = __shfl_down(H, 16);
          if (g <= 2) { H = A * H1 + H; A = A * A1; }
          A1 = __shfl_down(A, 32); H1 = __shfl_down(H, 32);
          if (g <= 1) { H = A * H1 + H; A = A * A1; }
          Aex = __shfl_down(A, 16); Hex = __shfl_down(H, 16);
          if (g == 3) { Aex = 1.f; Hex = 0.f; }
          At = __shfl(A, col); Ht = __shfl(H, col);
        }
        if (pass == 0) {
          hst[n] = At * hst[n] + Ht; arun[n] = At * arun[n];
        } else {
          float hc = Aex * hst[n] + Hex;
          hst[n] = At * hst[n] + Ht;
          float o[4];
          if (dir == 0) { for (int e = 0; e < 4; ++e) { hc = av[e] * hc + bv[e]; o[e] = hc; } }
          else { for (int e = 3; e >= 0; --e) { hc = av[e] * hc + bv[e]; o[e] = hc; } }
#pragma unroll
          for (int e = 0; e < 4; ++e) {
            bf16* yp = hfw + (t0 + 4 * g + e) * 64 + 16 * n + col;
            if (dir == 0) *yp = f2bf(o[e]); else *yp = f2bf(bf2f(*yp) + o[e]);
          }
        }
      }
    }
    if (pass == 0 && g == 0) {
#pragma unroll
      for (int n = 0; n < 4; ++n) {
        f32x2 cm = {arun[n], hst[n]};
        *(f32x2*)(P.comp + ((size_t)((bi * 2 + dir) * LCH + c) * 512 + 64 * j + 16 * n + col) * 2) = cm;
        *(f32x2*)(sComp + (dir * 64 + 16 * n + col) * 2) = cm;
      }
    }
  }
  if (pass == 1) {
    const int ntok = nsteps * 16;
    for (int i0 = 0; i0 < ntok * 8; i0 += 64 * 4) {
      u32x4 gr[4];
#pragma unroll
      for (int u = 0; u < 4; ++u) {
        const int id = i0 + u * 64 + lane;
        const int tk = id >> 3, cc = id & 7;
        gr[u] = u32x4{0, 0, 0, 0};
        if (tk < ntok) gr[u] = *(const u32x4*)(C1 + (size_t)(tokbase + tk) * C1LD + 1184 + 64 * j + cc * 8);
      }
#pragma unroll
      for (int u = 0; u < 4; ++u) {
        const int id = i0 + u * 64 + lane;
        const int tk = id >> 3, cc = id & 7;
        if (tk < ntok) {
          float hv[8], gv[8];
          unpack8(*(const u32x4*)(hfw + tk * 64 + cc * 8), hv);
          unpack8(gr[u], gv);
#pragma unroll
          for (int e = 0; e < 8; ++e) hv[e] *= geluf_(gv[e]);
          *(bf16x8*)(P.ycat + (size_t)(tokbase + tk) * 1024 + 512 + 64 * j + cc * 8) = pack8(hv);
        }
      }
    }
  }
}

DI void lru_block_item(const Params& P, float* fsm, int bi, int j, int grp, int pass) {
  const int tid = tidx(), wid = tid >> 6;
  const float* sGate = fsm;
  const float* sTaps = fsm + 3072;
  float* sComp = fsm + 5632;
  bf16* hfw = (bf16*)(fsm + 3072) + wid * 8192;
  lru_chunk(P, sGate, sTaps, hfw, bi, j, 16 + 8 * (grp - 1) + wid, pass, sComp + wid * 256);
  if (wid < 2) lru_chunk(P, sGate, sTaps, hfw, bi, j, 2 * (grp - 1) + wid, pass, sComp + (8 + wid) * 256);
  if (pass == 0) {
    __syncthreads();
    if (tid < 128) {
      const int dir = tid >> 6, ch = tid & 63;
      const int n = 8;
      float A = 1.f, H = 0.f;
      for (int i = 0; i < n; ++i) {
        const int cc = dir == 0 ? i : n - 1 - i;
        const float a = sComp[cc * 256 + (dir * 64 + ch) * 2], hh = sComp[cc * 256 + (dir * 64 + ch) * 2 + 1];
        H = a * H + hh; A = a * A;
      }
      f32x2 cm = {A, H};
      *(f32x2*)(P.gcomp + ((size_t)((bi * 2 + dir) * LGR + grp) * 512 + 64 * j + ch) * 2) = cm;
    }
    __syncthreads();
  }
}
DI void chunk_geom(int bi, int ck, int& L, int& sp0, int& tokbase, int& pos0) {
  const bool isctx = ck < 2;
  L = isctx ? LC : SEQ;
  sp0 = isctx ? ck * 128 : (ck - 2) * 128;
  tokbase = isctx ? (NL + bi * LC + sp0) : (bi * SEQ + sp0);
  pos0 = isctx ? sp0 : LC + sp0;
}

DI void ssd_conv_item(const Params& P, bf16* smem, int gc, int cr) {
  (void)smem;
  const int bi = gc / NCH, ck = gc % NCH;
  int L, sp0, tokbase, pos0; chunk_geom(bi, ck, L, sp0, tokbase, pos0);
  const int tid = tidx();
  const int cc = tid & 31, o = tid >> 5;
  const int c0 = cr * 256 + cc * 8;
  f32x4 wv[4][2], bv[2];
#pragma unroll
  for (int k = 0; k < 4; ++k) { wv[k][0] = *(const f32x4*)(P.ssd_conv_w + k * 1024 + c0); wv[k][1] = *(const f32x4*)(P.ssd_conv_w + k * 1024 + c0 + 4); }
  bv[0] = *(const f32x4*)(P.ssd_conv_b + c0); bv[1] = *(const f32x4*)(P.ssd_conv_b + c0 + 4);
  const int tA = 16 * (o >> 1) + 4 * (o & 1);
  u32x4 raw[2][7];
#pragma unroll
  for (int rn = 0; rn < 2; ++rn)
#pragma unroll
    for (int i = 0; i < 7; ++i) {
      const int t = tA + 8 * rn + i - 2, tt = sp0 + t;
      raw[rn][i] = u32x4{0, 0, 0, 0};
      if (tt >= 0 && tt < L) raw[rn][i] = *(const u32x4*)(P.cbuf + (size_t)(tokbase + t) * C2LD + 1280 + c0);
    }
  float ut[8][8];
#pragma unroll
  for (int rn = 0; rn < 2; ++rn)
#pragma unroll
    for (int i = 0; i < 4; ++i) {
      float a8[8];
#pragma unroll
      for (int e = 0; e < 4; ++e) { a8[e] = bv[0][e]; a8[4 + e] = bv[1][e]; }
#pragma unroll
      for (int k = 0; k < 4; ++k) {
        float x8[8];
        unpack8(raw[rn][i + k], x8);
#pragma unroll
        for (int e = 0; e < 4; ++e) { a8[e] += wv[k][0][e] * x8[e]; a8[4 + e] += wv[k][1][e] * x8[4 + e]; }
      }
#pragma unroll
      for (int e = 0; e < 8; ++e) { a8[e] = siluf_(a8[e]); ut[e][4 * rn + i] = a8[e]; }
      *(bf16x8*)(P.h + (size_t)(tokbase + tA + 8 * rn + i) * 1024 + c0) = pack8(a8);
    }
#pragma unroll
  for (int e = 0; e < 8; ++e) *(bf16x8*)(P.ut + ((size_t)(bi * 1024 + c0 + e)) * NPOS + pos0 + 8 * o) = pack8(ut[e]);
}

DI void ssd_cumsum_item(const Params& P, int gc) {
  const int bi = gc / NCH, ck = gc % NCH;
  int L, sp0, tokbase, pos0; chunk_geom(bi, ck, L, sp0, tokbase, pos0);
  const int lane = tidx() & 63;
  f32x4 raw[2][4];
#pragma unroll
  for (int u = 0; u < 2; ++u)
#pragma unroll
    for (int q = 0; q < 4; ++q) raw[u][q] = *(const f32x4*)(P.dtr + (size_t)(tokbase + 64 * u + lane) * 16 + 4 * q);
  const int perm = (lane & ~15) | swap23(lane & 15);
#pragma unroll
  for (int idx = 0; idx < 16; ++idx) {
    const float A = -__expf(P.ssd_a_log[idx]);
    const float bias = P.ssd_dt_bias[idx];
    const float dt0 = softplusf_(raw[0][idx >> 2][idx & 3] + bias), dt1 = softplusf_(raw[1][idx >> 2][idx & 3] + bias);
    const float a0 = dt0 * A, a1 = dt1 * A;
    float c0 = a0, c1 = a1;
#pragma unroll
    for (int d = 1; d < 64; d <<= 1) {
      const float v0 = __shfl_up(c0, d), v1 = __shfl_up(c1, d);
      if (lane >= d) { c0 += v0; c1 += v1; }
    }
    c1 += __shfl(c0, 63);
    const float total = __shfl(c1, 63);
    const size_t rowb = (size_t)(bi * 16 + idx) * NPOS + pos0;
    P.dtt[rowb + lane] = dt0; P.dtt[rowb + 64 + lane] = dt1;
    P.cst[rowb + lane] = c0; P.cst[rowb + 64 + lane] = c1;
    const float w0 = idx < 8 ? dt0 * __expf(total - c0) : dt0 * __expf(c0 - a0);
    const float w1 = idx < 8 ? dt1 * __expf(total - c1) : dt1 * __expf(c1 - a1);
    P.wgp[rowb + perm] = w0; P.wgp[rowb + 64 + perm] = w1;
  }
}

DI void ssd_passA_item(const Params& P, int gc, int hd, int dir, int pt) {
  const int bi = gc / NCH, ck = gc % NCH;
  int L, sp0, tokbase, pos0; chunk_geom(bi, ck, L, sp0, tokbase, pos0);
  const int lane = tidx() & 63, r = lane & 31, h = lane >> 5;
  const int idx = dir * 8 + hd, grp = hd >> 2;
  const bf16* xrow = P.ut + ((size_t)(bi * 1024 + hd * 64 + 32 * pt + r)) * NPOS + pos0 + 8 * h;
  const float* wrow = P.wgp + (size_t)(bi * 16 + idx) * NPOS + pos0 + 8 * h;
  const bf16* brow = P.ut + ((size_t)(bi * 1024 + 512 + grp * 128 + r)) * NPOS + pos0 + 8 * h;
  bf16x8 xs[8];
  {
    u32x4 xr[8]; f32x4 w0[8], w1[8];
#pragma unroll
    for (int ks = 0; ks < 8; ++ks) { xr[ks] = *(const u32x4*)(xrow + 16 * ks); w0[ks] = *(const f32x4*)(wrow + 16 * ks); w1[ks] = *(const f32x4*)(wrow + 16 * ks + 4); }
#pragma unroll
    for (int ks = 0; ks < 8; ++ks) {
      float x8[8];
      unpack8(xr[ks], x8);
#pragma unroll
      for (int e = 0; e < 4; ++e) { x8[e] *= w0[ks][e]; x8[4 + e] *= w1[ks][e]; }
      xs[ks] = pack8(x8);
    }
  }
  f32x16 acc[4];
#pragma unroll
  for (int nt = 0; nt < 4; ++nt)
#pragma unroll
    for (int e = 0; e < 16; ++e) acc[nt][e] = 0.f;
#pragma unroll
  for (int ks = 0; ks < 8; ++ks)
#pragma unroll
    for (int nt = 0; nt < 4; ++nt) acc[nt] = mfma32(*(const bf16x8*)(brow + (size_t)(32 * nt) * NPOS + 16 * ks), xs[ks], acc[nt]);
  bf16* dst = P.qkv + ST_OFF + ((size_t)(((bi * 2 + dir) * 8 + hd) * NCH + ck)) * 8192 + (32 * pt + r) * 128 + 4 * h;
#pragma unroll
  for (int nt = 0; nt < 4; ++nt)
#pragma unroll
    for (int g = 0; g < 4; ++g) *(u32x2*)(dst + 32 * nt + 8 * g) = pack4(acc[nt][4 * g], acc[nt][4 * g + 1], acc[nt][4 * g + 2], acc[nt][4 * g + 3]);
}

DI void ssd_passA_block(const Params& P, bf16* smem, int gc, int grp) {
  const int bi = gc / NCH, ck = gc % NCH;
  int L, sp0, tokbase, pos0; chunk_geom(bi, ck, L, sp0, tokbase, pos0);
  const int tid = tidx(), lane = tid & 63, wid = tid >> 6, r = lane & 31, h = lane >> 5;
  constexpr int LDB = 136;
  bf16* sBt = smem;
  bf16* sXt = smem + 128 * LDB;
  float* sWg = (float*)(smem + 384 * LDB);
  {
    u32x4 tb[4], tx[8];
#pragma unroll
    for (int i = 0; i < 4; ++i) {
      const int id = tid + 512 * i, row = id >> 4, c = id & 15;
      tb[i] = *(const u32x4*)(P.ut + ((size_t)(bi * 1024 + 512 + grp * 128 + row)) * NPOS + pos0 + c * 8);
    }
#pragma unroll
    for (int i = 0; i < 8; ++i) {
      const int id = tid + 512 * i, row = id >> 4, c = id & 15;
      tx[i] = *(const u32x4*)(P.ut + ((size_t)(bi * 1024 + grp * 256 + row)) * NPOS + pos0 + c * 8);
    }
    float wv[2];
#pragma unroll
    for (int i = 0; i < 2; ++i) {
      const int id = tid + 512 * i, dir = id >> 9, hl = (id >> 7) & 3, t = id & 127;
      wv[i] = P.wgp[(size_t)(bi * 16 + dir * 8 + grp * 4 + hl) * NPOS + pos0 + t];
    }
#pragma unroll
    for (int i = 0; i < 4; ++i) { const int id = tid + 512 * i; *(u32x4*)(sBt + (id >> 4) * LDB + (id & 15) * 8) = tb[i]; }
#pragma unroll
    for (int i = 0; i < 8; ++i) { const int id = tid + 512 * i; *(u32x4*)(sXt + (id >> 4) * LDB + (id & 15) * 8) = tx[i]; }
#pragma unroll
    for (int i = 0; i < 2; ++i) sWg[tid + 512 * i] = wv[i];
  }
  __syncthreads();
  const int hl = wid >> 1, dir = wid & 1, hd = grp * 4 + hl;
  f32x16 acc[4][2];
#pragma unroll
  for (int nt = 0; nt < 4; ++nt)
#pragma unroll
    for (int pt = 0; pt < 2; ++pt)
#pragma unroll
      for (int e = 0; e < 16; ++e) acc[nt][pt][e] = 0.f;
  const float* wrow = sWg + (dir * 4 + hl) * 128 + 8 * h;
#pragma unroll
  for (int ks = 0; ks < 8; ++ks) {
    const f32x4 w0 = *(const f32x4*)(wrow + 16 * ks), w1 = *(const f32x4*)(wrow + 16 * ks + 4);
    bf16x8 xs[2];
#pragma unroll
    for (int pt = 0; pt < 2; ++pt) {
      float x8[8];
      unpack8(*(const u32x4*)(sXt + (hl * 64 + 32 * pt + r) * LDB + 16 * ks + 8 * h), x8);
#pragma unroll
      for (int e = 0; e < 4; ++e) { x8[e] *= w0[e]; x8[4 + e] *= w1[e]; }
      xs[pt] = pack8(x8);
    }
#pragma unroll
    for (int nt = 0; nt < 4; ++nt) {
      const bf16x8 bf = *(const bf16x8*)(sBt + (32 * nt + r) * LDB + 16 * ks + 8 * h);
      acc[nt][0] = mfma32(bf, xs[0], acc[nt][0]);
      acc[nt][1] = mfma32(bf, xs[1], acc[nt][1]);
    }
  }
  bf16* dst = P.qkv + ST_OFF + ((size_t)(((bi * 2 + dir) * 8 + hd) * NCH + ck)) * 8192 + 4 * h;
#pragma unroll
  for (int pt = 0; pt < 2; ++pt)
#pragma unroll
    for (int nt = 0; nt < 4; ++nt)
#pragma unroll
      for (int g = 0; g < 4; ++g)
        *(u32x2*)(dst + (32 * pt + r) * 128 + 32 * nt + 8 * g) = pack4(acc[nt][pt][4 * g], acc[nt][pt][4 * g + 1], acc[nt][pt][4 * g + 2], acc[nt][pt][4 * g + 3]);
  __syncthreads();
}

DI void ssd_passB(const Params& P, int bid, int nblk) {
  const int nthr = nblk * 512;
  for (int id = bid * 512 + tidx(); id < NB * 2 * 8 * 2048; id += nthr) {
    const int e4 = id & 2047, hd = (id >> 11) & 7, dir = (id >> 14) & 1, bi = id >> 15;
    bf16* base = P.qkv + ST_OFF + ((size_t)((bi * 2 + dir) * 8 + hd)) * NCH * 8192 + e4 * 4;
    const float* crow_ = P.cst + (size_t)(bi * 16 + dir * 8 + hd) * NPOS;
    float S0 = 0.f, S1 = 0.f, S2 = 0.f, S3 = 0.f;
    for (int i0 = 0; i0 < NCH; i0 += 6) {
      u32x2 raw[6]; float dec[6]; int cks[6];
#pragma unroll
      for (int u = 0; u < 6; ++u) {
        const int i = i0 + u;
        const int ck = dir == 0 ? i : (i == 0 ? 1 : (i == 1 ? 0 : 67 - i));
        cks[u] = ck;
        raw[u] = *(const u32x2*)(base + (size_t)ck * 8192);
        dec[u] = __expf(crow_[ck * 128 + 127]);
      }
#pragma unroll
      for (int u = 0; u < 6; ++u) {
        *(u32x2*)(base + (size_t)cks[u] * 8192) = pack4(S0, S1, S2, S3);
        S0 = dec[u] * S0 + lo16(raw[u][0]); S1 = dec[u] * S1 + hi16(raw[u][0]);
        S2 = dec[u] * S2 + lo16(raw[u][1]); S3 = dec[u] * S3 + hi16(raw[u][1]);
      }
    }
  }
}

DI void ssd_passC_item(const Params& P, bf16* smem, int bi, int ck, int grp) {
  int L, sp0, tokbase, pos0; chunk_geom(bi, ck, L, sp0, tokbase, pos0);
  const int tid = tidx(), lane = tid & 63, wid = tid >> 6, r = lane & 31, h = lane >> 5;
  constexpr int LDB = 136;
  bf16* sB = smem;
  bf16* sC = smem + 128 * LDB;
  bf16* sX = smem + 256 * LDB;
  float* sCS = (float*)(smem + 512 * LDB);
  float* sDT = sCS + 1024;
  const bf16* U = P.h;
  {
    u32x4 tb[4], tc[4], tx[8];
#pragma unroll
    for (int i = 0; i < 4; ++i) {
      const int id = tid + 512 * i, row = id >> 4, c = id & 15;
      tb[i] = *(const u32x4*)(U + (size_t)(tokbase + row) * 1024 + 512 + grp * 128 + c * 8);
      tc[i] = *(const u32x4*)(U + (size_t)(tokbase + row) * 1024 + 768 + grp * 128 + c * 8);
    }
#pragma unroll
    for (int i = 0; i < 8; ++i) {
      const int id = tid + 512 * i, row = id >> 4, c = id & 15;
      tx[i] = *(const u32x4*)(P.ut + ((size_t)(bi * 1024 + grp * 256 + row)) * NPOS + pos0 + c * 8);
    }
    float cv[2], dv[2];
#pragma unroll
    for (int i = 0; i < 2; ++i) {
      const int id = tid + 512 * i, dir = id >> 9, hl = (id >> 7) & 3, t = id & 127;
      const size_t o = (size_t)(bi * 16 + dir * 8 + grp * 4 + hl) * NPOS + pos0 + t;
      cv[i] = P.cst[o]; dv[i] = P.dtt[o];
    }
#pragma unroll
    for (int i = 0; i < 4; ++i) {
      const int id = tid + 512 * i, row = id >> 4, c = id & 15;
      *(u32x4*)(sB + row * LDB + c * 8) = tb[i];
      *(u32x4*)(sC + row * LDB + c * 8) = tc[i];
    }
#pragma unroll
    for (int i = 0; i < 8; ++i) {
      const int id = tid + 512 * i, row = id >> 4, c = id & 15;
      *(u32x4*)(sX + row * LDB + c * 8) = tx[i];
    }
#pragma unroll
    for (int i = 0; i < 2; ++i) { sCS[tid + 512 * i] = cv[i]; sDT[tid + 512 * i] = dv[i]; }
  }
  __syncthreads();
  const int hl = wid >> 1, hd = grp * 4 + hl;
  const float Ah0 = -__expf(P.ssd_a_log[hd]), Ah1 = -__expf(P.ssd_a_log[8 + hd]);
  const float dsk = P.ssd_d[hd] + P.ssd_d[8 + hd];
  const float* csF = sCS + hl * 128;
  const float* csR = sCS + 512 + hl * 128;
  const float* dtF = sDT + hl * 128;
  const float* dtR = sDT + 512 + hl * 128;
#pragma unroll 1
  for (int lq = 0; lq < 2; ++lq) {
    const int lt = 2 * (wid & 1) + lq;
    const int l = lt * 32 + r;
    const size_t tok = tokbase + l;
    bf16x8 cfr[8];
#pragma unroll
    for (int ks = 0; ks < 8; ++ks) cfr[ks] = *(const bf16x8*)(sC + l * LDB + 16 * ks + 8 * h);
    f32x16 acc[2];
#pragma unroll
    for (int pt = 0; pt < 2; ++pt)
#pragma unroll
      for (int e = 0; e < 16; ++e) acc[pt][e] = 0.f;
    const float cslF = csF[l], cslR = csR[l];
    const float exlR = cslR - dtR[l] * Ah1;
#pragma unroll
    for (int dir = 0; dir < 2; ++dir) {
      const float fac = dir == 0 ? __expf(cslF) : __expf(csR[127] - exlR);
#pragma unroll
      for (int pt = 0; pt < 2; ++pt) {
        f32x16 yo;
#pragma unroll
        for (int e = 0; e < 16; ++e) yo[e] = 0.f;
        const bf16* srow = P.qkv + ST_OFF + ((size_t)(((bi * 2 + dir) * 8 + hd) * NCH + ck)) * 8192 + (32 * pt + r) * 128 + 8 * h;
#pragma unroll
        for (int ks = 0; ks < 8; ++ks) yo = mfma32(*(const bf16x8*)(srow + 16 * ks), cfr[ks], yo);
#pragma unroll
        for (int e = 0; e < 16; ++e) acc[pt][e] += fac * yo[e];
      }
    }
#pragma unroll 1
    for (int st = 0; st < 4; ++st) {
      f32x16 G;
#pragma unroll
      for (int e = 0; e < 16; ++e) G[e] = 0.f;
#pragma unroll
      for (int ks = 0; ks < 8; ++ks) G = mfma32(*(const bf16x8*)(sB + (st * 32 + r) * LDB + 16 * ks + 8 * h), cfr[ks], G);
      const bf16* x0p = sX + (hl * 64 + r) * LDB + st * 32 + 8 * h;
      const bf16x8 x00 = *(const bf16x8*)(x0p), x01 = *(const bf16x8*)(x0p + 16);
      const bf16x8 x10 = *(const bf16x8*)(x0p + 32 * LDB), x11 = *(const bf16x8*)(x0p + 32 * LDB + 16);
      if (st <= lt) {
        float m[16];
#pragma unroll
        for (int g = 0; g < 4; ++g) {
          const int sb = st * 32 + 8 * g + 4 * h;
          const f32x4 cs4 = *(const f32x4*)(csF + sb), dt4 = *(const f32x4*)(dtF + sb);
#pragma unroll
          for (int e = 0; e < 4; ++e) m[4 * g + e] = (sb + e <= l) ? G[4 * g + e] * __expf(cslF - cs4[e]) * dt4[e] : 0.f;
        }
        float t0[8], t1[8];
#pragma unroll
        for (int e = 0; e < 8; ++e) { t0[e] = m[e]; t1[e] = m[8 + e]; }
        const bf16x8 p0 = pack8(t0), p1 = pack8(t1);
        acc[0] = mfma32(x00, p0, acc[0]); acc[0] = mfma32(x01, p1, acc[0]);
        acc[1] = mfma32(x10, p0, acc[1]); acc[1] = mfma32(x11, p1, acc[1]);
      }
      if (st >= lt) {
        float m[16];
#pragma unroll
        for (int g = 0; g < 4; ++g) {
          const int sb = st * 32 + 8 * g + 4 * h;
          const f32x4 cs4 = *(const f32x4*)(csR + sb), dt4 = *(const f32x4*)(dtR + sb);
#pragma unroll
          for (int e = 0; e < 4; ++e) m[4 * g + e] = (sb + e >= l) ? G[4 * g + e] * __expf((cs4[e] - dt4[e] * Ah1) - exlR) * dt4[e] : 0.f;
        }
        float t0[8], t1[8];
#pragma unroll
        for (int e = 0; e < 8; ++e) { t0[e] = m[e]; t1[e] = m[8 + e]; }
        const bf16x8 p0 = pack8(t0), p1 = pack8(t1);
        acc[0] = mfma32(x00, p0, acc[0]); acc[0] = mfma32(x01, p1, acc[0]);
        acc[1] = mfma32(x10, p0, acc[1]); acc[1] = mfma32(x11, p1, acc[1]);
      }
    }
    (void)Ah0;
    float ss = 0.f;
#pragma unroll
    for (int pt = 0; pt < 2; ++pt)
#pragma unroll
      for (int g = 0; g < 4; ++g) {
        const int p0 = 32 * pt + 8 * g + 4 * h;
        const u32x2 xr = *(const u32x2*)(U + tok * 1024 + hd * 64 + p0);
        const u32x2 zr = *(const u32x2*)(P.cbuf + tok * C2LD + 768 + hd * 64 + p0);
        const float xs[4] = {lo16(xr[0]), hi16(xr[0]), lo16(xr[1]), hi16(xr[1])};
        const float zz[4] = {lo16(zr[0]), hi16(zr[0]), lo16(zr[1]), hi16(zr[1])};
        float o[4];
#pragma unroll
        for (int e = 0; e < 4; ++e) { o[e] = (acc[pt][4 * g + e] + dsk * xs[e]) * siluf_(zz[e]); ss += o[e] * o[e]; }
        *(u32x2*)(P.ycat + tok * 1024 + 512 + hd * 64 + p0) = pack4(o[0], o[1], o[2], o[3]);
      }
    ss = xor32(ss);
    if (h == 0) P.ssq2[tok * 8 + hd] = ss;
  }
  __syncthreads();
}

struct RouteRec { int e0, p0, e1, p1; float w0, w1; };
DI RouteRec route_rec(const Params& P, int tok) {
  const int* ti = P.tokinfo + (size_t)tok * 4;
  RouteRec r; r.e0 = ti[0]; r.p0 = ti[1]; r.e1 = ti[2]; r.p1 = ti[3]; r.w0 = P.tokw[tok * 2]; r.w1 = P.tokw[tok * 2 + 1]; return r;
}
DI void row_pass2(const Params& P, int mode, int layer, int tokA, int ntok, const int* sOff, const RouteRec (&rr)[2]) {
  const int lane = tidx() & 63;
  const int tk[2] = {tokA, tokA + 1 < ntok ? tokA + 1 : tokA};
  const bool ok1 = tokA + 1 < ntok;
  f32x4 v[2][4];
  const float* src[2];
  int bm[2];
#pragma unroll
  for (int u = 0; u < 2; ++u) {
    int b, pos; bool lat; tok_info(tk[u], bm[u], b, pos, lat);
    src[u] = mode != 2 ? (lat ? P.x + (size_t)tk[u] * 1024 : P.ctx + (size_t)(tk[u] - NL) * 1024)
                       : (lat ? P.out + (size_t)tk[u] * 1024 : P.xc + (size_t)(tk[u] - NL) * 1024);
#pragma unroll
    for (int i = 0; i < 4; ++i) v[u][i] = *(const f32x4*)(src[u] + 4 * lane + 256 * i);
  }
  f32x4 ngv[4], nsv[4], nhv[4];
  if (mode != 2) {
    const float* g1 = P.norm1_g + layer * 1024;
    const float* sh = P.mods + ((size_t)(layer * 5 + bm[0]) * 6 + 0) * 1024;
    const float* sc = P.mods + ((size_t)(layer * 5 + bm[0]) * 6 + 1) * 1024;
#pragma unroll
    for (int i = 0; i < 4; ++i) { const int k = 4 * lane + 256 * i; ngv[i] = *(const f32x4*)(g1 + k); nsv[i] = *(const f32x4*)(sc + k); nhv[i] = *(const f32x4*)(sh + k); }
  }
  if (mode != 0) {
    u32x2 dd[2][4];
#pragma unroll
    for (int u = 0; u < 2; ++u)
#pragma unroll
      for (int i = 0; i < 4; ++i) dd[u][i] = *(const u32x2*)(dbuf(P) + (size_t)tk[u] * 1024 + 4 * lane + 256 * i);
#pragma unroll
    for (int u = 0; u < 2; ++u)
#pragma unroll
      for (int i = 0; i < 4; ++i) { v[u][i][0] += lo16(dd[u][i][0]); v[u][i][1] += hi16(dd[u][i][0]); v[u][i][2] += lo16(dd[u][i][1]); v[u][i][3] += hi16(dd[u][i][1]); }
  }
  if (mode == 1 || mode == 2) {
    u32x2 y0[2][4], y1[2][4];
    float w0[2], w1[2];
#pragma unroll
    for (int u = 0; u < 2; ++u) {
      const int s0 = sOff[rr[u].e0] + rr[u].p0, s1 = sOff[rr[u].e1] + rr[u].p1;
      w0[u] = rr[u].w0; w1[u] = rr[u].w1;
#pragma unroll
      for (int i = 0; i < 4; ++i) {
        const int k = 4 * lane + 256 * i;
        y0[u][i] = *(const u32x2*)(P.qkv + (size_t)s0 * 1024 + k); y1[u][i] = *(const u32x2*)(P.qkv + (size_t)s1 * 1024 + k);
      }
    }
#pragma unroll
    for (int u = 0; u < 2; ++u) {
      const float* m5 = P.mods + ((size_t)((mode - 1) * 5 + bm[u]) * 6 + 5) * 1024;
      float* dst = tk[u] < NL ? P.out + (size_t)tk[u] * 1024 : P.xc + (size_t)(tk[u] - NL) * 1024;
#pragma unroll
      for (int i = 0; i < 4; ++i) {
        const int k = 4 * lane + 256 * i;
        const f32x4 mv = *(const f32x4*)(m5 + k);
        v[u][i][0] += mv[0] * (w0[u] * lo16(y0[u][i][0]) + w1[u] * lo16(y1[u][i][0]));
        v[u][i][1] += mv[1] * (w0[u] * hi16(y0[u][i][0]) + w1[u] * hi16(y1[u][i][0]));
        v[u][i][2] += mv[2] * (w0[u] * lo16(y0[u][i][1]) + w1[u] * lo16(y1[u][i][1]));
        v[u][i][3] += mv[3] * (w0[u] * hi16(y0[u][i][1]) + w1[u] * hi16(y1[u][i][1]));
        if (u == 0 || ok1) *(f32x4*)(dst + k) = v[u][i];
      }
    }
    if (mode == 2) return;
  }
#pragma unroll
  for (int u = 0; u < 2; ++u) {
    float ss = 0.f;
#pragma unroll
    for (int i = 0; i < 4; ++i) ss += v[u][i][0] * v[u][i][0] + v[u][i][1] * v[u][i][1] + v[u][i][2] * v[u][i][2] + v[u][i][3] * v[u][i][3];
    ss = wave_sum(ss);
    const float rstd = rsqrtf(ss * (1.f / 1024.f) + EPS);
    if (u == 0 || ok1) {
#pragma unroll
      for (int i = 0; i < 4; ++i) {
        const int k = 4 * lane + 256 * i;
        const f32x4 gv = ngv[i], sv = nsv[i], hv = nhv[i];
        float o[4];
#pragma unroll
        for (int e = 0; e < 4; ++e) o[e] = v[u][i][e] * rstd * gv[e] * (1.f + sv[e]) + hv[e];
        *(u32x2*)(P.h + (size_t)tk[u] * 1024 + k) = pack4(o[0], o[1], o[2], o[3]);
      }
    }
  }
}

DI void route_tokens(const Params& P, int layer, float* sW, int item, int tok_lo, int tok_hi) {
  const int tid = tidx(), lane = tid & 63, wid = tid >> 6, r = lane & 31, h = lane >> 5;
  float* sSS = sW;
  float* sAcc = sW + 256;
  int* sCnt = (int*)(sW + 256 + 8192);
  bf16* sH = (bf16*)(sW + 9216) + wid * 32 * 136;
  if (tid < 32) sCnt[tid] = 0;
  const int ks0 = 128 * wid;
  bf16x8 whi[8], wlo[8];
#pragma unroll
  for (int s = 0; s < 8; ++s) {
    float hi8[8], lo8[8];
#pragma unroll
    for (int j = 0; j < 8; ++j) {
      const float wv = P.router_w[(size_t)(ks0 + 16 * s + 8 * h + j) * 32 + r];
      const float hv = bf2f(f2bf(wv));
      hi8[j] = hv; lo8[j] = wv - hv;
    }
    whi[s] = pack8(hi8); wlo[s] = pack8(lo8);
  }
  const float* g2 = P.norm2_g + layer * 1024 + ks0 + 8 * h;
  __syncthreads();
  f32x4 xv[8][2];
  u32x4 dv[8];
  auto xload = [&](int t0) {
    const int tk = t0 + r < tok_hi ? t0 + r : tok_hi - 1;
    const float* src = (layer == 0 ? (tk < NL ? P.x + (size_t)tk * 1024 : P.ctx + (size_t)(tk - NL) * 1024)
                                   : (tk < NL ? P.out + (size_t)tk * 1024 : P.xc + (size_t)(tk - NL) * 1024)) + ks0 + 8 * h;
    const bf16* dsrc = dbuf(P) + (size_t)tk * 1024 + ks0 + 8 * h;
#pragma unroll
    for (int s = 0; s < 8; ++s) { xv[s][0] = *(const f32x4*)(src + 16 * s); xv[s][1] = *(const f32x4*)(src + 16 * s + 4); dv[s] = *(const u32x4*)(dsrc + 16 * s); }
  };
  if (tok_lo < tok_hi) xload(tok_lo);
  for (int t0 = tok_lo; t0 < tok_hi; t0 += 32) {
    const bool ok = t0 + r < tok_hi;
    const int tok = ok ? t0 + r : tok_hi - 1;
    const int bmod = tok < NL ? (tok >> 13) : 4;
    const float* shp = P.mods + ((size_t)(layer * 5 + bmod) * 6 + 3) * 1024 + ks0 + 8 * h;
    const float* scp = P.mods + ((size_t)(layer * 5 + bmod) * 6 + 4) * 1024 + ks0 + 8 * h;
    {
      float* xdst = (tok < NL ? P.out + (size_t)tok * 1024 : P.xc + (size_t)(tok - NL) * 1024) + ks0 + 8 * h;
#pragma unroll
      for (int s = 0; s < 8; ++s) {
        float d8[8];
        unpack8(dv[s], d8);
#pragma unroll
        for (int e = 0; e < 4; ++e) { xv[s][0][e] += d8[e]; xv[s][1][e] += d8[4 + e]; }
        if (ok && P.pad0 < 0) { *(f32x4*)(xdst + 16 * s) = xv[s][0]; *(f32x4*)(xdst + 16 * s + 4) = xv[s][1]; }
      }
    }
    float ss = 0.f;
#pragma unroll
    for (int s = 0; s < 8; ++s)
#pragma unroll
      for (int e = 0; e < 4; ++e) ss += xv[s][0][e] * xv[s][0][e] + xv[s][1][e] * xv[s][1][e];
    ss = xor32(ss);
    if (h == 0) sSS[wid * 32 + r] = ss;
    __syncthreads();
    float tot = 0.f;
#pragma unroll
    for (int w8 = 0; w8 < 8; ++w8) tot += sSS[w8 * 32 + r];
    const float rstd = rsqrtf(tot * (1.f / 1024.f) + EPS);
    f32x16 acc;
#pragma unroll
    for (int e = 0; e < 16; ++e) acc[e] = 0.f;
#pragma unroll
    for (int s = 0; s < 8; ++s) {
      const f32x4 g0 = *(const f32x4*)(g2 + 16 * s), g1 = *(const f32x4*)(g2 + 16 * s + 4);
      const f32x4 c0 = *(const f32x4*)(scp + 16 * s), c1 = *(const f32x4*)(scp + 16 * s + 4);
      const f32x4 s0 = *(const f32x4*)(shp + 16 * s), s1 = *(const f32x4*)(shp + 16 * s + 4);
      float hv[8], hi8[8], lo8[8];
#pragma unroll
      for (int e = 0; e < 4; ++e) {
        hv[e] = xv[s][0][e] * rstd * g0[e] * (1.f + c0[e]) + s0[e];
        hv[4 + e] = xv[s][1][e] * rstd * g1[e] * (1.f + c1[e]) + s1[e];
      }
      const bf16x8 hb = pack8(hv);
#pragma unroll
      for (int e = 0; e < 8; ++e) { hi8[e] = bf2f((bf16)hb[e]); lo8[e] = hv[e] - hi8[e]; }
      const bf16x8 lb = pack8(lo8);
      *(bf16x8*)(sH + r * 136 + 16 * s + 8 * h) = hb;
      acc = mfma32(whi[s], hb, acc);
      acc = mfma32(whi[s], lb, acc);
      acc = mfma32(wlo[s], hb, acc);
    }
#pragma unroll
    for (int e = 0; e < 16; ++e) sAcc[(wid * 16 + e) * 64 + lane] = acc[e];
#pragma unroll
    for (int k = 0; k < 8; ++k) {
      const int row = 4 * k + (lane >> 4), ch = lane & 15;
      const u32x4 hv4 = *(const u32x4*)(sH + row * 136 + ch * 8);
      if (t0 + row < tok_hi) *(u32x4*)(P.h + (size_t)(t0 + row) * 1024 + ks0 + ch * 8) = hv4;
    }
    if (t0 + 32 < tok_hi) xload(t0 + 32);
    __syncthreads();
    if (wid == 0) {
      float lo[16], hi[16];
#pragma unroll
      for (int e = 0; e < 16; ++e) {
        float v = 0.f;
#pragma unroll
        for (int w8 = 0; w8 < 8; ++w8) v += sAcc[(w8 * 16 + e) * 64 + lane];
        const float oth = __shfl_xor(v, 32);
        lo[e] = h == 0 ? v : oth; hi[e] = h == 0 ? oth : v;
      }
      float bestg = -3.0e38f, bu0 = 0.f, bu1 = 0.f;
      int be0 = 0, be1 = 0;
#pragma unroll
      for (int q = 0; q < 4; ++q) {
        float m1 = -3.0e38f, m2 = -3.0e38f, u1 = 0.f, u2 = 0.f;
        int i1 = 0, i2 = 0;
#pragma unroll
        for (int m = 0; m < 8; ++m) {
          const float lg = m < 4 ? lo[4 * q + (m & 3)] : hi[4 * q + (m & 3)];
          const float uu = 1.f / (1.f + expf(-lg));
          const float xb = uu + P.router_b[8 * q + m];
          if (xb > m1) { m2 = m1; i2 = i1; u2 = u1; m1 = xb; i1 = m; u1 = uu; }
          else if (xb > m2) { m2 = xb; i2 = m; u2 = uu; }
        }
        const float gs = m1 + m2;
        if (gs > bestg) { bestg = gs; be0 = 8 * q + i1; be1 = 8 * q + i2; bu0 = u1; bu1 = u2; }
      }
      if (ok && h == 0) {
        const int r0 = atomicAdd(&sCnt[be0], 1), r1 = atomicAdd(&sCnt[be1], 1);
        const float inv = 1.f / (bu0 + bu1);
        int* ti = P.tokinfo + (size_t)tok * 4;
        ti[0] = be0; ti[1] = r0; ti[2] = be1; ti[3] = r1;
        P.tokw[tok * 2] = bu0 * inv; P.tokw[tok * 2 + 1] = bu1 * inv;
      }
    }
    __syncthreads();
  }
  if (tid < 32) P.cntt[item * 32 + tid] = sCnt[tid];
  __syncthreads();
}
DI void conv_tile(float* sT, const float* src, int K, int N, bf16* dst, int dld, int rmode, const float* scale, int koff, int tk, int tn) {
  const int tid = tidx();
  const int k0 = tk * 64, n0 = tn * 256;
  {
    const int n4 = (tid & 63) * 4, kk = tid >> 6;
    f32x4 v[8];
#pragma unroll
    for (int p = 0; p < 8; ++p) {
      v[p] = f32x4{0.f, 0.f, 0.f, 0.f};
      if (n0 + n4 < N) v[p] = *(const f32x4*)(src + (size_t)(k0 + kk + 8 * p) * N + n0 + n4);
    }
#pragma unroll
    for (int p = 0; p < 8; ++p) {
      const int k = k0 + kk + 8 * p;
      float s = 1.f;
      if (scale != nullptr && k >= koff) s = scale[k - koff];
#pragma unroll
      for (int e = 0; e < 4; ++e) sT[(kk + 8 * p) * 257 + n4 + e] = v[p][e] * s;
    }
  }
  __syncthreads();
  {
    const int kc = (tid & 7) * 8;
#pragma unroll
    for (int q = 0; q < 4; ++q) {
      const int n = (tid >> 3) + 64 * q;
      if (n0 + n < N) {
        float v8[8];
#pragma unroll
        for (int e = 0; e < 8; ++e) v8[e] = sT[(kc + e) * 257 + n];
        const int nn = n0 + n;
        const int row = rmode == 0 ? nn : (64 * (nn >> 5) + (nn & 31) + (rmode == 2 ? 32 : 0));
        *(bf16x8*)(dst + (size_t)row * dld + k0 + kc) = pack8(v8);
      }
    }
  }
  __syncthreads();
}

DI void conv_moe_tile(const Params& P, float* sT, int layer, int t) {
  const int e = t / 96, u = t % 96;
  if (u < 32) conv_tile(sT, P.moe_w_gate + ((size_t)(layer * 32 + e)) * 1024 * 512, 1024, 512, P.wgut + (size_t)e * 1024 * 1024, 1024, 1, nullptr, 0, u >> 1, u & 1);
  else if (u < 64) conv_tile(sT, P.moe_w_up + ((size_t)(layer * 32 + e)) * 1024 * 512, 1024, 512, P.wgut + (size_t)e * 1024 * 1024, 1024, 2, nullptr, 0, (u - 32) >> 1, (u - 32) & 1);
  else conv_tile(sT, P.moe_w_down + ((size_t)(layer * 32 + e)) * 512 * 1024, 512, 1024, P.wdt + (size_t)e * 1024 * 512, 512, 0, nullptr, 0, (u - 64) >> 2, (u - 64) & 3);
}
constexpr int NCONV_MOE = 32 * 96;

constexpr int NCONV_DENSE = 112 + 18 + 16 + 64 + 160 + 64 + 32;
DI void conv_dense_tile(const Params& P, float* sT, int t) {
  if (t < 112) { conv_tile(sT, P.ab_w_in, 1024, 1696, P.win0t, 1024, 0, nullptr, 0, t / 7, t % 7); return; }
  t -= 112;
  if (t < 18) { conv_tile(sT, P.mla_w_q_up, 384, 768, P.wqt, 384, 0, P.mla_q_norm_g, 0, t / 3, t % 3); return; }
  t -= 18;
  if (t < 16) { conv_tile(sT, P.mla_w_kv_up, 256, 1024, P.wkvt, 256, 0, P.mla_kv_norm_g, 0, t / 4, t % 4); return; }
  t -= 16;
  if (t < 64) { conv_tile(sT, P.ab_w_out, 1024, 1024, P.wout0t, 1024, 0, nullptr, 0, t / 4, t % 4); return; }
  t -= 64;
  if (t < 160) { conv_tile(sT, P.cd_w_in, 1024, 2320, P.win1t, 1024, 0, nullptr, 0, t / 10, t % 10); return; }
  t -= 160;
  if (t < 64) { conv_tile(sT, P.cd_w_out, 1024, 1024, P.wout1t, 1024, 0, P.ssd_norm_g, 512, t / 4, t % 4); return; }
  t -= 64;
  {
    const int blk = t & 7, gate = (t >> 3) & 1, dir = t >> 4;
    const float* src = (gate ? P.lru_w_x : P.lru_w_a) + ((size_t)(dir * 8 + blk)) * 4096;
    conv_tile(sT, src, 64, 64, P.wlrut + ((size_t)((dir * 2 + gate) * 8 + blk)) * 4096, 64, 0, nullptr, 0, 0, 0);
  }
}

DI void mods_item(const Params& P, float* sS, float* sR, int layer, int cb) {
  const int tid = tidx(), col = tid & 63, kq = tid >> 6;
  float a[5] = {0.f, 0.f, 0.f, 0.f, 0.f};
  const float* wp = P.ada_w + (size_t)layer * 1024 * 6144 + cb * 64 + col;
  for (int k0 = kq * 128; k0 < kq * 128 + 128; k0 += 16) {
    float wv[16];
#pragma unroll
    for (int u = 0; u < 16; ++u) wv[u] = wp[(size_t)(k0 + u) * 6144];
#pragma unroll
    for (int u = 0; u < 16; ++u)
#pragma unroll
      for (int v = 0; v < 5; ++v) a[v] += sS[v * 1024 + k0 + u] * wv[u];
  }
#pragma unroll
  for (int v = 0; v < 5; ++v) sR[(kq * 5 + v) * 64 + col] = a[v];
  __syncthreads();
  if (tid < 320) {
    const int v = tid >> 6;
    float s = P.ada_b[layer * 6144 + cb * 64 + col];
    for (int q = 0; q < 8; ++q) s += sR[(q * 5 + v) * 64 + col];
    P.mods[((size_t)(layer * 5 + v)) * 6144 + cb * 64 + col] = s;
  }
  __syncthreads();
}

enum { PH_PREP, PH_NORM1_0, PH_C1, PH_QKV, PH_ATTN0, PH_OUT0, PH_NORM2_0, PH_SCAT0, PH_MOE1_0, PH_MOE2_0, PH_COMB0, PH_C2, PH_SSDPREP, PH_SSDA, PH_SSDB, PH_SSDC, PH_OUT1, PH_NORM2_1, PH_SCAT1, PH_MOE1_1, PH_MOE2_1, PH_FINAL, NPHASE };
constexpr int GEMM_LDS = (256 + 256) * 2 * 72 * 2;

DI void run_phase(const Params& P, int ph, unsigned char* lds, int bid, int nblk) {
  bf16* smem = (bf16*)lds;
  float* fsm = (float*)lds;
  int* ism = (int*)lds;
  const int tid = tidx(), wid = tid >> 6;
  const int gw = bid * 8 + wid, ngw = nblk * 8;
  const int nrep = 1 + ((P.pad0 >> ph) & 1);
#define REP for (int rep_ = 0; rep_ < nrep; ++rep_)
#define REPB(bit) for (int rep_ = 0, nr_ = 1 + ((P.pad0 >> (bit)) & 1); rep_ < nr_; ++rep_)
  switch (ph) {
    case PH_PREP: {
      if (bid == 0) {
        for (int i = tid; i < 128 * 8; i += 512) {
          const int p = i >> 3, f = i & 7;
          float rev = (float)p * __builtin_amdgcn_exp2f(-(float)f * (13.287712379549449f / 8.f)) * 0.15915494309189535f;
          rev -= floorf(rev);
          P.ropeM[i * 2] = __builtin_amdgcn_cosf(rev); P.ropeM[i * 2 + 1] = __builtin_amdgcn_sinf(rev);
        }
        for (int i = tid; i < 128 * 16; i += 512) {
          const int p = i >> 4, f = i & 15;
          float rev = (float)p * __builtin_amdgcn_exp2f(-(float)f * (13.287712379549449f / 16.f)) * 0.15915494309189535f;
          rev -= floorf(rev);
          P.ropeS[i * 2] = __builtin_amdgcn_cosf(rev); P.ropeS[i * 2 + 1] = __builtin_amdgcn_sinf(rev);
        }
        if (tid == 0) {
          float gq = 0.f, gk = 0.f, sq = 0.f, sk = 0.f, sm = 0.f;
          for (int i = 0; i < 96; ++i) { gq = fmaxf(gq, fabsf(P.mla_q_head_g[i])); gk = fmaxf(gk, fabsf(P.mla_k_head_g[i])); }
          for (int i = 0; i < 64; ++i) { sq = fmaxf(sq, fabsf(P.swa_q_head_g[i])); sk = fmaxf(sk, fabsf(P.swa_k_head_g[i])); }
          for (int i = 0; i < 8; ++i) sm = fmaxf(sm, P.swa_sink[i]);
          P.msh[0] = 9.797958971132712f * gq * gk * LOG2E;
          P.msh[1] = fmaxf(8.f * sq * sk, sm) * LOG2E;
        }
      }
      for (int i = tid; i < 5 * 1024; i += 512) {
        const float v = i < 4096 ? P.c[i] : P.c_ctx[i - 4096];
        fsm[i] = siluf_(v);
      }
      __syncthreads();
      REPB(30) for (int it = bid; it < 2 * 96; it += nblk) mods_item(P, fsm, fsm + 5120, it / 96, it % 96);
      __syncthreads();
      REP {
        const int ctot = NCONV_DENSE + NCONV_MOE;
        const bool skew = nblk == 256;
        const int c0 = skew ? (bid >= 192 ? bid - 192 : 1024 + bid) : bid, cs = skew ? (bid >= 192 ? 64 : 192) : nblk, c1 = skew && bid >= 192 ? 1024 : ctot;
        for (int it = c0; it < c1; it += cs) {
          if (it < NCONV_DENSE) conv_dense_tile(P, fsm, it); else conv_moe_tile(P, fsm, 0, it - NCONV_DENSE);
        }
      }
    } break;
    case PH_NORM1_0: {
      REP { const RouteRec none[2] = {{0, 0, 0, 0, 0.f, 0.f}, {0, 0, 0, 0, 0.f, 0.f}}; for (int tok = 2 * gw; tok < NT; tok += 2 * ngw) row_pass2(P, 0, 0, tok, NT, nullptr, none); }
    } break;
    case PH_C1: {
      REP for (int it = bid; it < 7 * 132; it += nblk) gemm_c1_item(P, smem, it % 7, it / 7);
    } break;
    case PH_QKV: {
      REP for (int it = bid; it < 264 * 8; it += nblk) {
        const int qt = it >> 3, u = it & 7;
        if (u < 4) gemm_q_item(P, smem, u, qt); else gemm_kv_item(P, smem, u - 4, qt);
      }
      __syncthreads();
      for (int i = tid; i < 2560; i += 512) fsm[3072 + i] = i < 2048 ? P.lru_conv_w[i] : P.lru_conv_b[i - 2048];
      for (int i = tid; i < 3072; i += 512) { const int d = i / 1536, u = i % 1536, k = u >> 9, ch = u & 511; fsm[i] = k == 0 ? P.lru_b_a[d * 512 + ch] : (k == 1 ? P.lru_b_x[d * 512 + ch] : 8.f * softplusf_(-P.lru_lambda[d * 512 + ch])); }
      __syncthreads();
      REPB(26) for (int it = bid; it < NB * 8 * 8; it += nblk) lru_block_item(P, fsm, it >> 6, (it >> 3) & 7, 1 + (it & 7), 0);
    } break;
    case PH_ATTN0: {
      for (int i = tid; i < 2560; i += 512) fsm[3072 + i] = i < 2048 ? P.lru_conv_w[i] : P.lru_conv_b[i - 2048];
      for (int i = tid; i < 3072; i += 512) { const int d = i / 1536, u = i % 1536, k = u >> 9, ch = u & 511; fsm[i] = k == 0 ? P.lru_b_a[d * 512 + ch] : (k == 1 ? P.lru_b_x[d * 512 + ch] : 8.f * softplusf_(-P.lru_lambda[d * 512 + ch])); }
      __syncthreads();
      REPB(27) for (int it = bid; it < NB * 8 * 8; it += nblk) lru_block_item(P, fsm, it >> 6, (it >> 3) & 7, 1 + (it & 7), 1);
      __syncthreads();
      const float negM = -P.msh[0];
      REP {
#ifdef ATTNVAR
        for (int u = bid; u < 512; u += nblk) {
          const int qb = u & 15, hd = (u >> 4) & 7, b = u >> 7;
          const size_t hb = (size_t)(b * 8 + hd) * NPOS;
          attn_item<96, false, false, ATTNVAR>(smem, P.qkv + QB_OFF + hb * 96, P.qkv + KB_OFF + hb * 96, P.qkv + VT_OFF + hb * 64, LC + qb * 512, 512, 132, 132, 0, 0, negM, 0.f,
                               P.ycat + (size_t)(b * SEQ + qb * 512) * 1024 + hd * 64);
        }
        __syncthreads();
#endif
        for (int u = bid; u < 512; u += nblk) {
          const int qb = u & 15, hd = (u >> 4) & 7, b = u >> 7;
          const size_t hb = (size_t)(b * 8 + hd) * NPOS;
          attn_item<96, false>(smem, P.qkv + QB_OFF + hb * 96, P.qkv + KB_OFF + hb * 96, P.qkv + VT_OFF + hb * 64, LC + qb * 512, 512, 132, 132, 0, 0, negM, 0.f,
                               P.ycat + (size_t)(b * SEQ + qb * 512) * 1024 + hd * 64);
        }
        for (int it = nblk - 1 - bid; it < 32; it += nblk) {
          const int b = it >> 3, hd = it & 7;
          const size_t hb = (size_t)(b * 8 + hd) * NPOS;
          attn_item<96, false>(smem, P.qkv + QB_OFF + hb * 96, P.qkv + KB_OFF + hb * 96, P.qkv + VT_OFF + hb * 64, 0, 256, 4, 4, 0, 0, negM, 0.f,
                               P.ycat + (size_t)(NL + b * LC) * 1024 + hd * 64);
        }
      }
    } break;
    case PH_OUT0: {
      REP for (int it = bid; it < 512 + 32; it += nblk) { if (it < 512) gemm_out_item<4>(P, smem, 0, it & 3, it >> 2); else gemm_out_item<2>(P, smem, 0, (it - 512) & 7, 128 + ((it - 512) >> 3)); }
    } break;
    case PH_NORM2_0: case PH_NORM2_1: {
      const int layer = ph == PH_NORM2_0 ? 0 : 1;
      const int ntok = layer == 0 ? NT : NL;
      const int T = (ntok + nblk - 1) / nblk;
      __syncthreads();
      { const int lo_ = bid * T, hi_ = lo_ + T < ntok ? lo_ + T : ntok; route_tokens(P, layer, fsm, bid, lo_ < ntok ? lo_ : ntok, hi_ > lo_ ? hi_ : lo_); }
      if (layer == 1) {
        __syncthreads();
        for (int it = bid; it < NCONV_MOE; it += nblk) conv_moe_tile(P, fsm, 1, it);
      }
    } break;
    case PH_SCAT0: case PH_SCAT1: {
      const int layer = ph == PH_SCAT0 ? 0 : 1;
      const int ntok = layer == 0 ? NT : NL;
      const int T = (ntok + nblk - 1) / nblk;
      const int nit = nblk;
      __syncthreads();
      for (int i = tid; i < nit * 32; i += 512) ism[i] = P.cntt[i];
      __syncthreads();
      if (tid < 32) {
        int run = 0;
        for (int i = 0; i < nit; ++i) { const int c = ism[i * 32 + tid]; ism[i * 32 + tid] = run; run += c; }
        if (bid == 0) P.cnt[layer * 32 + tid] = run;
      }
      __syncthreads();
      {
        const int lo_ = bid * T, hi_ = lo_ + T < ntok ? lo_ + T : ntok;
        for (int tok = lo_ + tid; tok < hi_; tok += 512) {
          int* ti = P.tokinfo + (size_t)tok * 4;
          const int e0 = ti[0], e1 = ti[2];
          const int p0 = ism[bid * 32 + e0] + ti[1], p1 = ism[bid * 32 + e1] + ti[3];
          ti[1] = p0; ti[3] = p1;
          P.list[(size_t)e0 * NT + p0] = tok;
          P.list[(size_t)e1 * NT + p1] = tok;
        }
      }
    } break;
    case PH_MOE1_0: case PH_MOE2_0: case PH_MOE1_1: case PH_MOE2_1: {
      const int layer = ph >= PH_MOE1_1 ? 1 : 0;
      const bool second = (ph == PH_MOE2_0 || ph == PH_MOE2_1);
      __syncthreads();
      if (tid == 0) {
        int off = 0, toff = 0;
        for (int e = 0; e < 32; ++e) { const int c = P.cnt[layer * 32 + e]; ism[e] = c; ism[32 + e] = off; ism[65 + e] = toff; off += c; toff += (c + 255) >> 8; }
        ism[64] = off; ism[97] = toff;
      }
      __syncthreads();
      const int ntile = ism[97], total = ism[64];
      const int nitems = ntile * 4, nfull = (nitems / nblk) * nblk, rem = nitems - nfull;
      bf16* gsm = smem + 256;
      REP {
        for (int it = bid; it < nfull; it += nblk) {
          const int mtg = it >> 2, pt = it & 3;
          int e = 0;
          while (e < 31 && ism[65 + e + 1] <= mtg) ++e;
          const int m0 = (mtg - ism[65 + e]) * 256, cnt_e = ism[e], off_e = ism[32 + e];
          if (!second) moe1_item(P, gsm, layer, e, m0, pt, cnt_e, off_e); else moe2_item(P, gsm, e, m0, pt, cnt_e, off_e, total);
        }
        for (int ht = bid; ht < 2 * rem; ht += nblk) {
          const int it = nfull + (ht >> 1), mtg = it >> 2, pt2 = (it & 3) * 2 + (ht & 1);
          int e = 0;
          while (e < 31 && ism[65 + e + 1] <= mtg) ++e;
          const int m0 = (mtg - ism[65 + e]) * 256, cnt_e = ism[e], off_e = ism[32 + e];
          if (!second) moe1_half(P, gsm, layer, e, m0, pt2, cnt_e, off_e); else moe2_half(P, gsm, e, m0, pt2, cnt_e, off_e, total);
        }
      }
    } break;
    case PH_COMB0: case PH_FINAL: {
      const int layer = ph == PH_COMB0 ? 0 : 1;
      __syncthreads();
      if (tid == 0) { int off = 0; for (int e = 0; e < 32; ++e) { ism[e] = off; off += P.cnt[layer * 32 + e]; } }
      __syncthreads();
      const int ntok = layer == 0 ? NT : NL;
      {
        int tok = 2 * gw;
        RouteRec nxt[2];
        if (tok < ntok) { nxt[0] = route_rec(P, tok); nxt[1] = route_rec(P, tok + 1 < ntok ? tok + 1 : tok); }
        for (; tok < ntok; tok += 2 * ngw) {
          const RouteRec cur[2] = {nxt[0], nxt[1]};
          const int nt = tok + 2 * ngw;
          if (nt < ntok) { nxt[0] = route_rec(P, nt); nxt[1] = route_rec(P, nt + 1 < ntok ? nt + 1 : nt); }
          row_pass2(P, layer == 0 ? 1 : 2, 1, tok, ntok, ism, cur);
        }
      }
    } break;
    case PH_C2: {
      REP for (int it = bid; it < 10 * 132; it += nblk) { if (it < 9 * 132) gemm_c2_item(P, smem, it % 9, it / 9); else gemm_c2dt_item(P, smem, it - 9 * 132); }
    } break;
    case PH_SSDPREP: {
      REPB(28) for (int it = bid + nblk * wid; it < NB * NCH; it += nblk * 8) ssd_cumsum_item(P, it);
      REPB(29) for (int it = bid; it < NB * NCH * 4; it += nblk) ssd_conv_item(P, smem, it >> 2, it & 3);
      __syncthreads();
      const float negM = -P.msh[1];
      REP for (int it = bid; it < 512; it += nblk) {
        const int qb = it & 63, kvh = (it >> 6) & 1, b = it >> 7;
        const size_t hb = (size_t)(b * 8 + kvh * 4) * NPOS, kb = (size_t)(b * 2 + kvh) * NPOS;
        const int q0 = qb * 128;
        const int k0 = q0 - 128 < 0 ? 0 : q0 - 128;
        const int k1 = q0 + 256 > SEQ ? SEQ : q0 + 256;
        attn_item<64, true, true>(smem, P.qkv + Q2_OFF + hb * 64, P.qkv + K2_OFF + kb * 64, P.qkv + V2T_OFF + kb * 64, LC + q0, 128, 4 + (k1 - k0) / 64, 4, k0, q0,
                                  negM, 0.f, P.ycat + (size_t)(b * SEQ + q0) * 1024 + kvh * 256, P.swa_sink + kvh * 4);
      }
    } break;
    case PH_SSDA: {
      REP {
        for (int it = bid; it < NB * 64 * 2; it += nblk) ssd_passA_block(P, smem, (it >> 7) * NCH + 2 + ((it >> 1) & 63), it & 1);
        for (int it = bid + nblk * wid; it < NB * 2 * 32; it += nblk * 8) {
          const int pt = it & 1, dir = (it >> 1) & 1, hd = (it >> 2) & 7, c = (it >> 5) & 1, bi = it >> 6;
          ssd_passA_item(P, bi * NCH + c, hd, dir, pt);
        }
      }
    } break;
    case PH_SSDB: ssd_passB(P, bid, nblk); break;
    case PH_SSDC: {
      REP for (int it = bid; it < NB * 64 * 2; it += nblk) ssd_passC_item(P, smem, it >> 7, 2 + ((it >> 1) & 63), it & 1);
    } break;
    case PH_OUT1: {
      for (int it = bid; it < 512; it += nblk) gemm_out_item<4>(P, smem, 1, it & 3, it >> 2);
    } break;
    default: break;
  }
}
#define XB_TMO      128
#define XB_XCNT(j)  (256  + 64 * (j))
#define XB_XSUB(j)  (1280 + 64 * (j))
#define XB_XGEN(j)  (2304 + 64 * (j))
#define XB_TOP      3328
#define XB_TOPGEN   3392
#define XCD_BAR_WORDS 3456
#define XB_SPIN_CAP (1u << 22)
#define LAS __attribute__((address_space(3)))
DI unsigned xb_ld(unsigned* p) { return __hip_atomic_load(p, __ATOMIC_RELAXED, __HIP_MEMORY_SCOPE_AGENT); }
DI unsigned xb_add(unsigned* p, unsigned v) { return __hip_atomic_fetch_add(p, v, __ATOMIC_RELAXED, __HIP_MEMORY_SCOPE_AGENT); }
DI unsigned xb_xcc_id() { return (unsigned)__builtin_amdgcn_s_getreg((3 << 11) | 20) & 0xFu; }
#define XB_SPIN(cond, bar) do { unsigned _sp = 0; while (cond) { __builtin_amdgcn_s_sleep(1); \
    if ((++_sp & 255u) == 0u) { if (xb_ld(&(bar)[XB_TMO])) break; if (_sp > XB_SPIN_CAP) { atomicAdd(&(bar)[XB_TMO], 1u); break; } } } } while (0)
struct XcdBarrier { unsigned* bar; unsigned x; volatile LAS unsigned* st; };
DI XcdBarrier xcd_barrier_post(unsigned* bar, volatile LAS unsigned* st) {
  XcdBarrier b; b.bar = bar; b.x = xb_xcc_id(); b.st = st;
  if (tidx() == 0) (void)xb_add(&bar[XB_XCNT(b.x)], 1u);
  return b;
}
DI void xcd_barrier_complete(unsigned* bar, unsigned x, unsigned& nloc, unsigned& nx) {
  const unsigned G = gridDim.x * gridDim.y * gridDim.z;
  unsigned sum, cnt, mine, sp = 0u;
  for (;;) {
    sum = 0u; cnt = 0u; mine = 0u;
#pragma unroll
    for (unsigned j = 0; j < 16; ++j) { const unsigned c = xb_ld(&bar[XB_XCNT(j)]); sum += c; cnt += (c > 0u) ? 1u : 0u; mine = (j == x) ? c : mine; }
    if (sum == G) break;
    __builtin_amdgcn_s_sleep(1);
    if ((++sp & 255u) == 0u) { if (xb_ld(&bar[XB_TMO])) break; if (sp > XB_SPIN_CAP) { atomicAdd(&bar[XB_TMO], 1u); break; } }
  }
  nloc = mine > 0u ? mine : 1u; nx = cnt > 0u ? cnt : 1u;
}
DI void xcd_barrier(const XcdBarrier& b) {
  asm volatile("s_waitcnt vmcnt(0)" ::: "memory");
  __syncthreads();
  if (tidx() == 0) {
    unsigned* bar = b.bar;
    __builtin_amdgcn_s_waitcnt(0);
    unsigned nloc = b.st[0], nx = b.st[1];
    if (nloc == 0u) { xcd_barrier_complete(bar, b.x, nloc, nx); b.st[0] = nloc; b.st[1] = nx; }
    const unsigned old = xb_add(&bar[XB_XSUB(b.x)], 1u);
    const unsigned gen = old / nloc;
    if (old + 1u == (gen + 1u) * nloc) {
      __builtin_amdgcn_fence(__ATOMIC_RELEASE, "agent");
      asm volatile("s_waitcnt vmcnt(0)" ::: "memory");
      const unsigned og = xb_add(&bar[XB_TOP], 1u);
      const unsigned tg = og / nx;
      if (og + 1u == (tg + 1u) * nx) xb_add(&bar[XB_TOPGEN], 1u);
      else XB_SPIN(xb_ld(&bar[XB_TOPGEN]) == tg, bar);
      __builtin_amdgcn_fence(__ATOMIC_ACQUIRE, "agent");
      xb_add(&bar[XB_XGEN(b.x)], 1u);
      asm volatile("s_waitcnt vmcnt(0)" ::: "memory");
    } else {
      XB_SPIN(xb_ld(&bar[XB_XGEN(b.x)]) == gen, bar);
      __builtin_amdgcn_fence(__ATOMIC_ACQUIRE, "agent");
      asm volatile("s_waitcnt vmcnt(0)" ::: "memory");
    }
  }
  __syncthreads();
}

#ifndef PROBE_K
#define PROBE_K 8
#endif
#ifndef REPMASK
#define REPMASK 0
#endif
#ifndef ONE_LAUNCH
#define ONE_LAUNCH 1
#endif
constexpr int LDS_BYTES = GEMM_LDS + 1024;

#if ONE_LAUNCH
#define BAR_ARG , const XcdBarrier& xb
#define BAR_PASS , xb
#else
#define BAR_ARG
#define BAR_PASS
#endif
template <int PH>
DI void phase_step(unsigned char* lds, int ph_lo, int ph_hi BAR_ARG) {
  if (PH >= ph_lo && PH < ph_hi) {
    const __attribute__((address_space(4))) Params* kp = (const __attribute__((address_space(4))) Params*)__builtin_amdgcn_kernarg_segment_ptr();
    asm volatile("" : "+s"(kp));
    run_phase(*(const Params*)kp, PH, lds, blockIdx.x, gridDim.x);
#if ONE_LAUNCH
    if (PROBE_PH >= 0 && PH + 1 == ph_hi) { asm volatile("s_waitcnt vmcnt(0)" ::: "memory"); __syncthreads(); }
    if (PROBE_PH >= 0 && tidx() == 0 && blockIdx.x == 0 && PH + 1 == ph_hi) ((volatile unsigned long long*)(lds + GEMM_LDS + 528))[PH + 1] = __builtin_amdgcn_s_memrealtime();
    if (PH + 1 < ph_hi) {
      if (PH == 0) cg::this_grid().sync(); else xcd_barrier(xb);
      if ((REPMASK >> 25) & 1) xcd_barrier(xb);
      if (PROBE_PH >= 0 && tidx() == 0 && blockIdx.x == 0) ((volatile unsigned long long*)(lds + GEMM_LDS + 528))[PH + 1] = __builtin_amdgcn_s_memrealtime();
    }
#endif
  }
}

__global__ void __launch_bounds__(512, 2) mega(Params P, int ph_lo, int ph_hi) {
  extern __shared__ __attribute__((aligned(16))) unsigned char lds[];
#if ONE_LAUNCH
  volatile LAS unsigned* st = (volatile LAS unsigned*)(lds + GEMM_LDS + 512);
  if (tidx() < 2) st[tidx()] = 0u;
  __syncthreads();
  XcdBarrier xb = xcd_barrier_post(P.bar, st);
  if (PROBE_PH == -2 && tidx() == 0) *(volatile unsigned long long*)(lds + PROBE_LDS_OFF) = 0ull;
#endif
#if ONE_LAUNCH
  if (PROBE_PH >= 0 && tidx() == 0 && blockIdx.x == 0) ((volatile unsigned long long*)(lds + GEMM_LDS + 528))[0] = __builtin_amdgcn_s_memrealtime();
#endif
#define STEP(N) phase_step<N>(lds, ph_lo, ph_hi BAR_PASS);
  STEP(0) STEP(1) STEP(2) STEP(3) STEP(4) STEP(5) STEP(6) STEP(7) STEP(8) STEP(9)
  STEP(10) STEP(11) STEP(12) STEP(13) STEP(14) STEP(15) STEP(16) STEP(17) STEP(18) STEP(19) STEP(20) STEP(21)
#undef STEP
#if ONE_LAUNCH
  if (PROBE_PH == -2 && tidx() == 0 && blockIdx.x == 0) {
    const unsigned long long dur = *(volatile unsigned long long*)(lds + PROBE_LDS_OFF);
    const unsigned long long until = __builtin_amdgcn_s_memrealtime() + (unsigned long long)PROBE_K * dur;
    while (__builtin_amdgcn_s_memrealtime() < until) __builtin_amdgcn_s_sleep(32);
  }
  if (PROBE_PH >= 0 && tidx() == 0 && blockIdx.x == 0) {
    volatile unsigned long long* ts = (volatile unsigned long long*)(lds + GEMM_LDS + 528);
    const unsigned long long dur = ts[PROBE_PH + 1] - ts[PROBE_PH];
    const unsigned long long until = ts[NPHASE] + (unsigned long long)PROBE_K * dur;
    while (__builtin_amdgcn_s_memrealtime() < until) __builtin_amdgcn_s_sleep(32);
  }
#endif
}

static size_t carve(size_t& off, size_t bytes) { size_t o = off; off = (off + bytes + 255) & ~(size_t)255; return o; }

extern "C" void kernel_launch(void* const* d_in, const int* in_sizes, int n_in, void* d_out, int out_size, void* d_ws, size_t ws_size, hipStream_t stream) {
  static int grid = 0;
  if (grid == 0) {
    int dev = 0, cus = 0, per_cu = 0;
    hipGetDevice(&dev);
    hipDeviceGetAttribute(&cus, hipDeviceAttributeMultiprocessorCount, dev);
    if (hipFuncSetAttribute((const void*)mega, hipFuncAttributeMaxDynamicSharedMemorySize, LDS_BYTES) != hipSuccess) { fprintf(stderr, "kernel_launch: hipFuncSetAttribute failed\n"); }
    hipOccupancyMaxActiveBlocksPerMultiprocessor(&per_cu, (const void*)mega, 512, LDS_BYTES);
    if (per_cu < 1) { fprintf(stderr, "kernel_launch: occupancy query says %d blocks per CU\n", per_cu); per_cu = 1; }
    (void)hipGetLastError();
    grid = cus;
  }
  Params P;
  memset(&P, 0, sizeof(P));
  P.pad0 = REPMASK;
  const float** in = (const float**)&P;
  for (int i = 0; i < 39 && i < n_in; ++i) in[i] = (const float*)d_in[i];
  P.out = (float*)d_out;
  char* ws = (char*)d_ws;
  size_t off = 0;
  P.bar = (unsigned*)(ws + carve(off, XCD_BAR_WORDS * 4));
  P.mods = (float*)(ws + carve(off, 2 * 5 * 6144 * 4));
  P.ropeM = (float*)(ws + carve(off, 128 * 8 * 2 * 4));
  P.ropeS = (float*)(ws + carve(off, 128 * 16 * 2 * 4));
  P.msh = (float*)(ws + carve(off, 64));
  P.win0t = (bf16*)(ws + carve(off, (size_t)1792 * 1024 * 2));
  P.wqt = (bf16*)(ws + carve(off, (size_t)768 * 384 * 2));
  P.wkvt = (bf16*)(ws + carve(off, (size_t)1024 * 256 * 2));
  P.wout0t = (bf16*)(ws + carve(off, (size_t)1024 * 1024 * 2));
  P.win1t = (bf16*)(ws + carve(off, (size_t)2432 * 1024 * 2));
  P.wout1t = (bf16*)(ws + carve(off, (size_t)1024 * 1024 * 2));
  P.wlrut = (bf16*)(ws + carve(off, (size_t)32 * 4096 * 2));
  P.wgut = (bf16*)(ws + carve(off, (size_t)32 * 1024 * 1024 * 2));
  P.wdt = (bf16*)(ws + carve(off, (size_t)32 * 1024 * 512 * 2));
  P.wrt = (bf16*)(ws + carve(off, (size_t)64 * 3072 * 2));
  P.ut = P.wgut;
  P.xc = (float*)(ws + carve(off, (size_t)NC * 1024 * 4));
  P.h = (bf16*)(ws + carve(off, (size_t)NT * 1024 * 2));
  P.cbuf = (bf16*)(ws + carve(off, (size_t)NT * C2LD * 2));
  P.qkv = (bf16*)(ws + carve(off, QKV_ELEMS * 2));
  P.ycat = (bf16*)(ws + carve(off, (size_t)NT * 1024 * 2));
  P.ssqc = (float*)(ws + carve(off, (size_t)NT * 16 * 4));
  P.ssqx = (float*)(ws + carve(off, (size_t)NT * 16 * 4));
  P.ssq2 = (float*)(ws + carve(off, (size_t)NT * 8 * 4));
  P.comp = (float*)(ws + carve(off, (size_t)NB * 2 * LCH * 512 * 2 * 4));
  P.gcomp = (float*)(ws + carve(off, (size_t)NB * 2 * LGR * 512 * 2 * 4));
  P.dtr = (float*)(ws + carve(off, (size_t)NT * 16 * 4));
  P.cst = (float*)(ws + carve(off, (size_t)NB * 16 * NPOS * 4));
  P.dtt = (float*)(ws + carve(off, (size_t)NB * 16 * NPOS * 4));
  P.wgp = (float*)(ws + carve(off, (size_t)NB * 16 * NPOS * 4));
  P.cnt = (int*)(ws + carve(off, 64 * 4));
  P.cntt = (int*)(ws + carve(off, (size_t)2048 * 32 * 4));
  P.tokinfo = (int*)(ws + carve(off, (size_t)NT * 4 * 4));
  P.tokw = (float*)(ws + carve(off, (size_t)NT * 2 * 4));
  P.list = (int*)(ws + carve(off, (size_t)32 * NT * 4));
  if (off > ws_size || n_in != 39 || out_size != NL * 1024) {
    fprintf(stderr, "kernel_launch: needs %zu bytes of workspace (got %zu), 39 inputs (got %d), out %d (got %d); nothing launched\n", off, ws_size, n_in, NL * 1024, out_size);
    return;
  }
#if ONE_LAUNCH
  hipMemsetAsync(P.bar, 0, XCD_BAR_WORDS * 4, stream);
  int lo = 0, hi = NPHASE;
  void* args[] = {&P, &lo, &hi};
  hipError_t e = hipLaunchCooperativeKernel((const void*)mega, dim3(grid), dim3(512), args, LDS_BYTES, stream);
  if (e != hipSuccess) fprintf(stderr, "kernel_launch: cooperative launch failed: %s (grid %d)\n", hipGetErrorString(e), grid);
#else
  for (int ph = 0; ph < NPHASE; ++ph) hipLaunchKernelGGL(mega, dim3(grid), dim3(512), LDS_BYTES, stream, P, ph, ph + 1);
#endif
}
```
